# Optimizing an MI355X kernel written in HIP

```python
import math
import jax, jax.numpy as jnp
from jax import lax
import numpy as np

D_MODEL = 1024
BATCH = 1
SEQ = 16384
DEPTH = 1

PLE_DIM = 256
D_MIX = D_MODEL
DA_HEADS = 4
DA_HEAD_DIM = 64
DA_WIDTH = DA_HEADS * 2 * DA_HEAD_DIM
Q_BLOCK = 128
ML_HEADS = 4
ML_WIDTH = D_MIX - DA_WIDTH
ML_HEAD_DIM = ML_WIDTH // ML_HEADS
ML_CHUNK = 64
CONV_WIDTH = 4
IN_WIDTHS = [DA_WIDTH, DA_WIDTH, DA_WIDTH,
             ML_WIDTH, ML_WIDTH, ML_WIDTH, ML_WIDTH,
             ML_HEADS, ML_HEADS]
N_IN = sum(IN_WIDTHS)
IN_SPLITS = [int(s) for s in np.cumsum(IN_WIDTHS)[:-1]]
N_KEYS = 128
N_EXPERTS = N_KEYS * N_KEYS
PEER_HEADS = 8
PEER_TOPK = 16
PEER_QUERY_DIM = 256
PEER_HALF_DIM = PEER_QUERY_DIM // 2
PEER_BLOCK = 128
NORM_EPS = 1e-6

kernel_name = "hymba_diffattn_mlstm_peer_block"


def rms_norm(x, g):
    xf = x.astype(jnp.float32)
    y = xf * lax.rsqrt(jnp.mean(xf * xf, axis=-1, keepdims=True) + NORM_EPS)
    return (y * g.astype(jnp.float32)).astype(x.dtype)


def alibi_slopes(n):
    def pow2_slopes(m):
        start = 2.0 ** (-8.0 / m)
        return [start ** (i + 1) for i in range(m)]
    if math.log2(n).is_integer():
        s = pow2_slopes(n)
    else:
        c = 2 ** math.floor(math.log2(n))
        s = pow2_slopes(c) + pow2_slopes(2 * c)[0::2][: n - c]
    return jnp.asarray(np.array(s, dtype=np.float32))


def causal_dwconv(x, w, b):
    c = x.shape[-1]
    y = lax.conv_general_dilated(x, w[:, None, :].astype(x.dtype), window_strides=(1,),
                                 padding=[(CONV_WIDTH - 1, 0)],
                                 dimension_numbers=('NWC', 'WIO', 'NWC'),
                                 feature_group_count=c)
    return y + b.astype(x.dtype)


def diff_attention(q, k, v, lam, subln_g, lambda_init):
    B, S = q.shape[0], q.shape[1]
    nb = S // Q_BLOCK
    scale = DA_HEAD_DIM ** -0.5
    slopes = alibi_slopes(DA_HEADS)
    kpos = jnp.arange(S)
    qb = q.reshape(B, nb, Q_BLOCK, DA_HEADS, 2, DA_HEAD_DIM).transpose(1, 0, 2, 3, 4, 5)

    def block(args):
        qblk, bi = args
        qpos = bi * Q_BLOCK + jnp.arange(Q_BLOCK)
        s = jnp.einsum('bqhcd,bkhcd->bhcqk', qblk, k,
                       preferred_element_type=jnp.float32) * scale
        dist = (qpos[:, None] - kpos[None, :]).astype(jnp.float32)
        bias = -slopes[:, None, None, None] * dist
        s = jnp.where(dist >= 0, s + bias, -jnp.inf)
        pr = jax.nn.softmax(s, axis=-1)
        w = pr[:, :, 0] - lam * pr[:, :, 1]
        return jnp.einsum('bhqk,bkhd->bqhd', w.astype(v.dtype), v)

    o = lax.map(block, (qb, jnp.arange(nb)))
    o = o.transpose(1, 0, 2, 3, 4).reshape(B, S, DA_HEADS, 2 * DA_HEAD_DIM)
    o = rms_norm(o, subln_g) * (1.0 - lambda_init)
    return o.reshape(B, S, DA_WIDTH)


def mlstm_chunkwise(q, k, v, i_pre, f_pre):
    B, S, H, d = q.shape
    L = ML_CHUNK
    nc = S // L
    f32 = jnp.float32

    def chunks(a):
        return a.astype(f32).reshape(B, nc, L, H, d).transpose(1, 0, 3, 2, 4)

    def gchunks(a):
        return a.astype(f32).reshape(B, nc, L, H).transpose(1, 0, 3, 2)

    qc_all = chunks(q) * (d ** -0.5)
    kc_all, vc_all = chunks(k), chunks(v)
    logf_all = gchunks(jax.nn.log_sigmoid(f_pre.astype(f32)))
    ig_all = gchunks(i_pre)
    causal = jnp.tril(jnp.ones((L, L), dtype=bool))

    def step(carry, xs):
        C, n, m = carry
        qc, kc, vc, lf, ig = xs
        b = jnp.cumsum(lf, axis=-1)
        D = jnp.where(causal, b[..., :, None] - b[..., None, :] + ig[..., None, :], -jnp.inf)
        inter = b + m[..., None]
        m_t = jnp.maximum(inter, jnp.max(D, axis=-1))
        Dw = jnp.exp(D - m_t[..., None])
        a_inter = jnp.exp(inter - m_t)
        sqk = jnp.einsum('bhld,bhsd->bhls', qc, kc) * Dw
        num = a_inter[..., None] * jnp.einsum('bhld,bhde->bhle', qc, C) + \
            jnp.einsum('bhls,bhse->bhle', sqk, vc)
        den = a_inter * jnp.einsum('bhld,bhd->bhl', qc, n) + jnp.sum(sqk, axis=-1)
        h = num / jnp.maximum(jnp.abs(den), jnp.exp(-m_t))[..., None]
        bL = b[..., -1]
        g = bL[..., None] - b + ig
        m_new = jnp.maximum(bL + m, jnp.max(g, axis=-1))
        decay = jnp.exp(bL + m - m_new)
        w = jnp.exp(g - m_new[..., None])
        C_new = decay[..., None, None] * C + jnp.einsum('bhsd,bhse->bhde', kc * w[..., None], vc)
        n_new = decay[..., None] * n + jnp.einsum('bhs,bhsd->bhd', w, kc)
        return (C_new, n_new, m_new), h

    init = (jnp.zeros((B, H, d, d), f32), jnp.zeros((B, H, d), f32), jnp.zeros((B, H), f32))
    _, hs = lax.scan(step, init, (qc_all, kc_all, vc_all, logf_all, ig_all))
    return hs.transpose(1, 0, 3, 2, 4).reshape(B, S, H, d)


def peer_ffn(x, w_query, sub_keys, expert_u, expert_v):
    B, S, D = x.shape
    T = B * S
    nb = T // PEER_BLOCK
    xt = x.reshape(nb, PEER_BLOCK, D)

    def block(xb):
        q = (xb @ w_query).reshape(PEER_BLOCK, PEER_HEADS, 2, PEER_HALF_DIM)
        s = jnp.einsum('thcd,hcnd->thcn', q, sub_keys,
                       preferred_element_type=jnp.float32)
        sv, si = lax.top_k(s, PEER_TOPK)
        cand = (sv[:, :, 0, :, None] + sv[:, :, 1, None, :]).reshape(PEER_BLOCK, PEER_HEADS, -1)
        cidx = (si[:, :, 0, :, None] * N_KEYS + si[:, :, 1, None, :]).reshape(PEER_BLOCK, PEER_HEADS, -1)
        top_s, pos = lax.top_k(cand, PEER_TOPK)
        eidx = jnp.take_along_axis(cidx, pos, axis=-1)
        g = jax.nn.softmax(top_s, axis=-1)
        u = expert_u[eidx]
        a = jax.nn.gelu(jnp.einsum('td,thkd->thk', xb, u), approximate=False)
        vv = expert_v[eidx]
        return jnp.einsum('thk,thkd->td', (g * a).astype(x.dtype), vv)

    return lax.map(block, xt).reshape(B, S, D)


def setup_inputs(seed: int = 0) -> dict:
    key = jax.random.key(seed)
    ks = jax.random.split(key, 32)
    f32 = jnp.float32

    def nrm(k, shape, scale):
        return jax.random.normal(k, shape, f32) * scale

    return {
        'x': nrm(ks[0], (BATCH, SEQ, D_MODEL), 1.0),
        'p': nrm(ks[1], (DEPTH, BATCH, SEQ, PLE_DIM), 1.0),
        'norm_mix_g': 1.0 + nrm(ks[2], (DEPTH, D_MODEL), 0.02),
        'w_in': nrm(ks[3], (DEPTH, D_MODEL, N_IN), D_MODEL ** -0.5),
        'conv_w': nrm(ks[4], (DEPTH, CONV_WIDTH, 2 * ML_WIDTH), CONV_WIDTH ** -0.5),
        'conv_b': nrm(ks[5], (DEPTH, 2 * ML_WIDTH), 0.02),
        'b_igate': nrm(ks[6], (DEPTH, ML_HEADS), 0.1),
        'b_fgate': jnp.linspace(3.0, 6.0, ML_HEADS, dtype=f32)[None, :] + nrm(ks[7], (DEPTH, ML_HEADS), 0.1),
        'lambda_q1': nrm(ks[8], (DEPTH, DA_HEAD_DIM), 0.1),
        'lambda_k1': nrm(ks[9], (DEPTH, DA_HEAD_DIM), 0.1),
        'lambda_q2': nrm(ks[10], (DEPTH, DA_HEAD_DIM), 0.1),
        'lambda_k2': nrm(ks[11], (DEPTH, DA_HEAD_DIM), 0.1),
        'da_subln_g': 1.0 + nrm(ks[12], (DEPTH, 2 * DA_HEAD_DIM), 0.02),
        'ml_norm_g': 1.0 + nrm(ks[13], (DEPTH, ML_HEADS, ML_HEAD_DIM), 0.02),
        'w_out': nrm(ks[14], (DEPTH, D_MIX, D_MODEL), D_MIX ** -0.5),
        'norm_ffn_g': 1.0 + nrm(ks[15], (DEPTH, D_MODEL), 0.02),
        'w_query': nrm(ks[16], (DEPTH, D_MODEL, PEER_HEADS * PEER_QUERY_DIM), D_MODEL ** -0.5),
        'sub_keys': nrm(ks[17], (DEPTH, PEER_HEADS, 2, N_KEYS, PEER_HALF_DIM), PEER_HALF_DIM ** -0.5),
        'expert_u': nrm(ks[18], (DEPTH, N_EXPERTS, D_MODEL), D_MODEL ** -0.5),
        'expert_v': nrm(ks[19], (DEPTH, N_EXPERTS, D_MODEL), PEER_HEADS ** -0.5),
        'norm_ple_g': 1.0 + nrm(ks[20], (DEPTH, D_MODEL), 0.02),
        'w_ple_gate': nrm(ks[21], (DEPTH, D_MODEL, D_MODEL), D_MODEL ** -0.5),
        'w_ple_proj': nrm(ks[22], (DEPTH, PLE_DIM, D_MODEL), PLE_DIM ** -0.5),
        'final_norm_g': 1.0 + nrm(ks[23], (D_MODEL,), 0.02),
    }


def reference(x, p, norm_mix_g, w_in, conv_w, conv_b, b_igate, b_fgate,
              lambda_q1, lambda_k1, lambda_q2, lambda_k2, da_subln_g, ml_norm_g, w_out,
              norm_ffn_g, w_query, sub_keys, expert_u, expert_v,
              norm_ple_g, w_ple_gate, w_ple_proj, final_norm_g):
    B, S, _ = x.shape
    for i in range(DEPTH):
        lambda_init = 0.8 - 0.6 * math.exp(-0.3 * i)
        h = rms_norm(x, norm_mix_g[i])
        proj = h @ w_in[i]
        da_q, da_k, da_v, ml_q, ml_k, ml_v, ml_o, ml_i, ml_f = jnp.split(proj, IN_SPLITS, axis=-1)
        lam = (jnp.exp(jnp.sum(lambda_q1[i] * lambda_k1[i]).astype(jnp.float32))
               - jnp.exp(jnp.sum(lambda_q2[i] * lambda_k2[i]).astype(jnp.float32)) + lambda_init)
        da_out = diff_attention(
            da_q.reshape(B, S, DA_HEADS, 2, DA_HEAD_DIM),
            da_k.reshape(B, S, DA_HEADS, 2, DA_HEAD_DIM),
            da_v.reshape(B, S, DA_HEADS, 2 * DA_HEAD_DIM),
            lam, da_subln_g[i], lambda_init)
        qk = jax.nn.silu(causal_dwconv(jnp.concatenate([ml_q, ml_k], axis=-1), conv_w[i], conv_b[i]))
        mq, mk = jnp.split(qk, 2, axis=-1)
        hs = mlstm_chunkwise(
            mq.reshape(B, S, ML_HEADS, ML_HEAD_DIM),
            mk.reshape(B, S, ML_HEADS, ML_HEAD_DIM),
            ml_v.reshape(B, S, ML_HEADS, ML_HEAD_DIM),
            ml_i + b_igate[i], ml_f + b_fgate[i]).astype(x.dtype)
        o_gate = jax.nn.sigmoid(ml_o).reshape(B, S, ML_HEADS, ML_HEAD_DIM)
        ml_out = rms_norm(o_gate * hs, ml_norm_g[i]).reshape(B, S, ML_WIDTH)
        x = x + jnp.concatenate([da_out, ml_out], axis=-1) @ w_out[i]
        x = x + peer_ffn(rms_norm(x, norm_ffn_g[i]), w_query[i], sub_keys[i], expert_u[i], expert_v[i])
        gate = jax.nn.sigmoid(rms_norm(x, norm_ple_g[i]) @ w_ple_gate[i])
        x = x + gate * (p[i] @ w_ple_proj[i])
    return rms_norm(x, final_norm_g)
```

```cpp
#include <hip/hip_runtime.h>
#include <cstdio>
#include <cstdint>
#include <cmath>

#ifndef MK_ONE_LAUNCH
#define MK_ONE_LAUNCH 0
#endif

constexpr int M = 16384, D = 1024, NIN = 3592, PLE = 256;
constexpr int NQ = 2048;
constexpr float EPS = 1e-6f;
constexpr float LOG2E = 1.4426950408889634f;
constexpr float C2 = 0.125f * LOG2E;
constexpr float LAMBDA_INIT = 0.2f;
constexpr int NWAVES = 8, NTHREADS = 512;
constexpr int LDS_BYTES = 147456;

typedef unsigned short bf16;
typedef float f32x4 __attribute__((ext_vector_type(4)));
typedef unsigned v4u __attribute__((ext_vector_type(4)));
typedef unsigned v2u __attribute__((ext_vector_type(2)));
#define LAS __attribute__((address_space(3)))

constexpr size_t MiB = 1u << 20;
constexpr size_t WS_CTL = 0, CTL_ZERO_BYTES = 1 * MiB;
constexpr size_t WS_GATES = 17 * MiB;
constexpr size_t WS_XN = 20 * MiB;
constexpr size_t WS_QA = 52 * MiB, WS_KA = 68 * MiB, WS_VA = 84 * MiB, WS_MQ = 100 * MiB, WS_MK = 116 * MiB, WS_MV = 132 * MiB, WS_MO = 148 * MiB;
constexpr size_t WS_O1 = 164 * MiB, WS_O2 = 180 * MiB;
constexpr size_t WS_CQ = 196 * MiB, WS_CK = 212 * MiB;
constexpr size_t WS_HS = WS_XN;
constexpr size_t WS_ACAT = WS_QA;
constexpr size_t WS_QP = WS_VA;
constexpr size_t WS_ROUTE = WS_MO;
constexpr size_t WS_PB = WS_QA;
constexpr size_t WS_G2 = WS_VA;
constexpr size_t WS_END = 256 * MiB;
constexpr int CW_BAR = 4096;

__device__ __forceinline__ float bf2f(unsigned v) { return __uint_as_float(v << 16); }
__device__ __forceinline__ unsigned f2bf(float f) { unsigned u = __float_as_uint(f); return (u + 0x7fffu + ((u >> 16) & 1u)) >> 16; }
__device__ __forceinline__ unsigned pk2(float lo, float hi) { return f2bf(lo) | (f2bf(hi) << 16); }
__device__ __forceinline__ float wave_sum(float v) {
#pragma unroll
    for (int o = 1; o < 64; o <<= 1) v += __shfl_xor(v, o);
    return v;
}
__device__ __forceinline__ float sigmoidf_(float x) { return 1.f / (1.f + __expf(-x)); }

#define XB_TMO      128
#define XB_XCNT(j)  (256  + 64 * (j))
#define XB_XSUB(j)  (1280 + 64 * (j))
#define XB_XGEN(j)  (2304 + 64 * (j))
#define XB_TOP      3328
#define XB_TOPGEN   3392
#define XCD_BAR_WORDS 3456
#define XB_SPIN_CAP (1u << 25)
__device__ __forceinline__ unsigned xb_ld(unsigned* p)              { return __hip_atomic_load(p, __ATOMIC_RELAXED, __HIP_MEMORY_SCOPE_AGENT); }
__device__ __forceinline__ unsigned xb_add(unsigned* p, unsigned v) { return __hip_atomic_fetch_add(p, v, __ATOMIC_RELAXED, __HIP_MEMORY_SCOPE_AGENT); }
__device__ __forceinline__ unsigned xb_xcc_id() { return (unsigned)__builtin_amdgcn_s_getreg((3 << 11) | 20) & 0xFu; }
#define XB_SPIN(cond, bar) do { unsigned _sp = 0; while (cond) { __builtin_amdgcn_s_sleep(1); \
    if ((++_sp & 255u) == 0u) { if (xb_ld(&(bar)[XB_TMO])) break; if (_sp > XB_SPIN_CAP) { atomicAdd(&(bar)[XB_TMO], 1u); break; } } } } while (0)
struct XcdBarrier { unsigned* bar; unsigned x; volatile LAS unsigned* st; };
__device__ __forceinline__ XcdBarrier xcd_barrier_post(unsigned* bar, volatile LAS unsigned* st) {
    XcdBarrier b; b.bar = bar; b.x = xb_xcc_id(); b.st = st;
    if (threadIdx.x == 0) (void)xb_add(&bar[XB_XCNT(b.x)], 1u);
    return b;
}
__device__ __forceinline__ void xcd_barrier_complete(unsigned* bar, unsigned x, unsigned& nloc, unsigned& nx) {
    const unsigned G = gridDim.x * gridDim.y * gridDim.z;
    unsigned sum, cnt, mine, sp = 0u;
    for (;;) {
        sum = 0u; cnt = 0u; mine = 0u;
#pragma unroll
        for (unsigned j = 0; j < 16; ++j) { const unsigned c = xb_ld(&bar[XB_XCNT(j)]); sum += c; cnt += (c > 0u) ? 1u : 0u; mine = (j == x) ? c : mine; }
        if (sum == G) break;
        __builtin_amdgcn_s_sleep(1);
        if ((++sp & 255u) == 0u) { if (xb_ld(&bar[XB_TMO])) break; if (sp > XB_SPIN_CAP) { atomicAdd(&bar[XB_TMO], 1u); break; } }
    }
    nloc = mine > 0u ? mine : 1u; nx = cnt > 0u ? cnt : 1u;
}
__device__ __forceinline__ void xcd_barrier(const XcdBarrier& b) {
    asm volatile("s_waitcnt vmcnt(0)" ::: "memory");
    __syncthreads();
    if (threadIdx.x == 0) {
        unsigned* bar = b.bar;
        __builtin_amdgcn_s_waitcnt(0);
        unsigned nloc = b.st[0], nx = b.st[1];
        if (nloc == 0u) { xcd_barrier_complete(bar, b.x, nloc, nx); b.st[0] = nloc; b.st[1] = nx; }
        const unsigned old = xb_add(&bar[XB_XSUB(b.x)], 1u);
        const unsigned gen = old / nloc;
        if (old + 1u == (gen + 1u) * nloc) {
            __builtin_amdgcn_fence(__ATOMIC_RELEASE, "agent");
            asm volatile("s_waitcnt vmcnt(0)" ::: "memory");
            const unsigned og = xb_add(&bar[XB_TOP], 1u);
            const unsigned tg = og / nx;
            if (og + 1u == (tg + 1u) * nx) xb_add(&bar[XB_TOPGEN], 1u);
            else XB_SPIN(xb_ld(&bar[XB_TOPGEN]) == tg, bar);
            __builtin_amdgcn_fence(__ATOMIC_ACQUIRE, "agent");
            xb_add(&bar[XB_XGEN(b.x)], 1u);
            asm volatile("s_waitcnt vmcnt(0)" ::: "memory");
        } else {
            XB_SPIN(xb_ld(&bar[XB_XGEN(b.x)]) == gen, bar);
            __builtin_amdgcn_fence(__ATOMIC_ACQUIRE, "agent");
            asm volatile("s_waitcnt vmcnt(0)" ::: "memory");
        }
    }
    __syncthreads();
}

__device__ __forceinline__ void ph_rmsnorm_bf16(const float* X, const float* g, bf16* O) {
    const int lane = threadIdx.x & 63, wave = threadIdx.x >> 6;
    const int gw = blockIdx.x * NWAVES + wave, NGW = gridDim.x * NWAVES;
    for (int m = gw; m < M; m += NGW) {
        const f32x4* xr = (const f32x4*)(X + (size_t)m * D) + lane;
        f32x4 v[4]; float s = 0.f;
#pragma unroll
        for (int j = 0; j < 4; ++j) { v[j] = xr[64 * j]; s += (v[j].x * v[j].x + v[j].y * v[j].y) + (v[j].z * v[j].z + v[j].w * v[j].w); }
        const float r = rsqrtf(wave_sum(s) * (1.f / D) + EPS);
        v2u* o8 = (v2u*)(O + (size_t)m * D) + lane;
#pragma unroll
        for (int j = 0; j < 4; ++j) { const f32x4 gg = ((const f32x4*)g)[lane + 64 * j]; v2u w; w.x = pk2(v[j].x * r * gg.x, v[j].y * r * gg.y); w.y = pk2(v[j].z * r * gg.z, v[j].w * r * gg.w); o8[64 * j] = w; }
    }
}
__device__ __forceinline__ void ph_rmsnorm_f32_inplace(float* X, const float* g) {
    const int lane = threadIdx.x & 63, wave = threadIdx.x >> 6;
    const int gw = blockIdx.x * NWAVES + wave, NGW = gridDim.x * NWAVES;
    for (int m = gw; m < M; m += NGW) {
        f32x4* xr = (f32x4*)(X + (size_t)m * D) + lane;
        f32x4 v[4]; float s = 0.f;
#pragma unroll
        for (int j = 0; j < 4; ++j) { v[j] = xr[64 * j]; s += (v[j].x * v[j].x + v[j].y * v[j].y) + (v[j].z * v[j].z + v[j].w * v[j].w); }
        const float r = rsqrtf(wave_sum(s) * (1.f / D) + EPS);
#pragma unroll
        for (int j = 0; j < 4; ++j) { const f32x4 gg = ((const f32x4*)g)[lane + 64 * j]; xr[64 * j] = v[j] * r * gg; }
    }
}

template <class Epi>
__device__ __forceinline__ void naive_gemm(const bf16* A, int lda, const float* W, int K, int N, float* lds, Epi epi) {
    float* As = lds;
    float* Ws = lds + 32 * 65;
    const int tid = threadIdx.x, tx = tid & 15, ty = tid >> 4;
    const int ntn = (N + 63) / 64, nt = (M / 64) * ntn;
    for (int t = blockIdx.x; t < nt; t += gridDim.x) {
        const int tm = t / ntn, tn = t % ntn, r0 = tm * 64, c0 = tn * 64;
        float acc[2][4];
#pragma unroll
        for (int i = 0; i < 2; ++i)
#pragma unroll
            for (int j = 0; j < 4; ++j) acc[i][j] = 0.f;
        for (int k0 = 0; k0 < K; k0 += 32) {
            { const int r = tid >> 3, kq = (tid & 7) * 4; const v2u v = *(const v2u*)(A + (size_t)(r0 + r) * lda + k0 + kq);
              As[(kq + 0) * 65 + r] = bf2f(v.x & 0xffffu); As[(kq + 1) * 65 + r] = bf2f(v.x >> 16); As[(kq + 2) * 65 + r] = bf2f(v.y & 0xffffu); As[(kq + 3) * 65 + r] = bf2f(v.y >> 16); }
            { const int kk = tid >> 4, nq = (tid & 15) * 4; const float* wp = W + (size_t)(k0 + kk) * N + c0 + nq;
#pragma unroll
              for (int j = 0; j < 4; ++j) Ws[kk * 64 + nq + j] = (c0 + nq + j < N) ? wp[j] : 0.f; }
            __syncthreads();
#pragma unroll 8
            for (int kk = 0; kk < 32; ++kk) {
                const float a0 = As[kk * 65 + ty], a1 = As[kk * 65 + ty + 32];
                const f32x4 b = *(const f32x4*)(Ws + kk * 64 + tx * 4);
                acc[0][0] += a0 * b.x; acc[0][1] += a0 * b.y; acc[0][2] += a0 * b.z; acc[0][3] += a0 * b.w;
                acc[1][0] += a1 * b.x; acc[1][1] += a1 * b.y; acc[1][2] += a1 * b.z; acc[1][3] += a1 * b.w;
            }
            __syncthreads();
        }
#pragma unroll
        for (int i = 0; i < 2; ++i)
#pragma unroll
            for (int j = 0; j < 4; ++j) { const int row = r0 + ty + 32 * i, col = c0 + tx * 4 + j; if (col < N) epi(row, col, acc[i][j]); }
    }
}

__device__ __forceinline__ void ph_attn_naive(const bf16* QA, const bf16* KA, const bf16* VA, bf16* O1, bf16* O2, float* lds) {
    float* Ks = lds; float* Vs = lds + 32 * 64; float* Ss = Vs + 32 * 128;
    const int tid = threadIdx.x, qi = tid >> 3, cg = tid & 7;
    for (int item = blockIdx.x; item < 8 * 256; item += gridDim.x) {
        const int hv = item & 7, qb = 255 - (item >> 3);
        const int h = hv >> 1, c = hv & 1, q0 = qb * 64, qpos = q0 + qi;
        const float slope2 = exp2f(-2.f * (float)(h + 1)) * LOG2E;
        float q[64];
        { const v4u* qp = (const v4u*)(QA + (size_t)qpos * 512 + hv * 64);
#pragma unroll
          for (int i = 0; i < 8; ++i) { const v4u v = qp[i];
              q[8 * i + 0] = bf2f(v.x & 0xffffu); q[8 * i + 1] = bf2f(v.x >> 16); q[8 * i + 2] = bf2f(v.y & 0xffffu); q[8 * i + 3] = bf2f(v.y >> 16);
              q[8 * i + 4] = bf2f(v.z & 0xffffu); q[8 * i + 5] = bf2f(v.z >> 16); q[8 * i + 6] = bf2f(v.w & 0xffffu); q[8 * i + 7] = bf2f(v.w >> 16); } }
        float m = -INFINITY, l = 0.f, acc[16];
#pragma unroll
        for (int i = 0; i < 16; ++i) acc[i] = 0.f;
        const int ntile = (q0 + 64) / 32;
        for (int kt = 0; kt < ntile; ++kt) {
            const int k0 = kt * 32;
            __syncthreads();
            { const int kk = tid >> 4, d4 = (tid & 15) * 4; const v2u v = *(const v2u*)(KA + (size_t)(k0 + kk) * 512 + hv * 64 + d4);
              float* kd = Ks + kk * 64 + d4; kd[0] = bf2f(v.x & 0xffffu); kd[1] = bf2f(v.x >> 16); kd[2] = bf2f(v.y & 0xffffu); kd[3] = bf2f(v.y >> 16); }
            { const int kk = tid >> 4, e8 = (tid & 15) * 8; const v4u v = *(const v4u*)(VA + (size_t)(k0 + kk) * 512 + h * 128 + e8);
              float* vd = Vs + kk * 128 + e8; vd[0] = bf2f(v.x & 0xffffu); vd[1] = bf2f(v.x >> 16); vd[2] = bf2f(v.y & 0xffffu); vd[3] = bf2f(v.y >> 16);
              vd[4] = bf2f(v.z & 0xffffu); vd[5] = bf2f(v.z >> 16); vd[6] = bf2f(v.w & 0xffffu); vd[7] = bf2f(v.w >> 16); }
            __syncthreads();
#pragma unroll
            for (int j = 0; j < 4; ++j) {
                const int kk = cg + 8 * j; const float* kr = Ks + kk * 64; float s = 0.f;
#pragma unroll
                for (int d = 0; d < 64; ++d) s += q[d] * kr[d];
                const int kpos = k0 + kk;
                s = (kpos <= qpos) ? s - slope2 * (float)(qpos - kpos) : -INFINITY;
                Ss[qi * 33 + kk] = s;
            }
            __syncthreads();
            float tmax = -INFINITY;
#pragma unroll 8
            for (int kk = 0; kk < 32; ++kk) tmax = fmaxf(tmax, Ss[qi * 33 + kk]);
            const float mn = fmaxf(m, tmax), alpha = exp2f(m - mn);
            l *= alpha;
#pragma unroll
            for (int i = 0; i < 16; ++i) acc[i] *= alpha;
            for (int kk = 0; kk < 32; ++kk) {
                const float p = exp2f(Ss[qi * 33 + kk] - mn); l += p;
                const float* vr = Vs + kk * 128 + 16 * cg;
#pragma unroll
                for (int i = 0; i < 16; ++i) acc[i] += p * vr[i];
            }
            m = mn;
        }
        const float il = 1.f / l;
        bf16* O = c ? O2 : O1;
        v4u w0, w1;
        w0.x = pk2(acc[0] * il, acc[1] * il); w0.y = pk2(acc[2] * il, acc[3] * il); w0.z = pk2(acc[4] * il, acc[5] * il); w0.w = pk2(acc[6] * il, acc[7] * il);
        w1.x = pk2(acc[8] * il, acc[9] * il); w1.y = pk2(acc[10] * il, acc[11] * il); w1.z = pk2(acc[12] * il, acc[13] * il); w1.w = pk2(acc[14] * il, acc[15] * il);
        v4u* op = (v4u*)(O + (size_t)qpos * 512 + h * 128 + 16 * cg); op[0] = w0; op[1] = w1;
    }
}

__device__ __forceinline__ void ph_conv_naive(const bf16* MQ, const bf16* MK, const float* cw, const float* cb, bf16* CQ, bf16* CK) {
    const size_t n = (size_t)M * 512, stride = (size_t)gridDim.x * NTHREADS;
    for (size_t i = (size_t)blockIdx.x * NTHREADS + threadIdx.x; i < n; i += stride) {
        const int t = (int)(i >> 9), c = (int)(i & 511);
        float aq = cb[c], ak = cb[512 + c];
#pragma unroll
        for (int j = 0; j < 4; ++j) { const int tt = t - 3 + j; if (tt >= 0) { aq += cw[j * 1024 + c] * bf2f(MQ[(size_t)tt * 512 + c]); ak += cw[j * 1024 + 512 + c] * bf2f(MK[(size_t)tt * 512 + c]); } }
        aq = aq * sigmoidf_(aq) * 0.08838834764831845f; ak = ak * sigmoidf_(ak);
        CQ[i] = (bf16)f2bf(aq); CK[i] = (bf16)f2bf(ak);
    }
}
__device__ __forceinline__ void ph_mlstm_naive(const bf16* CQ, const bf16* CK, const bf16* MV, const float* GATES, const float* b_i, const float* b_f, float* HS, float* lds) {
    if (blockIdx.x >= 4) return;
    const int h = blockIdx.x, tid = threadIdx.x, e = tid & 127, dg = tid >> 7;
    float* qs = lds; float* ks = qs + 64 * 128; float* vs = ks + 64 * 128; float* fs = vs + 64 * 128; float* is_ = fs + 64; float* red = is_ + 64; float* redd = red + 512;
    float C[32], n[32];
#pragma unroll
    for (int i = 0; i < 32; ++i) { C[i] = 0.f; n[i] = 0.f; }
    for (int c0 = 0; c0 < M; c0 += 64) {
        __syncthreads();
        for (int i = tid; i < 64 * 128; i += NTHREADS) { const int tt = i >> 7, d = i & 127; const size_t g = (size_t)(c0 + tt) * 512 + h * 128 + d; qs[i] = bf2f(CQ[g]); ks[i] = bf2f(CK[g]); vs[i] = bf2f(MV[g]); }
        if (tid < 64) { const float fp = GATES[(size_t)(c0 + tid) * 8 + 4 + h] + b_f[h], ip = GATES[(size_t)(c0 + tid) * 8 + h] + b_i[h]; fs[tid] = 1.f / (1.f + expf(-fp)); is_[tid] = expf(ip); }
        __syncthreads();
        for (int tt = 0; tt < 64; ++tt) {
            const float f = fs[tt], ii = is_[tt], ve = vs[tt * 128 + e]; float pn = 0.f, pd = 0.f;
#pragma unroll
            for (int i = 0; i < 32; ++i) { const float kd = ks[tt * 128 + dg * 32 + i], qd = qs[tt * 128 + dg * 32 + i], ik = ii * kd;
                C[i] = f * C[i] + ik * ve; n[i] = f * n[i] + ik; pn += qd * C[i]; pd += qd * n[i]; }
            red[dg * 128 + e] = pn; if (e == 0) redd[dg] = pd;
            __syncthreads();
            if (dg == 0) { const float num = (red[e] + red[128 + e]) + (red[256 + e] + red[384 + e]), den = (redd[0] + redd[1]) + (redd[2] + redd[3]);
                HS[(size_t)(c0 + tt) * 512 + h * 128 + e] = num / fmaxf(fabsf(den), 1.f); }
            __syncthreads();
        }
    }
}
__device__ __forceinline__ void ph_combine(const bf16* O1, const bf16* O2, const bf16* MO, const float* HS, const float* lq1, const float* lk1, const float* lq2, const float* lk2,
                                           const float* subln_g, const float* ml_g, bf16* ACAT) {
    const int lane = threadIdx.x & 63, wave = threadIdx.x >> 6;
    const int gw = blockIdx.x * NWAVES + wave, NGW = gridDim.x * NWAVES;
    const float lam = expf(wave_sum(lq1[lane] * lk1[lane])) - expf(wave_sum(lq2[lane] * lk2[lane])) + LAMBDA_INIT;
    for (int m = gw; m < M; m += NGW) {
        const int c0 = lane * 8;
        float a[8], b[8];
        { const v4u u1 = *(const v4u*)(O1 + (size_t)m * 512 + c0), u2 = *(const v4u*)(O2 + (size_t)m * 512 + c0);
          const unsigned w1[4] = {u1.x, u1.y, u1.z, u1.w}, w2[4] = {u2.x, u2.y, u2.z, u2.w};
#pragma unroll
          for (int i = 0; i < 4; ++i) { a[2 * i] = bf2f(w1[i] & 0xffffu) - lam * bf2f(w2[i] & 0xffffu); a[2 * i + 1] = bf2f(w1[i] >> 16) - lam * bf2f(w2[i] >> 16); } }
        { const v4u uo = *(const v4u*)(MO + (size_t)m * 512 + c0); const unsigned wo[4] = {uo.x, uo.y, uo.z, uo.w};
          const f32x4 h0 = *(const f32x4*)(HS + (size_t)m * 512 + c0), h1 = *(const f32x4*)(HS + (size_t)m * 512 + c0 + 4);
          const float hh[8] = {h0.x, h0.y, h0.z, h0.w, h1.x, h1.y, h1.z, h1.w};
#pragma unroll
          for (int i = 0; i < 4; ++i) { b[2 * i] = sigmoidf_(bf2f(wo[i] & 0xffffu)) * hh[2 * i]; b[2 * i + 1] = sigmoidf_(bf2f(wo[i] >> 16)) * hh[2 * i + 1]; } }
        float sa = 0.f, sb = 0.f;
#pragma unroll
        for (int i = 0; i < 8; ++i) { sa += a[i] * a[i]; sb += b[i] * b[i]; }
#pragma unroll
        for (int o = 1; o < 16; o <<= 1) { sa += __shfl_xor(sa, o); sb += __shfl_xor(sb, o); }
        const float ra = rsqrtf(sa * (1.f / 128.f) + EPS) * (1.f - LAMBDA_INIT), rb = rsqrtf(sb * (1.f / 128.f) + EPS);
        const int cc = c0 & 127, hh_ = lane >> 4;
        v4u wa, wb;
        { const float* g = subln_g + cc; wa.x = pk2(a[0] * ra * g[0], a[1] * ra * g[1]); wa.y = pk2(a[2] * ra * g[2], a[3] * ra * g[3]); wa.z = pk2(a[4] * ra * g[4], a[5] * ra * g[5]); wa.w = pk2(a[6] * ra * g[6], a[7] * ra * g[7]); }
        { const float* g = ml_g + hh_ * 128 + cc; wb.x = pk2(b[0] * rb * g[0], b[1] * rb * g[1]); wb.y = pk2(b[2] * rb * g[2], b[3] * rb * g[3]); wb.z = pk2(b[4] * rb * g[4], b[5] * rb * g[5]); wb.w = pk2(b[6] * rb * g[6], b[7] * rb * g[7]); }
        *(v4u*)(ACAT + (size_t)m * 1024 + c0) = wa; *(v4u*)(ACAT + (size_t)m * 1024 + 512 + c0) = wb;
    }
}

__device__ __forceinline__ void ph_route_naive(const bf16* QP, const float* SK, int2* ROUTE, float* lds) {
    float* qs = lds; float* sc = qs + 2048; float* sv = sc + 2048; int* si = (int*)(sv + 256); float* cand = (float*)(si + 256); float* tops = cand + 2048; int* tope = (int*)(tops + 128);
    const int tid = threadIdx.x;
    for (int t = blockIdx.x; t < M; t += gridDim.x) {
        __syncthreads();
        for (int i = tid; i < 2048; i += NTHREADS) qs[i] = bf2f(QP[(size_t)t * 2048 + i]);
        __syncthreads();
#pragma unroll 1
        for (int j = 0; j < 4; ++j) { const int sidx = tid + 512 * j, hc = sidx >> 7; const float* kp = SK + (size_t)sidx * 128; const float* qq = qs + hc * 128; float s = 0.f;
            for (int d = 0; d < 128; d += 4) { const f32x4 kv = *(const f32x4*)(kp + d); s += qq[d] * kv.x + qq[d + 1] * kv.y + qq[d + 2] * kv.z + qq[d + 3] * kv.w; }
            sc[sidx] = s; }
        __syncthreads();
        if (tid < 16) { const int hc = tid;
            for (int k = 0; k < 16; ++k) { float best = -INFINITY; int bi = 0;
                for (int n = 0; n < 128; ++n) { const float v = sc[hc * 128 + n]; if (v > best) { best = v; bi = n; } }
                sv[hc * 16 + k] = best; si[hc * 16 + k] = bi; sc[hc * 128 + bi] = -INFINITY; } }
        __syncthreads();
        for (int i = tid; i < 2048; i += NTHREADS) { const int h = i >> 8, a = (i >> 4) & 15, b = i & 15; cand[i] = sv[(2 * h) * 16 + a] + sv[(2 * h + 1) * 16 + b]; }
        __syncthreads();
        if (tid < 8) { const int h = tid;
            for (int k = 0; k < 16; ++k) { float best = -INFINITY; int bi = 0;
                for (int n = 0; n < 256; ++n) { const float v = cand[h * 256 + n]; if (v > best) { best = v; bi = n; } }
                tops[h * 16 + k] = best; tope[h * 16 + k] = si[(2 * h) * 16 + (bi >> 4)] * 128 + si[(2 * h + 1) * 16 + (bi & 15)]; cand[h * 256 + bi] = -INFINITY; }
            const float mx = tops[h * 16]; float sum = 0.f;
            for (int k = 0; k < 16; ++k) sum += expf(tops[h * 16 + k] - mx);
            const float inv = 1.f / sum;
            for (int k = 0; k < 16; ++k) ROUTE[((size_t)t * 8 + h) * 16 + k] = make_int2(tope[h * 16 + k], __float_as_int(expf(tops[h * 16 + k] - mx) * inv)); }
    }
}
__device__ __forceinline__ void ph_expert_naive(const bf16* XN, const int2* ROUTE, const float* EU, const float* EV, float* X, float* lds) {
    float* xs = lds; float* ws = xs + 1024; int* es = (int*)(ws + 128); float* gs = (float*)(es + 128);
    const int tid = threadIdx.x;
    for (int t = blockIdx.x; t < M; t += gridDim.x) {
        __syncthreads();
        for (int i = tid; i < 1024; i += NTHREADS) xs[i] = bf2f(XN[(size_t)t * 1024 + i]);
        if (tid < 128) { const int2 r = ROUTE[(size_t)t * 128 + tid]; es[tid] = r.x; gs[tid] = __int_as_float(r.y); }
        __syncthreads();
        { const int e = tid >> 2, part = tid & 3; const float* u = EU + (size_t)es[e] * 1024 + part * 4; const float* xx = xs + part * 4; float s = 0.f;
          for (int d = 0; d < 1024; d += 16) { const f32x4 uv = *(const f32x4*)(u + d); s += xx[d] * uv.x + xx[d + 1] * uv.y + xx[d + 2] * uv.z + xx[d + 3] * uv.w; }
          s += __shfl_xor(s, 1); s += __shfl_xor(s, 2);
          const float a = 0.5f * s * (1.f + erff(s * 0.7071067811865476f));
          if (part == 0) ws[e] = gs[e] * a; }
        __syncthreads();
#pragma unroll 1
        for (int j = 0; j < 2; ++j) { const int n = tid + 512 * j; float o = 0.f;
            for (int e = 0; e < 128; ++e) o += ws[e] * EV[(size_t)es[e] * 1024 + n];
            X[(size_t)t * 1024 + n] += o; }
    }
}

constexpr int NPHASE = 15;
struct Args { const float* in[24]; float* out; unsigned char* ws; int ph_lo, ph_hi, use_bar, pad; };

__global__ void __launch_bounds__(NTHREADS, 2) mk_fwd(Args args) {
    extern __shared__ __attribute__((aligned(16))) unsigned char lds_raw[];
    float* lds = (float*)lds_raw;
    volatile LAS unsigned* MISC = (volatile LAS unsigned*)((LAS unsigned char*)lds_raw + (LDS_BYTES - 64));
    unsigned char* ws = args.ws;
    unsigned* ctl = (unsigned*)(ws + WS_CTL);
    const float* x = args.in[0]; const float* p = args.in[1]; const float* norm_mix_g = args.in[2]; const float* w_in = args.in[3];
    const float* conv_w = args.in[4]; const float* conv_b = args.in[5]; const float* b_ig = args.in[6]; const float* b_fg = args.in[7];
    const float* lq1 = args.in[8]; const float* lk1 = args.in[9]; const float* lq2 = args.in[10]; const float* lk2 = args.in[11];
    const float* subln_g = args.in[12]; const float* ml_g = args.in[13]; const float* w_out = args.in[14]; const float* norm_ffn_g = args.in[15];
    const float* w_query = args.in[16]; const float* sub_keys = args.in[17]; const float* expert_u = args.in[18]; const float* expert_v = args.in[19];
    const float* norm_ple_g = args.in[20]; const float* w_ple_gate = args.in[21]; const float* w_ple_proj = args.in[22]; const float* final_g = args.in[23];
    float* out = args.out;
    bf16* XN = (bf16*)(ws + WS_XN); float* GATES = (float*)(ws + WS_GATES);
    bf16* QA = (bf16*)(ws + WS_QA); bf16* KA = (bf16*)(ws + WS_KA); bf16* VA = (bf16*)(ws + WS_VA);
    bf16* MQ = (bf16*)(ws + WS_MQ); bf16* MK = (bf16*)(ws + WS_MK); bf16* MV = (bf16*)(ws + WS_MV); bf16* MO = (bf16*)(ws + WS_MO);
    bf16* O1 = (bf16*)(ws + WS_O1); bf16* O2 = (bf16*)(ws + WS_O2); bf16* CQ = (bf16*)(ws + WS_CQ); bf16* CK = (bf16*)(ws + WS_CK);
    float* HS = (float*)(ws + WS_HS); bf16* ACAT = (bf16*)(ws + WS_ACAT); bf16* QP = (bf16*)(ws + WS_QP); int2* ROUTE = (int2*)(ws + WS_ROUTE);
    bf16* PB = (bf16*)(ws + WS_PB); bf16* G2 = (bf16*)(ws + WS_G2);

    XcdBarrier bar; bar.bar = ctl + CW_BAR; bar.x = 0; bar.st = nullptr;
    if (args.use_bar) {
        if (threadIdx.x < 16) MISC[threadIdx.x] = 0u;
        __syncthreads();
        bar = xcd_barrier_post(ctl + CW_BAR, MISC + 8);
    }
    const int lo = args.ph_lo, hi = args.ph_hi;
#define IN(k) (lo <= (k) && (k) < hi)
#define SEAM(k) do { if (IN(k) && IN((k) + 1)) xcd_barrier(bar); } while (0)

    if (IN(0)) { ph_rmsnorm_bf16(x, norm_mix_g, XN); } SEAM(0);
    if (IN(1)) {
        naive_gemm(XN, D, w_in, D, NIN, lds, [&](int row, int col, float v) {
            if (col >= 3584) { GATES[(size_t)row * 8 + (col - 3584)] = v; return; }
            const int t = col >> 9, cc = col & 511;
            bf16* dst = (t == 0) ? QA : (t == 1) ? KA : (t == 2) ? VA : (t == 3) ? MQ : (t == 4) ? MK : (t == 5) ? MV : MO;
            dst[(size_t)row * 512 + cc] = (bf16)f2bf(t == 0 ? v * C2 : v);
        });
    } SEAM(1);
    if (IN(2)) { ph_attn_naive(QA, KA, VA, O1, O2, lds); ph_conv_naive(MQ, MK, conv_w, conv_b, CQ, CK); } SEAM(2);
    if (IN(3)) { ph_mlstm_naive(CQ, CK, MV, GATES, b_ig, b_fg, HS, lds); } SEAM(3);
    if (IN(4)) { ph_combine(O1, O2, MO, HS, lq1, lk1, lq2, lk2, subln_g, ml_g, ACAT); } SEAM(4);
    if (IN(5)) {
        naive_gemm(ACAT, D, w_out, D, D, lds, [&](int row, int col, float v) { out[(size_t)row * D + col] = x[(size_t)row * D + col] + v; });
    } SEAM(5);
    if (IN(6)) { ph_rmsnorm_bf16(out, norm_ffn_g, XN); } SEAM(6);
    if (IN(7)) {
        naive_gemm(XN, D, w_query, D, NQ, lds, [&](int row, int col, float v) { QP[(size_t)row * NQ + col] = (bf16)f2bf(v); });
    } SEAM(7);
    if (IN(8)) { ph_route_naive(QP, sub_keys, ROUTE, lds); } SEAM(8);
    if (IN(9)) { ph_expert_naive(XN, ROUTE, expert_u, expert_v, out, lds); } SEAM(9);
    if (IN(10)) {
        ph_rmsnorm_bf16(out, norm_ple_g, XN);
        const size_t n = (size_t)M * PLE, stride = (size_t)gridDim.x * NTHREADS;
        for (size_t i = (size_t)blockIdx.x * NTHREADS + threadIdx.x; i < n; i += stride) PB[i] = (bf16)f2bf(p[i]);
    } SEAM(10);
    if (IN(11)) {
        naive_gemm(XN, D, w_ple_gate, D, D, lds, [&](int row, int col, float v) { G2[(size_t)row * D + col] = (bf16)f2bf(sigmoidf_(v)); });
    } SEAM(11);
    if (IN(12)) {
        naive_gemm(PB, PLE, w_ple_proj, PLE, D, lds, [&](int row, int col, float v) { out[(size_t)row * D + col] += bf2f(G2[(size_t)row * D + col]) * v; });
    } SEAM(12);
    if (IN(13)) { ph_rmsnorm_f32_inplace(out, final_g); }
#undef IN
#undef SEAM
}

extern "C" void kernel_launch(void* const* d_in, const int* in_sizes, int n_in, void* d_out, int out_size, void* d_ws, size_t ws_size, hipStream_t stream) {
    static int grid = 0;
    if (grid == 0) {
        if (n_in != 24 || in_sizes[0] != M * D || out_size != M * D || ws_size < WS_END) { fprintf(stderr, "kernel_launch: unexpected shapes (n_in %d, in0 %d, out %d, ws %zu)\n", n_in, n_in > 0 ? in_sizes[0] : -1, out_size, ws_size); grid = -1; return; }
        int dev = 0, cus = 0;
        if (hipGetDevice(&dev) != hipSuccess || hipDeviceGetAttribute(&cus, hipDeviceAttributeMultiprocessorCount, dev) != hipSuccess) { grid = -1; return; }
        if (hipFuncSetAttribute((const void*)mk_fwd, hipFuncAttributeMaxDynamicSharedMemorySize, LDS_BYTES) != hipSuccess) { fprintf(stderr, "kernel_launch: hipFuncSetAttribute failed\n"); grid = -1; return; }
        (void)hipGetLastError();
        grid = cus;
    }
    if (grid < 0) return;
    if (hipMemsetAsync((char*)d_ws + WS_CTL, 0, CTL_ZERO_BYTES, stream) != hipSuccess) return;
    Args a{};
    for (int i = 0; i < 24; ++i) a.in[i] = (const float*)d_in[i];
    a.out = (float*)d_out; a.ws = (unsigned char*)d_ws;
#if MK_ONE_LAUNCH
    a.ph_lo = 0; a.ph_hi = NPHASE; a.use_bar = 1;
    hipLaunchKernelGGL(mk_fwd, dim3(grid), dim3(NTHREADS), LDS_BYTES, stream, a);
#else
    for (int ph = 0; ph < 14; ++ph) {
        a.ph_lo = ph; a.ph_hi = ph + 1; a.use_bar = 0;
        hipLaunchKernelGGL(mk_fwd, dim3(grid), dim3(NTHREADS), LDS_BYTES, stream, a);
    }
#endif
}
```

```cpp
#include <hip/hip_runtime.h>
#include <cstdio>
#include <cstdint>
#include <cmath>

#ifndef MK_ONE_LAUNCH
#define MK_ONE_LAUNCH 1
#endif

constexpr int M = 16384, D = 1024, NIN = 3592, PLE = 256;
constexpr int NQ = 2048;
constexpr float EPS = 1e-6f;
constexpr float LOG2E = 1.4426950408889634f;
constexpr float C2 = 0.125f * LOG2E;
constexpr float LAMBDA_INIT = 0.2f;
constexpr int NWAVES = 8, NTHREADS = 512;
constexpr int LDS_BYTES = 147456;

typedef unsigned short bf16;
typedef float f32x4 __attribute__((ext_vector_type(4)));
typedef unsigned v4u __attribute__((ext_vector_type(4)));
typedef unsigned v2u __attribute__((ext_vector_type(2)));
#define LAS __attribute__((address_space(3)))

constexpr size_t MiB = 1u << 20;
constexpr size_t WS_CTL = 0, CTL_ZERO_BYTES = 1 * MiB;
constexpr size_t WS_WIN = 1 * MiB, WS_WOUT = 9 * MiB, WS_WQ = 11 * MiB, WS_WG = 15 * MiB, WS_WP = 18 * MiB;
constexpr int NINP = 3840;
constexpr size_t WS_SKB = 18 * MiB + 512 * 1024;
constexpr size_t WS_GATES = 17 * MiB;
constexpr size_t WS_XN = 20 * MiB;
constexpr size_t WS_QA = 52 * MiB, WS_KA = 68 * MiB, WS_VA = 84 * MiB, WS_MQ = 100 * MiB, WS_MK = 116 * MiB, WS_MV = 132 * MiB, WS_MO = 148 * MiB;
constexpr size_t WS_O1 = 164 * MiB, WS_O2 = 180 * MiB;
constexpr size_t WS_CQ = 196 * MiB, WS_CK = 212 * MiB;
constexpr size_t WS_HS = WS_XN;
constexpr size_t WS_ACAT = WS_QA;
constexpr size_t WS_QP = WS_VA;
constexpr size_t WS_ROUTE = WS_MO;
constexpr size_t WS_PB = 245 * MiB;
constexpr size_t WS_PP = WS_QA;
constexpr size_t WS_G2 = WS_VA;
constexpr size_t WS_EU8 = 20 * MiB, WS_EV8 = 36 * MiB;
constexpr size_t WS_SI = 19 * MiB;
constexpr size_t WS_RS = 253 * MiB;
constexpr size_t WS_X1G = 164 * MiB;
constexpr size_t WS_XN3 = 196 * MiB;
constexpr size_t WS_ST = 228 * MiB;
constexpr size_t WS_END = 256 * MiB;
constexpr int CW_BAR = 4096;
constexpr int CW_NORM = 64, CW_QUEUE = 128;

__device__ __forceinline__ float bf2f(unsigned v) { return __uint_as_float(v << 16); }
__device__ __forceinline__ unsigned f2bf(float f) { unsigned u = __float_as_uint(f); return (u + 0x7fffu + ((u >> 16) & 1u)) >> 16; }
__device__ __forceinline__ unsigned pk2(float lo, float hi) { return f2bf(lo) | (f2bf(hi) << 16); }
__device__ __forceinline__ float wave_sum(float v) {
#pragma unroll
    for (int o = 1; o < 64; o <<= 1) v += __shfl_xor(v, o);
    return v;
}
__device__ __forceinline__ float sigmoidf_(float x) { return 1.f / (1.f + __expf(-x)); }
__device__ __forceinline__ int tidx() { int t = threadIdx.x; asm volatile("" : "+v"(t)); return t; }

#define XB_TMO      128
#define XB_XCNT(j)  (256  + 64 * (j))
#define XB_XSUB(j)  (1280 + 64 * (j))
#define XB_XGEN(j)  (2304 + 64 * (j))
#define XB_TOP      3328
#define XB_TOPGEN   3392
#define XCD_BAR_WORDS 3456
#define XB_SPIN_CAP (1u << 25)
__device__ __forceinline__ unsigned xb_ld(unsigned* p)              { return __hip_atomic_load(p, __ATOMIC_RELAXED, __HIP_MEMORY_SCOPE_AGENT); }
__device__ __forceinline__ unsigned xb_add(unsigned* p, unsigned v) { return __hip_atomic_fetch_add(p, v, __ATOMIC_RELAXED, __HIP_MEMORY_SCOPE_AGENT); }
__device__ __forceinline__ unsigned xb_xcc_id() { return (unsigned)__builtin_amdgcn_s_getreg((3 << 11) | 20) & 0xFu; }
#define XB_SPIN(cond, bar) do { unsigned _sp = 0; while (cond) { __builtin_amdgcn_s_sleep(1); \
    if ((++_sp & 255u) == 0u) { if (xb_ld(&(bar)[XB_TMO])) break; if (_sp > XB_SPIN_CAP) { atomicAdd(&(bar)[XB_TMO], 1u); break; } } } } while (0)
struct XcdBarrier { unsigned* bar; unsigned x; volatile LAS unsigned* st; };
__device__ __forceinline__ XcdBarrier xcd_barrier_post(unsigned* bar, volatile LAS unsigned* st) {
    XcdBarrier b; b.bar = bar; b.x = xb_xcc_id(); b.st = st;
    if (tidx() == 0) (void)xb_add(&bar[XB_XCNT(b.x)], 1u);
    return b;
}
__device__ __forceinline__ void xcd_barrier_complete(unsigned* bar, unsigned x, unsigned& nloc, unsigned& nx) {
    const unsigned G = gridDim.x * gridDim.y * gridDim.z;
    unsigned sum, cnt, mine, sp = 0u;
    for (;;) {
        sum = 0u; cnt = 0u; mine = 0u;
#pragma unroll
        for (unsigned j = 0; j < 16; ++j) { const unsigned c = xb_ld(&bar[XB_XCNT(j)]); sum += c; cnt += (c > 0u) ? 1u : 0u; mine = (j == x) ? c : mine; }
        if (sum == G) break;
        __builtin_amdgcn_s_sleep(1);
        if ((++sp & 255u) == 0u) { if (xb_ld(&bar[XB_TMO])) break; if (sp > XB_SPIN_CAP) { atomicAdd(&bar[XB_TMO], 1u); break; } }
    }
    nloc = mine > 0u ? mine : 1u; nx = cnt > 0u ? cnt : 1u;
}
__device__ __forceinline__ void xcd_barrier(const XcdBarrier& b) {
    asm volatile("s_waitcnt vmcnt(0)" ::: "memory");
    __syncthreads();
    if (tidx() == 0) {
        unsigned* bar = b.bar;
        __builtin_amdgcn_s_waitcnt(0);
        unsigned nloc = b.st[0], nx = b.st[1];
        if (nloc == 0u) { xcd_barrier_complete(bar, b.x, nloc, nx); b.st[0] = nloc; b.st[1] = nx; }
        const unsigned old = xb_add(&bar[XB_XSUB(b.x)], 1u);
        const unsigned gen = old / nloc;
        if (old + 1u == (gen + 1u) * nloc) {
            __builtin_amdgcn_fence(__ATOMIC_RELEASE, "agent");
            asm volatile("s_waitcnt vmcnt(0)" ::: "memory");
            const unsigned og = xb_add(&bar[XB_TOP], 1u);
            const unsigned tg = og / nx;
            if (og + 1u == (tg + 1u) * nx) xb_add(&bar[XB_TOPGEN], 1u);
            else XB_SPIN(xb_ld(&bar[XB_TOPGEN]) == tg, bar);
            __builtin_amdgcn_fence(__ATOMIC_ACQUIRE, "agent");
            xb_add(&bar[XB_XGEN(b.x)], 1u);
            asm volatile("s_waitcnt vmcnt(0)" ::: "memory");
        } else {
            XB_SPIN(xb_ld(&bar[XB_XGEN(b.x)]) == gen, bar);
            __builtin_amdgcn_fence(__ATOMIC_ACQUIRE, "agent");
            asm volatile("s_waitcnt vmcnt(0)" ::: "memory");
        }
    }
    __syncthreads();
}

namespace pg8 {
#define PG8_LAS __attribute__((address_space(3)))
typedef unsigned short bf16_t;
typedef short bf16x8 __attribute__((ext_vector_type(8)));
typedef float f32x4 __attribute__((ext_vector_type(4)));
typedef unsigned u32x4 __attribute__((ext_vector_type(4)));
constexpr int BM = 256, BK = 64, HALF = 128, HTB = HALF * BK * 2  , STAGE_BYTES = 8 * HTB, NXCD = 8, WGM = 8;

__host__ __device__ __forceinline__ int lds_byte(int r, int c) { const int st = (r >> 4) * 2 + (c >> 5), rr = r & 15, cc = c & 31, ob = rr * 64 + cc * 2; return st * 1024 + (ob ^ (((ob >> 9) & 1) << 5)); }
__host__ __device__ __forceinline__ void stage_rc(int b, int& R, int& C) { const int st = b / 1024, sb = b % 1024, swz = sb ^ (((sb >> 9) & 1) << 5); R = (st >> 1) * 16 + swz / 64; C = (st & 1) * 32 + (swz % 64) / 2; }
__host__ __device__ __forceinline__ int perm32(int rho) { const int n = rho >> 4, i = rho & 15; return 8 * (i >> 2) + 4 * n + (i & 3); }

struct Unit { int pm, pn; };
struct Gemm { const bf16_t* A; const bf16_t* Bt; int M, N, K; };

struct StaticOrder {
    int nM, nN, nwg, G, c;
    __host__ __device__ void init(int M, int N, int G_, int c_) { nM = M / BM; nN = N / BM; nwg = nM * nN; G = G_; c = c_; }
    __host__ __device__ bool next(int i, Unit& u) const {
        const long L = (long)i * G + c; if (L >= nwg) return false;
        int wgid = (int)L; { const int q = nwg / NXCD, r = nwg % NXCD, xcd = wgid % NXCD, off = wgid / NXCD; wgid = (xcd < r ? xcd * (q + 1) : r * (q + 1) + (xcd - r) * q) + off; }
        const int nig = WGM * nN, gid = wgid / nig, fm = gid * WGM, gsz = (nM - fm) < WGM ? (nM - fm) : WGM;
        u.pm = fm + ((wgid % nig) % gsz); u.pn = (wgid % nig) / gsz; return true;
    }
    __device__ __forceinline__ void a_ready(const Unit&) const {}
    __device__ __forceinline__ void done(const Unit&) const {}
};

__device__ __forceinline__ unsigned cvt_pk_bf16(float lo, float hi) { unsigned r; asm volatile("v_cvt_pk_bf16_f32 %0, %1, %2" : "=v"(r) : "v"(lo), "v"(hi)); return r; }
typedef float f32x2 __attribute__((ext_vector_type(2)));
__device__ __forceinline__ f32x2 gelu_pk(f32x2 v) {
    const f32x2 av = __builtin_elementwise_abs(v), d = av * 0.2316418882f + 1.0f;
    f32x2 t; t.x = __builtin_amdgcn_rcpf(d.x); t.y = __builtin_amdgcn_rcpf(d.y);
    f32x2 q = t * 0.5307027145f + (-0.7265760135f); q = q * t + 0.7107068705f; q = q * t + (-0.142248368f); q = q * t + 0.127414796f; q = q * t;
    const f32x2 s = (v * v) * (-0.72134752044f);
    f32x2 e; e.x = __builtin_amdgcn_exp2f(s.x); e.y = __builtin_amdgcn_exp2f(s.y);
    const f32x2 m = v * (q * e), r = v - m;
    f32x2 o; o.x = v.x < 0.f ? m.x : r.x; o.y = v.y < 0.f ? m.y : r.y; return o;
}

template <int ACT  > struct EpiBf16 {
    static constexpr bool PERM = true, AFTER_DRAIN = false; static_assert(ACT == 0 || ACT == 1, "EpiBf16: ACT is 0 (none) or 1 (gelu_pk)");
    bf16_t* O; int ldc; const float* bias; int split_cols; size_t split_stride; float scale0;
    __device__ __forceinline__ void operator()(const f32x4 (&acc)[2][2][4][2], const Unit& u, int wr, int wc, int fr, int fq) const {
        const int row0 = u.pm * BM + wr * 64 + fr; int colt = u.pn * BM; bf16_t* base = O;
        float sc = 1.f; if (split_cols) { const int t = colt / split_cols; base += (size_t)t * split_stride; colt -= t * split_cols; if (t == 0) sc = scale0; }
        const int col0 = colt + wc * 32 + 8 * fq, bcol0 = u.pn * BM + wc * 32 + 8 * fq;
        f32x4 bv[2][2];
#pragma unroll
        for (int bj = 0; bj < 2; ++bj)
#pragma unroll
            for (int n = 0; n < 2; ++n) bv[bj][n] = bias ? *(const f32x4*)(bias + bcol0 + bj * HALF + 4 * n) : (f32x4){0.f, 0.f, 0.f, 0.f};
#pragma unroll
        for (int ai = 0; ai < 2; ++ai)
#pragma unroll
            for (int m = 0; m < 4; ++m) { bf16_t* rowp = base + (size_t)(row0 + ai * HALF + m * 16) * ldc + col0;
#pragma unroll
                for (int bj = 0; bj < 2; ++bj) { f32x4 v0 = acc[ai][bj][m][0] + bv[bj][0], v1 = acc[ai][bj][m][1] + bv[bj][1];
                    if (ACT == 1) { f32x2 a = gelu_pk((f32x2){v0[0], v0[1]}), b = gelu_pk((f32x2){v0[2], v0[3]}), c = gelu_pk((f32x2){v1[0], v1[1]}), d = gelu_pk((f32x2){v1[2], v1[3]});
                        v0 = (f32x4){a.x, a.y, b.x, b.y}; v1 = (f32x4){c.x, c.y, d.x, d.y}; }
                    v0 = v0 * sc; v1 = v1 * sc; u32x4 w; w.x = cvt_pk_bf16(v0[0], v0[1]); w.y = cvt_pk_bf16(v0[2], v0[3]); w.z = cvt_pk_bf16(v1[0], v1[1]); w.w = cvt_pk_bf16(v1[2], v1[3]);
                    *(u32x4*)(rowp + bj * HALF) = w; } }
    }
};

struct EpiProj {
    static constexpr bool PERM = true, AFTER_DRAIN = false;
    bf16_t* O; size_t split_stride; float scale0; float* gates;
    __device__ __forceinline__ void operator()(const f32x4 (&acc)[2][2][4][2], const Unit& u, int wr, int wc, int fr, int fq) const {
        const int row0 = u.pm * BM + wr * 64 + fr;
        if (u.pn == 14) {
            if (wc == 0 && fq == 0) {
#pragma unroll
                for (int ai = 0; ai < 2; ++ai)
#pragma unroll
                    for (int m = 0; m < 4; ++m) { float* g = gates + (size_t)(row0 + ai * HALF + m * 16) * 8; *(f32x4*)g = acc[ai][0][m][0]; *(f32x4*)(g + 4) = acc[ai][0][m][1]; }
            }
            return;
        }
        int colt = u.pn * BM; const int t = colt / 512; bf16_t* base = O + (size_t)t * split_stride; colt -= t * 512; const float sc = (t == 0) ? scale0 : 1.f;
        const int col0 = colt + wc * 32 + 8 * fq;
#pragma unroll
        for (int ai = 0; ai < 2; ++ai)
#pragma unroll
            for (int m = 0; m < 4; ++m) { bf16_t* rowp = base + (size_t)(row0 + ai * HALF + m * 16) * 512 + col0;
#pragma unroll
                for (int bj = 0; bj < 2; ++bj) { const f32x4 v0 = acc[ai][bj][m][0] * sc, v1 = acc[ai][bj][m][1] * sc;
                    u32x4 w; w.x = cvt_pk_bf16(v0[0], v0[1]); w.y = cvt_pk_bf16(v0[2], v0[3]); w.z = cvt_pk_bf16(v1[0], v1[1]); w.w = cvt_pk_bf16(v1[2], v1[3]);
                    *(u32x4*)(rowp + bj * HALF) = w; } }
    }
};
struct EpiResF32 {
    static constexpr bool PERM = false, AFTER_DRAIN = false;
    const float* base; float* out; int ldc;
    __device__ __forceinline__ void operator()(const f32x4 (&acc)[2][2][4][2], const Unit& u, int wr, int wc, int fr, int fq) const {
        const int row0 = u.pm * BM + wr * 64 + fr, col0 = u.pn * BM + wc * 32 + 4 * fq;
#pragma unroll
        for (int ai = 0; ai < 2; ++ai)
#pragma unroll
            for (int m = 0; m < 4; ++m) { const size_t off = (size_t)(row0 + ai * HALF + m * 16) * ldc + col0;
#pragma unroll
                for (int bj = 0; bj < 2; ++bj)
#pragma unroll
                    for (int n = 0; n < 2; ++n) { const size_t o = off + bj * HALF + n * 16; *(f32x4*)(out + o) = *(const f32x4*)(base + o) + acc[ai][bj][m][n]; } }
    }
};
struct EpiResX1 {
    static constexpr bool PERM = false, AFTER_DRAIN = false;
    const float* base; float* out; bf16_t* xg; float* rs; int ldc;
    __device__ __forceinline__ void operator()(const f32x4 (&acc)[2][2][4][2], const Unit& u, int wr, int wc, int fr, int fq) const {
        const int row0 = u.pm * BM + wr * 64 + fr, col0 = u.pn * BM + wc * 32 + 4 * fq;
#pragma unroll
        for (int ai = 0; ai < 2; ++ai)
#pragma unroll
            for (int m = 0; m < 4; ++m) { const int row = row0 + ai * HALF + m * 16; const size_t off = (size_t)row * ldc + col0; float ss = 0.f;
#pragma unroll
                for (int bj = 0; bj < 2; ++bj)
#pragma unroll
                    for (int n = 0; n < 2; ++n) { const size_t o = off + bj * HALF + n * 16; const f32x4 v = *(const f32x4*)(base + o) + acc[ai][bj][m][n]; *(f32x4*)(out + o) = v;
                        ss += (v[0] * v[0] + v[1] * v[1]) + (v[2] * v[2] + v[3] * v[3]);
                        typedef unsigned u32x2 __attribute__((ext_vector_type(2))); u32x2 pk; pk.x = cvt_pk_bf16(v[0], v[1]); pk.y = cvt_pk_bf16(v[2], v[3]); *(u32x2*)(xg + o) = pk; }
                ss += __shfl_xor(ss, 16); ss += __shfl_xor(ss, 32);
                if (fq == 0) rs[(size_t)row * 16 + u.pn * 4 + wc] = ss; }
    }
};
struct EpiSigBf16 {
    static constexpr bool PERM = true, AFTER_DRAIN = false;
    bf16_t* O; int ldc;
    __device__ __forceinline__ void operator()(const f32x4 (&acc)[2][2][4][2], const Unit& u, int wr, int wc, int fr, int fq) const {
        const int row0 = u.pm * BM + wr * 64 + fr, col0 = u.pn * BM + wc * 32 + 8 * fq;
#pragma unroll
        for (int ai = 0; ai < 2; ++ai)
#pragma unroll
            for (int m = 0; m < 4; ++m) { bf16_t* rowp = O + (size_t)(row0 + ai * HALF + m * 16) * ldc + col0;
#pragma unroll
                for (int bj = 0; bj < 2; ++bj) { f32x4 v0 = acc[ai][bj][m][0], v1 = acc[ai][bj][m][1];
#pragma unroll
                    for (int i = 0; i < 4; ++i) { v0[i] = 1.f / (1.f + __expf(-v0[i])); v1[i] = 1.f / (1.f + __expf(-v1[i])); }
                    u32x4 w; w.x = cvt_pk_bf16(v0[0], v0[1]); w.y = cvt_pk_bf16(v0[2], v0[3]); w.z = cvt_pk_bf16(v1[0], v1[1]); w.w = cvt_pk_bf16(v1[2], v1[3]);
                    *(u32x4*)(rowp + bj * HALF) = w; } }
    }
};
struct EpiGateFinal {
    static constexpr bool PERM = false, AFTER_DRAIN = false;
    const bf16_t* P; float* out; int ldc;
    __device__ __forceinline__ void operator()(const f32x4 (&acc)[2][2][4][2], const Unit& u, int wr, int wc, int fr, int fq) const {
        const int row0 = u.pm * BM + wr * 64 + fr, col0 = u.pn * BM + wc * 32 + 4 * fq;
#pragma unroll
        for (int ai = 0; ai < 2; ++ai)
#pragma unroll
            for (int m = 0; m < 4; ++m) { const size_t off = (size_t)(row0 + ai * HALF + m * 16) * ldc + col0;
#pragma unroll
                for (int bj = 0; bj < 2; ++bj)
#pragma unroll
                    for (int n = 0; n < 2; ++n) { const size_t o = off + bj * HALF + n * 16;
                        typedef unsigned u32x2 __attribute__((ext_vector_type(2))); const u32x2 g = *(const u32x2*)(P + o);
                        f32x4 pv; pv[0] = __uint_as_float(g.x << 16); pv[1] = __uint_as_float(g.x & 0xffff0000u); pv[2] = __uint_as_float(g.y << 16); pv[3] = __uint_as_float(g.y & 0xffff0000u);
                        f32x4 sg = acc[ai][bj][m][n];
#pragma unroll
                        for (int i = 0; i < 4; ++i) sg[i] = 1.f / (1.f + __expf(-sg[i]));
                        *(f32x4*)(out + o) = *(const f32x4*)(out + o) + sg * pv; } }
    }
};
struct EpiGateAcc {
    static constexpr bool PERM = false, AFTER_DRAIN = false;
    const bf16_t* G; float* out; int ldc;
    __device__ __forceinline__ void operator()(const f32x4 (&acc)[2][2][4][2], const Unit& u, int wr, int wc, int fr, int fq) const {
        const int row0 = u.pm * BM + wr * 64 + fr, col0 = u.pn * BM + wc * 32 + 4 * fq;
#pragma unroll
        for (int ai = 0; ai < 2; ++ai)
#pragma unroll
            for (int m = 0; m < 4; ++m) { const size_t off = (size_t)(row0 + ai * HALF + m * 16) * ldc + col0;
#pragma unroll
                for (int bj = 0; bj < 2; ++bj)
#pragma unroll
                    for (int n = 0; n < 2; ++n) { const size_t o = off + bj * HALF + n * 16;
                        typedef unsigned u32x2 __attribute__((ext_vector_type(2))); const u32x2 g = *(const u32x2*)(G + o);
                        f32x4 gv; gv[0] = __uint_as_float(g.x << 16); gv[1] = __uint_as_float(g.x & 0xffff0000u); gv[2] = __uint_as_float(g.y << 16); gv[3] = __uint_as_float(g.y & 0xffff0000u);
                        *(f32x4*)(out + o) = *(const f32x4*)(out + o) + gv * acc[ai][bj][m][n]; } }
    }
};
template <class Epi, class Sched, bool ALIGN_EPI = false, bool SP2 = false>
__device__ __forceinline__ void gemm_phase(PG8_LAS unsigned char* lds, const Gemm g, const Sched& S, const Epi& E) {
    const int tid = tidx(), wid = __builtin_amdgcn_readfirstlane(tid >> 6), lane = tid & 63, wr = wid >> 2, wc = wid & 3, fr = lane & 15, fq = lane >> 4;
    const int K = g.K, nt = K / BK;
    unsigned voffA[2], voffB[2];
#pragma unroll
    for (int i = 0; i < 2; ++i) { int R, C; stage_rc(tid * 16 + i * 8192, R, C); const int Rb = Epi::PERM ? ((R & ~31) + perm32(R & 31)) : R;
        voffA[i] = (unsigned)(R * K + C) * 2u; voffB[i] = (unsigned)(Rb * K + C) * 2u; }
    const size_t kstep = (size_t)(BK * 2);
    const size_t hstep = (size_t)HALF * K * 2;
    const size_t tstep = 2 * hstep;
    const unsigned ldsw = (unsigned)wid * 1024u;
    const int aoff = lds_byte(wr * 64 + fr, fq * 8), boff = lds_byte(wc * 32 + fr, fq * 8);
#define PG8_SA(b, h) (((b) * 2 + (h)) * HTB)
#define PG8_SB(b, h) ((4 + (b) * 2 + (h)) * HTB)
#define PG8_STAGE(bufoff, gbase, voff) do { _Pragma("unroll") for (int _i = 0; _i < 2; ++_i) \
        __builtin_amdgcn_global_load_lds((const unsigned*)((const char*)(gbase) + (voff)[_i]), (PG8_LAS unsigned*)(lds + (bufoff) + ldsw + _i * 8192), 16, 0, 0); } while (0)
#define PG8_LDA(dst, b, h) do { _Pragma("unroll") for (int m = 0; m < 4; ++m) _Pragma("unroll") for (int k = 0; k < 2; ++k) dst[m][k] = *(const PG8_LAS bf16x8*)(lds + PG8_SA(b, h) + aoff + m * 2048 + k * 1024); } while (0)
#define PG8_LDB(dst, b, h) do { _Pragma("unroll") for (int n = 0; n < 2; ++n) _Pragma("unroll") for (int k = 0; k < 2; ++k) dst[n][k] = *(const PG8_LAS bf16x8*)(lds + PG8_SB(b, h) + boff + n * 2048 + k * 1024); } while (0)
#define PG8_MMA(ai, bj, At, Bt) do { __builtin_amdgcn_s_setprio(1); _Pragma("unroll") for (int m = 0; m < 4; ++m) _Pragma("unroll") for (int n = 0; n < 2; ++n) _Pragma("unroll") for (int k = 0; k < 2; ++k) \
        acc[ai][bj][m][n] = __builtin_amdgcn_mfma_f32_16x16x32_bf16(Bt[n][k], At[m][k], acc[ai][bj][m][n], 0, 0, 0); __builtin_amdgcn_s_setprio(0); } while (0)
#define PG8_WAIT_V(n) asm volatile("s_waitcnt vmcnt(" #n ")" ::: "memory")
#define PG8_WAIT_L(n) asm volatile("s_waitcnt lgkmcnt(" #n ")" ::: "memory")
#define PG8_BAR __builtin_amdgcn_s_barrier()
#define PG8_SCHED __builtin_amdgcn_sched_barrier(0)
    Unit cur, nxt; int ui = 0;
    if (!S.next(0, cur)) return;
    f32x4 acc[2][2][4][2];
#pragma unroll
    for (int a = 0; a < 2; ++a)
#pragma unroll
        for (int b = 0; b < 2; ++b)
#pragma unroll
            for (int m = 0; m < 4; ++m)
#pragma unroll
                for (int n = 0; n < 2; ++n) acc[a][b][m][n] = (f32x4){0.f, 0.f, 0.f, 0.f};
    bf16x8 At[4][2], B0[2][2], B1[2][2];
    const char* cA = (const char*)g.A + (size_t)cur.pm * tstep; const char* cB = (const char*)g.Bt + (size_t)cur.pn * tstep;
    S.a_ready(cur);
    if constexpr (SP2) {
        PG8_STAGE(PG8_SB(0, 0), cB, voffB); PG8_STAGE(PG8_SB(0, 1), cB + hstep, voffB); PG8_STAGE(PG8_SA(0, 0), cA, voffA); PG8_STAGE(PG8_SA(0, 1), cA + hstep, voffA);
        if (wr == 1) PG8_BAR;
        PG8_WAIT_V(2); PG8_BAR;
        PG8_STAGE(PG8_SB(1, 0), cB + kstep, voffB); PG8_STAGE(PG8_SA(1, 0), cA + kstep, voffA); PG8_STAGE(PG8_SB(1, 1), cB + hstep + kstep, voffB);
        PG8_WAIT_V(6); PG8_BAR;
    } else {
        PG8_STAGE(PG8_SB(0, 0), cB, voffB); PG8_STAGE(PG8_SA(0, 0), cA, voffA); PG8_STAGE(PG8_SB(0, 1), cB + hstep, voffB); PG8_STAGE(PG8_SA(0, 1), cA + hstep, voffA);
        if (wr == 1) PG8_BAR;
        PG8_WAIT_V(4); PG8_BAR;
        PG8_STAGE(PG8_SB(1, 0), cB + kstep, voffB); PG8_STAGE(PG8_SA(1, 0), cA + kstep, voffA); PG8_STAGE(PG8_SB(1, 1), cB + hstep + kstep, voffB);
        PG8_WAIT_V(6); PG8_BAR;
    }
    for (;;) {
        const bool has_next = S.next(ui + 1, nxt);
        const char* nA = has_next ? (const char*)g.A + (size_t)nxt.pm * tstep : cA; const char* nB = has_next ? (const char*)g.Bt + (size_t)nxt.pn * tstep : cB;
        for (int t = 0; t < nt; t += 2) {
            const bool last = (t == nt - 2);
            const char* a1 = cA + (size_t)(t + 1) * kstep;
            const char* a2 = last ? nA : cA + (size_t)(t + 2) * kstep; const char* b2 = last ? nB : cB + (size_t)(t + 2) * kstep;
            const char* a3 = a2 + kstep; const char* b3 = b2 + kstep;
            if (last && has_next) S.a_ready(nxt);
            if constexpr (SP2) {
            PG8_LDB(B0, 0, 0); PG8_LDB(B1, 0, 1); PG8_SCHED; PG8_LDA(At, 0, 0); PG8_STAGE(PG8_SA(1, 1), a1 + hstep, voffA);
            PG8_WAIT_V(8); PG8_WAIT_L(0); PG8_BAR; PG8_MMA(0, 0, At, B0); PG8_MMA(0, 1, At, B1); PG8_BAR; PG8_SCHED;
            PG8_LDA(At, 0, 1); PG8_STAGE(PG8_SB(0, 0), b2, voffB); PG8_STAGE(PG8_SB(0, 1), b2 + hstep, voffB); PG8_STAGE(PG8_SA(0, 0), a2, voffA);
            PG8_WAIT_V(8); PG8_WAIT_L(0); PG8_BAR; PG8_MMA(1, 0, At, B0); PG8_MMA(1, 1, At, B1); PG8_BAR; PG8_SCHED;
            PG8_LDB(B0, 1, 0); PG8_LDB(B1, 1, 1); PG8_SCHED; PG8_LDA(At, 1, 0); PG8_STAGE(PG8_SA(0, 1), a2 + hstep, voffA);
            PG8_WAIT_V(8); PG8_WAIT_L(0); PG8_BAR; PG8_MMA(0, 0, At, B0); PG8_MMA(0, 1, At, B1); PG8_BAR; PG8_SCHED;
            PG8_LDA(At, 1, 1); PG8_STAGE(PG8_SB(1, 0), b3, voffB); PG8_STAGE(PG8_SB(1, 1), b3 + hstep, voffB); PG8_STAGE(PG8_SA(1, 0), a3, voffA);
            PG8_WAIT_V(8); PG8_WAIT_L(0); PG8_BAR; PG8_MMA(1, 0, At, B0); PG8_MMA(1, 1, At, B1); PG8_BAR; PG8_SCHED;
            } else {
            PG8_LDB(B0, 0, 0); PG8_SCHED; PG8_LDA(At, 0, 0); PG8_STAGE(PG8_SA(1, 1), a1 + hstep, voffA);
            PG8_WAIT_L(8); PG8_BAR; PG8_WAIT_L(0); PG8_MMA(0, 0, At, B0); PG8_BAR; PG8_SCHED;
            PG8_LDB(B1, 0, 1); PG8_STAGE(PG8_SB(0, 0), b2, voffB);
            PG8_BAR; PG8_WAIT_L(0); PG8_MMA(0, 1, At, B1); PG8_BAR;
            PG8_LDA(At, 0, 1); PG8_STAGE(PG8_SA(0, 0), a2, voffA);
            PG8_BAR; PG8_WAIT_L(0); PG8_MMA(1, 0, At, B0); PG8_BAR; PG8_SCHED;
            PG8_STAGE(PG8_SB(0, 1), b2 + hstep, voffB);
            PG8_WAIT_V(6); PG8_BAR; PG8_MMA(1, 1, At, B1); PG8_BAR;
            PG8_LDB(B0, 1, 0); PG8_SCHED; PG8_LDA(At, 1, 0); PG8_STAGE(PG8_SA(0, 1), a2 + hstep, voffA);
            PG8_WAIT_L(8); PG8_BAR; PG8_WAIT_L(0); PG8_MMA(0, 0, At, B0); PG8_BAR; PG8_SCHED;
            PG8_LDB(B1, 1, 1); PG8_STAGE(PG8_SB(1, 0), b3, voffB);
            PG8_BAR; PG8_WAIT_L(0); PG8_MMA(0, 1, At, B1); PG8_BAR;
            PG8_LDA(At, 1, 1); PG8_STAGE(PG8_SA(1, 0), a3, voffA);
            PG8_BAR; PG8_WAIT_L(0); PG8_MMA(1, 0, At, B0); PG8_BAR; PG8_SCHED;
            PG8_STAGE(PG8_SB(1, 1), b3 + hstep, voffB);
            PG8_WAIT_V(6); PG8_BAR; PG8_MMA(1, 1, At, B1); PG8_BAR;
            }
        }
        if constexpr (ALIGN_EPI) { if (wr == 0) PG8_BAR; }
        if constexpr (!Epi::AFTER_DRAIN) { E(acc, cur, wr, wc, fr, fq); S.done(cur); }
        if (!has_next) break;
#pragma unroll
        for (int a = 0; a < 2; ++a)
#pragma unroll
            for (int b = 0; b < 2; ++b)
#pragma unroll
                for (int m = 0; m < 4; ++m)
#pragma unroll
                    for (int n = 0; n < 2; ++n) acc[a][b][m][n] = (f32x4){0.f, 0.f, 0.f, 0.f};
        cur = nxt; cA = nA; cB = nB; ++ui;
        if constexpr (ALIGN_EPI) { if (wr == 1) PG8_BAR; }
    }
    PG8_WAIT_V(0);
    if constexpr (!ALIGN_EPI) { if (wr == 0) PG8_BAR; }
    PG8_BAR;
    if constexpr (Epi::AFTER_DRAIN) { E.fused(acc, cur, wr, wc, fr, fq, lds, wid, lane); S.done(cur); }
#undef PG8_SA
#undef PG8_SB
#undef PG8_STAGE
#undef PG8_LDA
#undef PG8_LDB
#undef PG8_MMA
#undef PG8_WAIT_V
#undef PG8_WAIT_L
#undef PG8_BAR
#undef PG8_SCHED
}
}

#include <hip/hip_bf16.h>
#include <cmath>
namespace attn_body {
using bf16=__hip_bfloat16;
using bf16x8=__attribute__((ext_vector_type(8)))short;
using s16x4=__attribute__((ext_vector_type(4)))short;
using f32x16=__attribute__((ext_vector_type(16)))float;
using u32x4=__attribute__((ext_vector_type(4)))unsigned;
constexpr int SEQ=16384,D=64,DM=512;
constexpr int NW=8,QBLK=32,QB=QBLK*NW,KVBLK=64,NQB=SEQ/QB;
constexpr int ATTN_PITCH=DM, ATTN_UNIT_ROWS=QB;
__device__ __forceinline__ int crow(int r,int hi){return (r&3)+8*(r>>2)+4*hi;}
#define SBAR() __builtin_amdgcn_sched_barrier(0)
__device__ __forceinline__ void cmask(f32x16&p0,f32x16&p1,int jb,int qrel,int hi){
  const float NEG=-INFINITY; int kb=64*jb+4*hi;
  #pragma unroll
  for(int r=0;r<16;++r){int kv=kb+(r&3)+8*(r>>2); if(kv>qrel)p0[r]=NEG; if(kv+32>qrel)p1[r]=NEG;}
}

constexpr int NSLOT=3, SLOTB=8192;
constexpr int LDS_K=0, LDS_V=NSLOT*SLOTB, LDS_WS=2*NSLOT*SLOTB, LDS_OST=LDS_WS+NW*64*4, LDS_BYTES=LDS_OST+NW*4096;
constexpr float C2=0.125f*1.4426950408889634f;
__device__ __forceinline__ void glds16(const void*gsrc,unsigned lds_dst){unsigned keep;
  asm volatile("s_mov_b32 %0, m0\n\ts_mov_b32 m0, %2\n\ts_nop 0\n\tglobal_load_lds_dwordx4 %1, off\n\ts_mov_b32 m0, %0":"=&s"(keep):"v"(gsrc),"s"(lds_dst):"memory");}
__device__ __forceinline__ float max3f(float a,float b,float c){float r;asm("v_max3_f32 %0, %1, %2, %3":"=v"(r):"v"(a),"v"(b),"v"(c));return r;}
__device__ __forceinline__ float max2f(float a,float b){float r;asm("v_max_f32_e32 %0, %1, %2":"=v"(r):"v"(a),"v"(b));return r;}
__device__ __forceinline__ float fadd_s(float a,float b){float r;asm("v_add_f32_e32 %0, %1, %2":"=v"(r):"v"(a),"v"(b));return r;}
__device__ __forceinline__ float fsub_s(float a,float b){float r;asm("v_sub_f32_e32 %0, %1, %2":"=v"(r):"v"(a),"v"(b));return r;}
typedef float f32x2_t __attribute__((ext_vector_type(2))); typedef __bf16 bf16x2_t __attribute__((ext_vector_type(2)));
__device__ __forceinline__ unsigned cvtpk_s(float lo,float hi){f32x2_t v={lo,hi};bf16x2_t b=__builtin_convertvector(v,bf16x2_t);return __builtin_bit_cast(unsigned,b);}
#define WAIT_BAR(N) asm volatile("s_waitcnt vmcnt(" #N ") lgkmcnt(0)\n\ts_barrier":::"memory")

__device__ __forceinline__ void qkt(f32x16&p0,f32x16&p1,const char*Kslot,const bf16x8*qr,int r32,int hi){
  const char*kb=Kslot+hi*1024+r32*16;
  #pragma unroll
  for(int d0=0;d0<4;++d0){
    const bf16x8 b0=*reinterpret_cast<const bf16x8*>(kb+d0*2048);
    const bf16x8 b1=*reinterpret_cast<const bf16x8*>(kb+d0*2048+512);
    p0=__builtin_amdgcn_mfma_f32_32x32x16_bf16(b0,qr[d0],p0,0,0,0);p1=__builtin_amdgcn_mfma_f32_32x32x16_bf16(b1,qr[d0],p1,0,0,0);}
}
typedef __attribute__((address_space(3))) const char* lds_cptr;
typedef short v4i16_t __attribute__((ext_vector_type(4)));
__device__ __forceinline__ void kload8(bf16x8*kf,lds_cptr kp){
  kf[0]=*(const __attribute__((address_space(3))) bf16x8*)(kp);      kf[1]=*(const __attribute__((address_space(3))) bf16x8*)(kp+512);
  kf[2]=*(const __attribute__((address_space(3))) bf16x8*)(kp+2048); kf[3]=*(const __attribute__((address_space(3))) bf16x8*)(kp+2560);
  kf[4]=*(const __attribute__((address_space(3))) bf16x8*)(kp+4096); kf[5]=*(const __attribute__((address_space(3))) bf16x8*)(kp+4608);
  kf[6]=*(const __attribute__((address_space(3))) bf16x8*)(kp+6144); kf[7]=*(const __attribute__((address_space(3))) bf16x8*)(kp+6656);
}
__device__ __forceinline__ void kload2(bf16x8*kf,lds_cptr kp,int j){ kf[2*j]=*(const __attribute__((address_space(3))) bf16x8*)(kp+j*2048); kf[2*j+1]=*(const __attribute__((address_space(3))) bf16x8*)(kp+j*2048+512); }
__device__ __forceinline__ s16x4 vtr(lds_cptr p){ return __builtin_bit_cast(s16x4,__builtin_amdgcn_ds_read_tr16_b64_v4i16((__attribute__((address_space(3))) v4i16_t*)p)); }
__device__ __forceinline__ float rowmax(const f32x16&p0,const f32x16&p1){
  float a=max3f(p0[0],p0[1],p1[0]),b=max3f(p0[2],p0[3],p1[1]);a=max3f(a,p1[2],p1[3]);
  #pragma unroll
  for(int r=4;r<16;r+=4){a=max3f(a,p0[r],p0[r+1]);b=max3f(b,p0[r+2],p0[r+3]);a=max3f(a,p1[r],p1[r+1]);b=max3f(b,p1[r+2],p1[r+3]);}
  const float m=max2f(a,b);
  auto rr=__builtin_amdgcn_permlane32_swap(__float_as_uint(m),__float_as_uint(m),false,false);
  return max2f(__uint_as_float(rr[0]),__uint_as_float(rr[1]));
}
__device__ __forceinline__ void pv(f32x16*o,int vb,bf16x8 pa0,bf16x8 pa1,bf16x8 pa2,bf16x8 pa3){
  #pragma unroll
  for(int d0=0;d0<2;++d0){s16x4 lo[4],hi[4];
    #pragma unroll
    for(int ks=0;ks<4;++ks){
      asm volatile("ds_read_b64_tr_b16 %0,%1 offset:%c2":"=&v"(lo[ks]):"v"(vb),"i"(d0*4096+ks*1024):"memory");
      asm volatile("ds_read_b64_tr_b16 %0,%1 offset:%c2":"=&v"(hi[ks]):"v"(vb),"i"(d0*4096+ks*1024+512):"memory");}
    asm volatile("s_waitcnt lgkmcnt(0)":::"memory");SBAR();
    #define PK(k) (bf16x8){lo[k][0],lo[k][1],lo[k][2],lo[k][3],hi[k][0],hi[k][1],hi[k][2],hi[k][3]}
    o[d0]=__builtin_amdgcn_mfma_f32_32x32x16_bf16(pa0,PK(0),o[d0],0,0,0);
    o[d0]=__builtin_amdgcn_mfma_f32_32x32x16_bf16(pa1,PK(1),o[d0],0,0,0);
    o[d0]=__builtin_amdgcn_mfma_f32_32x32x16_bf16(pa2,PK(2),o[d0],0,0,0);
    o[d0]=__builtin_amdgcn_mfma_f32_32x32x16_bf16(pa3,PK(3),o[d0],0,0,0);
    #undef PK
  }
}

#ifndef ATTN_STORE16
#define ATTN_STORE16(p,v) (*(u32x4*)(p)=(v))
#endif
template<int THRL> __device__ __forceinline__ void attn_unit(int qb,int t0,float slope2,const bf16*Q,const bf16*__restrict__ K,const bf16*__restrict__ V,bf16*O,char*shm){
  int tid_=tidx(); asm volatile("":"+v"(tid_));
  const int tid=tid_,lane=tid&63,r32=lane&31,hi=lane>>5; const int wid=__builtin_amdgcn_readfirstlane(tid>>6);
  const int q0=qb*QB;
  const bf16*Qw=Q+(long)(q0+wid*QBLK)*DM;
  const bf16*Kh=K+(long)t0*KVBLK*DM,*Vh=V+(long)t0*KVBLK*DM;
  const unsigned lds0=(unsigned)(uintptr_t)shm;
  float*wsf=(float*)(shm+LDS_WS)+wid*64;
  const bf16*ksrc=Kh+(long)lane*DM+wid*8;
  const bf16*vsrc=Vh+(long)(16*(wid&3)+(lane>>2))*DM+(wid>>2)*32+(lane&3)*8;
  const unsigned kdst=lds0+LDS_K+wid*1024, vdst=lds0+LDS_V+wid*1024;
  #define DMA_K(t,slot) glds16(ksrc+(long)(t)*KVBLK*DM,(unsigned)__builtin_amdgcn_readfirstlane(kdst+(slot)))
  #define DMA_V(t,slot) glds16(vsrc+(long)(t)*KVBLK*DM,(unsigned)__builtin_amdgcn_readfirstlane(vdst+(slot)))
  const int vb0=(int)(lds0+LDS_V)+((lane>>4)&1)*32+(lane&3)*8+(4*hi+((lane&15)>>2))*64;
  const char*Kbase=shm+LDS_K; bf16x8 kf[8];
  const lds_cptr shm3=(lds_cptr)shm; const lds_cptr kp0=shm3+LDS_K+hi*1024+r32*16; const lds_cptr vp0=shm3+LDS_V+((lane>>4)&1)*32+(lane&3)*8+(4*hi+((lane&15)>>2))*64;
  const int NT=(q0+QB)/KVBLK-t0;
  DMA_K(0,0);DMA_V(0,0);DMA_K(1,SLOTB);
  bf16x8 qr[4];
  #pragma unroll
  for(int d0=0;d0<4;++d0)qr[d0]=*reinterpret_cast<const bf16x8*>(&Qw[(long)r32*DM+d0*16+hi*8]);
  float mhat=0.f,l_reg=0.f;f32x16 o[2];o[0]=f32x16{};o[1]=f32x16{};
  #define CINIT(C0_,C1_,t_) do{ float s2_=slope2; asm volatile("":"+v"(s2_));   \
      const float bt_=fmaf(s2_,(float)(64*(t_)+4*hi),-mhat); const float bu_=fmaf(s2_,32.f,bt_); \
      _Pragma("unroll") for(int r=0;r<16;++r){ C0_[r]=fmaf(s2_,(float)((r&3)+8*(r>>2)),bt_); C1_[r]=fmaf(s2_,(float)((r&3)+8*(r>>2)),bu_); } }while(0)
  const int qrel=wid*QBLK+r32;
  #define CMASK(P0,P1,t) do{int jb_=(t)-(NT-4); if(jb_>=0)cmask(P0,P1,jb_,qrel,hi);}while(0)
  bool resc=false;
  #define START(P0,P1) do{ const float rm=rowmax(P0,P1); resc=false; \
    { const float dl=rm; mhat=fadd_s(mhat,dl); \
      _Pragma("unroll") for(int r=0;r<16;++r){P0[r]=fsub_s(P0[r],dl);P1[r]=fsub_s(P1[r],dl);} } \
    _Pragma("unroll") for(int r=0;r<16;++r)P0[r]=__builtin_amdgcn_exp2f(P0[r]); }while(0)
  #define RESC() do{ if(resc){ asm volatile("s_waitcnt lgkmcnt(0)":::"memory"); \
      _Pragma("unroll") for(int d_=0;d_<2;++d_) _Pragma("unroll") for(int r=0;r<16;++r)o[d_][r]*=wsf[crow(r,hi)]; } }while(0)
  f32x16 pA0,pA1,pB0,pB1;
  int sl_prev=0,sl_cur=0,sl_next=SLOTB;
  #define ROT() do{sl_prev=sl_cur;sl_cur=sl_next;sl_next=(sl_next==(NSLOT-1)*SLOTB)?0:sl_next+SLOTB;}while(0)
  DMA_K(2,2*SLOTB);
  WAIT_BAR(3);
  CINIT(pA0,pA1,0); qkt(pA0,pA1,Kbase,qr,r32,hi);asm volatile("s_nop 15\n\ts_nop 7":"+v"(pA0),"+v"(pA1));CMASK(pA0,pA1,0);
  START(pA0,pA1);
  _Pragma("unroll") for(int r=0;r<16;++r)pA1[r]=__builtin_amdgcn_exp2f(pA1[r]);
  WAIT_BAR(0);
  DMA_K(3,0);DMA_V(1,SLOTB);
  ROT();
  kload8(kf,kp0+sl_cur);
  WAIT_BAR(2);
  s16x4 vlo[8],vhi[8]; u32x4 pw0,pw1,pw2,pw3;
  #define PKW(P,B) cvtpk_s(P[B],P[B+1])
  #define PAF(k) __builtin_bit_cast(bf16x8,pw##k)
  #define VFR(i) (bf16x8){vlo[i][0],vlo[i][1],vlo[i][2],vlo[i][3],vhi[i][0],vhi[i][1],vhi[i][2],vhi[i][3]}
  #define PIN(x) asm volatile("":"+v"(x))
  #define MX3(a,b,c) __builtin_fmaxf(__builtin_fmaxf((a),(b)),(c))
  #define GAPA(MF,A0,A1,A2,A3,W0,W1,PW) do{ MF; sacc+=A0; sacc+=A1; sacc+=A2; sacc+=A3; PIN(sacc); W0; W1; PIN(PW); SBAR(); }while(0)
  #define EX(v) __builtin_amdgcn_exp2f(v)
  #define GAPB(MF,X,B) do{ MF; X[B]=EX(X[B]); X[B+1]=EX(X[B+1]); X[B+2]=EX(X[B+2]); X[B+3]=EX(X[B+3]); PIN(X); SBAR(); }while(0)
  #define VRD(i) do{ vlo[i]=vtr(vp_+(((i)>>2)*4096+((i)&3)*1024)); vhi[i]=vtr(vp_+(((i)>>2)*4096+((i)&3)*1024+512)); }while(0)
  #define KRD(G,j) do{ if(G){ kload2(kf,kp0+sl_next,j); SBAR(); } }while(0)
  #define STEP(C0,C1,P0,P1,t,GK,GV,GL) do{ SBAR(); \
    CINIT(C0,C1,t); PIN(C0); PIN(C1); SBAR(); \
    const lds_cptr vp_=vp0+sl_prev; \
    VRD(0); SBAR(); float sacc=(P0[0]+P0[1]); \
    GAPA(C0=__builtin_amdgcn_mfma_f32_32x32x16_bf16(kf[0],qr[0],C0,0,0,0), P0[2],P0[3],P0[4],P0[5],     pw0[0]=PKW(P0,0), pw0[1]=PKW(P0,2), pw0); \
    VRD(4); SBAR(); GAPA(C1=__builtin_amdgcn_mfma_f32_32x32x16_bf16(kf[1],qr[0],C1,0,0,0), P0[6],P0[7],P0[8],P0[9],     pw0[2]=PKW(P0,4), pw0[3]=PKW(P0,6), pw0); \
    VRD(1); SBAR(); GAPA(C0=__builtin_amdgcn_mfma_f32_32x32x16_bf16(kf[2],qr[1],C0,0,0,0),   P0[10],P0[11],P0[12],P0[13], pw1[0]=PKW(P0,8), pw1[1]=PKW(P0,10), pw1); \
    VRD(5); SBAR(); GAPA(C1=__builtin_amdgcn_mfma_f32_32x32x16_bf16(kf[3],qr[1],C1,0,0,0),   P0[14],P0[15],P1[0],P1[1],   pw1[2]=PKW(P0,12),pw1[3]=PKW(P0,14), pw1); \
    VRD(2); SBAR(); GAPA(C0=__builtin_amdgcn_mfma_f32_32x32x16_bf16(kf[4],qr[2],C0,0,0,0),   P1[2],P1[3],P1[4],P1[5],     pw2[0]=PKW(P1,0), pw2[1]=PKW(P1,2), pw2); \
    VRD(6); SBAR(); GAPA(C1=__builtin_amdgcn_mfma_f32_32x32x16_bf16(kf[5],qr[2],C1,0,0,0),   P1[6],P1[7],P1[8],P1[9],     pw2[2]=PKW(P1,4), pw2[3]=PKW(P1,6), pw2); \
    VRD(3); SBAR(); GAPA(C0=__builtin_amdgcn_mfma_f32_32x32x16_bf16(kf[6],qr[3],C0,0,0,0),   P1[10],P1[11],P1[12],P1[13], pw3[0]=PKW(P1,8), pw3[1]=PKW(P1,10), pw3); \
    VRD(7); SBAR(); GAPA(C1=__builtin_amdgcn_mfma_f32_32x32x16_bf16(kf[7],qr[3],C1,0,0,0),   P1[14],P1[15],0.f,0.f,       pw3[2]=PKW(P1,12),pw3[3]=PKW(P1,14), pw3); \
    l_reg+=sacc; \
    if(GK){DMA_K((t)+3,sl_cur);} if(GV){DMA_V((t)+1,sl_next);} \
    CMASK(C0,C1,t); \
    { float a=MX3(C0[0],C0[1],C1[0]),b=MX3(C0[2],C0[3],C1[1]); a=MX3(a,C1[2],C1[3]); \
      _Pragma("unroll") for(int r=4;r<16;r+=4){a=MX3(a,C0[r],C0[r+1]);b=MX3(b,C0[r+2],C0[r+3]);a=MX3(a,C1[r],C1[r+1]);b=MX3(b,C1[r+2],C1[r+3]);} \
      float rm=__builtin_fmaxf(a,b); { auto rr=__builtin_amdgcn_permlane32_swap(__float_as_uint(rm),__float_as_uint(rm),false,false); rm=__builtin_fmaxf(__uint_as_float(rr[0]),__uint_as_float(rr[1])); } \
      resc=false; \
      if(__builtin_expect(__any(rm>(float)THRL),0)){ const float dl=__builtin_fmaxf(rm,0.f); mhat+=dl; \
        _Pragma("unroll") for(int r=0;r<16;++r){C0[r]-=dl;C1[r]-=dl;} \
        const float f=__builtin_amdgcn_exp2f(-dl); l_reg*=f; if(hi==0)wsf[r32]=f; resc=true; } } \
    SBAR(); \
    GAPB(o[0]=__builtin_amdgcn_mfma_f32_32x32x16_bf16(PAF(0),VFR(0),o[0],0,0,0), C0,0); \
    GAPB(o[1]=__builtin_amdgcn_mfma_f32_32x32x16_bf16(PAF(0),VFR(4),o[1],0,0,0), C0,4); \
    KRD(GL,0); GAPB(o[0]=__builtin_amdgcn_mfma_f32_32x32x16_bf16(PAF(1),VFR(1),o[0],0,0,0), C0,8); \
    KRD(GL,1); GAPB(o[1]=__builtin_amdgcn_mfma_f32_32x32x16_bf16(PAF(1),VFR(5),o[1],0,0,0), C0,12); \
    KRD(GL,2); GAPB(o[0]=__builtin_amdgcn_mfma_f32_32x32x16_bf16(PAF(2),VFR(2),o[0],0,0,0), C1,0); \
    KRD(GL,3); GAPB(o[1]=__builtin_amdgcn_mfma_f32_32x32x16_bf16(PAF(2),VFR(6),o[1],0,0,0), C1,4); \
    GAPB(o[0]=__builtin_amdgcn_mfma_f32_32x32x16_bf16(PAF(3),VFR(3),o[0],0,0,0), C1,8); \
    GAPB(o[1]=__builtin_amdgcn_mfma_f32_32x32x16_bf16(PAF(3),VFR(7),o[1],0,0,0), C1,12); \
    }while(0)
  int t=1;
  #undef CMASK
  #define CMASK(P0,P1,t) do{}while(0)
  for(;t+5<NT;t+=2){
    STEP(pB0,pB1,pA0,pA1,t,true,true,true);     WAIT_BAR(2); RESC(); ROT();
    STEP(pA0,pA1,pB0,pB1,t+1,true,true,true);   WAIT_BAR(2); RESC(); ROT();
  }
  #undef CMASK
  #define CMASK(P0,P1,t) do{int jb_=(t)-(NT-4); if(jb_>=0)cmask(P0,P1,jb_,qrel,hi);}while(0)
  #define ENDW(tt) do{ if((tt)+3<NT){WAIT_BAR(2);} else if((tt)+2<NT){WAIT_BAR(1);} else {WAIT_BAR(0);} }while(0)
  for(;t+1<NT;t+=2){
    STEP(pB0,pB1,pA0,pA1,t,(t+3<NT),(t+1<NT),(t+1<NT));       ENDW(t);   RESC(); ROT();
    STEP(pA0,pA1,pB0,pB1,t+1,(t+4<NT),(t+2<NT),(t+2<NT));     ENDW(t+1); RESC(); ROT();
  }
  STEP(pB0,pB1,pA0,pA1,NT-1,false,false,false); RESC();
  { float sacc=pB0[0]+pB0[1]; _Pragma("unroll") for(int r=2;r<16;++r)sacc+=pB0[r]; _Pragma("unroll") for(int r=0;r<16;++r)sacc+=pB1[r]; l_reg+=sacc;
    pw0=(u32x4){PKW(pB0,0),PKW(pB0,2),PKW(pB0,4),PKW(pB0,6)};pw1=(u32x4){PKW(pB0,8),PKW(pB0,10),PKW(pB0,12),PKW(pB0,14)};pw2=(u32x4){PKW(pB1,0),PKW(pB1,2),PKW(pB1,4),PKW(pB1,6)};pw3=(u32x4){PKW(pB1,8),PKW(pB1,10),PKW(pB1,12),PKW(pB1,14)};
    SBAR(); pv(o,vb0+sl_cur,PAF(0),PAF(1),PAF(2),PAF(3)); }
  #undef PKW
  #undef PAF
  #undef VFR
  #undef PIN
  #undef MX3
  #undef GAPA
  #undef GAPB
  #undef EX
  #undef VRD
  #undef KRD
  #undef STEP
  #undef ENDW
  {auto rr=__builtin_amdgcn_permlane32_swap(__float_as_uint(l_reg),__float_as_uint(l_reg),false,false);l_reg=__uint_as_float(rr[0])+__uint_as_float(rr[1]);}
  if(hi==0)wsf[32+r32]=l_reg;asm volatile("s_waitcnt lgkmcnt(0)":::"memory");
  float rli[16];
  #pragma unroll
  for(int r=0;r<16;++r)rli[r]=__builtin_amdgcn_rcpf(wsf[32+crow(r,hi)]);
  bf16*Ow=O+(long)(q0+wid*QBLK)*DM;
  { bf16*stg=(bf16*)(shm+LDS_OST)+wid*2048;
    #pragma unroll
    for(int r=0;r<16;++r){const int orow=crow(r,hi);
      #pragma unroll
      for(int d0=0;d0<2;++d0)stg[orow*64+d0*32+r32]=__float2bfloat16(o[d0][r]*rli[r]);}
    asm volatile("s_waitcnt lgkmcnt(0)":::"memory");
    #pragma unroll
    for(int i=0;i<4;++i){const int row=i*8+(lane>>3),ch=lane&7; const u32x4 v=*(const u32x4*)(stg+row*64+ch*8); ATTN_STORE16(Ow+(long)row*DM+ch*8,v);} }
  asm volatile("s_waitcnt lgkmcnt(0)\n\ts_barrier":::"memory");
  #undef DMA_K
  #undef DMA_V
  #undef CMASK
  #undef CINIT
  #undef START
  #undef RESC
  #undef ROT
}
constexpr int ATTN_LDS_BYTES=LDS_BYTES;
template<int THRL=8> __device__ __forceinline__ void attn_dispatch(int u,char*lds,const bf16*QA,const bf16*KA,const bf16*VA,bf16*O1,bf16*O2,const unsigned*norms){
    const int h=3-(u>>8), r=u&255, qb=63-(r>>2), c=(r>>1)&1, vhalf=r&1, hv=h*2+c;
    const float slope2=__uint_as_float(__builtin_amdgcn_readfirstlane((0x3fb8aa3bu)-((unsigned)(2*(h+1))<<23)));
    const float Bnd=sqrtf(__uint_as_float(norms[hv]))*sqrtf(__uint_as_float(norms[8+hv]))*1.0001f;
    const float W=(2.f*Bnd+34.f)/slope2+1.f;
    const int q0=qb*QB; int t0=0; if((float)q0>W){ t0=((int)(((float)q0-W)*(1.f/64.f)))&~1; }
    t0=__builtin_amdgcn_readfirstlane(t0);
    const bf16*Q=QA+hv*64; const bf16*K=KA+hv*64; const bf16*V=VA+h*128+vhalf*64; bf16*O=(c?O2:O1)+h*128+vhalf*64;
    attn_unit<THRL>(qb,t0,slope2,Q,K,V,O,lds);
}
#undef SBAR
#undef WAIT_BAR
}

__device__ __forceinline__ void ph_rmsnorm_bf16(const float* X, const float* g, bf16* O) {
    const int lane = tidx() & 63, wave = tidx() >> 6;
    const int gw = blockIdx.x * NWAVES + wave, NGW = gridDim.x * NWAVES;
    for (int m = gw; m < M; m += NGW) {
        const f32x4* xr = (const f32x4*)(X + (size_t)m * D) + lane;
        f32x4 v[4]; float s = 0.f;
#pragma unroll
        for (int j = 0; j < 4; ++j) { v[j] = xr[64 * j]; s += (v[j].x * v[j].x + v[j].y * v[j].y) + (v[j].z * v[j].z + v[j].w * v[j].w); }
        const float r = rsqrtf(wave_sum(s) * (1.f / D) + EPS);
        v2u* o8 = (v2u*)(O + (size_t)m * D) + lane;
#pragma unroll
        for (int j = 0; j < 4; ++j) { const f32x4 gg = ((const f32x4*)g)[lane + 64 * j]; v2u w; w.x = pk2(v[j].x * r * gg.x, v[j].y * r * gg.y); w.y = pk2(v[j].z * r * gg.z, v[j].w * r * gg.w); o8[64 * j] = w; }
    }
}
__device__ __forceinline__ void ph_rmsnorm_f32_inplace(float* X, const float* g) {
    const int lane = tidx() & 63, wave = tidx() >> 6;
    const int gw = blockIdx.x * NWAVES + wave, NGW = gridDim.x * NWAVES;
    for (int m = gw; m < M; m += NGW) {
        f32x4* xr = (f32x4*)(X + (size_t)m * D) + lane;
        f32x4 v[4]; float s = 0.f;
#pragma unroll
        for (int j = 0; j < 4; ++j) { v[j] = xr[64 * j]; s += (v[j].x * v[j].x + v[j].y * v[j].y) + (v[j].z * v[j].z + v[j].w * v[j].w); }
        const float r = rsqrtf(wave_sum(s) * (1.f / D) + EPS);
#pragma unroll
        for (int j = 0; j < 4; ++j) { const f32x4 gg = ((const f32x4*)g)[lane + 64 * j]; xr[64 * j] = v[j] * r * gg; }
    }
}

__device__ __forceinline__ void transpose_item(const float* W, int K, int N, int Npad, bf16* WT, LAS float* scr, int item, int lane, const float* kgain = nullptr) {
    const int nblk = Npad / 32, kb = item / nblk, nb = item % nblk, k0 = 64 * kb, n0 = 32 * nb;
    const int nn = n0 + (lane & 31);
#pragma unroll 8
    for (int i = 0; i < 32; ++i) { const int kk = 2 * i + (lane >> 5); const float gk = kgain ? kgain[k0 + kk] : 1.f; scr[kk * 33 + (lane & 31)] = (nn < N) ? W[(size_t)(k0 + kk) * N + nn] * gk : 0.f; }
    asm volatile("s_waitcnt lgkmcnt(0)" ::: "memory");
    const int c = lane & 7;
#pragma unroll
    for (int j = 0; j < 4; ++j) { const int n = (lane >> 3) + 8 * j; const LAS float* sp = scr + (8 * c) * 33 + n;
        v4u o; o.x = pk2(sp[0 * 33], sp[1 * 33]); o.y = pk2(sp[2 * 33], sp[3 * 33]); o.z = pk2(sp[4 * 33], sp[5 * 33]); o.w = pk2(sp[6 * 33], sp[7 * 33]);
        *(v4u*)(WT + (size_t)(n0 + n) * K + k0 + 8 * c) = o; }
    asm volatile("s_waitcnt lgkmcnt(0)" ::: "memory");
}
__device__ __forceinline__ void ph_weights_in(const float* w_in, bf16* WIN, LAS unsigned char* lds) {
    const int lane = tidx() & 63, wave = __builtin_amdgcn_readfirstlane(tidx() >> 6);
    LAS float* scr = (LAS float*)(lds + wave * 16384);
    const int gw = blockIdx.x * NWAVES + wave, NGW = gridDim.x * NWAVES;
    constexpr int I_IN = (D / 64) * (NINP / 32);
    for (int it = gw; it < I_IN; it += NGW) transpose_item(w_in, D, NIN, NINP, WIN, scr, it, lane);
}
constexpr int WCH_OUT = (D / 64) * (D / 32), WCH_Q = (D / 64) * (NQ / 32), WCH_P = (PLE / 64) * (D / 32), WCH_ITEMS = 2 * WCH_OUT + WCH_Q + WCH_P, WCH_CHUNKS = (WCH_ITEMS + 7) / 8;
__device__ __forceinline__ void weights_chunk(int chunk, const float* w_out, const float* w_query, const float* g_query, const float* w_gate, const float* w_proj, bf16* WOUT, bf16* WQ, bf16* WG, bf16* WP, LAS unsigned char* lds) {
    const int lane = tidx() & 63, wave = __builtin_amdgcn_readfirstlane(tidx() >> 6);
    LAS float* scr = (LAS float*)(lds + wave * 16384);
    int r = chunk * 8 + wave;
    if (r >= WCH_ITEMS) return;
    if (r < WCH_OUT) { transpose_item(w_out, D, D, D, WOUT, scr, r, lane); return; } r -= WCH_OUT;
    if (r < WCH_Q) { transpose_item(w_query, D, NQ, NQ, WQ, scr, r, lane, g_query); return; } r -= WCH_Q;
    if (r < WCH_OUT) { transpose_item(w_gate, D, D, D, WG, scr, r, lane); return; } r -= WCH_OUT;
    transpose_item(w_proj, PLE, D, D, WP, scr, r, lane);
}

template <class Epi>
__device__ __forceinline__ void naive_gemm(const bf16* A, int lda, const float* W, int K, int N, float* lds, Epi epi) {
    float* As = lds;
    float* Ws = lds + 32 * 65;
    const int tid = tidx(), tx = tid & 15, ty = tid >> 4;
    const int ntn = (N + 63) / 64, nt = (M / 64) * ntn;
    for (int t = blockIdx.x; t < nt; t += gridDim.x) {
        const int tm = t / ntn, tn = t % ntn, r0 = tm * 64, c0 = tn * 64;
        float acc[2][4];
#pragma unroll
        for (int i = 0; i < 2; ++i)
#pragma unroll
            for (int j = 0; j < 4; ++j) acc[i][j] = 0.f;
        for (int k0 = 0; k0 < K; k0 += 32) {
            { const int r = tid >> 3, kq = (tid & 7) * 4; const v2u v = *(const v2u*)(A + (size_t)(r0 + r) * lda + k0 + kq);
              As[(kq + 0) * 65 + r] = bf2f(v.x & 0xffffu); As[(kq + 1) * 65 + r] = bf2f(v.x >> 16); As[(kq + 2) * 65 + r] = bf2f(v.y & 0xffffu); As[(kq + 3) * 65 + r] = bf2f(v.y >> 16); }
            { const int kk = tid >> 4, nq = (tid & 15) * 4; const float* wp = W + (size_t)(k0 + kk) * N + c0 + nq;
#pragma unroll
              for (int j = 0; j < 4; ++j) Ws[kk * 64 + nq + j] = (c0 + nq + j < N) ? wp[j] : 0.f; }
            __syncthreads();
#pragma unroll 8
            for (int kk = 0; kk < 32; ++kk) {
                const float a0 = As[kk * 65 + ty], a1 = As[kk * 65 + ty + 32];
                const f32x4 b = *(const f32x4*)(Ws + kk * 64 + tx * 4);
                acc[0][0] += a0 * b.x; acc[0][1] += a0 * b.y; acc[0][2] += a0 * b.z; acc[0][3] += a0 * b.w;
                acc[1][0] += a1 * b.x; acc[1][1] += a1 * b.y; acc[1][2] += a1 * b.z; acc[1][3] += a1 * b.w;
            }
            __syncthreads();
        }
#pragma unroll
        for (int i = 0; i < 2; ++i)
#pragma unroll
            for (int j = 0; j < 4; ++j) { const int row = r0 + ty + 32 * i, col = c0 + tx * 4 + j; if (col < N) epi(row, col, acc[i][j]); }
    }
}

__device__ __forceinline__ void ph_attn_naive(const bf16* QA, const bf16* KA, const bf16* VA, bf16* O1, bf16* O2, float* lds) {
    float* Ks = lds; float* Vs = lds + 32 * 64; float* Ss = Vs + 32 * 128;
    const int tid = tidx(), qi = tid >> 3, cg = tid & 7;
    for (int item = blockIdx.x; item < 8 * 256; item += gridDim.x) {
        const int hv = item & 7, qb = 255 - (item >> 3);
        const int h = hv >> 1, c = hv & 1, q0 = qb * 64, qpos = q0 + qi;
        const float slope2 = exp2f(-2.f * (float)(h + 1)) * LOG2E;
        float q[64];
        { const v4u* qp = (const v4u*)(QA + (size_t)qpos * 512 + hv * 64);
#pragma unroll
          for (int i = 0; i < 8; ++i) { const v4u v = qp[i];
              q[8 * i + 0] = bf2f(v.x & 0xffffu); q[8 * i + 1] = bf2f(v.x >> 16); q[8 * i + 2] = bf2f(v.y & 0xffffu); q[8 * i + 3] = bf2f(v.y >> 16);
              q[8 * i + 4] = bf2f(v.z & 0xffffu); q[8 * i + 5] = bf2f(v.z >> 16); q[8 * i + 6] = bf2f(v.w & 0xffffu); q[8 * i + 7] = bf2f(v.w >> 16); } }
        float m = -INFINITY, l = 0.f, acc[16];
#pragma unroll
        for (int i = 0; i < 16; ++i) acc[i] = 0.f;
        const int ntile = (q0 + 64) / 32;
        for (int kt = 0; kt < ntile; ++kt) {
            const int k0 = kt * 32;
            __syncthreads();
            { const int kk = tid >> 4, d4 = (tid & 15) * 4; const v2u v = *(const v2u*)(KA + (size_t)(k0 + kk) * 512 + hv * 64 + d4);
              float* kd = Ks + kk * 64 + d4; kd[0] = bf2f(v.x & 0xffffu); kd[1] = bf2f(v.x >> 16); kd[2] = bf2f(v.y & 0xffffu); kd[3] = bf2f(v.y >> 16); }
            { const int kk = tid >> 4, e8 = (tid & 15) * 8; const v4u v = *(const v4u*)(VA + (size_t)(k0 + kk) * 512 + h * 128 + e8);
              float* vd = Vs + kk * 128 + e8; vd[0] = bf2f(v.x & 0xffffu); vd[1] = bf2f(v.x >> 16); vd[2] = bf2f(v.y & 0xffffu); vd[3] = bf2f(v.y >> 16);
              vd[4] = bf2f(v.z & 0xffffu); vd[5] = bf2f(v.z >> 16); vd[6] = bf2f(v.w & 0xffffu); vd[7] = bf2f(v.w >> 16); }
            __syncthreads();
#pragma unroll
            for (int j = 0; j < 4; ++j) {
                const int kk = cg + 8 * j; const float* kr = Ks + kk * 64; float s = 0.f;
#pragma unroll
                for (int d = 0; d < 64; ++d) s += q[d] * kr[d];
                const int kpos = k0 + kk;
                s = (kpos <= qpos) ? s - slope2 * (float)(qpos - kpos) : -INFINITY;
                Ss[qi * 33 + kk] = s;
            }
            __syncthreads();
            float tmax = -INFINITY;
#pragma unroll 8
            for (int kk = 0; kk < 32; ++kk) tmax = fmaxf(tmax, Ss[qi * 33 + kk]);
            const float mn = fmaxf(m, tmax), alpha = exp2f(m - mn);
            l *= alpha;
#pragma unroll
            for (int i = 0; i < 16; ++i) acc[i] *= alpha;
            for (int kk = 0; kk < 32; ++kk) {
                const float p = exp2f(Ss[qi * 33 + kk] - mn); l += p;
                const float* vr = Vs + kk * 128 + 16 * cg;
#pragma unroll
                for (int i = 0; i < 16; ++i) acc[i] += p * vr[i];
            }
            m = mn;
        }
        const float il = 1.f / l;
        bf16* O = c ? O2 : O1;
        v4u w0, w1;
        w0.x = pk2(acc[0] * il, acc[1] * il); w0.y = pk2(acc[2] * il, acc[3] * il); w0.z = pk2(acc[4] * il, acc[5] * il); w0.w = pk2(acc[6] * il, acc[7] * il);
        w1.x = pk2(acc[8] * il, acc[9] * il); w1.y = pk2(acc[10] * il, acc[11] * il); w1.z = pk2(acc[12] * il, acc[13] * il); w1.w = pk2(acc[14] * il, acc[15] * il);
        v4u* op = (v4u*)(O + (size_t)qpos * 512 + h * 128 + 16 * cg); op[0] = w0; op[1] = w1;
    }
}

__device__ __forceinline__ void ph_conv_naive(const bf16* MQ, const bf16* MK, const float* cw, const float* cb, bf16* CQ, bf16* CK) {
    const size_t n = (size_t)M * 512, stride = (size_t)gridDim.x * NTHREADS;
    for (size_t i = (size_t)blockIdx.x * NTHREADS + tidx(); i < n; i += stride) {
        const int t = (int)(i >> 9), c = (int)(i & 511);
        float aq = cb[c], ak = cb[512 + c];
#pragma unroll
        for (int j = 0; j < 4; ++j) { const int tt = t - 3 + j; if (tt >= 0) { aq += cw[j * 1024 + c] * bf2f(MQ[(size_t)tt * 512 + c]); ak += cw[j * 1024 + 512 + c] * bf2f(MK[(size_t)tt * 512 + c]); } }
        aq = aq * sigmoidf_(aq) * 0.08838834764831845f; ak = ak * sigmoidf_(ak);
        CQ[i] = (bf16)f2bf(aq); CK[i] = (bf16)f2bf(ak);
    }
}
__device__ __forceinline__ void ph_mlstm_naive(const bf16* CQ, const bf16* CK, const bf16* MV, const float* GATES, const float* b_i, const float* b_f, float* HS, float* lds) {
    if (blockIdx.x >= 4) return;
    const int h = blockIdx.x, tid = tidx(), e = tid & 127, dg = tid >> 7;
    float* qs = lds; float* ks = qs + 64 * 128; float* vs = ks + 64 * 128; float* fs = vs + 64 * 128; float* is_ = fs + 64; float* red = is_ + 64; float* redd = red + 512;
    float C[32], n[32];
#pragma unroll
    for (int i = 0; i < 32; ++i) { C[i] = 0.f; n[i] = 0.f; }
    for (int c0 = 0; c0 < M; c0 += 64) {
        __syncthreads();
        for (int i = tid; i < 64 * 128; i += NTHREADS) { const int tt = i >> 7, d = i & 127; const size_t g = (size_t)(c0 + tt) * 512 + h * 128 + d; qs[i] = bf2f(CQ[g]); ks[i] = bf2f(CK[g]); vs[i] = bf2f(MV[g]); }
        if (tid < 64) { const float fp = GATES[(size_t)(c0 + tid) * 8 + 4 + h] + b_f[h], ip = GATES[(size_t)(c0 + tid) * 8 + h] + b_i[h]; fs[tid] = 1.f / (1.f + expf(-fp)); is_[tid] = expf(ip); }
        __syncthreads();
        for (int tt = 0; tt < 64; ++tt) {
            const float f = fs[tt], ii = is_[tt], ve = vs[tt * 128 + e]; float pn = 0.f, pd = 0.f;
#pragma unroll
            for (int i = 0; i < 32; ++i) { const float kd = ks[tt * 128 + dg * 32 + i], qd = qs[tt * 128 + dg * 32 + i], ik = ii * kd;
                C[i] = f * C[i] + ik * ve; n[i] = f * n[i] + ik; pn += qd * C[i]; pd += qd * n[i]; }
            red[dg * 128 + e] = pn; if (e == 0) redd[dg] = pd;
            __syncthreads();
            if (dg == 0) { const float num = (red[e] + red[128 + e]) + (red[256 + e] + red[384 + e]), den = (redd[0] + redd[1]) + (redd[2] + redd[3]);
                HS[(size_t)(c0 + tt) * 512 + h * 128 + e] = num / fmaxf(fabsf(den), 1.f); }
            __syncthreads();
        }
    }
}
template <bool DO_ML>
__device__ __forceinline__ void ph_combine(const bf16* O1, const bf16* O2, const bf16* MO, const float* HS, const float* lq1, const float* lk1, const float* lq2, const float* lk2,
                                           const float* subln_g, const float* ml_g, bf16* ACAT) {
    const int lane = tidx() & 63, wave = tidx() >> 6;
    const int gw = blockIdx.x * NWAVES + wave, NGW = gridDim.x * NWAVES;
    const float lam = expf(wave_sum(lq1[lane] * lk1[lane])) - expf(wave_sum(lq2[lane] * lk2[lane])) + LAMBDA_INIT;
    for (int m = gw; m < M; m += NGW) {
        const int c0 = lane * 8;
        float a[8], b[8];
        { const v4u u1 = *(const v4u*)(O1 + (size_t)m * 512 + c0), u2 = *(const v4u*)(O2 + (size_t)m * 512 + c0);
          const unsigned w1[4] = {u1.x, u1.y, u1.z, u1.w}, w2[4] = {u2.x, u2.y, u2.z, u2.w};
#pragma unroll
          for (int i = 0; i < 4; ++i) { a[2 * i] = bf2f(w1[i] & 0xffffu) - lam * bf2f(w2[i] & 0xffffu); a[2 * i + 1] = bf2f(w1[i] >> 16) - lam * bf2f(w2[i] >> 16); } }
        if (DO_ML) { const v4u uo = *(const v4u*)(MO + (size_t)m * 512 + c0); const unsigned wo[4] = {uo.x, uo.y, uo.z, uo.w};
          const f32x4 h0 = *(const f32x4*)(HS + (size_t)m * 512 + c0), h1 = *(const f32x4*)(HS + (size_t)m * 512 + c0 + 4);
          const float hh[8] = {h0.x, h0.y, h0.z, h0.w, h1.x, h1.y, h1.z, h1.w};
#pragma unroll
          for (int i = 0; i < 4; ++i) { b[2 * i] = sigmoidf_(bf2f(wo[i] & 0xffffu)) * hh[2 * i]; b[2 * i + 1] = sigmoidf_(bf2f(wo[i] >> 16)) * hh[2 * i + 1]; } }
        else {
#pragma unroll
          for (int i = 0; i < 8; ++i) b[i] = 0.f; }
        float sa = 0.f, sb = 0.f;
#pragma unroll
        for (int i = 0; i < 8; ++i) { sa += a[i] * a[i]; sb += b[i] * b[i]; }
#pragma unroll
        for (int o = 1; o < 16; o <<= 1) { sa += __shfl_xor(sa, o); sb += __shfl_xor(sb, o); }
        const float ra = rsqrtf(sa * (1.f / 128.f) + EPS) * (1.f - LAMBDA_INIT), rb = rsqrtf(sb * (1.f / 128.f) + EPS);
        const int cc = c0 & 127, hh_ = lane >> 4;
        v4u wa, wb;
        { const float* g = subln_g + cc; wa.x = pk2(a[0] * ra * g[0], a[1] * ra * g[1]); wa.y = pk2(a[2] * ra * g[2], a[3] * ra * g[3]); wa.z = pk2(a[4] * ra * g[4], a[5] * ra * g[5]); wa.w = pk2(a[6] * ra * g[6], a[7] * ra * g[7]); }
        { const float* g = ml_g + hh_ * 128 + cc; wb.x = pk2(b[0] * rb * g[0], b[1] * rb * g[1]); wb.y = pk2(b[2] * rb * g[2], b[3] * rb * g[3]); wb.z = pk2(b[4] * rb * g[4], b[5] * rb * g[5]); wb.w = pk2(b[6] * rb * g[6], b[7] * rb * g[7]); }
        *(v4u*)(ACAT + (size_t)m * 1024 + c0) = wa; if (DO_ML) *(v4u*)(ACAT + (size_t)m * 1024 + 512 + c0) = wb;
    }
}


namespace ml {
typedef short bf16x8 __attribute__((ext_vector_type(8)));
typedef float f32x16 __attribute__((ext_vector_type(16)));
typedef LAS unsigned char* lptr;
constexpr int LD128 = 272, LD64 = 144;
constexpr int QP_OFF = 0, K_OFF = 17408, Y_OFF = 0, KWT_OFF = 34816, VT_OFF = 53248, SM_OFF = 71680, CT_OFF = 80896, SMALL_OFF = 115712;
constexpr int LDY = 132;
constexpr int ST_STRIDE = 16384 + 256;
__device__ __forceinline__ int crow(int r, int hi) { return (r & 3) + 8 * (r >> 2) + 4 * hi; }
template <int KS>
__device__ __forceinline__ void mm_tile(f32x16& acc, lptr A, int lda, lptr Bt, int ldb, int r32, int hi) {
    lptr ap = A + r32 * lda + hi * 16; lptr bp = Bt + r32 * ldb + hi * 16;
#pragma unroll
    for (int ks = 0; ks < KS; ++ks) {
        const bf16x8 a = *(const LAS bf16x8*)(ap + ks * 32);
        const bf16x8 b = *(const LAS bf16x8*)(bp + ks * 32);
        acc = __builtin_amdgcn_mfma_f32_32x32x16_bf16(a, b, acc, 0, 0, 0);
    }
}
__device__ __forceinline__ float gates_chunk(const float* GATES, float bi, float bf_, int t0, int h, int lane, LAS float* eb, LAS float* wcol, LAS float* wupd, LAS float* misc) {
    const float fp = GATES[(size_t)(t0 + lane) * 8 + 4 + h] + bf_, ip = GATES[(size_t)(t0 + lane) * 8 + h] + bi;
    const float lf = fminf(fp, 0.f) - log1pf(__expf(-fabsf(fp)));
    float b = lf;
#pragma unroll
    for (int o = 1; o < 64; o <<= 1) { const float u = __shfl_up(b, o); if (lane >= o) b += u; }
    const float bL = __shfl(b, 63);
    eb[lane] = __expf(b); wcol[lane] = __expf(ip - b); wupd[lane] = __expf(bL - b + ip); if (lane == 0) misc[0] = __expf(bL);
    return bL;
}
__device__ __forceinline__ void stage_transposed(const bf16* CK, const bf16* MV, int t0, int h, lptr lds, const LAS float* wupd, int tid) {
    const int sp = tid & 31, c = tid >> 5;
    const size_t g0 = (size_t)(t0 + 2 * sp) * 512 + h * 128 + c * 8;
    const v4u k0 = *(const v4u*)(CK + g0), k1 = *(const v4u*)(CK + g0 + 512), v0 = *(const v4u*)(MV + g0), v1 = *(const v4u*)(MV + g0 + 512);
    const float w0 = wupd[2 * sp], w1 = wupd[2 * sp + 1];
    const unsigned ka[4] = {k0.x, k0.y, k0.z, k0.w}, kb[4] = {k1.x, k1.y, k1.z, k1.w}, va[4] = {v0.x, v0.y, v0.z, v0.w}, vb[4] = {v1.x, v1.y, v1.z, v1.w};
    lptr kw = lds + KWT_OFF + (8 * c) * LD64 + 4 * sp; lptr vt = lds + VT_OFF + (8 * c) * LD64 + 4 * sp;
#pragma unroll
    for (int i = 0; i < 4; ++i) {
        *(LAS unsigned*)(kw + (2 * i) * LD64) = pk2(w0 * bf2f(ka[i] & 0xffffu), w1 * bf2f(kb[i] & 0xffffu));
        *(LAS unsigned*)(kw + (2 * i + 1) * LD64) = pk2(w0 * bf2f(ka[i] >> 16), w1 * bf2f(kb[i] >> 16));
        *(LAS unsigned*)(vt + (2 * i) * LD64) = (va[i] & 0xffffu) | (vb[i] << 16);
        *(LAS unsigned*)(vt + (2 * i + 1) * LD64) = (va[i] >> 16) | (vb[i] & 0xffff0000u);
    }
}
__device__ __forceinline__ void state_update(f32x16 (&accS)[2], lptr lds, float aL, int wave, int r32, int hi) {
    const int er = wave & 3, dc0 = 2 * (wave >> 2);
#pragma unroll
    for (int i = 0; i < 2; ++i) {
#pragma unroll
        for (int r = 0; r < 16; ++r) accS[i][r] *= aL;
        mm_tile<4>(accS[i], lds + VT_OFF + (32 * er) * LD64, LD64, lds + KWT_OFF + (32 * (dc0 + i)) * LD64, LD64, r32, hi);
    }
}
__device__ __forceinline__ float kwt_rowsum(lptr lds, int d) {
    float s = 0.f; lptr p = lds + KWT_OFF + d * LD64;
#pragma unroll
    for (int i = 0; i < 8; ++i) { const v4u q = *(const LAS v4u*)(p + 16 * i);
        s += (bf2f(q.x & 0xffffu) + bf2f(q.x >> 16)) + (bf2f(q.y & 0xffffu) + bf2f(q.y >> 16)) + (bf2f(q.z & 0xffffu) + bf2f(q.z >> 16)) + (bf2f(q.w & 0xffffu) + bf2f(q.w >> 16)); }
    return s;
}

__device__ __forceinline__ void conv_items(const bf16* MQ, const bf16* MK, const float* cw, const float* cb, bf16* CQ, bf16* CK) {
    const int tid = tidx();
    for (int item = blockIdx.x; item < 256; item += gridDim.x) {
        const int h = item >> 6, j = item & 63;
#pragma unroll 1
        for (int i = 0; i < 8; ++i) {
            const int p = tid + 512 * i, row = p >> 4, ch = p & 15, t = j * 256 + row, col = h * 128 + ch * 8;
            float aq[8], ak[8];
#pragma unroll
            for (int e = 0; e < 8; ++e) { aq[e] = cb[col + e]; ak[e] = cb[512 + col + e]; }
#pragma unroll
            for (int jj = 0; jj < 4; ++jj) { const int tt = t - 3 + jj; if (tt >= 0) {
                const v4u q = *(const v4u*)(MQ + (size_t)tt * 512 + col), k = *(const v4u*)(MK + (size_t)tt * 512 + col);
                const unsigned qa[4] = {q.x, q.y, q.z, q.w}, ka[4] = {k.x, k.y, k.z, k.w};
                const float* wq = cw + jj * 1024 + col; const float* wk = wq + 512;
#pragma unroll
                for (int e = 0; e < 4; ++e) { aq[2 * e] += wq[2 * e] * bf2f(qa[e] & 0xffffu); aq[2 * e + 1] += wq[2 * e + 1] * bf2f(qa[e] >> 16);
                                              ak[2 * e] += wk[2 * e] * bf2f(ka[e] & 0xffffu); ak[2 * e + 1] += wk[2 * e + 1] * bf2f(ka[e] >> 16); } } }
#pragma unroll
            for (int e = 0; e < 8; ++e) { aq[e] = aq[e] * sigmoidf_(aq[e]) * 0.08838834764831845f; ak[e] = ak[e] * sigmoidf_(ak[e]); }
            v4u oq, ok; oq.x = pk2(aq[0], aq[1]); oq.y = pk2(aq[2], aq[3]); oq.z = pk2(aq[4], aq[5]); oq.w = pk2(aq[6], aq[7]);
            ok.x = pk2(ak[0], ak[1]); ok.y = pk2(ak[2], ak[3]); ok.z = pk2(ak[4], ak[5]); ok.w = pk2(ak[6], ak[7]);
            *(v4u*)(CQ + (size_t)t * 512 + col) = oq; *(v4u*)(CK + (size_t)t * 512 + col) = ok;
        }
    }
}
__device__ __forceinline__ void b1_item(int item, const bf16* CK, const bf16* MV, const float* GATES, const float* b_i, const float* b_f, float* ST, lptr lds) {
    const int tid = tidx(), lane = tid & 63, r32 = lane & 31, hi = lane >> 5; const int wave = __builtin_amdgcn_readfirstlane(tid >> 6);
    LAS float* eb = (LAS float*)(lds + SMALL_OFF); LAS float* wcol = eb + 64; LAS float* wupd = wcol + 64; LAS float* misc = wupd + 64 + 64 + 128;
    {
        const int h = item >> 6, j = item & 63;
        f32x16 accS[2]; accS[0] = f32x16{}; accS[1] = f32x16{};
        float nv = 0.f, sumb = 0.f;
        const float bi = b_i[h], bf_ = b_f[h];
        for (int c = 0; c < 4; ++c) {
            const int t0 = j * 256 + c * 64;
            __syncthreads();
            if (wave == 0) sumb += gates_chunk(GATES, bi, bf_, t0, h, lane, eb, wcol, wupd, misc);
            __syncthreads();
            stage_transposed(CK, MV, t0, h, lds, wupd, tid);
            const float aL = misc[0];
            __syncthreads();
            state_update(accS, lds, aL, wave, r32, hi);
            if (tid < 128) nv = aL * nv + kwt_rowsum(lds, tid);
        }
        float* st = ST + (size_t)item * ST_STRIDE;
#pragma unroll
        for (int i = 0; i < 2; ++i)
#pragma unroll
            for (int r = 0; r < 16; ++r) st[((wave * 2 + i) * 16 + r) * 64 + lane] = accS[i][r];
        if (tid < 128) st[16384 + tid] = nv;
        if (tid == 0) st[16384 + 128] = __expf(sumb);
    }
}
__device__ __forceinline__ void phase_b2(float* ST) {
    const int gt = blockIdx.x * NTHREADS + tidx(), NGT = gridDim.x * NTHREADS;
    for (int q = gt; q < 4 * (16384 + 128); q += NGT) {
        const int h = q / (16384 + 128), e = q % (16384 + 128);
        float* base = ST + (size_t)h * 64 * ST_STRIDE;
        float c = 0.f;
#pragma unroll 1
        for (int jb = 0; jb < 64; jb += 16) {
            float u[16], a[16];
#pragma unroll
            for (int k = 0; k < 16; ++k) { u[k] = base[(size_t)(jb + k) * ST_STRIDE + e]; a[k] = base[(size_t)(jb + k) * ST_STRIDE + 16384 + 128]; }
#pragma unroll
            for (int k = 0; k < 16; ++k) { base[(size_t)(jb + k) * ST_STRIDE + e] = c; c = a[k] * c + u[k]; }
        }
    }
}
__device__ __forceinline__ void phase_b3(const bf16* CQ, const bf16* CK, const bf16* MV, const bf16* MO, const float* GATES, const float* b_i, const float* b_f, const float* ml_g,
                                         const float* ST, bf16* ACAT, lptr lds) {
    const int tid = tidx(), lane = tid & 63, r32 = lane & 31, hi = lane >> 5; const int wave = __builtin_amdgcn_readfirstlane(tid >> 6);
    LAS float* eb = (LAS float*)(lds + SMALL_OFF); LAS float* wcol = eb + 64; LAS float* wupd = wcol + 64; LAS float* dinv = wupd + 64; LAS float* nvec = dinv + 64; LAS float* misc = nvec + 128;
    const int er = wave & 3, dc0 = 2 * (wave >> 2);
    for (int item = blockIdx.x; item < 256; item += gridDim.x) {
        const int h = item >> 6, j = item & 63;
        const float* st = ST + (size_t)item * ST_STRIDE;
        f32x16 accS[2];
#pragma unroll
        for (int i = 0; i < 2; ++i)
#pragma unroll
            for (int r = 0; r < 16; ++r) accS[i][r] = st[((wave * 2 + i) * 16 + r) * 64 + lane];
        __syncthreads();
        if (tid < 128) nvec[tid] = st[16384 + tid];
#pragma unroll
        for (int i = 0; i < 2; ++i)
#pragma unroll
            for (int r = 0; r < 16; ++r) *(LAS unsigned short*)(lds + CT_OFF + (32 * er + crow(r, hi)) * LD128 + (32 * (dc0 + i) + r32) * 2) = (unsigned short)f2bf(accS[i][r]);
        const float bi = b_i[h], bf_ = b_f[h];
        for (int c = 0; c < 4; ++c) {
            const int t0 = j * 256 + c * 64;
            __syncthreads();
            if (wave == 0) (void)gates_chunk(GATES, bi, bf_, t0, h, lane, eb, wcol, wupd, misc);
            __syncthreads();
#pragma unroll
            for (int i = 0; i < 2; ++i) { const int p = tid + 512 * i, row = p >> 4, ch = p & 15; const size_t g = (size_t)(t0 + row) * 512 + h * 128 + ch * 8;
                const v4u qv = *(const v4u*)(CQ + g), kv = *(const v4u*)(CK + g); const float e_ = eb[row];
                v4u qo; qo.x = pk2(e_ * bf2f(qv.x & 0xffffu), e_ * bf2f(qv.x >> 16)); qo.y = pk2(e_ * bf2f(qv.y & 0xffffu), e_ * bf2f(qv.y >> 16));
                qo.z = pk2(e_ * bf2f(qv.z & 0xffffu), e_ * bf2f(qv.z >> 16)); qo.w = pk2(e_ * bf2f(qv.w & 0xffffu), e_ * bf2f(qv.w >> 16));
                *(LAS v4u*)(lds + QP_OFF + row * LD128 + ch * 16) = qo; *(LAS v4u*)(lds + K_OFF + row * LD128 + ch * 16) = kv; }
            stage_transposed(CK, MV, t0, h, lds, wupd, tid);
            const float aL = misc[0];
            __syncthreads();
            const int tr = wave >> 2, tc = wave & 3;
            if (wave < 4) {
                const int sr = wave >> 1, sc = wave & 1;
                f32x16 sa = f32x16{};
                mm_tile<8>(sa, lds + QP_OFF + (32 * sr) * LD128, LD128, lds + K_OFF + (32 * sc) * LD128, LD128, r32, hi);
                const int s_ = 32 * sc + r32; const float wc_ = wcol[s_];
#pragma unroll
                for (int r = 0; r < 16; ++r) { const int t_ = 32 * sr + crow(r, hi); const float v = (s_ <= t_) ? sa[r] * wc_ : 0.f;
                    *(LAS unsigned short*)(lds + SM_OFF + t_ * LD64 + s_ * 2) = (unsigned short)f2bf(v); }
            }
            f32x16 acc = f32x16{};
            mm_tile<8>(acc, lds + QP_OFF + (32 * tr) * LD128, LD128, lds + CT_OFF + (32 * tc) * LD128, LD128, r32, hi);
            __syncthreads();
            mm_tile<4>(acc, lds + SM_OFF + (32 * tr) * LD64, LD64, lds + VT_OFF + (32 * tc) * LD64, LD64, r32, hi);
            if (tid < 64) {
                float dn = 0.f; lptr qp = lds + QP_OFF + tid * LD128;
#pragma unroll 4
                for (int i = 0; i < 16; ++i) { const v4u q = *(const LAS v4u*)(qp + 16 * i); const LAS float* nn = nvec + 8 * i;
                    dn += bf2f(q.x & 0xffffu) * nn[0] + bf2f(q.x >> 16) * nn[1] + bf2f(q.y & 0xffffu) * nn[2] + bf2f(q.y >> 16) * nn[3]
                        + bf2f(q.z & 0xffffu) * nn[4] + bf2f(q.z >> 16) * nn[5] + bf2f(q.w & 0xffffu) * nn[6] + bf2f(q.w >> 16) * nn[7]; }
                lptr sp_ = lds + SM_OFF + tid * LD64;
#pragma unroll
                for (int i = 0; i < 8; ++i) { const v4u q = *(const LAS v4u*)(sp_ + 16 * i);
                    dn += (bf2f(q.x & 0xffffu) + bf2f(q.x >> 16)) + (bf2f(q.y & 0xffffu) + bf2f(q.y >> 16)) + (bf2f(q.z & 0xffffu) + bf2f(q.z >> 16)) + (bf2f(q.w & 0xffffu) + bf2f(q.w >> 16)); }
                dinv[tid] = 1.f / fmaxf(fabsf(dn), 1.f);
            }
            __syncthreads();
#pragma unroll
            for (int r = 0; r < 16; ++r) { const int t_ = 32 * tr + crow(r, hi); *(LAS float*)(lds + Y_OFF + (t_ * LDY + 32 * tc + r32) * 4) = acc[r] * dinv[t_]; }
            state_update(accS, lds, aL, wave, r32, hi);
            float nnew = 0.f;
            if (tid < 128) nnew = aL * nvec[tid] + kwt_rowsum(lds, tid);
            __syncthreads();
            if (tid < 128) nvec[tid] = nnew;
#pragma unroll
            for (int i = 0; i < 2; ++i)
#pragma unroll
                for (int r = 0; r < 16; ++r) *(LAS unsigned short*)(lds + CT_OFF + (32 * er + crow(r, hi)) * LD128 + (32 * (dc0 + i) + r32) * 2) = (unsigned short)f2bf(accS[i][r]);
#pragma unroll 2
            for (int rr = 0; rr < 8; ++rr) { const int t_ = wave * 8 + rr; const size_t grow = (size_t)(t0 + t_);
                const float y0 = *(const LAS float*)(lds + Y_OFF + (t_ * LDY + 2 * lane) * 4), y1 = *(const LAS float*)(lds + Y_OFF + (t_ * LDY + 2 * lane + 1) * 4);
                const unsigned ov = *(const unsigned*)(MO + grow * 512 + h * 128 + 2 * lane);
                const float z0 = y0 * sigmoidf_(bf2f(ov & 0xffffu)), z1 = y1 * sigmoidf_(bf2f(ov >> 16));
                const float rs = rsqrtf(wave_sum(z0 * z0 + z1 * z1) * (1.f / 128.f) + EPS);
                *(unsigned*)(ACAT + grow * 1024 + 512 + h * 128 + 2 * lane) = pk2(z0 * rs * ml_g[h * 128 + 2 * lane], z1 * rs * ml_g[h * 128 + 2 * lane + 1]); }
        }
    }
}
}

__device__ __forceinline__ void ph_route_naive(const bf16* QP, const float* SK, int2* ROUTE, float* lds) {
    float* qs = lds; float* sc = qs + 2048; float* sv = sc + 2048; int* si = (int*)(sv + 256); float* cand = (float*)(si + 256); float* tops = cand + 2048; int* tope = (int*)(tops + 128);
    const int tid = tidx();
    for (int t = blockIdx.x; t < M; t += gridDim.x) {
        __syncthreads();
        for (int i = tid; i < 2048; i += NTHREADS) qs[i] = bf2f(QP[(size_t)t * 2048 + i]);
        __syncthreads();
#pragma unroll 1
        for (int j = 0; j < 4; ++j) { const int sidx = tid + 512 * j, hc = sidx >> 7; const float* kp = SK + (size_t)sidx * 128; const float* qq = qs + hc * 128; float s = 0.f;
            for (int d = 0; d < 128; d += 4) { const f32x4 kv = *(const f32x4*)(kp + d); s += qq[d] * kv.x + qq[d + 1] * kv.y + qq[d + 2] * kv.z + qq[d + 3] * kv.w; }
            sc[sidx] = s; }
        __syncthreads();
        if (tid < 16) { const int hc = tid;
            for (int k = 0; k < 16; ++k) { float best = -INFINITY; int bi = 0;
                for (int n = 0; n < 128; ++n) { const float v = sc[hc * 128 + n]; if (v > best) { best = v; bi = n; } }
                sv[hc * 16 + k] = best; si[hc * 16 + k] = bi; sc[hc * 128 + bi] = -INFINITY; } }
        __syncthreads();
        for (int i = tid; i < 2048; i += NTHREADS) { const int h = i >> 8, a = (i >> 4) & 15, b = i & 15; cand[i] = sv[(2 * h) * 16 + a] + sv[(2 * h + 1) * 16 + b]; }
        __syncthreads();
        if (tid < 8) { const int h = tid;
            for (int k = 0; k < 16; ++k) { float best = -INFINITY; int bi = 0;
                for (int n = 0; n < 256; ++n) { const float v = cand[h * 256 + n]; if (v > best) { best = v; bi = n; } }
                tops[h * 16 + k] = best; tope[h * 16 + k] = si[(2 * h) * 16 + (bi >> 4)] * 128 + si[(2 * h + 1) * 16 + (bi & 15)]; cand[h * 256 + bi] = -INFINITY; }
            const float mx = tops[h * 16]; float sum = 0.f;
            for (int k = 0; k < 16; ++k) sum += expf(tops[h * 16 + k] - mx);
            const float inv = 1.f / sum;
            for (int k = 0; k < 16; ++k) ROUTE[((size_t)t * 8 + h) * 16 + k] = make_int2(tope[h * 16 + k], __float_as_int(expf(tops[h * 16 + k] - mx) * inv)); }
    }
}
__device__ __forceinline__ void ph_expert_naive(const bf16* XN, const int2* ROUTE, const float* EU, const float* EV, float* X, float* lds) {
    float* xs = lds; float* ws = xs + 1024; int* es = (int*)(ws + 128); float* gs = (float*)(es + 128);
    const int tid = tidx();
    for (int t = blockIdx.x; t < M; t += gridDim.x) {
        __syncthreads();
        for (int i = tid; i < 1024; i += NTHREADS) xs[i] = bf2f(XN[(size_t)t * 1024 + i]);
        if (tid < 128) { const int2 r = ROUTE[(size_t)t * 128 + tid]; es[tid] = r.x; gs[tid] = __int_as_float(r.y); }
        __syncthreads();
        { const int e = tid >> 2, part = tid & 3; const float* u = EU + (size_t)es[e] * 1024 + part * 4; const float* xx = xs + part * 4; float s = 0.f;
          for (int d = 0; d < 1024; d += 16) { const f32x4 uv = *(const f32x4*)(u + d); s += xx[d] * uv.x + xx[d + 1] * uv.y + xx[d + 2] * uv.z + xx[d + 3] * uv.w; }
          s += __shfl_xor(s, 1); s += __shfl_xor(s, 2);
          const float a = 0.5f * s * (1.f + erff(s * 0.7071067811865476f));
          if (part == 0) ws[e] = gs[e] * a; }
        __syncthreads();
#pragma unroll 1
        for (int j = 0; j < 2; ++j) { const int n = tid + 512 * j; float o = 0.f;
            for (int e = 0; e < 128; ++e) o += ws[e] * EV[(size_t)es[e] * 1024 + n];
            X[(size_t)t * 1024 + n] += o; }
    }
}


namespace peer {
typedef __bf16 bf16x2_t __attribute__((ext_vector_type(2)));
typedef float f32x2_t __attribute__((ext_vector_type(2)));
typedef LAS unsigned char* lptr;
__device__ __forceinline__ float dot2(unsigned a, unsigned b, float c) { return __builtin_amdgcn_fdot2_f32_bf16(__builtin_bit_cast(bf16x2_t, a), __builtin_bit_cast(bf16x2_t, b), c, false); }
template <int CTRL> __device__ __forceinline__ float dpp(float x) { return __builtin_bit_cast(float, __builtin_amdgcn_mov_dpp(__builtin_bit_cast(int, x), CTRL, 0xf, 0xf, true)); }
__device__ __forceinline__ float row16_sum(float x) { x += dpp<0x128>(x); x += dpp<0x124>(x); x += dpp<0x122>(x); x += dpp<0x121>(x); return x; }
__device__ __forceinline__ unsigned fp8lo_bf16(unsigned w) { return __builtin_bit_cast(unsigned, __builtin_amdgcn_cvt_scalef32_pk_bf16_fp8(w, 1.0f, false)); }
__device__ __forceinline__ unsigned fp8hi_bf16(unsigned w) { return __builtin_bit_cast(unsigned, __builtin_amdgcn_cvt_scalef32_pk_bf16_fp8(w, 1.0f, true)); }
__device__ __forceinline__ float dot16(const v4u& u, const v4u& x0, const v4u& x1, float d) {
    d = dot2(fp8lo_bf16(u.x), x0.x, d); d = dot2(fp8hi_bf16(u.x), x0.y, d); d = dot2(fp8lo_bf16(u.y), x0.z, d); d = dot2(fp8hi_bf16(u.y), x0.w, d);
    d = dot2(fp8lo_bf16(u.z), x1.x, d); d = dot2(fp8hi_bf16(u.z), x1.y, d); d = dot2(fp8lo_bf16(u.w), x1.z, d); return dot2(fp8hi_bf16(u.w), x1.w, d);
}
__device__ __forceinline__ void convert_tables(const float* EU, const float* EV, const float* gu, unsigned char* EU8, unsigned char* EV8, float* SI) {
    const int lane = tidx() & 63, wave = tidx() >> 6;
    const int gw = blockIdx.x * NWAVES + wave, NGW = gridDim.x * NWAVES;
    f32x4 gg[4];
#pragma unroll
    for (int j = 0; j < 4; ++j) gg[j] = *(const f32x4*)(gu + 4 * lane + 256 * j);
    for (int r0 = gw * 4; r0 < 2 * 16384; r0 += NGW * 4) {
        f32x4 v[4][4];
#pragma unroll
        for (int q = 0; q < 4; ++q) { const int r = r0 + q; const bool second = r >= 16384; const float* src = (second ? EV : EU) + (size_t)(second ? r - 16384 : r) * 1024 + 4 * lane;
#pragma unroll
            for (int j = 0; j < 4; ++j) v[q][j] = *(const f32x4*)(src + 256 * j); }
#pragma unroll
        for (int q = 0; q < 4; ++q) { const int r = r0 + q; const bool second = r >= 16384; const int row = second ? r - 16384 : r;
            float am = 0.f;
#pragma unroll
            for (int j = 0; j < 4; ++j) { if (!second) v[q][j] = v[q][j] * gg[j];
                am = fmaxf(am, fmaxf(fmaxf(fabsf(v[q][j].x), fabsf(v[q][j].y)), fmaxf(fabsf(v[q][j].z), fabsf(v[q][j].w)))); }
#pragma unroll
            for (int o = 1; o < 64; o <<= 1) am = fmaxf(am, __shfl_xor(am, o));
            const int e = (int)((__float_as_uint(am) >> 23) & 0xffu) - 127;
            const bool ok = am > 1e-30f;
            const float sc = ok ? __uint_as_float((unsigned)(127 + 6 - e) << 23) : 1.f, isc = ok ? __uint_as_float((unsigned)(127 - 6 + e) << 23) : 1.f;
            unsigned char* dst = (second ? EV8 : EU8) + (size_t)row * 1024 + 4 * lane;
#pragma unroll
            for (int j = 0; j < 4; ++j) { int p = __builtin_amdgcn_cvt_pk_fp8_f32(v[q][j].x * sc, v[q][j].y * sc, 0, false); p = __builtin_amdgcn_cvt_pk_fp8_f32(v[q][j].z * sc, v[q][j].w * sc, p, true); *(unsigned*)(dst + 256 * j) = (unsigned)p; }
            if (lane == 0) SI[r] = isc; }
    }
}
__device__ __forceinline__ void expert_phase(const bf16* XG, const float* RS, bf16* XN, const int2* ROUTE, const unsigned char* EU8, const unsigned char* EV8, const float* SI, const float* X, float* XO, const float* g_next, lptr lds) {
    const int lane = tidx() & 63, grp = lane >> 4, li = lane & 15; const int wave = __builtin_amdgcn_readfirstlane(tidx() >> 6);
    LAS int* ids = (LAS int*)(lds + wave * 1024); LAS float* wts = (LAS float*)(ids + 128);
    const int gw = blockIdx.x * NWAVES + wave, NGW = gridDim.x * NWAVES;
    for (int t = gw; t < M; t += NGW) {
        v4u xq[8];
#pragma unroll
        for (int j = 0; j < 4; ++j) { const bf16* xp = XG + (size_t)t * 1024 + 256 * j + 16 * li; xq[2 * j] = *(const v4u*)xp; xq[2 * j + 1] = *(const v4u*)(xp + 8); }
        const float rt = rsqrtf(row16_sum(RS[(size_t)t * 16 + li]) * (1.f / D) + EPS);
        { const int2 r0 = ROUTE[(size_t)t * 128 + lane], r1 = ROUTE[(size_t)t * 128 + 64 + lane];
          ids[lane] = r0.x; ids[lane + 64] = r1.x; wts[lane] = __int_as_float(r0.y); wts[lane + 64] = __int_as_float(r1.y); }
        v4u ua[8], ub[8];
#define PEER_ULOAD(buf, b) do { _Pragma("unroll") for (int ps = 0; ps < 2; ++ps) { const unsigned char* up_ = EU8 + (size_t)ids[8 * (b) + 4 * ps + grp] * 1024 + 16 * li; \
            _Pragma("unroll") for (int j = 0; j < 4; ++j) buf[4 * ps + j] = *(const v4u*)(up_ + 256 * j); } } while (0)
#define PEER_UCOMP(buf, b) do { _Pragma("unroll") for (int ps = 0; ps < 2; ++ps) { float d_ = 0.f; \
            _Pragma("unroll") for (int j = 0; j < 4; ++j) d_ = dot16(buf[4 * ps + j], xq[2 * j], xq[2 * j + 1], d_); \
            d_ = row16_sum(d_) * (rt * SI[ids[8 * (b) + 4 * ps + grp]]); \
            const float a_ = 0.5f * d_ * (1.f + erff(d_ * 0.7071067811865476f)); if (li == 0) wts[8 * (b) + 4 * ps + grp] *= a_; } } while (0)
        PEER_ULOAD(ua, 0);
#pragma unroll 1
        for (int b = 0; b < 16; b += 2) {
            PEER_ULOAD(ub, b + 1);
            PEER_UCOMP(ua, b);
            if (b + 2 < 16) PEER_ULOAD(ua, b + 2);
            PEER_UCOMP(ub, b + 1);
        }
#undef PEER_ULOAD
#undef PEER_UCOMP
        float acc[16];
#pragma unroll
        for (int i = 0; i < 16; ++i) acc[i] = 0.f;
        v4u va[8], vb[8];
#define PEER_VLOAD(buf, b) do { _Pragma("unroll") for (int k = 0; k < 8; ++k) buf[k] = *(const v4u*)(EV8 + (size_t)ids[8 * (b) + k] * 1024 + 16 * lane); } while (0)
#define PEER_VCOMP(buf, b) do { _Pragma("unroll") for (int k = 0; k < 8; ++k) { const float w_ = wts[8 * (b) + k] * SI[16384 + ids[8 * (b) + k]]; const v4u q_ = buf[k]; \
            const unsigned qq_[4] = {q_.x, q_.y, q_.z, q_.w}; \
            _Pragma("unroll") for (int i = 0; i < 4; ++i) { const f32x2_t lo_ = __builtin_amdgcn_cvt_pk_f32_fp8((int)qq_[i], false), hi_ = __builtin_amdgcn_cvt_pk_f32_fp8((int)qq_[i], true); \
                acc[4 * i + 0] = fmaf(w_, lo_.x, acc[4 * i + 0]); acc[4 * i + 1] = fmaf(w_, lo_.y, acc[4 * i + 1]); acc[4 * i + 2] = fmaf(w_, hi_.x, acc[4 * i + 2]); acc[4 * i + 3] = fmaf(w_, hi_.y, acc[4 * i + 3]); } } } while (0)
        PEER_VLOAD(va, 0);
#pragma unroll 1
        for (int b = 0; b < 16; b += 2) {
            PEER_VLOAD(vb, b + 1);
            PEER_VCOMP(va, b);
            if (b + 2 < 16) PEER_VLOAD(va, b + 2);
            PEER_VCOMP(vb, b + 1);
        }
#undef PEER_VLOAD
#undef PEER_VCOMP
        { const float* xi = X + (size_t)t * 1024 + 16 * lane; float* xo = XO + (size_t)t * 1024 + 16 * lane;
#pragma unroll
          for (int i = 0; i < 4; ++i) { f32x4 a = *(const f32x4*)(xi + 4 * i); a.x += acc[4 * i + 0]; a.y += acc[4 * i + 1]; a.z += acc[4 * i + 2]; a.w += acc[4 * i + 3]; *(f32x4*)(xo + 4 * i) = a;
              acc[4 * i + 0] = a.x; acc[4 * i + 1] = a.y; acc[4 * i + 2] = a.z; acc[4 * i + 3] = a.w; }
          float ss = 0.f;
#pragma unroll
          for (int i = 0; i < 16; ++i) ss += acc[i] * acc[i];
          const float rn = rsqrtf(wave_sum(ss) * (1.f / D) + EPS);
          const float* gp = g_next + 16 * lane; v4u w0, w1;
          w0.x = pk2(acc[0] * rn * gp[0], acc[1] * rn * gp[1]); w0.y = pk2(acc[2] * rn * gp[2], acc[3] * rn * gp[3]); w0.z = pk2(acc[4] * rn * gp[4], acc[5] * rn * gp[5]); w0.w = pk2(acc[6] * rn * gp[6], acc[7] * rn * gp[7]);
          w1.x = pk2(acc[8] * rn * gp[8], acc[9] * rn * gp[9]); w1.y = pk2(acc[10] * rn * gp[10], acc[11] * rn * gp[11]); w1.z = pk2(acc[12] * rn * gp[12], acc[13] * rn * gp[13]); w1.w = pk2(acc[14] * rn * gp[14], acc[15] * rn * gp[15]);
          bf16* xnp = XN + (size_t)t * 1024 + 16 * lane; *(v4u*)xnp = w0; *(v4u*)(xnp + 8) = w1; }
    }
}
}


namespace route {
typedef short bf16x8 __attribute__((ext_vector_type(8)));
typedef float f32x16 __attribute__((ext_vector_type(16)));
typedef LAS unsigned char* lptr;
__device__ __forceinline__ unsigned f2sort(float f) { const unsigned u = __float_as_uint(f); return (u & 0x80000000u) ? ~u : (u | 0x80000000u); }
__device__ __forceinline__ float sort2f(unsigned s) { return __uint_as_float((s & 0x80000000u) ? (s & 0x7fffffffu) : ~s); }
__device__ __forceinline__ unsigned umax_(unsigned a, unsigned b) { return a > b ? a : b; }
__device__ __forceinline__ unsigned umin_(unsigned a, unsigned b) { return a < b ? a : b; }
__device__ __forceinline__ unsigned selu(int hi, unsigned a, unsigned b) { asm volatile("" : "+v"(a), "+v"(b)); return hi ? b : a; }
__device__ __forceinline__ float self(int hi, float a, float b) { asm volatile("" : "+v"(a), "+v"(b)); return hi ? b : a; }
__device__ __forceinline__ unsigned partner32(unsigned x, int hi) { auto r = __builtin_amdgcn_permlane32_swap(x, x, false, false); return hi ? r[0] : r[1]; }
__device__ __forceinline__ void sort16_desc(unsigned (&x)[16]) {
#pragma unroll
    for (int k = 2; k <= 16; k <<= 1)
#pragma unroll
        for (int j = k >> 1; j > 0; j >>= 1)
#pragma unroll
            for (int i = 0; i < 16; ++i) { const int l = i ^ j; if (l > i) { const bool desc = ((i & k) == 0); const unsigned a = x[i], b = x[l], mx = umax_(a, b), mn = umin_(a, b); x[i] = desc ? mx : mn; x[l] = desc ? mn : mx; } }
}
__device__ __forceinline__ void merge_top16(unsigned (&a)[16], const unsigned (&b)[16]) {
#pragma unroll
    for (int i = 0; i < 16; ++i) a[i] = umax_(a[i], b[15 - i]);
#pragma unroll
    for (int j = 8; j > 0; j >>= 1)
#pragma unroll
        for (int i = 0; i < 16; ++i) { const int l = i ^ j; if (l > i) { const unsigned p = a[i], q = a[l]; a[i] = umax_(p, q); a[l] = umin_(p, q); } }
}
__device__ __forceinline__ void convert_subkeys(const float* SK, bf16* SKB) {
    const int n8 = 16 * 128 * 128 / 8, stride = gridDim.x * NTHREADS;
    for (int i = blockIdx.x * NTHREADS + tidx(); i < n8; i += stride) { const f32x4 a = *(const f32x4*)(SK + (size_t)i * 8), b = *(const f32x4*)(SK + (size_t)i * 8 + 4);
        v4u o; o.x = pk2(a.x, a.y); o.y = pk2(a.z, a.w); o.z = pk2(b.x, b.y); o.w = pk2(b.z, b.w); *(v4u*)(SKB + (size_t)i * 8) = o; }
}
__device__ __forceinline__ void route_phase(const bf16* QP, const bf16* SKB, const float* RS, int2* ROUTE, lptr lds) {
    const int lane = tidx() & 63, r32 = lane & 31, hi = lane >> 5; const int wave = __builtin_amdgcn_readfirstlane(tidx() >> 6);
    LAS int* myl = (LAS int*)(lds + wave * 8448) + lane * 33;
    const int gw = blockIdx.x * NWAVES + wave, NGW = gridDim.x * NWAVES;
    for (int it = gw; it < 4096; it += NGW) {
        const int tb = it >> 3, h = it & 7, token = tb * 32 + r32;
        unsigned top0[16], top1[16];
#pragma unroll
        for (int i = 0; i < 16; ++i) { top0[i] = 0u; top1[i] = 0u; }
#pragma unroll
        for (int c = 0; c < 2; ++c) {
            const int hc = h * 2 + c;
            bf16x8 qf[8];
#pragma unroll
            for (int ks = 0; ks < 8; ++ks) qf[ks] = *(const bf16x8*)(QP + (size_t)token * 2048 + hc * 128 + 16 * ks + 8 * hi);
#pragma unroll 1
            for (int kt = 0; kt < 4; ++kt) {
                const bf16* ap = SKB + ((size_t)(hc * 128 + 32 * kt + r32)) * 128 + 8 * hi;
                f32x16 acc = f32x16{};
#pragma unroll
                for (int ks = 0; ks < 8; ++ks) { const bf16x8 a = *(const bf16x8*)(ap + 16 * ks); acc = __builtin_amdgcn_mfma_f32_32x32x16_bf16(a, qf[ks], acc, 0, 0, 0); }
                const unsigned code0 = 127u - (unsigned)(32 * kt + 4 * hi);
                unsigned pt[16];
#pragma unroll
                for (int r = 0; r < 16; ++r) pt[r] = (f2sort(acc[r]) & ~0x7Fu) | (code0 - (unsigned)((r & 3) + 8 * (r >> 2)));
                sort16_desc(pt);
                if (c == 0) merge_top16(top0, pt); else merge_top16(top1, pt);
            }
            { unsigned oth[16];
#pragma unroll
              for (int i = 0; i < 16; ++i) oth[i] = partner32(c == 0 ? top0[i] : top1[i], hi);
              if (c == 0) merge_top16(top0, oth); else merge_top16(top1, oth); }
        }
#pragma unroll
        for (int i = 0; i < 16; ++i) { myl[i] = 127 - (int)(top0[i] & 0x7Fu); myl[16 + i] = 127 - (int)(top1[i] & 0x7Fu); }
        float a1[16], ai[8];
#pragma unroll
        for (int i = 0; i < 16; ++i) a1[i] = sort2f(top1[i] & ~0x7Fu);
#pragma unroll
        for (int i = 0; i < 8; ++i) ai[i] = sort2f(selu(hi, top0[i], top0[8 + i]) & ~0x7Fu);
        unsigned top2[16];
#pragma unroll
        for (int i = 0; i < 16; ++i) top2[i] = 0u;
#pragma unroll
        for (int ii = 0; ii < 8; ++ii) {
            unsigned rw[16];
#pragma unroll
            for (int j = 0; j < 16; ++j) rw[j] = (f2sort(ai[ii] + a1[j]) & ~0xFFu) | (255u - (unsigned)(128 * hi + 16 * ii + j));
            merge_top16(top2, rw);
        }
        { unsigned oth[16];
#pragma unroll
          for (int i = 0; i < 16; ++i) oth[i] = partner32(top2[i], hi);
          merge_top16(top2, oth); }
        float rt; { const f32x4* rp = (const f32x4*)(RS + (size_t)token * 16); const f32x4 a = rp[0], b = rp[1], c = rp[2], d = rp[3];
            rt = rsqrtf((((a.x + a.y) + (a.z + a.w)) + ((b.x + b.y) + (b.z + b.w)) + ((c.x + c.y) + (c.z + c.w)) + ((d.x + d.y) + (d.z + d.w))) * (1.f / D) + EPS); }
        const float mx = sort2f(top2[0] & ~0xFFu);
        float ex[16], sum = 0.f;
#pragma unroll
        for (int k = 0; k < 16; ++k) { ex[k] = __expf(rt * (sort2f(top2[k] & ~0xFFu) - mx)); sum += ex[k]; }
        const float inv = 1.f / sum;
        int2* dst = ROUTE + ((size_t)token * 8 + h) * 16 + 8 * hi;
#pragma unroll
        for (int k = 0; k < 8; k += 2) {
            const unsigned p0 = selu(hi, top2[k], top2[8 + k]), p1 = selu(hi, top2[k + 1], top2[9 + k]);
            const float g0 = self(hi, ex[k], ex[8 + k]) * inv, g1 = self(hi, ex[k + 1], ex[9 + k]) * inv;
            const int pos0 = 255 - (int)(p0 & 0xFFu), pos1 = 255 - (int)(p1 & 0xFFu);
            const int e0 = myl[pos0 >> 4] * 128 + myl[16 + (pos0 & 15)], e1 = myl[pos1 >> 4] * 128 + myl[16 + (pos1 & 15)];
            v4u o; o.x = (unsigned)e0; o.y = __float_as_uint(g0); o.z = (unsigned)e1; o.w = __float_as_uint(g1);
            *(v4u*)(dst + k) = o;
        }
    }
}
}


__device__ __forceinline__ void ph_qk_norms(const bf16* QA, const bf16* KA, unsigned* norms) {
    const int lane = tidx() & 63, wave = tidx() >> 6;
    const int gw = blockIdx.x * NWAVES + wave, NGW = gridDim.x * NWAVES;
    float mq = 0.f, mk = 0.f;
    for (int m = gw; m < M; m += NGW) {
        const v4u q = *(const v4u*)(QA + (size_t)m * 512 + lane * 8), k = *(const v4u*)(KA + (size_t)m * 512 + lane * 8);
        const unsigned qa[4] = {q.x, q.y, q.z, q.w}, ka[4] = {k.x, k.y, k.z, k.w};
        float sq = 0.f, sk = 0.f;
#pragma unroll
        for (int i = 0; i < 4; ++i) { const float a = bf2f(qa[i] & 0xffffu), b = bf2f(qa[i] >> 16), c = bf2f(ka[i] & 0xffffu), d = bf2f(ka[i] >> 16); sq += a * a + b * b; sk += c * c + d * d; }
#pragma unroll
        for (int o = 1; o < 8; o <<= 1) { sq += __shfl_xor(sq, o); sk += __shfl_xor(sk, o); }
        mq = fmaxf(mq, sq); mk = fmaxf(mk, sk);
    }
    if ((lane & 7) == 0) { atomicMax(norms + (lane >> 3), __float_as_uint(mq)); atomicMax(norms + 8 + (lane >> 3), __float_as_uint(mk)); }
}
constexpr int NPHASE = 12;
struct Args { const float* in[24]; float* out; unsigned char* ws; int ph_lo, ph_hi, use_bar, pad; };

__global__ void __launch_bounds__(NTHREADS, 2) mk_fwd(Args args) {
    extern __shared__ __attribute__((aligned(16))) unsigned char lds_raw[];
    float* lds = (float*)lds_raw;
    volatile LAS unsigned* MISC = (volatile LAS unsigned*)((LAS unsigned char*)lds_raw + (LDS_BYTES - 64));
    unsigned char* ws = args.ws;
    unsigned* ctl = (unsigned*)(ws + WS_CTL);
    const float* x = args.in[0]; const float* p = args.in[1]; const float* norm_mix_g = args.in[2]; const float* w_in = args.in[3];
    const float* conv_w = args.in[4]; const float* conv_b = args.in[5]; const float* b_ig = args.in[6]; const float* b_fg = args.in[7];
    const float* lq1 = args.in[8]; const float* lk1 = args.in[9]; const float* lq2 = args.in[10]; const float* lk2 = args.in[11];
    const float* subln_g = args.in[12]; const float* ml_g = args.in[13]; const float* w_out = args.in[14]; const float* norm_ffn_g = args.in[15];
    const float* w_query = args.in[16]; const float* sub_keys = args.in[17]; const float* expert_u = args.in[18]; const float* expert_v = args.in[19];
    const float* norm_ple_g = args.in[20]; const float* w_ple_gate = args.in[21]; const float* w_ple_proj = args.in[22]; const float* final_g = args.in[23];
    float* out = args.out;
    bf16* XN = (bf16*)(ws + WS_XN); float* GATES = (float*)(ws + WS_GATES);
    bf16* QA = (bf16*)(ws + WS_QA); bf16* KA = (bf16*)(ws + WS_KA); bf16* VA = (bf16*)(ws + WS_VA);
    bf16* MQ = (bf16*)(ws + WS_MQ); bf16* MK = (bf16*)(ws + WS_MK); bf16* MV = (bf16*)(ws + WS_MV); bf16* MO = (bf16*)(ws + WS_MO);
    bf16* O1 = (bf16*)(ws + WS_O1); bf16* O2 = (bf16*)(ws + WS_O2); bf16* CQ = (bf16*)(ws + WS_CQ); bf16* CK = (bf16*)(ws + WS_CK);
    float* HS = (float*)(ws + WS_HS); bf16* ACAT = (bf16*)(ws + WS_ACAT); bf16* QP = (bf16*)(ws + WS_QP); int2* ROUTE = (int2*)(ws + WS_ROUTE);
    bf16* PB = (bf16*)(ws + WS_PB); bf16* PP = (bf16*)(ws + WS_PP);
    float* ST = (float*)(ws + WS_ST);
    bf16* SKB = (bf16*)(ws + WS_SKB);
    unsigned char* EU8 = ws + WS_EU8; unsigned char* EV8 = ws + WS_EV8; float* SI = (float*)(ws + WS_SI);
    float* RS = (float*)(ws + WS_RS); bf16* X1G = (bf16*)(ws + WS_X1G); bf16* XN3 = (bf16*)(ws + WS_XN3);
    bf16* WIN = (bf16*)(ws + WS_WIN); bf16* WOUT = (bf16*)(ws + WS_WOUT); bf16* WQ = (bf16*)(ws + WS_WQ); bf16* WG = (bf16*)(ws + WS_WG); bf16* WP = (bf16*)(ws + WS_WP);
    LAS unsigned char* ldsb = (LAS unsigned char*)lds_raw;

    XcdBarrier bar; bar.bar = ctl + CW_BAR; bar.x = 0; bar.st = nullptr;
    if (args.use_bar) {
        if (tidx() < 16) MISC[tidx()] = 0u;
        __syncthreads();
        bar = xcd_barrier_post(ctl + CW_BAR, MISC + 8);
    }
    const int lo = args.ph_lo, hi = args.ph_hi;
#define IN(k) (lo <= (k) && (k) < hi)
#define SEAM(k) do { if (IN(k) && IN((k) + 1)) xcd_barrier(bar); } while (0)

    if (IN(0)) { route::convert_subkeys(sub_keys, SKB); ph_weights_in(w_in, WIN, ldsb);
        for (int ch = blockIdx.x; ch < WCH_CHUNKS; ch += gridDim.x) weights_chunk(ch, w_out, w_query, norm_ffn_g, w_ple_gate, w_ple_proj, WOUT, WQ, WG, WP, ldsb);
        ph_rmsnorm_bf16(x, norm_mix_g, XN);
        { const size_t n = (size_t)M * PLE / 8, stride = (size_t)gridDim.x * NTHREADS;
          for (size_t i = (size_t)blockIdx.x * NTHREADS + tidx(); i < n; i += stride) { const f32x4 a = *(const f32x4*)(p + i * 8), b = *(const f32x4*)(p + i * 8 + 4);
              v4u o; o.x = pk2(a.x, a.y); o.y = pk2(a.z, a.w); o.z = pk2(b.x, b.y); o.w = pk2(b.z, b.w); *(v4u*)(PB + i * 8) = o; } }
    } SEAM(0);
    if (IN(1)) {
        pg8::Gemm g{XN, WIN, M, NINP, D}; pg8::StaticOrder S; S.init(M, NINP, (int)gridDim.x, (int)blockIdx.x);
        pg8::EpiProj E{QA, (size_t)(WS_KA - WS_QA) / 2, C2, GATES};
        pg8::gemm_phase<pg8::EpiProj, pg8::StaticOrder, true, true>(ldsb, g, S, E);
    } SEAM(1);
    if (IN(2)) { ph_qk_norms(QA, KA, ctl + CW_NORM); ml::conv_items(MQ, MK, conv_w, conv_b, CQ, CK); peer::convert_tables(expert_u, expert_v, norm_ffn_g, EU8, EV8, SI); } SEAM(2);
    if (IN(3)) {
        constexpr int Q_ATT = 1024, Q_END = Q_ATT + 256;
        for (;;) {
            __syncthreads();
            if (tidx() == 0) MISC[0] = __hip_atomic_fetch_add(ctl + CW_QUEUE, 1u, __ATOMIC_RELAXED, __HIP_MEMORY_SCOPE_AGENT);
            __syncthreads();
            const int u = (int)__builtin_amdgcn_readfirstlane(MISC[0]);
            if (u >= Q_END) break;
            if (u < Q_ATT) attn_body::attn_dispatch<8>(u, (char*)lds_raw, (const attn_body::bf16*)QA, (const attn_body::bf16*)KA, (const attn_body::bf16*)VA, (attn_body::bf16*)O1, (attn_body::bf16*)O2, ctl + CW_NORM);
            else ml::b1_item(u - Q_ATT, CK, MV, GATES, b_ig, b_fg, ST, ldsb);
        }
    } SEAM(3);
    if (IN(4)) { ml::phase_b2(ST); } SEAM(4);
    if (IN(5)) { ml::phase_b3(CQ, CK, MV, MO, GATES, b_ig, b_fg, ml_g, ST, ACAT, ldsb); ph_combine<false>(O1, O2, MO, HS, lq1, lk1, lq2, lk2, subln_g, ml_g, ACAT); } SEAM(5);
    if (IN(6)) {
        pg8::Gemm g{ACAT, WOUT, M, D, D}; pg8::StaticOrder S; S.init(M, D, (int)gridDim.x, (int)blockIdx.x);
        pg8::EpiResX1 E{x, out, X1G, RS, D};
        pg8::gemm_phase<pg8::EpiResX1, pg8::StaticOrder, true, true>(ldsb, g, S, E);
    } SEAM(6);
    if (IN(7)) {
        { pg8::Gemm g{X1G, WQ, M, NQ, D}; pg8::StaticOrder S; S.init(M, NQ, (int)gridDim.x, (int)blockIdx.x);
          pg8::EpiBf16<0> E{QP, NQ, nullptr, 0, 0, 1.f};
          pg8::gemm_phase<pg8::EpiBf16<0>, pg8::StaticOrder, true, true>(ldsb, g, S, E); }
        { pg8::Gemm g{PB, WP, M, D, PLE}; pg8::StaticOrder S; S.init(M, D, (int)gridDim.x, (int)blockIdx.x);
          pg8::EpiBf16<0> E{PP, D, nullptr, 0, 0, 1.f};
          pg8::gemm_phase<pg8::EpiBf16<0>, pg8::StaticOrder, true, true>(ldsb, g, S, E); }
    } SEAM(7);
    if (IN(8)) { route::route_phase(QP, SKB, RS, ROUTE, ldsb); } SEAM(8);
    if (IN(9)) { peer::expert_phase(X1G, RS, XN3, ROUTE, EU8, EV8, SI, out, out, norm_ple_g, ldsb); } SEAM(9);
    if (IN(10)) {
        pg8::Gemm g{XN3, WG, M, D, D}; pg8::StaticOrder S; S.init(M, D, (int)gridDim.x, (int)blockIdx.x);
        pg8::EpiGateFinal E{PP, out, D};
        pg8::gemm_phase<pg8::EpiGateFinal, pg8::StaticOrder, true, true>(ldsb, g, S, E);
    } SEAM(10);
    if (IN(11)) { ph_rmsnorm_f32_inplace(out, final_g); }
#undef IN
#undef SEAM
}

extern "C" void kernel_launch(void* const* d_in, const int* in_sizes, int n_in, void* d_out, int out_size, void* d_ws, size_t ws_size, hipStream_t stream) {
    static int grid = 0;
    if (grid == 0) {
        if (n_in != 24 || in_sizes[0] != M * D || out_size != M * D || ws_size < WS_END) { fprintf(stderr, "kernel_launch: unexpected shapes (n_in %d, in0 %d, out %d, ws %zu)\n", n_in, n_in > 0 ? in_sizes[0] : -1, out_size, ws_size); grid = -1; return; }
        int dev = 0, cus = 0;
        if (hipGetDevice(&dev) != hipSuccess || hipDeviceGetAttribute(&cus, hipDeviceAttributeMultiprocessorCount, dev) != hipSuccess) { grid = -1; return; }
        if (hipFuncSetAttribute((const void*)mk_fwd, hipFuncAttributeMaxDynamicSharedMemorySize, LDS_BYTES) != hipSuccess) { fprintf(stderr, "kernel_launch: hipFuncSetAttribute failed\n"); grid = -1; return; }
        (void)hipGetLastError();
        grid = cus;
    }
    if (grid < 0) return;
    if (hipMemsetAsync((char*)d_ws + WS_CTL, 0, CTL_ZERO_BYTES, stream) != hipSuccess) return;
    Args a{};
    for (int i = 0; i < 24; ++i) a.in[i] = (const float*)d_in[i];
    a.out = (float*)d_out; a.ws = (unsigned char*)d_ws;
#if MK_ONE_LAUNCH
    a.ph_lo = 0; a.ph_hi = NPHASE; a.use_bar = 1;
    hipLaunchKernelGGL(mk_fwd, dim3(grid), dim3(NTHREADS), LDS_BYTES, stream, a);
#else
    for (int ph = 0; ph < NPHASE; ++ph) {
        a.ph_lo = ph; a.ph_hi = ph + 1; a.use_bar = 0;
        hipLaunchKernelGGL(mk_fwd, dim3(grid), dim3(NTHREADS), LDS_BYTES, stream, a);
    }
#endif
}
```

```cpp
#include <hip/hip_runtime.h>
#include <cstdio>
#include <cstdint>
#include <cmath>

#ifndef MK_ONE_LAUNCH
#define MK_ONE_LAUNCH 1
#endif

constexpr int M = 16384, D = 1024, NIN = 3592, PLE = 256;
constexpr int NQ = 2048;
constexpr float EPS = 1e-6f;
constexpr float LOG2E = 1.4426950408889634f;
constexpr float C2 = 0.125f * LOG2E;
constexpr float LAMBDA_INIT = 0.2f;
constexpr int NWAVES = 8, NTHREADS = 512;
constexpr int LDS_BYTES = 147456;

typedef unsigned short bf16;
typedef float f32x4 __attribute__((ext_vector_type(4)));
typedef unsigned v4u __attribute__((ext_vector_type(4)));
typedef unsigned v2u __attribute__((ext_vector_type(2)));
#define LAS __attribute__((address_space(3)))

constexpr size_t MiB = 1u << 20;
constexpr size_t WS_CTL = 0, CTL_ZERO_BYTES = 1 * MiB;
constexpr size_t WS_WIN = 1 * MiB, WS_WOUT = 9 * MiB, WS_WQ = 11 * MiB, WS_WG = 15 * MiB, WS_WP = 18 * MiB;
constexpr int NINP = 3840;
constexpr size_t WS_SKB = 18 * MiB + 512 * 1024;
constexpr size_t WS_GATES = 17 * MiB;
constexpr size_t WS_XN = 20 * MiB;
constexpr size_t WS_QA = 52 * MiB, WS_KA = 68 * MiB, WS_VA = 84 * MiB, WS_MQ = 100 * MiB, WS_MK = 116 * MiB, WS_MV = 132 * MiB, WS_MO = 148 * MiB;
constexpr size_t WS_O1 = 164 * MiB, WS_O2 = 180 * MiB;
constexpr size_t WS_CQ = 196 * MiB, WS_CK = 212 * MiB;
constexpr size_t WS_HS = WS_XN;
constexpr size_t WS_ACAT = WS_QA;
constexpr size_t WS_QP = WS_VA;
constexpr size_t WS_ROUTE = WS_MO;
constexpr size_t WS_PB = 245 * MiB;
constexpr size_t WS_PP = WS_QA;
constexpr size_t WS_G2 = WS_VA;
constexpr size_t WS_EU8 = 20 * MiB, WS_EV8 = 36 * MiB;
constexpr size_t WS_SI = 19 * MiB;
constexpr size_t WS_RS = 253 * MiB;
constexpr size_t WS_X1G = 164 * MiB;
constexpr size_t WS_XN3 = 196 * MiB;
constexpr size_t WS_ST = 228 * MiB;
constexpr size_t WS_END = 256 * MiB;
constexpr int CW_BAR = 4096;
constexpr int CW_NORM = 64, CW_QUEUE = 128;

__device__ __forceinline__ float bf2f(unsigned v) { return __uint_as_float(v << 16); }
__device__ __forceinline__ unsigned f2bf(float f) { unsigned u = __float_as_uint(f); return (u + 0x7fffu + ((u >> 16) & 1u)) >> 16; }
__device__ __forceinline__ unsigned pk2(float lo, float hi) { return f2bf(lo) | (f2bf(hi) << 16); }
__device__ __forceinline__ float wave_sum(float v) {
#pragma unroll
    for (int o = 1; o < 64; o <<= 1) v += __shfl_xor(v, o);
    return v;
}
__device__ __forceinline__ float sigmoidf_(float x) { return 1.f / (1.f + __expf(-x)); }
__device__ __forceinline__ int tidx() { int t = threadIdx.x; asm volatile("" : "+v"(t)); return t; }

#define XB_TMO      128
#define XB_XCNT(j)  (256  + 64 * (j))
#define XB_XSUB(j)  (1280 + 64 * (j))
#define XB_XGEN(j)  (2304 + 64 * (j))
#define XB_TOP      3328
#define XB_TOPGEN   3392
#define XCD_BAR_WORDS 3456
#define XB_SPIN_CAP (1u << 25)
__device__ __forceinline__ unsigned xb_ld(unsigned* p)              { return __hip_atomic_load(p, __ATOMIC_RELAXED, __HIP_MEMORY_SCOPE_AGENT); }
__device__ __forceinline__ unsigned xb_add(unsigned* p, unsigned v) { return __hip_atomic_fetch_add(p, v, __ATOMIC_RELAXED, __HIP_MEMORY_SCOPE_AGENT); }
__device__ __forceinline__ unsigned xb_xcc_id() { return (unsigned)__builtin_amdgcn_s_getreg((3 << 11) | 20) & 0xFu; }
#define XB_SPIN(cond, bar) do { unsigned _sp = 0; while (cond) { __builtin_amdgcn_s_sleep(1); \
    if ((++_sp & 255u) == 0u) { if (xb_ld(&(bar)[XB_TMO])) break; if (_sp > XB_SPIN_CAP) { atomicAdd(&(bar)[XB_TMO], 1u); break; } } } } while (0)
struct XcdBarrier { unsigned* bar; unsigned x; volatile LAS unsigned* st; };
__device__ __forceinline__ XcdBarrier xcd_barrier_post(unsigned* bar, volatile LAS unsigned* st) {
    XcdBarrier b; b.bar = bar; b.x = xb_xcc_id(); b.st = st;
    if (tidx() == 0) (void)xb_add(&bar[XB_XCNT(b.x)], 1u);
    return b;
}
__device__ __forceinline__ void xcd_barrier_complete(unsigned* bar, unsigned x, unsigned& nloc, unsigned& nx) {
    const unsigned G = gridDim.x * gridDim.y * gridDim.z;
    unsigned sum, cnt, mine, sp = 0u;
    for (;;) {
        sum = 0u; cnt = 0u; mine = 0u;
#pragma unroll
        for (unsigned j = 0; j < 16; ++j) { const unsigned c = xb_ld(&bar[XB_XCNT(j)]); sum += c; cnt += (c > 0u) ? 1u : 0u; mine = (j == x) ? c : mine; }
        if (sum == G) break;
        __builtin_amdgcn_s_sleep(1);
        if ((++sp & 255u) == 0u) { if (xb_ld(&bar[XB_TMO])) break; if (sp > XB_SPIN_CAP) { atomicAdd(&bar[XB_TMO], 1u); break; } }
    }
    nloc = mine > 0u ? mine : 1u; nx = cnt > 0u ? cnt : 1u;
}
__device__ __forceinline__ void xcd_barrier(const XcdBarrier& b) {
    asm volatile("s_waitcnt vmcnt(0)" ::: "memory");
    __syncthreads();
    if (tidx() == 0) {
        unsigned* bar = b.bar;
        __builtin_amdgcn_s_waitcnt(0);
        unsigned nloc = b.st[0], nx = b.st[1];
        if (nloc == 0u) { xcd_barrier_complete(bar, b.x, nloc, nx); b.st[0] = nloc; b.st[1] = nx; }
        const unsigned old = xb_add(&bar[XB_XSUB(b.x)], 1u);
        const unsigned gen = old / nloc;
        if (old + 1u == (gen + 1u) * nloc) {
            __builtin_amdgcn_fence(__ATOMIC_RELEASE, "agent");
            asm volatile("s_waitcnt vmcnt(0)" ::: "memory");
            const unsigned og = xb_add(&bar[XB_TOP], 1u);
            const unsigned tg = og / nx;
            if (og + 1u == (tg + 1u) * nx) xb_add(&bar[XB_TOPGEN], 1u);
            else XB_SPIN(xb_ld(&bar[XB_TOPGEN]) == tg, bar);
            __builtin_amdgcn_fence(__ATOMIC_ACQUIRE, "agent");
            xb_add(&bar[XB_XGEN(b.x)], 1u);
            asm volatile("s_waitcnt vmcnt(0)" ::: "memory");
        } else {
            XB_SPIN(xb_ld(&bar[XB_XGEN(b.x)]) == gen, bar);
            __builtin_amdgcn_fence(__ATOMIC_ACQUIRE, "agent");
            asm volatile("s_waitcnt vmcnt(0)" ::: "memory");
        }
    }
    __syncthreads();
}

namespace pg8 {
#define PG8_LAS __attribute__((address_space(3)))
typedef unsigned short bf16_t;
typedef short bf16x8 __attribute__((ext_vector_type(8)));
typedef float f32x4 __attribute__((ext_vector_type(4)));
typedef unsigned u32x4 __attribute__((ext_vector_type(4)));
constexpr int BM = 256, BK = 64, HALF = 128, HTB = HALF * BK * 2  , STAGE_BYTES = 8 * HTB, NXCD = 8, WGM = 8;

__host__ __device__ __forceinline__ int lds_byte(int r, int c) { const int st = (r >> 4) * 2 + (c >> 5), rr = r & 15, cc = c & 31, ob = rr * 64 + cc * 2; return st * 1024 + (ob ^ (((ob >> 9) & 1) << 5)); }
__host__ __device__ __forceinline__ void stage_rc(int b, int& R, int& C) { const int st = b / 1024, sb = b % 1024, swz = sb ^ (((sb >> 9) & 1) << 5); R = (st >> 1) * 16 + swz / 64; C = (st & 1) * 32 + (swz % 64) / 2; }
__host__ __device__ __forceinline__ int perm32(int rho) { const int n = rho >> 4, i = rho & 15; return 8 * (i >> 2) + 4 * n + (i & 3); }

struct Unit { int pm, pn; };
struct Gemm { const bf16_t* A; const bf16_t* Bt; int M, N, K; };

struct StaticOrder {
    int nM, nN, nwg, G, c;
    __host__ __device__ void init(int M, int N, int G_, int c_) { nM = M / BM; nN = N / BM; nwg = nM * nN; G = G_; c = c_; }
    __host__ __device__ bool next(int i, Unit& u) const {
        const long L = (long)i * G + c; if (L >= nwg) return false;
        int wgid = (int)L; { const int q = nwg / NXCD, r = nwg % NXCD, xcd = wgid % NXCD, off = wgid / NXCD; wgid = (xcd < r ? xcd * (q + 1) : r * (q + 1) + (xcd - r) * q) + off; }
        const int nig = WGM * nN, gid = wgid / nig, fm = gid * WGM, gsz = (nM - fm) < WGM ? (nM - fm) : WGM;
        u.pm = fm + ((wgid % nig) % gsz); u.pn = (wgid % nig) / gsz; return true;
    }
    __device__ __forceinline__ void a_ready(const Unit&) const {}
    __device__ __forceinline__ void done(const Unit&) const {}
};

__device__ __forceinline__ unsigned cvt_pk_bf16(float lo, float hi) { unsigned r; asm volatile("v_cvt_pk_bf16_f32 %0, %1, %2" : "=v"(r) : "v"(lo), "v"(hi)); return r; }
typedef float f32x2 __attribute__((ext_vector_type(2)));
__device__ __forceinline__ f32x2 gelu_pk(f32x2 v) {
    const f32x2 av = __builtin_elementwise_abs(v), d = av * 0.2316418882f + 1.0f;
    f32x2 t; t.x = __builtin_amdgcn_rcpf(d.x); t.y = __builtin_amdgcn_rcpf(d.y);
    f32x2 q = t * 0.5307027145f + (-0.7265760135f); q = q * t + 0.7107068705f; q = q * t + (-0.142248368f); q = q * t + 0.127414796f; q = q * t;
    const f32x2 s = (v * v) * (-0.72134752044f);
    f32x2 e; e.x = __builtin_amdgcn_exp2f(s.x); e.y = __builtin_amdgcn_exp2f(s.y);
    const f32x2 m = v * (q * e), r = v - m;
    f32x2 o; o.x = v.x < 0.f ? m.x : r.x; o.y = v.y < 0.f ? m.y : r.y; return o;
}

template <int ACT  > struct EpiBf16 {
    static constexpr bool PERM = true, AFTER_DRAIN = false; static_assert(ACT == 0 || ACT == 1, "EpiBf16: ACT is 0 (none) or 1 (gelu_pk)");
    bf16_t* O; int ldc; const float* bias; int split_cols; size_t split_stride; float scale0;
    __device__ __forceinline__ void operator()(const f32x4 (&acc)[2][2][4][2], const Unit& u, int wr, int wc, int fr, int fq) const {
        const int row0 = u.pm * BM + wr * 64 + fr; int colt = u.pn * BM; bf16_t* base = O;
        float sc = 1.f; if (split_cols) { const int t = colt / split_cols; base += (size_t)t * split_stride; colt -= t * split_cols; if (t == 0) sc = scale0; }
        const int col0 = colt + wc * 32 + 8 * fq, bcol0 = u.pn * BM + wc * 32 + 8 * fq;
        f32x4 bv[2][2];
#pragma unroll
        for (int bj = 0; bj < 2; ++bj)
#pragma unroll
            for (int n = 0; n < 2; ++n) bv[bj][n] = bias ? *(const f32x4*)(bias + bcol0 + bj * HALF + 4 * n) : (f32x4){0.f, 0.f, 0.f, 0.f};
#pragma unroll
        for (int ai = 0; ai < 2; ++ai)
#pragma unroll
            for (int m = 0; m < 4; ++m) { bf16_t* rowp = base + (size_t)(row0 + ai * HALF + m * 16) * ldc + col0;
#pragma unroll
                for (int bj = 0; bj < 2; ++bj) { f32x4 v0 = acc[ai][bj][m][0] + bv[bj][0], v1 = acc[ai][bj][m][1] + bv[bj][1];
                    if (ACT == 1) { f32x2 a = gelu_pk((f32x2){v0[0], v0[1]}), b = gelu_pk((f32x2){v0[2], v0[3]}), c = gelu_pk((f32x2){v1[0], v1[1]}), d = gelu_pk((f32x2){v1[2], v1[3]});
                        v0 = (f32x4){a.x, a.y, b.x, b.y}; v1 = (f32x4){c.x, c.y, d.x, d.y}; }
                    v0 = v0 * sc; v1 = v1 * sc; u32x4 w; w.x = cvt_pk_bf16(v0[0], v0[1]); w.y = cvt_pk_bf16(v0[2], v0[3]); w.z = cvt_pk_bf16(v1[0], v1[1]); w.w = cvt_pk_bf16(v1[2], v1[3]);
                    *(u32x4*)(rowp + bj * HALF) = w; } }
    }
};

struct EpiProj {
    static constexpr bool PERM = true, AFTER_DRAIN = false;
    bf16_t* O; size_t split_stride; float scale0; float* gates;
    __device__ __forceinline__ void operator()(const f32x4 (&acc)[2][2][4][2], const Unit& u, int wr, int wc, int fr, int fq) const {
        const int row0 = u.pm * BM + wr * 64 + fr;
        if (u.pn == 14) {
            if (wc == 0 && fq == 0) {
#pragma unroll
                for (int ai = 0; ai < 2; ++ai)
#pragma unroll
                    for (int m = 0; m < 4; ++m) { float* g = gates + (size_t)(row0 + ai * HALF + m * 16) * 8; *(f32x4*)g = acc[ai][0][m][0]; *(f32x4*)(g + 4) = acc[ai][0][m][1]; }
            }
            return;
        }
        int colt = u.pn * BM; const int t = colt / 512; bf16_t* base = O + (size_t)t * split_stride; colt -= t * 512; const float sc = (t == 0) ? scale0 : 1.f;
        const int col0 = colt + wc * 32 + 8 * fq;
#pragma unroll
        for (int ai = 0; ai < 2; ++ai)
#pragma unroll
            for (int m = 0; m < 4; ++m) { bf16_t* rowp = base + (size_t)(row0 + ai * HALF + m * 16) * 512 + col0;
#pragma unroll
                for (int bj = 0; bj < 2; ++bj) { const f32x4 v0 = acc[ai][bj][m][0] * sc, v1 = acc[ai][bj][m][1] * sc;
                    u32x4 w; w.x = cvt_pk_bf16(v0[0], v0[1]); w.y = cvt_pk_bf16(v0[2], v0[3]); w.z = cvt_pk_bf16(v1[0], v1[1]); w.w = cvt_pk_bf16(v1[2], v1[3]);
                    *(u32x4*)(rowp + bj * HALF) = w; } }
    }
};
struct EpiResF32 {
    static constexpr bool PERM = false, AFTER_DRAIN = false;
    const float* base; float* out; int ldc;
    __device__ __forceinline__ void operator()(const f32x4 (&acc)[2][2][4][2], const Unit& u, int wr, int wc, int fr, int fq) const {
        const int row0 = u.pm * BM + wr * 64 + fr, col0 = u.pn * BM + wc * 32 + 4 * fq;
#pragma unroll
        for (int ai = 0; ai < 2; ++ai)
#pragma unroll
            for (int m = 0; m < 4; ++m) { const size_t off = (size_t)(row0 + ai * HALF + m * 16) * ldc + col0;
#pragma unroll
                for (int bj = 0; bj < 2; ++bj)
#pragma unroll
                    for (int n = 0; n < 2; ++n) { const size_t o = off + bj * HALF + n * 16; *(f32x4*)(out + o) = *(const f32x4*)(base + o) + acc[ai][bj][m][n]; } }
    }
};
struct EpiResX1 {
    static constexpr bool PERM = false, AFTER_DRAIN = false;
    const float* base; float* out; bf16_t* xg; float* rs; int ldc;
    __device__ __forceinline__ void operator()(const f32x4 (&acc)[2][2][4][2], const Unit& u, int wr, int wc, int fr, int fq) const {
        const int row0 = u.pm * BM + wr * 64 + fr, col0 = u.pn * BM + wc * 32 + 4 * fq;
#pragma unroll
        for (int ai = 0; ai < 2; ++ai)
#pragma unroll
            for (int m = 0; m < 4; ++m) { const int row = row0 + ai * HALF + m * 16; const size_t off = (size_t)row * ldc + col0; float ss = 0.f;
#pragma unroll
                for (int bj = 0; bj < 2; ++bj)
#pragma unroll
                    for (int n = 0; n < 2; ++n) { const size_t o = off + bj * HALF + n * 16; const f32x4 v = *(const f32x4*)(base + o) + acc[ai][bj][m][n]; *(f32x4*)(out + o) = v;
                        ss += (v[0] * v[0] + v[1] * v[1]) + (v[2] * v[2] + v[3] * v[3]);
                        typedef unsigned u32x2 __attribute__((ext_vector_type(2))); u32x2 pk; pk.x = cvt_pk_bf16(v[0], v[1]); pk.y = cvt_pk_bf16(v[2], v[3]); *(u32x2*)(xg + o) = pk; }
                ss += __shfl_xor(ss, 16); ss += __shfl_xor(ss, 32);
                if (fq == 0) rs[(size_t)row * 16 + u.pn * 4 + wc] = ss; }
    }
};
struct EpiSigBf16 {
    static constexpr bool PERM = true, AFTER_DRAIN = false;
    bf16_t* O; int ldc;
    __device__ __forceinline__ void operator()(const f32x4 (&acc)[2][2][4][2], const Unit& u, int wr, int wc, int fr, int fq) const {
        const int row0 = u.pm * BM + wr * 64 + fr, col0 = u.pn * BM + wc * 32 + 8 * fq;
#pragma unroll
        for (int ai = 0; ai < 2; ++ai)
#pragma unroll
            for (int m = 0; m < 4; ++m) { bf16_t* rowp = O + (size_t)(row0 + ai * HALF + m * 16) * ldc + col0;
#pragma unroll
                for (int bj = 0; bj < 2; ++bj) { f32x4 v0 = acc[ai][bj][m][0], v1 = acc[ai][bj][m][1];
#pragma unroll
                    for (int i = 0; i < 4; ++i) { v0[i] = 1.f / (1.f + __expf(-v0[i])); v1[i] = 1.f / (1.f + __expf(-v1[i])); }
                    u32x4 w; w.x = cvt_pk_bf16(v0[0], v0[1]); w.y = cvt_pk_bf16(v0[2], v0[3]); w.z = cvt_pk_bf16(v1[0], v1[1]); w.w = cvt_pk_bf16(v1[2], v1[3]);
                    *(u32x4*)(rowp + bj * HALF) = w; } }
    }
};
struct EpiGateFinal {
    static constexpr bool PERM = false, AFTER_DRAIN = false;
    const bf16_t* P; float* out; int ldc;
    __device__ __forceinline__ void operator()(const f32x4 (&acc)[2][2][4][2], const Unit& u, int wr, int wc, int fr, int fq) const {
        const int row0 = u.pm * BM + wr * 64 + fr, col0 = u.pn * BM + wc * 32 + 4 * fq;
#pragma unroll
        for (int ai = 0; ai < 2; ++ai)
#pragma unroll
            for (int m = 0; m < 4; ++m) { const size_t off = (size_t)(row0 + ai * HALF + m * 16) * ldc + col0;
#pragma unroll
                for (int bj = 0; bj < 2; ++bj)
#pragma unroll
                    for (int n = 0; n < 2; ++n) { const size_t o = off + bj * HALF + n * 16;
                        typedef unsigned u32x2 __attribute__((ext_vector_type(2))); const u32x2 g = *(const u32x2*)(P + o);
                        f32x4 pv; pv[0] = __uint_as_float(g.x << 16); pv[1] = __uint_as_float(g.x & 0xffff0000u); pv[2] = __uint_as_float(g.y << 16); pv[3] = __uint_as_float(g.y & 0xffff0000u);
                        f32x4 sg = acc[ai][bj][m][n];
#pragma unroll
                        for (int i = 0; i < 4; ++i) sg[i] = 1.f / (1.f + __expf(-sg[i]));
                        *(f32x4*)(out + o) = *(const f32x4*)(out + o) + sg * pv; } }
    }
};
struct EpiGateAcc {
    static constexpr bool PERM = false, AFTER_DRAIN = false;
    const bf16_t* G; float* out; int ldc;
    __device__ __forceinline__ void operator()(const f32x4 (&acc)[2][2][4][2], const Unit& u, int wr, int wc, int fr, int fq) const {
        const int row0 = u.pm * BM + wr * 64 + fr, col0 = u.pn * BM + wc * 32 + 4 * fq;
#pragma unroll
        for (int ai = 0; ai < 2; ++ai)
#pragma unroll
            for (int m = 0; m < 4; ++m) { const size_t off = (size_t)(row0 + ai * HALF + m * 16) * ldc + col0;
#pragma unroll
                for (int bj = 0; bj < 2; ++bj)
#pragma unroll
                    for (int n = 0; n < 2; ++n) { const size_t o = off + bj * HALF + n * 16;
                        typedef unsigned u32x2 __attribute__((ext_vector_type(2))); const u32x2 g = *(const u32x2*)(G + o);
                        f32x4 gv; gv[0] = __uint_as_float(g.x << 16); gv[1] = __uint_as_float(g.x & 0xffff0000u); gv[2] = __uint_as_float(g.y << 16); gv[3] = __uint_as_float(g.y & 0xffff0000u);
                        *(f32x4*)(out + o) = *(const f32x4*)(out + o) + gv * acc[ai][bj][m][n]; } }
    }
};
template <class Epi, class Sched, bool ALIGN_EPI = false, bool SP2 = false>
__device__ __forceinline__ void gemm_phase(PG8_LAS unsigned char* lds, const Gemm g, const Sched& S, const Epi& E) {
    const int tid = tidx(), wid = __builtin_amdgcn_readfirstlane(tid >> 6), lane = tid & 63, wr = wid >> 2, wc = wid & 3, fr = lane & 15, fq = lane >> 4;
    const int K = g.K, nt = K / BK;
    unsigned voffA[2], voffB[2];
#pragma unroll
    for (int i = 0; i < 2; ++i) { int R, C; stage_rc(tid * 16 + i * 8192, R, C); const int Rb = Epi::PERM ? ((R & ~31) + perm32(R & 31)) : R;
        voffA[i] = (unsigned)(R * K + C) * 2u; voffB[i] = (unsigned)(Rb * K + C) * 2u; }
    const size_t kstep = (size_t)(BK * 2);
    const size_t hstep = (size_t)HALF * K * 2;
    const size_t tstep = 2 * hstep;
    const unsigned ldsw = (unsigned)wid * 1024u;
    const int aoff = lds_byte(wr * 64 + fr, fq * 8), boff = lds_byte(wc * 32 + fr, fq * 8);
#define PG8_SA(b, h) (((b) * 2 + (h)) * HTB)
#define PG8_SB(b, h) ((4 + (b) * 2 + (h)) * HTB)
#define PG8_STAGE(bufoff, gbase, voff) do { _Pragma("unroll") for (int _i = 0; _i < 2; ++_i) \
        __builtin_amdgcn_global_load_lds((const unsigned*)((const char*)(gbase) + (voff)[_i]), (PG8_LAS unsigned*)(lds + (bufoff) + ldsw + _i * 8192), 16, 0, 0); } while (0)
#define PG8_LDA(dst, b, h) do { _Pragma("unroll") for (int m = 0; m < 4; ++m) _Pragma("unroll") for (int k = 0; k < 2; ++k) dst[m][k] = *(const PG8_LAS bf16x8*)(lds + PG8_SA(b, h) + aoff + m * 2048 + k * 1024); } while (0)
#define PG8_LDB(dst, b, h) do { _Pragma("unroll") for (int n = 0; n < 2; ++n) _Pragma("unroll") for (int k = 0; k < 2; ++k) dst[n][k] = *(const PG8_LAS bf16x8*)(lds + PG8_SB(b, h) + boff + n * 2048 + k * 1024); } while (0)
#define PG8_MMA(ai, bj, At, Bt) do { __builtin_amdgcn_s_setprio(1); _Pragma("unroll") for (int m = 0; m < 4; ++m) _Pragma("unroll") for (int n = 0; n < 2; ++n) _Pragma("unroll") for (int k = 0; k < 2; ++k) \
        acc[ai][bj][m][n] = __builtin_amdgcn_mfma_f32_16x16x32_bf16(Bt[n][k], At[m][k], acc[ai][bj][m][n], 0, 0, 0); __builtin_amdgcn_s_setprio(0); } while (0)
#define PG8_WAIT_V(n) asm volatile("s_waitcnt vmcnt(" #n ")" ::: "memory")
#define PG8_WAIT_L(n) asm volatile("s_waitcnt lgkmcnt(" #n ")" ::: "memory")
#define PG8_BAR __builtin_amdgcn_s_barrier()
#define PG8_SCHED __builtin_amdgcn_sched_barrier(0)
    Unit cur, nxt; int ui = 0;
    if (!S.next(0, cur)) return;
    f32x4 acc[2][2][4][2];
#pragma unroll
    for (int a = 0; a < 2; ++a)
#pragma unroll
        for (int b = 0; b < 2; ++b)
#pragma unroll
            for (int m = 0; m < 4; ++m)
#pragma unroll
                for (int n = 0; n < 2; ++n) acc[a][b][m][n] = (f32x4){0.f, 0.f, 0.f, 0.f};
    bf16x8 At[4][2], B0[2][2], B1[2][2];
    const char* cA = (const char*)g.A + (size_t)cur.pm * tstep; const char* cB = (const char*)g.Bt + (size_t)cur.pn * tstep;
    S.a_ready(cur);
    if constexpr (SP2) {
        PG8_STAGE(PG8_SB(0, 0), cB, voffB); PG8_STAGE(PG8_SB(0, 1), cB + hstep, voffB); PG8_STAGE(PG8_SA(0, 0), cA, voffA); PG8_STAGE(PG8_SA(0, 1), cA + hstep, voffA);
        if (wr == 1) PG8_BAR;
        PG8_WAIT_V(2); PG8_BAR;
        PG8_STAGE(PG8_SB(1, 0), cB + kstep, voffB); PG8_STAGE(PG8_SA(1, 0), cA + kstep, voffA); PG8_STAGE(PG8_SB(1, 1), cB + hstep + kstep, voffB);
        PG8_WAIT_V(6); PG8_BAR;
    } else {
        PG8_STAGE(PG8_SB(0, 0), cB, voffB); PG8_STAGE(PG8_SA(0, 0), cA, voffA); PG8_STAGE(PG8_SB(0, 1), cB + hstep, voffB); PG8_STAGE(PG8_SA(0, 1), cA + hstep, voffA);
        if (wr == 1) PG8_BAR;
        PG8_WAIT_V(4); PG8_BAR;
        PG8_STAGE(PG8_SB(1, 0), cB + kstep, voffB); PG8_STAGE(PG8_SA(1, 0), cA + kstep, voffA); PG8_STAGE(PG8_SB(1, 1), cB + hstep + kstep, voffB);
        PG8_WAIT_V(6); PG8_BAR;
    }
    for (;;) {
        const bool has_next = S.next(ui + 1, nxt);
        const char* nA = has_next ? (const char*)g.A + (size_t)nxt.pm * tstep : cA; const char* nB = has_next ? (const char*)g.Bt + (size_t)nxt.pn * tstep : cB;
        for (int t = 0; t < nt; t += 2) {
            const bool last = (t == nt - 2);
            const char* a1 = cA + (size_t)(t + 1) * kstep;
            const char* a2 = last ? nA : cA + (size_t)(t + 2) * kstep; const char* b2 = last ? nB : cB + (size_t)(t + 2) * kstep;
            const char* a3 = a2 + kstep; const char* b3 = b2 + kstep;
            if (last && has_next) S.a_ready(nxt);
            if constexpr (SP2) {
            PG8_LDB(B0, 0, 0); PG8_LDB(B1, 0, 1); PG8_SCHED; PG8_LDA(At, 0, 0); PG8_STAGE(PG8_SA(1, 1), a1 + hstep, voffA);
            PG8_WAIT_V(8); PG8_WAIT_L(0); PG8_BAR; PG8_MMA(0, 0, At, B0); PG8_MMA(0, 1, At, B1); PG8_BAR; PG8_SCHED;
            PG8_LDA(At, 0, 1); PG8_STAGE(PG8_SB(0, 0), b2, voffB); PG8_STAGE(PG8_SB(0, 1), b2 + hstep, voffB); PG8_STAGE(PG8_SA(0, 0), a2, voffA);
            PG8_WAIT_V(8); PG8_WAIT_L(0); PG8_BAR; PG8_MMA(1, 0, At, B0); PG8_MMA(1, 1, At, B1); PG8_BAR; PG8_SCHED;
            PG8_LDB(B0, 1, 0); PG8_LDB(B1, 1, 1); PG8_SCHED; PG8_LDA(At, 1, 0); PG8_STAGE(PG8_SA(0, 1), a2 + hstep, voffA);
            PG8_WAIT_V(8); PG8_WAIT_L(0); PG8_BAR; PG8_MMA(0, 0, At, B0); PG8_MMA(0, 1, At, B1); PG8_BAR; PG8_SCHED;
            PG8_LDA(At, 1, 1); PG8_STAGE(PG8_SB(1, 0), b3, voffB); PG8_STAGE(PG8_SB(1, 1), b3 + hstep, voffB); PG8_STAGE(PG8_SA(1, 0), a3, voffA);
            PG8_WAIT_V(8); PG8_WAIT_L(0); PG8_BAR; PG8_MMA(1, 0, At, B0); PG8_MMA(1, 1, At, B1); PG8_BAR; PG8_SCHED;
            } else {
            PG8_LDB(B0, 0, 0); PG8_SCHED; PG8_LDA(At, 0, 0); PG8_STAGE(PG8_SA(1, 1), a1 + hstep, voffA);
            PG8_WAIT_L(8); PG8_BAR; PG8_WAIT_L(0); PG8_MMA(0, 0, At, B0); PG8_BAR; PG8_SCHED;
            PG8_LDB(B1, 0, 1); PG8_STAGE(PG8_SB(0, 0), b2, voffB);
            PG8_BAR; PG8_WAIT_L(0); PG8_MMA(0, 1, At, B1); PG8_BAR;
            PG8_LDA(At, 0, 1); PG8_STAGE(PG8_SA(0, 0), a2, voffA);
            PG8_BAR; PG8_WAIT_L(0); PG8_MMA(1, 0, At, B0); PG8_BAR; PG8_SCHED;
            PG8_STAGE(PG8_SB(0, 1), b2 + hstep, voffB);
            PG8_WAIT_V(6); PG8_BAR; PG8_MMA(1, 1, At, B1); PG8_BAR;
            PG8_LDB(B0, 1, 0); PG8_SCHED; PG8_LDA(At, 1, 0); PG8_STAGE(PG8_SA(0, 1), a2 + hstep, voffA);
            PG8_WAIT_L(8); PG8_BAR; PG8_WAIT_L(0); PG8_MMA(0, 0, At, B0); PG8_BAR; PG8_SCHED;
            PG8_LDB(B1, 1, 1); PG8_STAGE(PG8_SB(1, 0), b3, voffB);
            PG8_BAR; PG8_WAIT_L(0); PG8_MMA(0, 1, At, B1); PG8_BAR;
            PG8_LDA(At, 1, 1); PG8_STAGE(PG8_SA(1, 0), a3, voffA);
            PG8_BAR; PG8_WAIT_L(0); PG8_MMA(1, 0, At, B0); PG8_BAR; PG8_SCHED;
            PG8_STAGE(PG8_SB(1, 1), b3 + hstep, voffB);
            PG8_WAIT_V(6); PG8_BAR; PG8_MMA(1, 1, At, B1); PG8_BAR;
            }
        }
        if constexpr (ALIGN_EPI) { if (wr == 0) PG8_BAR; }
        if constexpr (!Epi::AFTER_DRAIN) { E(acc, cur, wr, wc, fr, fq); S.done(cur); }
        if (!has_next) break;
#pragma unroll
        for (int a = 0; a < 2; ++a)
#pragma unroll
            for (int b = 0; b < 2; ++b)
#pragma unroll
                for (int m = 0; m < 4; ++m)
#pragma unroll
                    for (int n = 0; n < 2; ++n) acc[a][b][m][n] = (f32x4){0.f, 0.f, 0.f, 0.f};
        cur = nxt; cA = nA; cB = nB; ++ui;
        if constexpr (ALIGN_EPI) { if (wr == 1) PG8_BAR; }
    }
    PG8_WAIT_V(0);
    if constexpr (!ALIGN_EPI) { if (wr == 0) PG8_BAR; }
    PG8_BAR;
    if constexpr (Epi::AFTER_DRAIN) { E.fused(acc, cur, wr, wc, fr, fq, lds, wid, lane); S.done(cur); }
#undef PG8_SA
#undef PG8_SB
#undef PG8_STAGE
#undef PG8_LDA
#undef PG8_LDB
#undef PG8_MMA
#undef PG8_WAIT_V
#undef PG8_WAIT_L
#undef PG8_BAR
#undef PG8_SCHED
}
}

#include <hip/hip_bf16.h>
#include <cmath>
namespace attn_body {
using bf16=__hip_bfloat16;
using bf16x8=__attribute__((ext_vector_type(8)))short;
using s16x4=__attribute__((ext_vector_type(4)))short;
using f32x16=__attribute__((ext_vector_type(16)))float;
using u32x4=__attribute__((ext_vector_type(4)))unsigned;
constexpr int SEQ=16384,D=64,DM=512;
constexpr int NW=8,QBLK=32,QB=QBLK*NW,KVBLK=64,NQB=SEQ/QB;
constexpr int ATTN_PITCH=DM, ATTN_UNIT_ROWS=QB;
__device__ __forceinline__ int crow(int r,int hi){return (r&3)+8*(r>>2)+4*hi;}
#define SBAR() __builtin_amdgcn_sched_barrier(0)
__device__ __forceinline__ void cmask(f32x16&p0,f32x16&p1,int jb,int qrel,int hi){
  const float NEG=-INFINITY; int kb=64*jb+4*hi;
  #pragma unroll
  for(int r=0;r<16;++r){int kv=kb+(r&3)+8*(r>>2); if(kv>qrel)p0[r]=NEG; if(kv+32>qrel)p1[r]=NEG;}
}

constexpr int NSLOT=3, SLOTB=8192;
constexpr int LDS_K=0, LDS_V=NSLOT*SLOTB, LDS_WS=2*NSLOT*SLOTB, LDS_OST=LDS_WS+NW*64*4, LDS_BYTES=LDS_OST+NW*4096;
constexpr float C2=0.125f*1.4426950408889634f;
__device__ __forceinline__ void glds16(const void*gsrc,unsigned lds_dst){unsigned keep;
  asm volatile("s_mov_b32 %0, m0\n\ts_mov_b32 m0, %2\n\ts_nop 0\n\tglobal_load_lds_dwordx4 %1, off\n\ts_mov_b32 m0, %0":"=&s"(keep):"v"(gsrc),"s"(lds_dst):"memory");}
__device__ __forceinline__ float max3f(float a,float b,float c){float r;asm("v_max3_f32 %0, %1, %2, %3":"=v"(r):"v"(a),"v"(b),"v"(c));return r;}
__device__ __forceinline__ float max2f(float a,float b){float r;asm("v_max_f32_e32 %0, %1, %2":"=v"(r):"v"(a),"v"(b));return r;}
__device__ __forceinline__ float fadd_s(float a,float b){float r;asm("v_add_f32_e32 %0, %1, %2":"=v"(r):"v"(a),"v"(b));return r;}
__device__ __forceinline__ float fsub_s(float a,float b){float r;asm("v_sub_f32_e32 %0, %1, %2":"=v"(r):"v"(a),"v"(b));return r;}
typedef float f32x2_t __attribute__((ext_vector_type(2))); typedef __bf16 bf16x2_t __attribute__((ext_vector_type(2)));
__device__ __forceinline__ unsigned cvtpk_s(float lo,float hi){f32x2_t v={lo,hi};bf16x2_t b=__builtin_convertvector(v,bf16x2_t);return __builtin_bit_cast(unsigned,b);}
#define WAIT_BAR(N) asm volatile("s_waitcnt vmcnt(" #N ") lgkmcnt(0)\n\ts_barrier":::"memory")

__device__ __forceinline__ void qkt(f32x16&p0,f32x16&p1,const char*Kslot,const bf16x8*qr,int r32,int hi){
  const char*kb=Kslot+hi*1024+r32*16;
  #pragma unroll
  for(int d0=0;d0<4;++d0){
    const bf16x8 b0=*reinterpret_cast<const bf16x8*>(kb+d0*2048);
    const bf16x8 b1=*reinterpret_cast<const bf16x8*>(kb+d0*2048+512);
    p0=__builtin_amdgcn_mfma_f32_32x32x16_bf16(b0,qr[d0],p0,0,0,0);p1=__builtin_amdgcn_mfma_f32_32x32x16_bf16(b1,qr[d0],p1,0,0,0);}
}
typedef __attribute__((address_space(3))) const char* lds_cptr;
typedef short v4i16_t __attribute__((ext_vector_type(4)));
__device__ __forceinline__ void kload8(bf16x8*kf,lds_cptr kp){
  kf[0]=*(const __attribute__((address_space(3))) bf16x8*)(kp);      kf[1]=*(const __attribute__((address_space(3))) bf16x8*)(kp+512);
  kf[2]=*(const __attribute__((address_space(3))) bf16x8*)(kp+2048); kf[3]=*(const __attribute__((address_space(3))) bf16x8*)(kp+2560);
  kf[4]=*(const __attribute__((address_space(3))) bf16x8*)(kp+4096); kf[5]=*(const __attribute__((address_space(3))) bf16x8*)(kp+4608);
  kf[6]=*(const __attribute__((address_space(3))) bf16x8*)(kp+6144); kf[7]=*(const __attribute__((address_space(3))) bf16x8*)(kp+6656);
}
__device__ __forceinline__ void kload2(bf16x8*kf,lds_cptr kp,int j){ kf[2*j]=*(const __attribute__((address_space(3))) bf16x8*)(kp+j*2048); kf[2*j+1]=*(const __attribute__((address_space(3))) bf16x8*)(kp+j*2048+512); }
__device__ __forceinline__ s16x4 vtr(lds_cptr p){ return __builtin_bit_cast(s16x4,__builtin_amdgcn_ds_read_tr16_b64_v4i16((__attribute__((address_space(3))) v4i16_t*)p)); }
__device__ __forceinline__ float rowmax(const f32x16&p0,const f32x16&p1){
  float a=max3f(p0[0],p0[1],p1[0]),b=max3f(p0[2],p0[3],p1[1]);a=max3f(a,p1[2],p1[3]);
  #pragma unroll
  for(int r=4;r<16;r+=4){a=max3f(a,p0[r],p0[r+1]);b=max3f(b,p0[r+2],p0[r+3]);a=max3f(a,p1[r],p1[r+1]);b=max3f(b,p1[r+2],p1[r+3]);}
  const float m=max2f(a,b);
  auto rr=__builtin_amdgcn_permlane32_swap(__float_as_uint(m),__float_as_uint(m),false,false);
  return max2f(__uint_as_float(rr[0]),__uint_as_float(rr[1]));
}
__device__ __forceinline__ void pv(f32x16*o,int vb,bf16x8 pa0,bf16x8 pa1,bf16x8 pa2,bf16x8 pa3){
  #pragma unroll
  for(int d0=0;d0<2;++d0){s16x4 lo[4],hi[4];
    #pragma unroll
    for(int ks=0;ks<4;++ks){
      asm volatile("ds_read_b64_tr_b16 %0,%1 offset:%c2":"=&v"(lo[ks]):"v"(vb),"i"(d0*4096+ks*1024):"memory");
      asm volatile("ds_read_b64_tr_b16 %0,%1 offset:%c2":"=&v"(hi[ks]):"v"(vb),"i"(d0*4096+ks*1024+512):"memory");}
    asm volatile("s_waitcnt lgkmcnt(0)":::"memory");SBAR();
    #define PK(k) (bf16x8){lo[k][0],lo[k][1],lo[k][2],lo[k][3],hi[k][0],hi[k][1],hi[k][2],hi[k][3]}
    o[d0]=__builtin_amdgcn_mfma_f32_32x32x16_bf16(pa0,PK(0),o[d0],0,0,0);
    o[d0]=__builtin_amdgcn_mfma_f32_32x32x16_bf16(pa1,PK(1),o[d0],0,0,0);
    o[d0]=__builtin_amdgcn_mfma_f32_32x32x16_bf16(pa2,PK(2),o[d0],0,0,0);
    o[d0]=__builtin_amdgcn_mfma_f32_32x32x16_bf16(pa3,PK(3),o[d0],0,0,0);
    #undef PK
  }
}

#ifndef ATTN_STORE16
#define ATTN_STORE16(p,v) (*(u32x4*)(p)=(v))
#endif
template<int THRL> __device__ __forceinline__ void attn_unit(int qb,int t0,float slope2,const bf16*Q,const bf16*__restrict__ K,const bf16*__restrict__ V,bf16*O,char*shm){
  int tid_=tidx(); asm volatile("":"+v"(tid_));
  const int tid=tid_,lane=tid&63,r32=lane&31,hi=lane>>5; const int wid=__builtin_amdgcn_readfirstlane(tid>>6);
  const int q0=qb*QB;
  const bf16*Qw=Q+(long)(q0+wid*QBLK)*DM;
  const bf16*Kh=K+(long)t0*KVBLK*DM,*Vh=V+(long)t0*KVBLK*DM;
  const unsigned lds0=(unsigned)(uintptr_t)shm;
  float*wsf=(float*)(shm+LDS_WS)+wid*64;
  const bf16*ksrc=Kh+(long)lane*DM+wid*8;
  const bf16*vsrc=Vh+(long)(16*(wid&3)+(lane>>2))*DM+(wid>>2)*32+(lane&3)*8;
  const unsigned kdst=lds0+LDS_K+wid*1024, vdst=lds0+LDS_V+wid*1024;
  #define DMA_K(t,slot) glds16(ksrc+(long)(t)*KVBLK*DM,(unsigned)__builtin_amdgcn_readfirstlane(kdst+(slot)))
  #define DMA_V(t,slot) glds16(vsrc+(long)(t)*KVBLK*DM,(unsigned)__builtin_amdgcn_readfirstlane(vdst+(slot)))
  const int vb0=(int)(lds0+LDS_V)+((lane>>4)&1)*32+(lane&3)*8+(4*hi+((lane&15)>>2))*64;
  const char*Kbase=shm+LDS_K; bf16x8 kf[8];
  const lds_cptr shm3=(lds_cptr)shm; const lds_cptr kp0=shm3+LDS_K+hi*1024+r32*16; const lds_cptr vp0=shm3+LDS_V+((lane>>4)&1)*32+(lane&3)*8+(4*hi+((lane&15)>>2))*64;
  const int NT=(q0+QB)/KVBLK-t0;
  DMA_K(0,0);DMA_V(0,0);DMA_K(1,SLOTB);
  bf16x8 qr[4];
  #pragma unroll
  for(int d0=0;d0<4;++d0)qr[d0]=*reinterpret_cast<const bf16x8*>(&Qw[(long)r32*DM+d0*16+hi*8]);
  float mhat=0.f,l_reg=0.f;f32x16 o[2];o[0]=f32x16{};o[1]=f32x16{};
  #define CINIT(C0_,C1_,t_) do{ float s2_=slope2; asm volatile("":"+v"(s2_));   \
      const float bt_=fmaf(s2_,(float)(64*(t_)+4*hi),-mhat); const float bu_=fmaf(s2_,32.f,bt_); \
      _Pragma("unroll") for(int r=0;r<16;++r){ C0_[r]=fmaf(s2_,(float)((r&3)+8*(r>>2)),bt_); C1_[r]=fmaf(s2_,(float)((r&3)+8*(r>>2)),bu_); } }while(0)
  const int qrel=wid*QBLK+r32;
  #define CMASK(P0,P1,t) do{int jb_=(t)-(NT-4); if(jb_>=0)cmask(P0,P1,jb_,qrel,hi);}while(0)
  bool resc=false;
  #define START(P0,P1) do{ const float rm=rowmax(P0,P1); resc=false; \
    { const float dl=rm; mhat=fadd_s(mhat,dl); \
      _Pragma("unroll") for(int r=0;r<16;++r){P0[r]=fsub_s(P0[r],dl);P1[r]=fsub_s(P1[r],dl);} } \
    _Pragma("unroll") for(int r=0;r<16;++r)P0[r]=__builtin_amdgcn_exp2f(P0[r]); }while(0)
  #define RESC() do{ if(resc){ asm volatile("s_waitcnt lgkmcnt(0)":::"memory"); \
      _Pragma("unroll") for(int d_=0;d_<2;++d_) _Pragma("unroll") for(int r=0;r<16;++r)o[d_][r]*=wsf[crow(r,hi)]; } }while(0)
  f32x16 pA0,pA1,pB0,pB1;
  int sl_prev=0,sl_cur=0,sl_next=SLOTB;
  #define ROT() do{sl_prev=sl_cur;sl_cur=sl_next;sl_next=(sl_next==(NSLOT-1)*SLOTB)?0:sl_next+SLOTB;}while(0)
  DMA_K(2,2*SLOTB);
  WAIT_BAR(3);
  CINIT(pA0,pA1,0); qkt(pA0,pA1,Kbase,qr,r32,hi);asm volatile("s_nop 15\n\ts_nop 7":"+v"(pA0),"+v"(pA1));CMASK(pA0,pA1,0);
  START(pA0,pA1);
  _Pragma("unroll") for(int r=0;r<16;++r)pA1[r]=__builtin_amdgcn_exp2f(pA1[r]);
  WAIT_BAR(0);
  DMA_K(3,0);DMA_V(1,SLOTB);
  ROT();
  kload8(kf,kp0+sl_cur);
  WAIT_BAR(2);
  s16x4 vlo[8],vhi[8]; u32x4 pw0,pw1,pw2,pw3;
  #define PKW(P,B) cvtpk_s(P[B],P[B+1])
  #define PAF(k) __builtin_bit_cast(bf16x8,pw##k)
  #define VFR(i) (bf16x8){vlo[i][0],vlo[i][1],vlo[i][2],vlo[i][3],vhi[i][0],vhi[i][1],vhi[i][2],vhi[i][3]}
  #define PIN(x) asm volatile("":"+v"(x))
  #define MX3(a,b,c) __builtin_fmaxf(__builtin_fmaxf((a),(b)),(c))
  #define GAPA(MF,A0,A1,A2,A3,W0,W1,PW) do{ MF; sacc+=A0; sacc+=A1; sacc+=A2; sacc+=A3; PIN(sacc); W0; W1; PIN(PW); SBAR(); }while(0)
  #define EX(v) __builtin_amdgcn_exp2f(v)
  #define GAPB(MF,X,B) do{ MF; X[B]=EX(X[B]); X[B+1]=EX(X[B+1]); X[B+2]=EX(X[B+2]); X[B+3]=EX(X[B+3]); PIN(X); SBAR(); }while(0)
  #define VRD(i) do{ vlo[i]=vtr(vp_+(((i)>>2)*4096+((i)&3)*1024)); vhi[i]=vtr(vp_+(((i)>>2)*4096+((i)&3)*1024+512)); }while(0)
  #define KRD(G,j) do{ if(G){ kload2(kf,kp0+sl_next,j); SBAR(); } }while(0)
  #define STEP(C0,C1,P0,P1,t,GK,GV,GL) do{ SBAR(); \
    CINIT(C0,C1,t); PIN(C0); PIN(C1); SBAR(); \
    const lds_cptr vp_=vp0+sl_prev; \
    VRD(0); SBAR(); float sacc=(P0[0]+P0[1]); \
    GAPA(C0=__builtin_amdgcn_mfma_f32_32x32x16_bf16(kf[0],qr[0],C0,0,0,0), P0[2],P0[3],P0[4],P0[5],     pw0[0]=PKW(P0,0), pw0[1]=PKW(P0,2), pw0); \
    VRD(4); SBAR(); GAPA(C1=__builtin_amdgcn_mfma_f32_32x32x16_bf16(kf[1],qr[0],C1,0,0,0), P0[6],P0[7],P0[8],P0[9],     pw0[2]=PKW(P0,4), pw0[3]=PKW(P0,6), pw0); \
    VRD(1); SBAR(); GAPA(C0=__builtin_amdgcn_mfma_f32_32x32x16_bf16(kf[2],qr[1],C0,0,0,0),   P0[10],P0[11],P0[12],P0[13], pw1[0]=PKW(P0,8), pw1[1]=PKW(P0,10), pw1); \
    VRD(5); SBAR(); GAPA(C1=__builtin_amdgcn_mfma_f32_32x32x16_bf16(kf[3],qr[1],C1,0,0,0),   P0[14],P0[15],P1[0],P1[1],   pw1[2]=PKW(P0,12),pw1[3]=PKW(P0,14), pw1); \
    VRD(2); SBAR(); GAPA(C0=__builtin_amdgcn_mfma_f32_32x32x16_bf16(kf[4],qr[2],C0,0,0,0),   P1[2],P1[3],P1[4],P1[5],     pw2[0]=PKW(P1,0), pw2[1]=PKW(P1,2), pw2); \
    VRD(6); SBAR(); GAPA(C1=__builtin_amdgcn_mfma_f32_32x32x16_bf16(kf[5],qr[2],C1,0,0,0),   P1[6],P1[7],P1[8],P1[9],     pw2[2]=PKW(P1,4), pw2[3]=PKW(P1,6), pw2); \
    VRD(3); SBAR(); GAPA(C0=__builtin_amdgcn_mfma_f32_32x32x16_bf16(kf[6],qr[3],C0,0,0,0),   P1[10],P1[11],P1[12],P1[13], pw3[0]=PKW(P1,8), pw3[1]=PKW(P1,10), pw3); \
    VRD(7); SBAR(); GAPA(C1=__builtin_amdgcn_mfma_f32_32x32x16_bf16(kf[7],qr[3],C1,0,0,0),   P1[14],P1[15],0.f,0.f,       pw3[2]=PKW(P1,12),pw3[3]=PKW(P1,14), pw3); \
    l_reg+=sacc; \
    if(GK){DMA_K((t)+3,sl_cur);} if(GV){DMA_V((t)+1,sl_next);} \
    CMASK(C0,C1,t); \
    { float a=MX3(C0[0],C0[1],C1[0]),b=MX3(C0[2],C0[3],C1[1]); a=MX3(a,C1[2],C1[3]); \
      _Pragma("unroll") for(int r=4;r<16;r+=4){a=MX3(a,C0[r],C0[r+1]);b=MX3(b,C0[r+2],C0[r+3]);a=MX3(a,C1[r],C1[r+1]);b=MX3(b,C1[r+2],C1[r+3]);} \
      float rm=__builtin_fmaxf(a,b); { auto rr=__builtin_amdgcn_permlane32_swap(__float_as_uint(rm),__float_as_uint(rm),false,false); rm=__builtin_fmaxf(__uint_as_float(rr[0]),__uint_as_float(rr[1])); } \
      resc=false; \
      if(__builtin_expect(__any(rm>(float)THRL),0)){ const float dl=__builtin_fmaxf(rm,0.f); mhat+=dl; \
        _Pragma("unroll") for(int r=0;r<16;++r){C0[r]-=dl;C1[r]-=dl;} \
        const float f=__builtin_amdgcn_exp2f(-dl); l_reg*=f; if(hi==0)wsf[r32]=f; resc=true; } } \
    SBAR(); \
    GAPB(o[0]=__builtin_amdgcn_mfma_f32_32x32x16_bf16(PAF(0),VFR(0),o[0],0,0,0), C0,0); \
    GAPB(o[1]=__builtin_amdgcn_mfma_f32_32x32x16_bf16(PAF(0),VFR(4),o[1],0,0,0), C0,4); \
    KRD(GL,0); GAPB(o[0]=__builtin_amdgcn_mfma_f32_32x32x16_bf16(PAF(1),VFR(1),o[0],0,0,0), C0,8); \
    KRD(GL,1); GAPB(o[1]=__builtin_amdgcn_mfma_f32_32x32x16_bf16(PAF(1),VFR(5),o[1],0,0,0), C0,12); \
    KRD(GL,2); GAPB(o[0]=__builtin_amdgcn_mfma_f32_32x32x16_bf16(PAF(2),VFR(2),o[0],0,0,0), C1,0); \
    KRD(GL,3); GAPB(o[1]=__builtin_amdgcn_mfma_f32_32x32x16_bf16(PAF(2),VFR(6),o[1],0,0,0), C1,4); \
    GAPB(o[0]=__builtin_amdgcn_mfma_f32_32x32x16_bf16(PAF(3),VFR(3),o[0],0,0,0), C1,8); \
    GAPB(o[1]=__builtin_amdgcn_mfma_f32_32x32x16_bf16(PAF(3),VFR(7),o[1],0,0,0), C1,12); \
    }while(0)
  int t=1;
  #undef CMASK
  #define CMASK(P0,P1,t) do{}while(0)
  for(;t+5<NT;t+=2){
    STEP(pB0,pB1,pA0,pA1,t,true,true,true);     WAIT_BAR(2); RESC(); ROT();
    STEP(pA0,pA1,pB0,pB1,t+1,true,true,true);   WAIT_BAR(2); RESC(); ROT();
  }
  #undef CMASK
  #define CMASK(P0,P1,t) do{int jb_=(t)-(NT-4); if(jb_>=0)cmask(P0,P1,jb_,qrel,hi);}while(0)
  #define ENDW(tt) do{ if((tt)+3<NT){WAIT_BAR(2);} else if((tt)+2<NT){WAIT_BAR(1);} else {WAIT_BAR(0);} }while(0)
  for(;t+1<NT;t+=2){
    STEP(pB0,pB1,pA0,pA1,t,(t+3<NT),(t+1<NT),(t+1<NT));       ENDW(t);   RESC(); ROT();
    STEP(pA0,pA1,pB0,pB1,t+1,(t+4<NT),(t+2<NT),(t+2<NT));     ENDW(t+1); RESC(); ROT();
  }
  STEP(pB0,pB1,pA0,pA1,NT-1,false,false,false); RESC();
  { float sacc=pB0[0]+pB0[1]; _Pragma("unroll") for(int r=2;r<16;++r)sacc+=pB0[r]; _Pragma("unroll") for(int r=0;r<16;++r)sacc+=pB1[r]; l_reg+=sacc;
    pw0=(u32x4){PKW(pB0,0),PKW(pB0,2),PKW(pB0,4),PKW(pB0,6)};pw1=(u32x4){PKW(pB0,8),PKW(pB0,10),PKW(pB0,12),PKW(pB0,14)};pw2=(u32x4){PKW(pB1,0),PKW(pB1,2),PKW(pB1,4),PKW(pB1,6)};pw3=(u32x4){PKW(pB1,8),PKW(pB1,10),PKW(pB1,12),PKW(pB1,14)};
    SBAR(); pv(o,vb0+sl_cur,PAF(0),PAF(1),PAF(2),PAF(3)); }
  #undef PKW
  #undef PAF
  #undef VFR
  #undef PIN
  #undef MX3
  #undef GAPA
  #undef GAPB
  #undef EX
  #undef VRD
  #undef KRD
  #undef STEP
  #undef ENDW
  {auto rr=__builtin_amdgcn_permlane32_swap(__float_as_uint(l_reg),__float_as_uint(l_reg),false,false);l_reg=__uint_as_float(rr[0])+__uint_as_float(rr[1]);}
  if(hi==0)wsf[32+r32]=l_reg;asm volatile("s_waitcnt lgkmcnt(0)":::"memory");
  float rli[16];
  #pragma unroll
  for(int r=0;r<16;++r)rli[r]=__builtin_amdgcn_rcpf(wsf[32+crow(r,hi)]);
  bf16*Ow=O+(long)(q0+wid*QBLK)*DM;
  { bf16*stg=(bf16*)(shm+LDS_OST)+wid*2048;
    #pragma unroll
    for(int r=0;r<16;++r){const int orow=crow(r,hi);
      #pragma unroll
      for(int d0=0;d0<2;++d0)stg[orow*64+d0*32+r32]=__float2bfloat16(o[d0][r]*rli[r]);}
    asm volatile("s_waitcnt lgkmcnt(0)":::"memory");
    #pragma unroll
    for(int i=0;i<4;++i){const int row=i*8+(lane>>3),ch=lane&7; const u32x4 v=*(const u32x4*)(stg+row*64+ch*8); ATTN_STORE16(Ow+(long)row*DM+ch*8,v);} }
  asm volatile("s_waitcnt lgkmcnt(0)\n\ts_barrier":::"memory");
  #undef DMA_K
  #undef DMA_V
  #undef CMASK
  #undef CINIT
  #undef START
  #undef RESC
  #undef ROT
}
constexpr int ATTN_LDS_BYTES=LDS_BYTES;
template<int THRL=8> __device__ __forceinline__ void attn_dispatch(int u,char*lds,const bf16*QA,const bf16*KA,const bf16*VA,bf16*O1,bf16*O2,const unsigned*norms){
    const int h=3-(u>>8), r=u&255, qb=63-(r>>2), c=(r>>1)&1, vhalf=r&1, hv=h*2+c;
    const float slope2=__uint_as_float(__builtin_amdgcn_readfirstlane((0x3fb8aa3bu)-((unsigned)(2*(h+1))<<23)));
    const float Bnd=sqrtf(__uint_as_float(norms[hv]))*sqrtf(__uint_as_float(norms[8+hv]))*1.0001f;
    const float W=(2.f*Bnd+34.f)/slope2+1.f;
    const int q0=qb*QB; int t0=0; if((float)q0>W){ t0=((int)(((float)q0-W)*(1.f/64.f)))&~1; }
    t0=__builtin_amdgcn_readfirstlane(t0);
    const bf16*Q=QA+hv*64; const bf16*K=KA+hv*64; const bf16*V=VA+h*128+vhalf*64; bf16*O=(c?O2:O1)+h*128+vhalf*64;
    attn_unit<THRL>(qb,t0,slope2,Q,K,V,O,lds);
}
#undef SBAR
#undef WAIT_BAR
}

__device__ __forceinline__ void ph_rmsnorm_bf16(const float* X, const float* g, bf16* O) {
    const int lane = tidx() & 63, wave = tidx() >> 6;
    const int gw = blockIdx.x * NWAVES + wave, NGW = gridDim.x * NWAVES;
    for (int m = gw; m < M; m += NGW) {
        const f32x4* xr = (const f32x4*)(X + (size_t)m * D) + lane;
        f32x4 v[4]; float s = 0.f;
#pragma unroll
        for (int j = 0; j < 4; ++j) { v[j] = xr[64 * j]; s += (v[j].x * v[j].x + v[j].y * v[j].y) + (v[j].z * v[j].z + v[j].w * v[j].w); }
        const float r = rsqrtf(wave_sum(s) * (1.f / D) + EPS);
        v2u* o8 = (v2u*)(O + (size_t)m * D) + lane;
#pragma unroll
        for (int j = 0; j < 4; ++j) { const f32x4 gg = ((const f32x4*)g)[lane + 64 * j]; v2u w; w.x = pk2(v[j].x * r * gg.x, v[j].y * r * gg.y); w.y = pk2(v[j].z * r * gg.z, v[j].w * r * gg.w); o8[64 * j] = w; }
    }
}
__device__ __forceinline__ void ph_rmsnorm_f32_inplace(float* X, const float* g) {
    const int lane = tidx() & 63, wave = tidx() >> 6;
    const int gw = blockIdx.x * NWAVES + wave, NGW = gridDim.x * NWAVES;
    for (int m = gw; m < M; m += NGW) {
        f32x4* xr = (f32x4*)(X + (size_t)m * D) + lane;
        f32x4 v[4]; float s = 0.f;
#pragma unroll
        for (int j = 0; j < 4; ++j) { v[j] = xr[64 * j]; s += (v[j].x * v[j].x + v[j].y * v[j].y) + (v[j].z * v[j].z + v[j].w * v[j].w); }
        const float r = rsqrtf(wave_sum(s) * (1.f / D) + EPS);
#pragma unroll
        for (int j = 0; j < 4; ++j) { const f32x4 gg = ((const f32x4*)g)[lane + 64 * j]; xr[64 * j] = v[j] * r * gg; }
    }
}

__device__ __forceinline__ void transpose_item(const float* W, int K, int N, int Npad, bf16* WT, LAS float* scr, int item, int lane, const float* kgain = nullptr) {
    const int nblk = Npad / 32, kb = item / nblk, nb = item % nblk, k0 = 64 * kb, n0 = 32 * nb;
    const int nn = n0 + (lane & 31);
#pragma unroll 8
    for (int i = 0; i < 32; ++i) { const int kk = 2 * i + (lane >> 5); const float gk = kgain ? kgain[k0 + kk] : 1.f; scr[kk * 33 + (lane & 31)] = (nn < N) ? W[(size_t)(k0 + kk) * N + nn] * gk : 0.f; }
    asm volatile("s_waitcnt lgkmcnt(0)" ::: "memory");
    const int c = lane & 7;
#pragma unroll
    for (int j = 0; j < 4; ++j) { const int n = (lane >> 3) + 8 * j; const LAS float* sp = scr + (8 * c) * 33 + n;
        v4u o; o.x = pk2(sp[0 * 33], sp[1 * 33]); o.y = pk2(sp[2 * 33], sp[3 * 33]); o.z = pk2(sp[4 * 33], sp[5 * 33]); o.w = pk2(sp[6 * 33], sp[7 * 33]);
        *(v4u*)(WT + (size_t)(n0 + n) * K + k0 + 8 * c) = o; }
    asm volatile("s_waitcnt lgkmcnt(0)" ::: "memory");
}
__device__ __forceinline__ void ph_weights_in(const float* w_in, bf16* WIN, LAS unsigned char* lds) {
    const int lane = tidx() & 63, wave = __builtin_amdgcn_readfirstlane(tidx() >> 6);
    LAS float* scr = (LAS float*)(lds + wave * 16384);
    const int gw = blockIdx.x * NWAVES + wave, NGW = gridDim.x * NWAVES;
    constexpr int I_IN = (D / 64) * (NINP / 32);
    for (int it = gw; it < I_IN; it += NGW) transpose_item(w_in, D, NIN, NINP, WIN, scr, it, lane);
}
constexpr int WCH_OUT = (D / 64) * (D / 32), WCH_Q = (D / 64) * (NQ / 32), WCH_P = (PLE / 64) * (D / 32), WCH_ITEMS = 2 * WCH_OUT + WCH_Q + WCH_P, WCH_CHUNKS = (WCH_ITEMS + 7) / 8;
__device__ __forceinline__ void weights_chunk(int chunk, const float* w_out, const float* w_query, const float* g_query, const float* w_gate, const float* w_proj, bf16* WOUT, bf16* WQ, bf16* WG, bf16* WP, LAS unsigned char* lds) {
    const int lane = tidx() & 63, wave = __builtin_amdgcn_readfirstlane(tidx() >> 6);
    LAS float* scr = (LAS float*)(lds + wave * 16384);
    int r = chunk * 8 + wave;
    if (r >= WCH_ITEMS) return;
    if (r < WCH_OUT) { transpose_item(w_out, D, D, D, WOUT, scr, r, lane); return; } r -= WCH_OUT;
    if (r < WCH_Q) { transpose_item(w_query, D, NQ, NQ, WQ, scr, r, lane, g_query); return; } r -= WCH_Q;
    if (r < WCH_OUT) { transpose_item(w_gate, D, D, D, WG, scr, r, lane); return; } r -= WCH_OUT;
    transpose_item(w_proj, PLE, D, D, WP, scr, r, lane);
}

template <class Epi>
__device__ __forceinline__ void naive_gemm(const bf16* A, int lda, const float* W, int K, int N, float* lds, Epi epi) {
    float* As = lds;
    float* Ws = lds + 32 * 65;
    const int tid = tidx(), tx = tid & 15, ty = tid >> 4;
    const int ntn = (N + 63) / 64, nt = (M / 64) * ntn;
    for (int t = blockIdx.x; t < nt; t += gridDim.x) {
        const int tm = t / ntn, tn = t % ntn, r0 = tm * 64, c0 = tn * 64;
        float acc[2][4];
#pragma unroll
        for (int i = 0; i < 2; ++i)
#pragma unroll
            for (int j = 0; j < 4; ++j) acc[i][j] = 0.f;
        for (int k0 = 0; k0 < K; k0 += 32) {
            { const int r = tid >> 3, kq = (tid & 7) * 4; const v2u v = *(const v2u*)(A + (size_t)(r0 + r) * lda + k0 + kq);
              As[(kq + 0) * 65 + r] = bf2f(v.x & 0xffffu); As[(kq + 1) * 65 + r] = bf2f(v.x >> 16); As[(kq + 2) * 65 + r] = bf2f(v.y & 0xffffu); As[(kq + 3) * 65 + r] = bf2f(v.y >> 16); }
            { const int kk = tid >> 4, nq = (tid & 15) * 4; const float* wp = W + (size_t)(k0 + kk) * N + c0 + nq;
#pragma unroll
              for (int j = 0; j < 4; ++j) Ws[kk * 64 + nq + j] = (c0 + nq + j < N) ? wp[j] : 0.f; }
            __syncthreads();
#pragma unroll 8
            for (int kk = 0; kk < 32; ++kk) {
                const float a0 = As[kk * 65 + ty], a1 = As[kk * 65 + ty + 32];
                const f32x4 b = *(const f32x4*)(Ws + kk * 64 + tx * 4);
                acc[0][0] += a0 * b.x; acc[0][1] += a0 * b.y; acc[0][2] += a0 * b.z; acc[0][3] += a0 * b.w;
                acc[1][0] += a1 * b.x; acc[1][1] += a1 * b.y; acc[1][2] += a1 * b.z; acc[1][3] += a1 * b.w;
            }
            __syncthreads();
        }
#pragma unroll
        for (int i = 0; i < 2; ++i)
#pragma unroll
            for (int j = 0; j < 4; ++j) { const int row = r0 + ty + 32 * i, col = c0 + tx * 4 + j; if (col < N) epi(row, col, acc[i][j]); }
    }
}

__device__ __forceinline__ void ph_attn_naive(const bf16* QA, const bf16* KA, const bf16* VA, bf16* O1, bf16* O2, float* lds) {
    float* Ks = lds; float* Vs = lds + 32 * 64; float* Ss = Vs + 32 * 128;
    const int tid = tidx(), qi = tid >> 3, cg = tid & 7;
    for (int item = blockIdx.x; item < 8 * 256; item += gridDim.x) {
        const int hv = item & 7, qb = 255 - (item >> 3);
        const int h = hv >> 1, c = hv & 1, q0 = qb * 64, qpos = q0 + qi;
        const float slope2 = exp2f(-2.f * (float)(h + 1)) * LOG2E;
        float q[64];
        { const v4u* qp = (const v4u*)(QA + (size_t)qpos * 512 + hv * 64);
#pragma unroll
          for (int i = 0; i < 8; ++i) { const v4u v = qp[i];
              q[8 * i + 0] = bf2f(v.x & 0xffffu); q[8 * i + 1] = bf2f(v.x >> 16); q[8 * i + 2] = bf2f(v.y & 0xffffu); q[8 * i + 3] = bf2f(v.y >> 16);
              q[8 * i + 4] = bf2f(v.z & 0xffffu); q[8 * i + 5] = bf2f(v.z >> 16); q[8 * i + 6] = bf2f(v.w & 0xffffu); q[8 * i + 7] = bf2f(v.w >> 16); } }
        float m = -INFINITY, l = 0.f, acc[16];
#pragma unroll
        for (int i = 0; i < 16; ++i) acc[i] = 0.f;
        const int ntile = (q0 + 64) / 32;
        for (int kt = 0; kt < ntile; ++kt) {
            const int k0 = kt * 32;
            __syncthreads();
            { const int kk = tid >> 4, d4 = (tid & 15) * 4; const v2u v = *(const v2u*)(KA + (size_t)(k0 + kk) * 512 + hv * 64 + d4);
              float* kd = Ks + kk * 64 + d4; kd[0] = bf2f(v.x & 0xffffu); kd[1] = bf2f(v.x >> 16); kd[2] = bf2f(v.y & 0xffffu); kd[3] = bf2f(v.y >> 16); }
            { const int kk = tid >> 4, e8 = (tid & 15) * 8; const v4u v = *(const v4u*)(VA + (size_t)(k0 + kk) * 512 + h * 128 + e8);
              float* vd = Vs + kk * 128 + e8; vd[0] = bf2f(v.x & 0xffffu); vd[1] = bf2f(v.x >> 16); vd[2] = bf2f(v.y & 0xffffu); vd[3] = bf2f(v.y >> 16);
              vd[4] = bf2f(v.z & 0xffffu); vd[5] = bf2f(v.z >> 16); vd[6] = bf2f(v.w & 0xffffu); vd[7] = bf2f(v.w >> 16); }
            __syncthreads();
#pragma unroll
            for (int j = 0; j < 4; ++j) {
                const int kk = cg + 8 * j; const float* kr = Ks + kk * 64; float s = 0.f;
#pragma unroll
                for (int d = 0; d < 64; ++d) s += q[d] * kr[d];
                const int kpos = k0 + kk;
                s = (kpos <= qpos) ? s - slope2 * (float)(qpos - kpos) : -INFINITY;
                Ss[qi * 33 + kk] = s;
            }
            __syncthreads();
            float tmax = -INFINITY;
#pragma unroll 8
            for (int kk = 0; kk < 32; ++kk) tmax = fmaxf(tmax, Ss[qi * 33 + kk]);
            const float mn = fmaxf(m, tmax), alpha = exp2f(m - mn);
            l *= alpha;
#pragma unroll
            for (int i = 0; i < 16; ++i) acc[i] *= alpha;
            for (int kk = 0; kk < 32; ++kk) {
                const float p = exp2f(Ss[qi * 33 + kk] - mn); l += p;
                const float* vr = Vs + kk * 128 + 16 * cg;
#pragma unroll
                for (int i = 0; i < 16; ++i) acc[i] += p * vr[i];
            }
            m = mn;
        }
        const float il = 1.f / l;
        bf16* O = c ? O2 : O1;
        v4u w0, w1;
        w0.x = pk2(acc[0] * il, acc[1] * il); w0.y = pk2(acc[2] * il, acc[3] * il); w0.z = pk2(acc[4] * il, acc[5] * il); w0.w = pk2(acc[6] * il, acc[7] * il);
        w1.x = pk2(acc[8] * il, acc[9] * il); w1.y = pk2(acc[10] * il, acc[11] * il); w1.z = pk2(acc[12] * il, acc[13] * il); w1.w = pk2(acc[14] * il, acc[15] * il);
        v4u* op = (v4u*)(O + (size_t)qpos * 512 + h * 128 + 16 * cg); op[0] = w0; op[1] = w1;
    }
}

__device__ __forceinline__ void ph_conv_naive(const bf16* MQ, const bf16* MK, const float* cw, const float* cb, bf16* CQ, bf16* CK) {
    const size_t n = (size_t)M * 512, stride = (size_t)gridDim.x * NTHREADS;
    for (size_t i = (size_t)blockIdx.x * NTHREADS + tidx(); i < n; i += stride) {
        const int t = (int)(i >> 9), c = (int)(i & 511);
        float aq = cb[c], ak = cb[512 + c];
#pragma unroll
        for (int j = 0; j < 4; ++j) { const int tt = t - 3 + j; if (tt >= 0) { aq += cw[j * 1024 + c] * bf2f(MQ[(size_t)tt * 512 + c]); ak += cw[j * 1024 + 512 + c] * bf2f(MK[(size_t)tt * 512 + c]); } }
        aq = aq * sigmoidf_(aq) * 0.08838834764831845f; ak = ak * sigmoidf_(ak);
        CQ[i] = (bf16)f2bf(aq); CK[i] = (bf16)f2bf(ak);
    }
}
__device__ __forceinline__ void ph_mlstm_naive(const bf16* CQ, const bf16* CK, const bf16* MV, const float* GATES, const float* b_i, const float* b_f, float* HS, float* lds) {
    if (blockIdx.x >= 4) return;
    const int h = blockIdx.x, tid = tidx(), e = tid & 127, dg = tid >> 7;
    float* qs = lds; float* ks = qs + 64 * 128; float* vs = ks + 64 * 128; float* fs = vs + 64 * 128; float* is_ = fs + 64; float* red = is_ + 64; float* redd = red + 512;
    float C[32], n[32];
#pragma unroll
    for (int i = 0; i < 32; ++i) { C[i] = 0.f; n[i] = 0.f; }
    for (int c0 = 0; c0 < M; c0 += 64) {
        __syncthreads();
        for (int i = tid; i < 64 * 128; i += NTHREADS) { const int tt = i >> 7, d = i & 127; const size_t g = (size_t)(c0 + tt) * 512 + h * 128 + d; qs[i] = bf2f(CQ[g]); ks[i] = bf2f(CK[g]); vs[i] = bf2f(MV[g]); }
        if (tid < 64) { const float fp = GATES[(size_t)(c0 + tid) * 8 + 4 + h] + b_f[h], ip = GATES[(size_t)(c0 + tid) * 8 + h] + b_i[h]; fs[tid] = 1.f / (1.f + expf(-fp)); is_[tid] = expf(ip); }
        __syncthreads();
        for (int tt = 0; tt < 64; ++tt) {
            const float f = fs[tt], ii = is_[tt], ve = vs[tt * 128 + e]; float pn = 0.f, pd = 0.f;
#pragma unroll
            for (int i = 0; i < 32; ++i) { const float kd = ks[tt * 128 + dg * 32 + i], qd = qs[tt * 128 + dg * 32 + i], ik = ii * kd;
                C[i] = f * C[i] + ik * ve; n[i] = f * n[i] + ik; pn += qd * C[i]; pd += qd * n[i]; }
            red[dg * 128 + e] = pn; if (e == 0) redd[dg] = pd;
            __syncthreads();
            if (dg == 0) { const float num = (red[e] + red[128 + e]) + (red[256 + e] + red[384 + e]), den = (redd[0] + redd[1]) + (redd[2] + redd[3]);
                HS[(size_t)(c0 + tt) * 512 + h * 128 + e] = num / fmaxf(fabsf(den), 1.f); }
            __syncthreads();
        }
    }
}
template <bool DO_ML>
__device__ __forceinline__ void ph_combine(const bf16* O1, const bf16* O2, const bf16* MO, const float* HS, const float* lq1, const float* lk1, const float* lq2, const float* lk2,
                                           const float* subln_g, const float* ml_g, bf16* ACAT) {
    const int lane = tidx() & 63, wave = tidx() >> 6;
    const int gw = blockIdx.x * NWAVES + wave, NGW = gridDim.x * NWAVES;
    const float lam = expf(wave_sum(lq1[lane] * lk1[lane])) - expf(wave_sum(lq2[lane] * lk2[lane])) + LAMBDA_INIT;
    for (int m = gw; m < M; m += NGW) {
        const int c0 = lane * 8;
        float a[8], b[8];
        { const v4u u1 = *(const v4u*)(O1 + (size_t)m * 512 + c0), u2 = *(const v4u*)(O2 + (size_t)m * 512 + c0);
          const unsigned w1[4] = {u1.x, u1.y, u1.z, u1.w}, w2[4] = {u2.x, u2.y, u2.z, u2.w};
#pragma unroll
          for (int i = 0; i < 4; ++i) { a[2 * i] = bf2f(w1[i] & 0xffffu) - lam * bf2f(w2[i] & 0xffffu); a[2 * i + 1] = bf2f(w1[i] >> 16) - lam * bf2f(w2[i] >> 16); } }
        if (DO_ML) { const v4u uo = *(const v4u*)(MO + (size_t)m * 512 + c0); const unsigned wo[4] = {uo.x, uo.y, uo.z, uo.w};
          const f32x4 h0 = *(const f32x4*)(HS + (size_t)m * 512 + c0), h1 = *(const f32x4*)(HS + (size_t)m * 512 + c0 + 4);
          const float hh[8] = {h0.x, h0.y, h0.z, h0.w, h1.x, h1.y, h1.z, h1.w};
#pragma unroll
          for (int i = 0; i < 4; ++i) { b[2 * i] = sigmoidf_(bf2f(wo[i] & 0xffffu)) * hh[2 * i]; b[2 * i + 1] = sigmoidf_(bf2f(wo[i] >> 16)) * hh[2 * i + 1]; } }
        else {
#pragma unroll
          for (int i = 0; i < 8; ++i) b[i] = 0.f; }
        float sa = 0.f, sb = 0.f;
#pragma unroll
        for (int i = 0; i < 8; ++i) { sa += a[i] * a[i]; sb += b[i] * b[i]; }
#pragma unroll
        for (int o = 1; o < 16; o <<= 1) { sa += __shfl_xor(sa, o); sb += __shfl_xor(sb, o); }
        const float ra = rsqrtf(sa * (1.f / 128.f) + EPS) * (1.f - LAMBDA_INIT), rb = rsqrtf(sb * (1.f / 128.f) + EPS);
        const int cc = c0 & 127, hh_ = lane >> 4;
        v4u wa, wb;
        { const float* g = subln_g + cc; wa.x = pk2(a[0] * ra * g[0], a[1] * ra * g[1]); wa.y = pk2(a[2] * ra * g[2], a[3] * ra * g[3]); wa.z = pk2(a[4] * ra * g[4], a[5] * ra * g[5]); wa.w = pk2(a[6] * ra * g[6], a[7] * ra * g[7]); }
        { const float* g = ml_g + hh_ * 128 + cc; wb.x = pk2(b[0] * rb * g[0], b[1] * rb * g[1]); wb.y = pk2(b[2] * rb * g[2], b[3] * rb * g[3]); wb.z = pk2(b[4] * rb * g[4], b[5] * rb * g[5]); wb.w = pk2(b[6] * rb * g[6], b[7] * rb * g[7]); }
        *(v4u*)(ACAT + (size_t)m * 1024 + c0) = wa; if (DO_ML) *(v4u*)(ACAT + (size_t)m * 1024 + 512 + c0) = wb;
    }
}


namespace ml {
typedef short bf16x8 __attribute__((ext_vector_type(8)));
typedef float f32x16 __attribute__((ext_vector_type(16)));
typedef LAS unsigned char* lptr;
constexpr int LD128 = 272, LD64 = 144;
constexpr int QP_OFF = 0, K_OFF = 17408, Y_OFF = 0, KWT_OFF = 34816, VT_OFF = 53248, SM_OFF = 71680, CT_OFF = 80896, SMALL_OFF = 115712;
constexpr int LDY = 132;
constexpr int ST_STRIDE = 16384 + 256;
__device__ __forceinline__ int crow(int r, int hi) { return (r & 3) + 8 * (r >> 2) + 4 * hi; }
template <int KS>
__device__ __forceinline__ void mm_tile(f32x16& acc, lptr A, int lda, lptr Bt, int ldb, int r32, int hi) {
    lptr ap = A + r32 * lda + hi * 16; lptr bp = Bt + r32 * ldb + hi * 16;
#pragma unroll
    for (int ks = 0; ks < KS; ++ks) {
        const bf16x8 a = *(const LAS bf16x8*)(ap + ks * 32);
        const bf16x8 b = *(const LAS bf16x8*)(bp + ks * 32);
        acc = __builtin_amdgcn_mfma_f32_32x32x16_bf16(a, b, acc, 0, 0, 0);
    }
}
__device__ __forceinline__ float gates_chunk(const float* GATES, float bi, float bf_, int t0, int h, int lane, LAS float* eb, LAS float* wcol, LAS float* wupd, LAS float* misc) {
    const float fp = GATES[(size_t)(t0 + lane) * 8 + 4 + h] + bf_, ip = GATES[(size_t)(t0 + lane) * 8 + h] + bi;
    const float lf = fminf(fp, 0.f) - log1pf(__expf(-fabsf(fp)));
    float b = lf;
#pragma unroll
    for (int o = 1; o < 64; o <<= 1) { const float u = __shfl_up(b, o); if (lane >= o) b += u; }
    const float bL = __shfl(b, 63);
    eb[lane] = __expf(b); wcol[lane] = __expf(ip - b); wupd[lane] = __expf(bL - b + ip); if (lane == 0) misc[0] = __expf(bL);
    return bL;
}
__device__ __forceinline__ void stage_transposed(const bf16* CK, const bf16* MV, int t0, int h, lptr lds, const LAS float* wupd, int tid) {
    const int sp = tid & 31, c = tid >> 5;
    const size_t g0 = (size_t)(t0 + 2 * sp) * 512 + h * 128 + c * 8;
    const v4u k0 = *(const v4u*)(CK + g0), k1 = *(const v4u*)(CK + g0 + 512), v0 = *(const v4u*)(MV + g0), v1 = *(const v4u*)(MV + g0 + 512);
    const float w0 = wupd[2 * sp], w1 = wupd[2 * sp + 1];
    const unsigned ka[4] = {k0.x, k0.y, k0.z, k0.w}, kb[4] = {k1.x, k1.y, k1.z, k1.w}, va[4] = {v0.x, v0.y, v0.z, v0.w}, vb[4] = {v1.x, v1.y, v1.z, v1.w};
    lptr kw = lds + KWT_OFF + (8 * c) * LD64 + 4 * sp; lptr vt = lds + VT_OFF + (8 * c) * LD64 + 4 * sp;
#pragma unroll
    for (int i = 0; i < 4; ++i) {
        *(LAS unsigned*)(kw + (2 * i) * LD64) = pk2(w0 * bf2f(ka[i] & 0xffffu), w1 * bf2f(kb[i] & 0xffffu));
        *(LAS unsigned*)(kw + (2 * i + 1) * LD64) = pk2(w0 * bf2f(ka[i] >> 16), w1 * bf2f(kb[i] >> 16));
        *(LAS unsigned*)(vt + (2 * i) * LD64) = (va[i] & 0xffffu) | (vb[i] << 16);
        *(LAS unsigned*)(vt + (2 * i + 1) * LD64) = (va[i] >> 16) | (vb[i] & 0xffff0000u);
    }
}
__device__ __forceinline__ void state_update(f32x16 (&accS)[2], lptr lds, float aL, int wave, int r32, int hi) {
    const int er = wave & 3, dc0 = 2 * (wave >> 2);
#pragma unroll
    for (int i = 0; i < 2; ++i) {
#pragma unroll
        for (int r = 0; r < 16; ++r) accS[i][r] *= aL;
        mm_tile<4>(accS[i], lds + VT_OFF + (32 * er) * LD64, LD64, lds + KWT_OFF + (32 * (dc0 + i)) * LD64, LD64, r32, hi);
    }
}
__device__ __forceinline__ float kwt_rowsum(lptr lds, int d) {
    float s = 0.f; lptr p = lds + KWT_OFF + d * LD64;
#pragma unroll
    for (int i = 0; i < 8; ++i) { const v4u q = *(const LAS v4u*)(p + 16 * i);
        s += (bf2f(q.x & 0xffffu) + bf2f(q.x >> 16)) + (bf2f(q.y & 0xffffu) + bf2f(q.y >> 16)) + (bf2f(q.z & 0xffffu) + bf2f(q.z >> 16)) + (bf2f(q.w & 0xffffu) + bf2f(q.w >> 16)); }
    return s;
}

__device__ __forceinline__ void conv_items(const bf16* MQ, const bf16* MK, const float* cw, const float* cb, bf16* CQ, bf16* CK) {
    const int tid = tidx(), ch = tid & 15, rg = tid >> 4;
    for (int item = blockIdx.x; item < 256; item += gridDim.x) {
        const int h = item >> 6, j = item & 63, col = h * 128 + ch * 8;
        float wq[4][8], wk[4][8], bq[8], bk[8];
#pragma unroll
        for (int jj = 0; jj < 4; ++jj)
#pragma unroll
            for (int e = 0; e < 8; e += 4) { const f32x4 a = *(const f32x4*)(cw + jj * 1024 + col + e), b = *(const f32x4*)(cw + jj * 1024 + 512 + col + e);
                wq[jj][e] = a.x; wq[jj][e + 1] = a.y; wq[jj][e + 2] = a.z; wq[jj][e + 3] = a.w; wk[jj][e] = b.x; wk[jj][e + 1] = b.y; wk[jj][e + 2] = b.z; wk[jj][e + 3] = b.w; }
#pragma unroll
        for (int e = 0; e < 8; ++e) { bq[e] = cb[col + e]; bk[e] = cb[512 + col + e]; }
#pragma unroll 1
        for (int ps = 0; ps < 2; ++ps) {
            const int t0 = j * 256 + rg * 8 + ps * 4;
            v4u qi[7], ki[7];
#pragma unroll
            for (int r = 0; r < 7; ++r) { const int tt = t0 - 3 + r; if (tt >= 0) { qi[r] = *(const v4u*)(MQ + (size_t)tt * 512 + col); ki[r] = *(const v4u*)(MK + (size_t)tt * 512 + col); } else { qi[r] = (v4u){0u, 0u, 0u, 0u}; ki[r] = (v4u){0u, 0u, 0u, 0u}; } }
#pragma unroll
            for (int o = 0; o < 4; ++o) {
                float aq[8], ak[8];
#pragma unroll
                for (int e = 0; e < 8; ++e) { aq[e] = bq[e]; ak[e] = bk[e]; }
#pragma unroll
                for (int jj = 0; jj < 4; ++jj) { const v4u q = qi[o + jj], k = ki[o + jj]; const unsigned qa[4] = {q.x, q.y, q.z, q.w}, ka[4] = {k.x, k.y, k.z, k.w};
#pragma unroll
                    for (int e = 0; e < 4; ++e) { aq[2 * e] += wq[jj][2 * e] * bf2f(qa[e] & 0xffffu); aq[2 * e + 1] += wq[jj][2 * e + 1] * bf2f(qa[e] >> 16);
                                                  ak[2 * e] += wk[jj][2 * e] * bf2f(ka[e] & 0xffffu); ak[2 * e + 1] += wk[jj][2 * e + 1] * bf2f(ka[e] >> 16); } }
#pragma unroll
                for (int e = 0; e < 8; ++e) { aq[e] = aq[e] * sigmoidf_(aq[e]) * 0.08838834764831845f; ak[e] = ak[e] * sigmoidf_(ak[e]); }
                v4u oq, ok; oq.x = pk2(aq[0], aq[1]); oq.y = pk2(aq[2], aq[3]); oq.z = pk2(aq[4], aq[5]); oq.w = pk2(aq[6], aq[7]);
                ok.x = pk2(ak[0], ak[1]); ok.y = pk2(ak[2], ak[3]); ok.z = pk2(ak[4], ak[5]); ok.w = pk2(ak[6], ak[7]);
                *(v4u*)(CQ + (size_t)(t0 + o) * 512 + col) = oq; *(v4u*)(CK + (size_t)(t0 + o) * 512 + col) = ok;
            }
        }
    }
}
__device__ __forceinline__ void b1_item(int item, const bf16* CK, const bf16* MV, const float* GATES, const float* b_i, const float* b_f, float* ST, lptr lds) {
    const int tid = tidx(), lane = tid & 63, r32 = lane & 31, hi = lane >> 5; const int wave = __builtin_amdgcn_readfirstlane(tid >> 6);
    LAS float* eb = (LAS float*)(lds + SMALL_OFF); LAS float* wcol = eb + 64; LAS float* wupd = wcol + 64; LAS float* misc = wupd + 64 + 64 + 128;
    {
        const int h = item >> 6, j = item & 63;
        f32x16 accS[2]; accS[0] = f32x16{}; accS[1] = f32x16{};
        float nv = 0.f, sumb = 0.f;
        const float bi = b_i[h], bf_ = b_f[h];
        for (int c = 0; c < 4; ++c) {
            const int t0 = j * 256 + c * 64;
            __syncthreads();
            if (wave == 0) sumb += gates_chunk(GATES, bi, bf_, t0, h, lane, eb, wcol, wupd, misc);
            __syncthreads();
            stage_transposed(CK, MV, t0, h, lds, wupd, tid);
            const float aL = misc[0];
            __syncthreads();
            state_update(accS, lds, aL, wave, r32, hi);
            if (tid < 128) nv = aL * nv + kwt_rowsum(lds, tid);
        }
        float* st = ST + (size_t)item * ST_STRIDE;
#pragma unroll
        for (int i = 0; i < 2; ++i)
#pragma unroll
            for (int r = 0; r < 16; ++r) st[((wave * 2 + i) * 16 + r) * 64 + lane] = accS[i][r];
        if (tid < 128) st[16384 + tid] = nv;
        if (tid == 0) st[16384 + 128] = __expf(sumb);
    }
}
__device__ __forceinline__ void phase_b2(float* ST) {
    const int gt = blockIdx.x * NTHREADS + tidx(), NGT = gridDim.x * NTHREADS;
    for (int q = gt; q < 4 * (16384 + 128); q += NGT) {
        const int h = q / (16384 + 128), e = q % (16384 + 128);
        float* base = ST + (size_t)h * 64 * ST_STRIDE;
        float c = 0.f;
#pragma unroll 1
        for (int jb = 0; jb < 64; jb += 16) {
            float u[16], a[16];
#pragma unroll
            for (int k = 0; k < 16; ++k) { u[k] = base[(size_t)(jb + k) * ST_STRIDE + e]; a[k] = base[(size_t)(jb + k) * ST_STRIDE + 16384 + 128]; }
#pragma unroll
            for (int k = 0; k < 16; ++k) { base[(size_t)(jb + k) * ST_STRIDE + e] = c; c = a[k] * c + u[k]; }
        }
    }
}
__device__ __forceinline__ void phase_b3(const bf16* CQ, const bf16* CK, const bf16* MV, const bf16* MO, const float* GATES, const float* b_i, const float* b_f, const float* ml_g,
                                         const float* ST, bf16* ACAT, lptr lds) {
    const int tid = tidx(), lane = tid & 63, r32 = lane & 31, hi = lane >> 5; const int wave = __builtin_amdgcn_readfirstlane(tid >> 6);
    LAS float* eb = (LAS float*)(lds + SMALL_OFF); LAS float* wcol = eb + 64; LAS float* wupd = wcol + 64; LAS float* dinv = wupd + 64; LAS float* nvec = dinv + 64; LAS float* misc = nvec + 128;
    const int er = wave & 3, dc0 = 2 * (wave >> 2);
    for (int item = blockIdx.x; item < 256; item += gridDim.x) {
        const int h = item >> 6, j = item & 63;
        const float* st = ST + (size_t)item * ST_STRIDE;
        f32x16 accS[2];
#pragma unroll
        for (int i = 0; i < 2; ++i)
#pragma unroll
            for (int r = 0; r < 16; ++r) accS[i][r] = st[((wave * 2 + i) * 16 + r) * 64 + lane];
        __syncthreads();
        if (tid < 128) nvec[tid] = st[16384 + tid];
#pragma unroll
        for (int i = 0; i < 2; ++i)
#pragma unroll
            for (int r = 0; r < 16; ++r) *(LAS unsigned short*)(lds + CT_OFF + (32 * er + crow(r, hi)) * LD128 + (32 * (dc0 + i) + r32) * 2) = (unsigned short)f2bf(accS[i][r]);
        const float bi = b_i[h], bf_ = b_f[h];
        for (int c = 0; c < 4; ++c) {
            const int t0 = j * 256 + c * 64;
            __syncthreads();
            if (wave == 0) (void)gates_chunk(GATES, bi, bf_, t0, h, lane, eb, wcol, wupd, misc);
            __syncthreads();
#pragma unroll
            for (int i = 0; i < 2; ++i) { const int p = tid + 512 * i, row = p >> 4, ch = p & 15; const size_t g = (size_t)(t0 + row) * 512 + h * 128 + ch * 8;
                const v4u qv = *(const v4u*)(CQ + g), kv = *(const v4u*)(CK + g); const float e_ = eb[row];
                v4u qo; qo.x = pk2(e_ * bf2f(qv.x & 0xffffu), e_ * bf2f(qv.x >> 16)); qo.y = pk2(e_ * bf2f(qv.y & 0xffffu), e_ * bf2f(qv.y >> 16));
                qo.z = pk2(e_ * bf2f(qv.z & 0xffffu), e_ * bf2f(qv.z >> 16)); qo.w = pk2(e_ * bf2f(qv.w & 0xffffu), e_ * bf2f(qv.w >> 16));
                *(LAS v4u*)(lds + QP_OFF + row * LD128 + ch * 16) = qo; *(LAS v4u*)(lds + K_OFF + row * LD128 + ch * 16) = kv; }
            stage_transposed(CK, MV, t0, h, lds, wupd, tid);
            const float aL = misc[0];
            __syncthreads();
            const int tr = wave >> 2, tc = wave & 3;
            if (wave < 4) {
                const int sr = wave >> 1, sc = wave & 1;
                f32x16 sa = f32x16{};
                mm_tile<8>(sa, lds + QP_OFF + (32 * sr) * LD128, LD128, lds + K_OFF + (32 * sc) * LD128, LD128, r32, hi);
                const int s_ = 32 * sc + r32; const float wc_ = wcol[s_];
#pragma unroll
                for (int r = 0; r < 16; ++r) { const int t_ = 32 * sr + crow(r, hi); const float v = (s_ <= t_) ? sa[r] * wc_ : 0.f;
                    *(LAS unsigned short*)(lds + SM_OFF + t_ * LD64 + s_ * 2) = (unsigned short)f2bf(v); }
            }
            f32x16 acc = f32x16{};
            mm_tile<8>(acc, lds + QP_OFF + (32 * tr) * LD128, LD128, lds + CT_OFF + (32 * tc) * LD128, LD128, r32, hi);
            __syncthreads();
            mm_tile<4>(acc, lds + SM_OFF + (32 * tr) * LD64, LD64, lds + VT_OFF + (32 * tc) * LD64, LD64, r32, hi);
            if (tid < 64) {
                float dn = 0.f; lptr qp = lds + QP_OFF + tid * LD128;
#pragma unroll 4
                for (int i = 0; i < 16; ++i) { const v4u q = *(const LAS v4u*)(qp + 16 * i); const LAS float* nn = nvec + 8 * i;
                    dn += bf2f(q.x & 0xffffu) * nn[0] + bf2f(q.x >> 16) * nn[1] + bf2f(q.y & 0xffffu) * nn[2] + bf2f(q.y >> 16) * nn[3]
                        + bf2f(q.z & 0xffffu) * nn[4] + bf2f(q.z >> 16) * nn[5] + bf2f(q.w & 0xffffu) * nn[6] + bf2f(q.w >> 16) * nn[7]; }
                lptr sp_ = lds + SM_OFF + tid * LD64;
#pragma unroll
                for (int i = 0; i < 8; ++i) { const v4u q = *(const LAS v4u*)(sp_ + 16 * i);
                    dn += (bf2f(q.x & 0xffffu) + bf2f(q.x >> 16)) + (bf2f(q.y & 0xffffu) + bf2f(q.y >> 16)) + (bf2f(q.z & 0xffffu) + bf2f(q.z >> 16)) + (bf2f(q.w & 0xffffu) + bf2f(q.w >> 16)); }
                dinv[tid] = 1.f / fmaxf(fabsf(dn), 1.f);
            }
            __syncthreads();
#pragma unroll
            for (int r = 0; r < 16; ++r) { const int t_ = 32 * tr + crow(r, hi); *(LAS float*)(lds + Y_OFF + (t_ * LDY + 32 * tc + r32) * 4) = acc[r] * dinv[t_]; }
            state_update(accS, lds, aL, wave, r32, hi);
            float nnew = 0.f;
            if (tid < 128) nnew = aL * nvec[tid] + kwt_rowsum(lds, tid);
            __syncthreads();
            if (tid < 128) nvec[tid] = nnew;
#pragma unroll
            for (int i = 0; i < 2; ++i)
#pragma unroll
                for (int r = 0; r < 16; ++r) *(LAS unsigned short*)(lds + CT_OFF + (32 * er + crow(r, hi)) * LD128 + (32 * (dc0 + i) + r32) * 2) = (unsigned short)f2bf(accS[i][r]);
#pragma unroll 2
            for (int rr = 0; rr < 8; ++rr) { const int t_ = wave * 8 + rr; const size_t grow = (size_t)(t0 + t_);
                const float y0 = *(const LAS float*)(lds + Y_OFF + (t_ * LDY + 2 * lane) * 4), y1 = *(const LAS float*)(lds + Y_OFF + (t_ * LDY + 2 * lane + 1) * 4);
                const unsigned ov = *(const unsigned*)(MO + grow * 512 + h * 128 + 2 * lane);
                const float z0 = y0 * sigmoidf_(bf2f(ov & 0xffffu)), z1 = y1 * sigmoidf_(bf2f(ov >> 16));
                const float rs = rsqrtf(wave_sum(z0 * z0 + z1 * z1) * (1.f / 128.f) + EPS);
                *(unsigned*)(ACAT + grow * 1024 + 512 + h * 128 + 2 * lane) = pk2(z0 * rs * ml_g[h * 128 + 2 * lane], z1 * rs * ml_g[h * 128 + 2 * lane + 1]); }
        }
    }
}
}

__device__ __forceinline__ void ph_route_naive(const bf16* QP, const float* SK, int2* ROUTE, float* lds) {
    float* qs = lds; float* sc = qs + 2048; float* sv = sc + 2048; int* si = (int*)(sv + 256); float* cand = (float*)(si + 256); float* tops = cand + 2048; int* tope = (int*)(tops + 128);
    const int tid = tidx();
    for (int t = blockIdx.x; t < M; t += gridDim.x) {
        __syncthreads();
        for (int i = tid; i < 2048; i += NTHREADS) qs[i] = bf2f(QP[(size_t)t * 2048 + i]);
        __syncthreads();
#pragma unroll 1
        for (int j = 0; j < 4; ++j) { const int sidx = tid + 512 * j, hc = sidx >> 7; const float* kp = SK + (size_t)sidx * 128; const float* qq = qs + hc * 128; float s = 0.f;
            for (int d = 0; d < 128; d += 4) { const f32x4 kv = *(const f32x4*)(kp + d); s += qq[d] * kv.x + qq[d + 1] * kv.y + qq[d + 2] * kv.z + qq[d + 3] * kv.w; }
            sc[sidx] = s; }
        __syncthreads();
        if (tid < 16) { const int hc = tid;
            for (int k = 0; k < 16; ++k) { float best = -INFINITY; int bi = 0;
                for (int n = 0; n < 128; ++n) { const float v = sc[hc * 128 + n]; if (v > best) { best = v; bi = n; } }
                sv[hc * 16 + k] = best; si[hc * 16 + k] = bi; sc[hc * 128 + bi] = -INFINITY; } }
        __syncthreads();
        for (int i = tid; i < 2048; i += NTHREADS) { const int h = i >> 8, a = (i >> 4) & 15, b = i & 15; cand[i] = sv[(2 * h) * 16 + a] + sv[(2 * h + 1) * 16 + b]; }
        __syncthreads();
        if (tid < 8) { const int h = tid;
            for (int k = 0; k < 16; ++k) { float best = -INFINITY; int bi = 0;
                for (int n = 0; n < 256; ++n) { const float v = cand[h * 256 + n]; if (v > best) { best = v; bi = n; } }
                tops[h * 16 + k] = best; tope[h * 16 + k] = si[(2 * h) * 16 + (bi >> 4)] * 128 + si[(2 * h + 1) * 16 + (bi & 15)]; cand[h * 256 + bi] = -INFINITY; }
            const float mx = tops[h * 16]; float sum = 0.f;
            for (int k = 0; k < 16; ++k) sum += expf(tops[h * 16 + k] - mx);
            const float inv = 1.f / sum;
            for (int k = 0; k < 16; ++k) ROUTE[((size_t)t * 8 + h) * 16 + k] = make_int2(tope[h * 16 + k], __float_as_int(expf(tops[h * 16 + k] - mx) * inv)); }
    }
}
__device__ __forceinline__ void ph_expert_naive(const bf16* XN, const int2* ROUTE, const float* EU, const float* EV, float* X, float* lds) {
    float* xs = lds; float* ws = xs + 1024; int* es = (int*)(ws + 128); float* gs = (float*)(es + 128);
    const int tid = tidx();
    for (int t = blockIdx.x; t < M; t += gridDim.x) {
        __syncthreads();
        for (int i = tid; i < 1024; i += NTHREADS) xs[i] = bf2f(XN[(size_t)t * 1024 + i]);
        if (tid < 128) { const int2 r = ROUTE[(size_t)t * 128 + tid]; es[tid] = r.x; gs[tid] = __int_as_float(r.y); }
        __syncthreads();
        { const int e = tid >> 2, part = tid & 3; const float* u = EU + (size_t)es[e] * 1024 + part * 4; const float* xx = xs + part * 4; float s = 0.f;
          for (int d = 0; d < 1024; d += 16) { const f32x4 uv = *(const f32x4*)(u + d); s += xx[d] * uv.x + xx[d + 1] * uv.y + xx[d + 2] * uv.z + xx[d + 3] * uv.w; }
          s += __shfl_xor(s, 1); s += __shfl_xor(s, 2);
          const float a = 0.5f * s * (1.f + erff(s * 0.7071067811865476f));
          if (part == 0) ws[e] = gs[e] * a; }
        __syncthreads();
#pragma unroll 1
        for (int j = 0; j < 2; ++j) { const int n = tid + 512 * j; float o = 0.f;
            for (int e = 0; e < 128; ++e) o += ws[e] * EV[(size_t)es[e] * 1024 + n];
            X[(size_t)t * 1024 + n] += o; }
    }
}


namespace peer {
typedef __bf16 bf16x2_t __attribute__((ext_vector_type(2)));
typedef float f32x2_t __attribute__((ext_vector_type(2)));
typedef LAS unsigned char* lptr;
__device__ __forceinline__ float dot2(unsigned a, unsigned b, float c) { return __builtin_amdgcn_fdot2_f32_bf16(__builtin_bit_cast(bf16x2_t, a), __builtin_bit_cast(bf16x2_t, b), c, false); }
template <int CTRL> __device__ __forceinline__ float dpp(float x) { return __builtin_bit_cast(float, __builtin_amdgcn_mov_dpp(__builtin_bit_cast(int, x), CTRL, 0xf, 0xf, true)); }
__device__ __forceinline__ float row16_sum(float x) { x += dpp<0x128>(x); x += dpp<0x124>(x); x += dpp<0x122>(x); x += dpp<0x121>(x); return x; }
__device__ __forceinline__ unsigned fp8lo_bf16(unsigned w) { return __builtin_bit_cast(unsigned, __builtin_amdgcn_cvt_scalef32_pk_bf16_fp8(w, 1.0f, false)); }
__device__ __forceinline__ unsigned fp8hi_bf16(unsigned w) { return __builtin_bit_cast(unsigned, __builtin_amdgcn_cvt_scalef32_pk_bf16_fp8(w, 1.0f, true)); }
__device__ __forceinline__ float dot16(const v4u& u, const v4u& x0, const v4u& x1, float d) {
    d = dot2(fp8lo_bf16(u.x), x0.x, d); d = dot2(fp8hi_bf16(u.x), x0.y, d); d = dot2(fp8lo_bf16(u.y), x0.z, d); d = dot2(fp8hi_bf16(u.y), x0.w, d);
    d = dot2(fp8lo_bf16(u.z), x1.x, d); d = dot2(fp8hi_bf16(u.z), x1.y, d); d = dot2(fp8lo_bf16(u.w), x1.z, d); return dot2(fp8hi_bf16(u.w), x1.w, d);
}
__device__ __forceinline__ void convert_tables(const float* EU, const float* EV, const float* gu, unsigned char* EU8, unsigned char* EV8, float* SI) {
    const int lane = tidx() & 63, wave = tidx() >> 6;
    const int gw = blockIdx.x * NWAVES + wave, NGW = gridDim.x * NWAVES;
    f32x4 gg[4];
#pragma unroll
    for (int j = 0; j < 4; ++j) gg[j] = *(const f32x4*)(gu + 4 * lane + 256 * j);
    for (int r0 = gw * 4; r0 < 2 * 16384; r0 += NGW * 4) {
        f32x4 v[4][4];
#pragma unroll
        for (int q = 0; q < 4; ++q) { const int r = r0 + q; const bool second = r >= 16384; const float* src = (second ? EV : EU) + (size_t)(second ? r - 16384 : r) * 1024 + 4 * lane;
#pragma unroll
            for (int j = 0; j < 4; ++j) v[q][j] = *(const f32x4*)(src + 256 * j); }
#pragma unroll
        for (int q = 0; q < 4; ++q) { const int r = r0 + q; const bool second = r >= 16384; const int row = second ? r - 16384 : r;
            float am = 0.f;
#pragma unroll
            for (int j = 0; j < 4; ++j) { if (!second) v[q][j] = v[q][j] * gg[j];
                am = fmaxf(am, fmaxf(fmaxf(fabsf(v[q][j].x), fabsf(v[q][j].y)), fmaxf(fabsf(v[q][j].z), fabsf(v[q][j].w)))); }
#pragma unroll
            for (int o = 1; o < 64; o <<= 1) am = fmaxf(am, __shfl_xor(am, o));
            const int e = (int)((__float_as_uint(am) >> 23) & 0xffu) - 127;
            const bool ok = am > 1e-30f;
            const float sc = ok ? __uint_as_float((unsigned)(127 + 6 - e) << 23) : 1.f, isc = ok ? __uint_as_float((unsigned)(127 - 6 + e) << 23) : 1.f;
            unsigned char* dst = (second ? EV8 : EU8) + (size_t)row * 1024 + 4 * lane;
#pragma unroll
            for (int j = 0; j < 4; ++j) { int p = __builtin_amdgcn_cvt_pk_fp8_f32(v[q][j].x * sc, v[q][j].y * sc, 0, false); p = __builtin_amdgcn_cvt_pk_fp8_f32(v[q][j].z * sc, v[q][j].w * sc, p, true); *(unsigned*)(dst + 256 * j) = (unsigned)p; }
            if (lane == 0) SI[r] = isc; }
    }
}
__device__ __forceinline__ void expert_phase(const bf16* XG, const float* RS, bf16* XN, const int2* ROUTE, const unsigned char* EU8, const unsigned char* EV8, const float* SI, const float* X, float* XO, const float* g_next, lptr lds) {
    const int lane = tidx() & 63, grp = lane >> 4, li = lane & 15; const int wave = __builtin_amdgcn_readfirstlane(tidx() >> 6);
    LAS int* ids = (LAS int*)(lds + wave * 1536); LAS float* wts = (LAS float*)(ids + 128); LAS float* sus = wts + 128;
    const int gw = blockIdx.x * NWAVES + wave, NGW = gridDim.x * NWAVES;
    for (int t = gw; t < M; t += NGW) {
        v4u xq[8];
#pragma unroll
        for (int j = 0; j < 4; ++j) { const bf16* xp = XG + (size_t)t * 1024 + 256 * j + 16 * li; xq[2 * j] = *(const v4u*)xp; xq[2 * j + 1] = *(const v4u*)(xp + 8); }
        const float rt = rsqrtf(row16_sum(RS[(size_t)t * 16 + li]) * (1.f / D) + EPS);
        { const int2 r0 = ROUTE[(size_t)t * 128 + lane], r1 = ROUTE[(size_t)t * 128 + 64 + lane];
          ids[lane] = r0.x; ids[lane + 64] = r1.x; wts[lane] = __int_as_float(r0.y) * SI[16384 + r0.x]; wts[lane + 64] = __int_as_float(r1.y) * SI[16384 + r1.x]; sus[lane] = SI[r0.x]; sus[lane + 64] = SI[r1.x]; }
        v4u ua[8], ub[8];
#define PEER_ULOAD(buf, b) do { _Pragma("unroll") for (int ps = 0; ps < 2; ++ps) { const unsigned char* up_ = EU8 + (size_t)ids[8 * (b) + 4 * ps + grp] * 1024 + 16 * li; \
            _Pragma("unroll") for (int j = 0; j < 4; ++j) buf[4 * ps + j] = *(const v4u*)(up_ + 256 * j); } } while (0)
#define PEER_UCOMP(buf, b) do { _Pragma("unroll") for (int ps = 0; ps < 2; ++ps) { float d_ = 0.f; \
            _Pragma("unroll") for (int j = 0; j < 4; ++j) d_ = dot16(buf[4 * ps + j], xq[2 * j], xq[2 * j + 1], d_); \
            d_ = row16_sum(d_) * (rt * sus[8 * (b) + 4 * ps + grp]); \
            const float a_ = 0.5f * d_ * (1.f + erff(d_ * 0.7071067811865476f)); if (li == 0) wts[8 * (b) + 4 * ps + grp] *= a_; } } while (0)
        PEER_ULOAD(ua, 0);
#pragma unroll 1
        for (int b = 0; b < 16; b += 2) {
            PEER_ULOAD(ub, b + 1);
            PEER_UCOMP(ua, b);
            if (b + 2 < 16) PEER_ULOAD(ua, b + 2);
            PEER_UCOMP(ub, b + 1);
        }
#undef PEER_ULOAD
#undef PEER_UCOMP
        float acc[16];
#pragma unroll
        for (int i = 0; i < 16; ++i) acc[i] = 0.f;
        v4u va[8], vb[8];
#define PEER_VLOAD(buf, b) do { _Pragma("unroll") for (int k = 0; k < 8; ++k) buf[k] = *(const v4u*)(EV8 + (size_t)ids[8 * (b) + k] * 1024 + 16 * lane); } while (0)
#define PEER_VCOMP(buf, b) do { _Pragma("unroll") for (int k = 0; k < 8; ++k) { const float w_ = wts[8 * (b) + k]; const v4u q_ = buf[k]; \
            const unsigned qq_[4] = {q_.x, q_.y, q_.z, q_.w}; \
            _Pragma("unroll") for (int i = 0; i < 4; ++i) { const f32x2_t lo_ = __builtin_amdgcn_cvt_pk_f32_fp8((int)qq_[i], false), hi_ = __builtin_amdgcn_cvt_pk_f32_fp8((int)qq_[i], true); \
                acc[4 * i + 0] = fmaf(w_, lo_.x, acc[4 * i + 0]); acc[4 * i + 1] = fmaf(w_, lo_.y, acc[4 * i + 1]); acc[4 * i + 2] = fmaf(w_, hi_.x, acc[4 * i + 2]); acc[4 * i + 3] = fmaf(w_, hi_.y, acc[4 * i + 3]); } } } while (0)
        PEER_VLOAD(va, 0);
#pragma unroll 1
        for (int b = 0; b < 16; b += 2) {
            PEER_VLOAD(vb, b + 1);
            PEER_VCOMP(va, b);
            if (b + 2 < 16) PEER_VLOAD(va, b + 2);
            PEER_VCOMP(vb, b + 1);
        }
#undef PEER_VLOAD
#undef PEER_VCOMP
        { const float* xi = X + (size_t)t * 1024 + 16 * lane; float* xo = XO + (size_t)t * 1024 + 16 * lane;
#pragma unroll
          for (int i = 0; i < 4; ++i) { f32x4 a = *(const f32x4*)(xi + 4 * i); a.x += acc[4 * i + 0]; a.y += acc[4 * i + 1]; a.z += acc[4 * i + 2]; a.w += acc[4 * i + 3]; *(f32x4*)(xo + 4 * i) = a;
              acc[4 * i + 0] = a.x; acc[4 * i + 1] = a.y; acc[4 * i + 2] = a.z; acc[4 * i + 3] = a.w; }
          float ss = 0.f;
#pragma unroll
          for (int i = 0; i < 16; ++i) ss += acc[i] * acc[i];
          const float rn = rsqrtf(wave_sum(ss) * (1.f / D) + EPS);
          const float* gp = g_next + 16 * lane; v4u w0, w1;
          w0.x = pk2(acc[0] * rn * gp[0], acc[1] * rn * gp[1]); w0.y = pk2(acc[2] * rn * gp[2], acc[3] * rn * gp[3]); w0.z = pk2(acc[4] * rn * gp[4], acc[5] * rn * gp[5]); w0.w = pk2(acc[6] * rn * gp[6], acc[7] * rn * gp[7]);
          w1.x = pk2(acc[8] * rn * gp[8], acc[9] * rn * gp[9]); w1.y = pk2(acc[10] * rn * gp[10], acc[11] * rn * gp[11]); w1.z = pk2(acc[12] * rn * gp[12], acc[13] * rn * gp[13]); w1.w = pk2(acc[14] * rn * gp[14], acc[15] * rn * gp[15]);
          bf16* xnp = XN + (size_t)t * 1024 + 16 * lane; *(v4u*)xnp = w0; *(v4u*)(xnp + 8) = w1; }
    }
}

template <int P>
__device__ __forceinline__ void expert_phase_mp(const bf16* XG, const float* RS, bf16* XN, const int2* ROUTE, const unsigned char* EU8, const unsigned char* EV8, const float* SI,
                                                const float* X, float* XO, const float* g_next, lptr lds) {
    constexpr int SH = (P == 8) ? 11 : (P == 4) ? 12 : (P == 2) ? 13 : 14;
    const int lane = tidx() & 63, grp = lane >> 4, li = lane & 15; const int wave = __builtin_amdgcn_readfirstlane(tidx() >> 6);
    lptr wl = lds + wave * 15616;
    lptr XS = wl;
    LAS unsigned* FLE = (LAS unsigned*)(wl + 8192);
    LAS float* SW = (LAS float*)(wl + 8192 + 3072);
    LAS float* RT = (LAS float*)(wl + 8192 + 3072 + 2048);
    LAS int* QS = (LAS int*)(wl + 8192 + 3072 + 2048 + 16);
    LAS float* SU = (LAS float*)(wl + 8192 + 3072 + 2048 + 16 + 48);
    const int gw = blockIdx.x * NWAVES + wave, NGW = gridDim.x * NWAVES;
    const unsigned long long ltmask = (1ull << lane) - 1ull;
#pragma unroll 1
    for (int g4 = 0; g4 < 2; ++g4) {
        int tk[4];
#pragma unroll
        for (int k = 0; k < 4; ++k) tk[k] = gw + (g4 * 4 + k) * NGW;
        int2 e0[4], e1[4];
#pragma unroll
        for (int k = 0; k < 4; ++k) {
            const v4u a = *(const v4u*)(XG + (size_t)tk[k] * 1024 + 16 * lane), b = *(const v4u*)(XG + (size_t)tk[k] * 1024 + 16 * lane + 8);
            *(LAS v4u*)(XS + k * 2048 + 32 * lane) = a; *(LAS v4u*)(XS + k * 2048 + 32 * lane + 16) = b;
            e0[k] = ROUTE[(size_t)tk[k] * 128 + lane]; e1[k] = ROUTE[(size_t)tk[k] * 128 + 64 + lane];
            SW[k * 128 + lane] = __int_as_float(e0[k].y) * SI[16384 + e0[k].x]; SW[k * 128 + 64 + lane] = __int_as_float(e1[k].y) * SI[16384 + e1[k].x];
            SU[k * 128 + lane] = SI[e0[k].x]; SU[k * 128 + 64 + lane] = SI[e1[k].x];
            const float r = rsqrtf(row16_sum(RS[(size_t)tk[k] * 16 + li]) * (1.f / D) + EPS); if (lane == 0) RT[k] = r;
        }
        int qbase = 0;
#pragma unroll 1
        for (int p = 0; p < P; ++p) {
            if (lane == 0) QS[p] = qbase;
            int base = 4 * qbase;
#pragma unroll
            for (int k = 0; k < 4; ++k) {
                const bool in0 = (e0[k].x >> SH) == p, in1 = (e1[k].x >> SH) == p;
                const unsigned long long m0 = __ballot(in0), m1 = __ballot(in1);
                const int c0 = __popcll(m0), c1 = __popcll(m1), n = c0 + c1, npad = (n + 3) & ~3;
                if (in0) FLE[base + __popcll(m0 & ltmask)] = (unsigned)e0[k].x | 0x4000u | ((unsigned)(k * 128 + lane) << 16);
                if (in1) FLE[base + c0 + __popcll(m1 & ltmask)] = (unsigned)e1[k].x | 0x4000u | ((unsigned)(k * 128 + 64 + lane) << 16);
                if (lane < npad - n) FLE[base + n + lane] = (unsigned)(p << SH) | ((unsigned)(k * 128) << 16);
                base += npad;
            }
            { const int nq = base >> 2, ext = (4 - (nq & 3)) & 3;
              if (lane < 4 * ext) FLE[base + lane] = (unsigned)(p << SH) | ((unsigned)(3 * 128) << 16); base += 4 * ext; }
            qbase = base >> 2;
        }
        if (lane == 0) QS[P] = qbase;
        v4u ua[8], ub[8]; unsigned ea[2], eb_[2];
#define MP_ULOAD(buf, ent, q) do { _Pragma("unroll") for (int h2 = 0; h2 < 2; ++h2) { ent[h2] = FLE[4 * ((q) + h2) + grp]; const unsigned char* up_ = EU8 + (size_t)(ent[h2] & 0x3FFFu) * 1024 + 16 * li; \
            _Pragma("unroll") for (int j = 0; j < 4; ++j) buf[4 * h2 + j] = *(const v4u*)(up_ + 256 * j); } } while (0)
#define MP_UCOMP(buf, ent) do { _Pragma("unroll") for (int h2 = 0; h2 < 2; ++h2) { const int tok_ = (int)(ent[h2] >> 23) & 3; lptr xp_ = XS + tok_ * 2048 + 32 * li; float d_ = 0.f; \
            _Pragma("unroll") for (int j = 0; j < 4; ++j) { const v4u x0_ = *(const LAS v4u*)(xp_ + 512 * j), x1_ = *(const LAS v4u*)(xp_ + 512 * j + 16); d_ = dot16(buf[4 * h2 + j], x0_, x1_, d_); } \
            d_ = row16_sum(d_) * (RT[tok_] * SU[(ent[h2] >> 16) & 511u]); \
            const float a_ = 0.5f * d_ * (1.f + erff(d_ * 0.7071067811865476f)); if (li == 0 && (ent[h2] & 0x4000u)) SW[ent[h2] >> 16] *= a_; } } while (0)
#pragma unroll 1
        for (int p = 0; p < P; ++p) {
            const int q0 = QS[p], q1 = QS[p + 1];
            if (q0 < q1) {
                MP_ULOAD(ua, ea, q0);
#pragma unroll 1
                for (int q = q0; q < q1; q += 4) {
                    MP_ULOAD(ub, eb_, q + 2);
                    MP_UCOMP(ua, ea);
                    if (q + 4 < q1) MP_ULOAD(ua, ea, q + 4);
                    MP_UCOMP(ub, eb_);
                }
            }
        }
#undef MP_ULOAD
#undef MP_UCOMP
        float acc[4][16];
#pragma unroll
        for (int k = 0; k < 4; ++k)
#pragma unroll
            for (int i = 0; i < 16; ++i) acc[k][i] = 0.f;
        v4u va[8], vb[8]; unsigned na[8], nb[8];
#define MP_VLOAD(buf, ents, q) do { _Pragma("unroll") for (int r = 0; r < 8; ++r) { ents[r] = FLE[4 * (q) + r]; buf[r] = *(const v4u*)(EV8 + (size_t)(ents[r] & 0x3FFFu) * 1024 + 16 * lane); } } while (0)
#define MP_VACC(K, buf, ents, R0) do { _Pragma("unroll") for (int r = R0; r < R0 + 4; ++r) { const float w_ = (ents[r] & 0x4000u) ? SW[ents[r] >> 16] : 0.f; const v4u q_ = buf[r]; \
            const unsigned qq_[4] = {q_.x, q_.y, q_.z, q_.w}; \
            _Pragma("unroll") for (int i = 0; i < 4; ++i) { const f32x2_t lo_ = __builtin_amdgcn_cvt_pk_f32_fp8((int)qq_[i], false), hi_ = __builtin_amdgcn_cvt_pk_f32_fp8((int)qq_[i], true); \
                acc[K][4 * i + 0] = fmaf(w_, lo_.x, acc[K][4 * i + 0]); acc[K][4 * i + 1] = fmaf(w_, lo_.y, acc[K][4 * i + 1]); acc[K][4 * i + 2] = fmaf(w_, hi_.x, acc[K][4 * i + 2]); acc[K][4 * i + 3] = fmaf(w_, hi_.y, acc[K][4 * i + 3]); } } } while (0)
#define MP_VCOMP1(buf, ents, R0) do { const int tok_ = __builtin_amdgcn_readfirstlane((int)(ents[R0] >> 23) & 3); \
            if (tok_ == 0) MP_VACC(0, buf, ents, R0); else if (tok_ == 1) MP_VACC(1, buf, ents, R0); else if (tok_ == 2) MP_VACC(2, buf, ents, R0); else MP_VACC(3, buf, ents, R0); } while (0)
#define MP_VCOMP(buf, ents) do { MP_VCOMP1(buf, ents, 0); MP_VCOMP1(buf, ents, 4); } while (0)
#pragma unroll 1
        for (int p = 0; p < P; ++p) {
            const int q0 = QS[p], q1 = QS[p + 1];
            if (q0 < q1) {
                MP_VLOAD(va, na, q0);
#pragma unroll 1
                for (int q = q0; q < q1; q += 4) {
                    MP_VLOAD(vb, nb, q + 2);
                    MP_VCOMP(va, na);
                    if (q + 4 < q1) MP_VLOAD(va, na, q + 4);
                    MP_VCOMP(vb, nb);
                }
            }
        }
#undef MP_VLOAD
#undef MP_VACC
#undef MP_VCOMP1
#undef MP_VCOMP
#pragma unroll
        for (int k = 0; k < 4; ++k) {
            const float* xi = X + (size_t)tk[k] * 1024 + 16 * lane; float* xo = XO + (size_t)tk[k] * 1024 + 16 * lane;
            float ss = 0.f;
#pragma unroll
            for (int i = 0; i < 4; ++i) { f32x4 a = *(const f32x4*)(xi + 4 * i); a.x += acc[k][4 * i + 0]; a.y += acc[k][4 * i + 1]; a.z += acc[k][4 * i + 2]; a.w += acc[k][4 * i + 3]; *(f32x4*)(xo + 4 * i) = a;
                acc[k][4 * i + 0] = a.x; acc[k][4 * i + 1] = a.y; acc[k][4 * i + 2] = a.z; acc[k][4 * i + 3] = a.w; ss += (a.x * a.x + a.y * a.y) + (a.z * a.z + a.w * a.w); }
            const float rn = rsqrtf(wave_sum(ss) * (1.f / D) + EPS);
            const float* gp = g_next + 16 * lane; v4u w0, w1;
            w0.x = pk2(acc[k][0] * rn * gp[0], acc[k][1] * rn * gp[1]); w0.y = pk2(acc[k][2] * rn * gp[2], acc[k][3] * rn * gp[3]); w0.z = pk2(acc[k][4] * rn * gp[4], acc[k][5] * rn * gp[5]); w0.w = pk2(acc[k][6] * rn * gp[6], acc[k][7] * rn * gp[7]);
            w1.x = pk2(acc[k][8] * rn * gp[8], acc[k][9] * rn * gp[9]); w1.y = pk2(acc[k][10] * rn * gp[10], acc[k][11] * rn * gp[11]); w1.z = pk2(acc[k][12] * rn * gp[12], acc[k][13] * rn * gp[13]); w1.w = pk2(acc[k][14] * rn * gp[14], acc[k][15] * rn * gp[15]);
            bf16* xnp = XN + (size_t)tk[k] * 1024 + 16 * lane; *(v4u*)xnp = w0; *(v4u*)(xnp + 8) = w1;
        }
    }
}
}


namespace route {
typedef short bf16x8 __attribute__((ext_vector_type(8)));
typedef float f32x16 __attribute__((ext_vector_type(16)));
typedef LAS unsigned char* lptr;
__device__ __forceinline__ unsigned f2sort(float f) { const unsigned u = __float_as_uint(f); return (u & 0x80000000u) ? ~u : (u | 0x80000000u); }
__device__ __forceinline__ float sort2f(unsigned s) { return __uint_as_float((s & 0x80000000u) ? (s & 0x7fffffffu) : ~s); }
__device__ __forceinline__ unsigned umax_(unsigned a, unsigned b) { return a > b ? a : b; }
__device__ __forceinline__ unsigned umin_(unsigned a, unsigned b) { return a < b ? a : b; }
__device__ __forceinline__ unsigned selu(int hi, unsigned a, unsigned b) { asm volatile("" : "+v"(a), "+v"(b)); return hi ? b : a; }
__device__ __forceinline__ float self(int hi, float a, float b) { asm volatile("" : "+v"(a), "+v"(b)); return hi ? b : a; }
__device__ __forceinline__ unsigned partner32(unsigned x, int hi) { auto r = __builtin_amdgcn_permlane32_swap(x, x, false, false); return hi ? r[0] : r[1]; }
__device__ __forceinline__ void sort16_desc(unsigned (&x)[16]) {
#pragma unroll
    for (int k = 2; k <= 16; k <<= 1)
#pragma unroll
        for (int j = k >> 1; j > 0; j >>= 1)
#pragma unroll
            for (int i = 0; i < 16; ++i) { const int l = i ^ j; if (l > i) { const bool desc = ((i & k) == 0); const unsigned a = x[i], b = x[l], mx = umax_(a, b), mn = umin_(a, b); x[i] = desc ? mx : mn; x[l] = desc ? mn : mx; } }
}
__device__ __forceinline__ void merge_top16(unsigned (&a)[16], const unsigned (&b)[16]) {
#pragma unroll
    for (int i = 0; i < 16; ++i) a[i] = umax_(a[i], b[15 - i]);
#pragma unroll
    for (int j = 8; j > 0; j >>= 1)
#pragma unroll
        for (int i = 0; i < 16; ++i) { const int l = i ^ j; if (l > i) { const unsigned p = a[i], q = a[l]; a[i] = umax_(p, q); a[l] = umin_(p, q); } }
}
__device__ __forceinline__ void convert_subkeys(const float* SK, bf16* SKB) {
    const int n8 = 16 * 128 * 128 / 8, stride = gridDim.x * NTHREADS;
    for (int i = blockIdx.x * NTHREADS + tidx(); i < n8; i += stride) { const f32x4 a = *(const f32x4*)(SK + (size_t)i * 8), b = *(const f32x4*)(SK + (size_t)i * 8 + 4);
        v4u o; o.x = pk2(a.x, a.y); o.y = pk2(a.z, a.w); o.z = pk2(b.x, b.y); o.w = pk2(b.z, b.w); *(v4u*)(SKB + (size_t)i * 8) = o; }
}
__device__ __forceinline__ void route_phase(const bf16* QP, const bf16* SKB, const float* RS, int2* ROUTE, lptr lds) {
    const int lane = tidx() & 63, r32 = lane & 31, hi = lane >> 5; const int wave = __builtin_amdgcn_readfirstlane(tidx() >> 6);
    LAS int* myl = (LAS int*)(lds + wave * 8448) + lane * 33;
    const int gw = blockIdx.x * NWAVES + wave, NGW = gridDim.x * NWAVES;
    for (int it = gw; it < 4096; it += NGW) {
        const int tb = it >> 3, h = it & 7, token = tb * 32 + r32;
        unsigned top0[16], top1[16];
#pragma unroll
        for (int i = 0; i < 16; ++i) { top0[i] = 0u; top1[i] = 0u; }
#pragma unroll
        for (int c = 0; c < 2; ++c) {
            const int hc = h * 2 + c;
            bf16x8 qf[8];
#pragma unroll
            for (int ks = 0; ks < 8; ++ks) qf[ks] = *(const bf16x8*)(QP + (size_t)token * 2048 + hc * 128 + 16 * ks + 8 * hi);
#pragma unroll 1
            for (int kt = 0; kt < 4; ++kt) {
                const bf16* ap = SKB + ((size_t)(hc * 128 + 32 * kt + r32)) * 128 + 8 * hi;
                f32x16 acc = f32x16{};
#pragma unroll
                for (int ks = 0; ks < 8; ++ks) { const bf16x8 a = *(const bf16x8*)(ap + 16 * ks); acc = __builtin_amdgcn_mfma_f32_32x32x16_bf16(a, qf[ks], acc, 0, 0, 0); }
                const unsigned code0 = 127u - (unsigned)(32 * kt + 4 * hi);
                unsigned pt[16];
#pragma unroll
                for (int r = 0; r < 16; ++r) pt[r] = (f2sort(acc[r]) & ~0x7Fu) | (code0 - (unsigned)((r & 3) + 8 * (r >> 2)));
                sort16_desc(pt);
                if (c == 0) merge_top16(top0, pt); else merge_top16(top1, pt);
            }
            { unsigned oth[16];
#pragma unroll
              for (int i = 0; i < 16; ++i) oth[i] = partner32(c == 0 ? top0[i] : top1[i], hi);
              if (c == 0) merge_top16(top0, oth); else merge_top16(top1, oth); }
        }
#pragma unroll
        for (int i = 0; i < 16; ++i) { myl[i] = 127 - (int)(top0[i] & 0x7Fu); myl[16 + i] = 127 - (int)(top1[i] & 0x7Fu); }
        float a1[16], ai[8];
#pragma unroll
        for (int i = 0; i < 16; ++i) a1[i] = sort2f(top1[i] & ~0x7Fu);
#pragma unroll
        for (int i = 0; i < 8; ++i) ai[i] = sort2f(selu(hi, top0[i], top0[8 + i]) & ~0x7Fu);
        unsigned top2[16];
#pragma unroll
        for (int i = 0; i < 16; ++i) top2[i] = 0u;
#pragma unroll
        for (int ii = 0; ii < 8; ++ii) {
            unsigned rw[16];
#pragma unroll
            for (int j = 0; j < 16; ++j) rw[j] = (f2sort(ai[ii] + a1[j]) & ~0xFFu) | (255u - (unsigned)(128 * hi + 16 * ii + j));
            merge_top16(top2, rw);
        }
        { unsigned oth[16];
#pragma unroll
          for (int i = 0; i < 16; ++i) oth[i] = partner32(top2[i], hi);
          merge_top16(top2, oth); }
        float rt; { const f32x4* rp = (const f32x4*)(RS + (size_t)token * 16); const f32x4 a = rp[0], b = rp[1], c = rp[2], d = rp[3];
            rt = rsqrtf((((a.x + a.y) + (a.z + a.w)) + ((b.x + b.y) + (b.z + b.w)) + ((c.x + c.y) + (c.z + c.w)) + ((d.x + d.y) + (d.z + d.w))) * (1.f / D) + EPS); }
        const float mx = sort2f(top2[0] & ~0xFFu);
        float ex[16], sum = 0.f;
#pragma unroll
        for (int k = 0; k < 16; ++k) { ex[k] = __expf(rt * (sort2f(top2[k] & ~0xFFu) - mx)); sum += ex[k]; }
        const float inv = 1.f / sum;
        int2* dst = ROUTE + ((size_t)token * 8 + h) * 16 + 8 * hi;
#pragma unroll
        for (int k = 0; k < 8; k += 2) {
            const unsigned p0 = selu(hi, top2[k], top2[8 + k]), p1 = selu(hi, top2[k + 1], top2[9 + k]);
            const float g0 = self(hi, ex[k], ex[8 + k]) * inv, g1 = self(hi, ex[k + 1], ex[9 + k]) * inv;
            const int pos0 = 255 - (int)(p0 & 0xFFu), pos1 = 255 - (int)(p1 & 0xFFu);
            const int e0 = myl[pos0 >> 4] * 128 + myl[16 + (pos0 & 15)], e1 = myl[pos1 >> 4] * 128 + myl[16 + (pos1 & 15)];
            v4u o; o.x = (unsigned)e0; o.y = __float_as_uint(g0); o.z = (unsigned)e1; o.w = __float_as_uint(g1);
            *(v4u*)(dst + k) = o;
        }
    }
}
}


__device__ __forceinline__ void ph_qk_norms(const bf16* QA, const bf16* KA, unsigned* norms) {
    const int lane = tidx() & 63, wave = tidx() >> 6;
    const int gw = blockIdx.x * NWAVES + wave, NGW = gridDim.x * NWAVES;
    float mq = 0.f, mk = 0.f;
    for (int m0 = gw * 8; m0 < M; m0 += NGW * 8) {
        v4u q[8], k[8];
#pragma unroll
        for (int r = 0; r < 8; ++r) { q[r] = *(const v4u*)(QA + (size_t)(m0 + r) * 512 + lane * 8); k[r] = *(const v4u*)(KA + (size_t)(m0 + r) * 512 + lane * 8); }
#pragma unroll
        for (int r = 0; r < 8; ++r) {
            const unsigned qa[4] = {q[r].x, q[r].y, q[r].z, q[r].w}, ka[4] = {k[r].x, k[r].y, k[r].z, k[r].w};
            float sq = 0.f, sk = 0.f;
#pragma unroll
            for (int i = 0; i < 4; ++i) { const float a = bf2f(qa[i] & 0xffffu), b = bf2f(qa[i] >> 16), c = bf2f(ka[i] & 0xffffu), d = bf2f(ka[i] >> 16); sq += a * a + b * b; sk += c * c + d * d; }
#pragma unroll
            for (int o = 1; o < 8; o <<= 1) { sq += __shfl_xor(sq, o); sk += __shfl_xor(sk, o); }
            mq = fmaxf(mq, sq); mk = fmaxf(mk, sk);
        }
    }
    if ((lane & 7) == 0) { atomicMax(norms + (lane >> 3), __float_as_uint(mq)); atomicMax(norms + 8 + (lane >> 3), __float_as_uint(mk)); }
}

constexpr int NPHASE = 12;
struct Args { const float* in[24]; float* out; unsigned char* ws; int ph_lo, ph_hi, use_bar, pad; };

__global__ void __launch_bounds__(NTHREADS, 2) mk_fwd(Args args) {
    extern __shared__ __attribute__((aligned(16))) unsigned char lds_raw[];
    float* lds = (float*)lds_raw;
    volatile LAS unsigned* MISC = (volatile LAS unsigned*)((LAS unsigned char*)lds_raw + (LDS_BYTES - 64));
    unsigned char* ws = args.ws;
    unsigned* ctl = (unsigned*)(ws + WS_CTL);
    const float* x = args.in[0]; const float* p = args.in[1]; const float* norm_mix_g = args.in[2]; const float* w_in = args.in[3];
    const float* conv_w = args.in[4]; const float* conv_b = args.in[5]; const float* b_ig = args.in[6]; const float* b_fg = args.in[7];
    const float* lq1 = args.in[8]; const float* lk1 = args.in[9]; const float* lq2 = args.in[10]; const float* lk2 = args.in[11];
    const float* subln_g = args.in[12]; const float* ml_g = args.in[13]; const float* w_out = args.in[14]; const float* norm_ffn_g = args.in[15];
    const float* w_query = args.in[16]; const float* sub_keys = args.in[17]; const float* expert_u = args.in[18]; const float* expert_v = args.in[19];
    const float* norm_ple_g = args.in[20]; const float* w_ple_gate = args.in[21]; const float* w_ple_proj = args.in[22]; const float* final_g = args.in[23];
    float* out = args.out;
    bf16* XN = (bf16*)(ws + WS_XN); float* GATES = (float*)(ws + WS_GATES);
    bf16* QA = (bf16*)(ws + WS_QA); bf16* KA = (bf16*)(ws + WS_KA); bf16* VA = (bf16*)(ws + WS_VA);
    bf16* MQ = (bf16*)(ws + WS_MQ); bf16* MK = (bf16*)(ws + WS_MK); bf16* MV = (bf16*)(ws + WS_MV); bf16* MO = (bf16*)(ws + WS_MO);
    bf16* O1 = (bf16*)(ws + WS_O1); bf16* O2 = (bf16*)(ws + WS_O2); bf16* CQ = (bf16*)(ws + WS_CQ); bf16* CK = (bf16*)(ws + WS_CK);
    float* HS = (float*)(ws + WS_HS); bf16* ACAT = (bf16*)(ws + WS_ACAT); bf16* QP = (bf16*)(ws + WS_QP); int2* ROUTE = (int2*)(ws + WS_ROUTE);
    bf16* PB = (bf16*)(ws + WS_PB); bf16* PP = (bf16*)(ws + WS_PP);
    float* ST = (float*)(ws + WS_ST);
    bf16* SKB = (bf16*)(ws + WS_SKB);
    unsigned char* EU8 = ws + WS_EU8; unsigned char* EV8 = ws + WS_EV8; float* SI = (float*)(ws + WS_SI);
    float* RS = (float*)(ws + WS_RS); bf16* X1G = (bf16*)(ws + WS_X1G); bf16* XN3 = (bf16*)(ws + WS_XN3);
    bf16* WIN = (bf16*)(ws + WS_WIN); bf16* WOUT = (bf16*)(ws + WS_WOUT); bf16* WQ = (bf16*)(ws + WS_WQ); bf16* WG = (bf16*)(ws + WS_WG); bf16* WP = (bf16*)(ws + WS_WP);
    LAS unsigned char* ldsb = (LAS unsigned char*)lds_raw;

    XcdBarrier bar; bar.bar = ctl + CW_BAR; bar.x = 0; bar.st = nullptr;
    if (args.use_bar) {
        if (tidx() < 16) MISC[tidx()] = 0u;
        __syncthreads();
        bar = xcd_barrier_post(ctl + CW_BAR, MISC + 8);
    }
    const int lo = args.ph_lo, hi = args.ph_hi;
#define IN(k) (lo <= (k) && (k) < hi)
#define SEAM(k) do { if (IN(k) && IN((k) + 1)) xcd_barrier(bar); } while (0)

    if (IN(0)) { route::convert_subkeys(sub_keys, SKB); ph_weights_in(w_in, WIN, ldsb);
        for (int ch = blockIdx.x; ch < WCH_CHUNKS; ch += gridDim.x) weights_chunk(ch, w_out, w_query, norm_ffn_g, w_ple_gate, w_ple_proj, WOUT, WQ, WG, WP, ldsb);
        ph_rmsnorm_bf16(x, norm_mix_g, XN);
        { const size_t n = (size_t)M * PLE / 8, stride = (size_t)gridDim.x * NTHREADS;
          for (size_t i = (size_t)blockIdx.x * NTHREADS + tidx(); i < n; i += stride) { const f32x4 a = *(const f32x4*)(p + i * 8), b = *(const f32x4*)(p + i * 8 + 4);
              v4u o; o.x = pk2(a.x, a.y); o.y = pk2(a.z, a.w); o.z = pk2(b.x, b.y); o.w = pk2(b.z, b.w); *(v4u*)(PB + i * 8) = o; } }
    } SEAM(0);
    if (IN(1)) {
        pg8::Gemm g{XN, WIN, M, NINP, D}; pg8::StaticOrder S; S.init(M, NINP, (int)gridDim.x, (int)blockIdx.x);
        pg8::EpiProj E{QA, (size_t)(WS_KA - WS_QA) / 2, C2, GATES};
        pg8::gemm_phase<pg8::EpiProj, pg8::StaticOrder, true, true>(ldsb, g, S, E);
    } SEAM(1);
    if (IN(2)) { ph_qk_norms(QA, KA, ctl + CW_NORM); ml::conv_items(MQ, MK, conv_w, conv_b, CQ, CK); } SEAM(2);
    if (IN(3)) {
        constexpr int Q_ATT = 1024, Q_END = Q_ATT + 256;
        for (;;) {
            __syncthreads();
            if (tidx() == 0) MISC[0] = __hip_atomic_fetch_add(ctl + CW_QUEUE, 1u, __ATOMIC_RELAXED, __HIP_MEMORY_SCOPE_AGENT);
            __syncthreads();
            const int u = (int)__builtin_amdgcn_readfirstlane(MISC[0]);
            if (u >= Q_END) break;
            if (u < Q_ATT) attn_body::attn_dispatch<8>(u, (char*)lds_raw, (const attn_body::bf16*)QA, (const attn_body::bf16*)KA, (const attn_body::bf16*)VA, (attn_body::bf16*)O1, (attn_body::bf16*)O2, ctl + CW_NORM);
            else ml::b1_item(u - Q_ATT, CK, MV, GATES, b_ig, b_fg, ST, ldsb);
        }
    } SEAM(3);
    if (IN(4)) { ml::phase_b2(ST); peer::convert_tables(expert_u, expert_v, norm_ffn_g, EU8, EV8, SI); } SEAM(4);
    if (IN(5)) { ml::phase_b3(CQ, CK, MV, MO, GATES, b_ig, b_fg, ml_g, ST, ACAT, ldsb); ph_combine<false>(O1, O2, MO, HS, lq1, lk1, lq2, lk2, subln_g, ml_g, ACAT); } SEAM(5);
    if (IN(6)) {
        pg8::Gemm g{ACAT, WOUT, M, D, D}; pg8::StaticOrder S; S.init(M, D, (int)gridDim.x, (int)blockIdx.x);
        pg8::EpiResX1 E{x, out, X1G, RS, D};
        pg8::gemm_phase<pg8::EpiResX1, pg8::StaticOrder, true, true>(ldsb, g, S, E);
    } SEAM(6);
    if (IN(7)) {
        { pg8::Gemm g{X1G, WQ, M, NQ, D}; pg8::StaticOrder S; S.init(M, NQ, (int)gridDim.x, (int)blockIdx.x);
          pg8::EpiBf16<0> E{QP, NQ, nullptr, 0, 0, 1.f};
          pg8::gemm_phase<pg8::EpiBf16<0>, pg8::StaticOrder, true, true>(ldsb, g, S, E); }
        { pg8::Gemm g{PB, WP, M, D, PLE}; pg8::StaticOrder S; S.init(M, D, (int)gridDim.x, (int)blockIdx.x);
          pg8::EpiBf16<0> E{PP, D, nullptr, 0, 0, 1.f};
          pg8::gemm_phase<pg8::EpiBf16<0>, pg8::StaticOrder, true, true>(ldsb, g, S, E); }
    } SEAM(7);
    if (IN(8)) { route::route_phase(QP, SKB, RS, ROUTE, ldsb); } SEAM(8);
    if (IN(9)) { peer::expert_phase_mp<4>(X1G, RS, XN3, ROUTE, EU8, EV8, SI, out, out, norm_ple_g, ldsb); } SEAM(9);
    if (IN(10)) {
        pg8::Gemm g{XN3, WG, M, D, D}; pg8::StaticOrder S; S.init(M, D, (int)gridDim.x, (int)blockIdx.x);
        pg8::EpiGateFinal E{PP, out, D};
        pg8::gemm_phase<pg8::EpiGateFinal, pg8::StaticOrder, true, true>(ldsb, g, S, E);
    } SEAM(10);
    if (IN(11)) { ph_rmsnorm_f32_inplace(out, final_g); }
#undef IN
#undef SEAM
}

extern "C" void kernel_launch(void* const* d_in, const int* in_sizes, int n_in, void* d_out, int out_size, void* d_ws, size_t ws_size, hipStream_t stream) {
    static int grid = 0;
    if (grid == 0) {
        if (n_in != 24 || in_sizes[0] != M * D || out_size != M * D || ws_size < WS_END) { fprintf(stderr, "kernel_launch: unexpected shapes (n_in %d, in0 %d, out %d, ws %zu)\n", n_in, n_in > 0 ? in_sizes[0] : -1, out_size, ws_size); grid = -1; return; }
        int dev = 0, cus = 0;
        if (hipGetDevice(&dev) != hipSuccess || hipDeviceGetAttribute(&cus, hipDeviceAttributeMultiprocessorCount, dev) != hipSuccess) { grid = -1; return; }
        if (hipFuncSetAttribute((const void*)mk_fwd, hipFuncAttributeMaxDynamicSharedMemorySize, LDS_BYTES) != hipSuccess) { fprintf(stderr, "kernel_launch: hipFuncSetAttribute failed\n"); grid = -1; return; }
        (void)hipGetLastError();
        grid = cus;
    }
    if (grid < 0) return;
    if (hipMemsetAsync((char*)d_ws + WS_CTL, 0, CTL_ZERO_BYTES, stream) != hipSuccess) return;
    Args a{};
    for (int i = 0; i < 24; ++i) a.in[i] = (const float*)d_in[i];
    a.out = (float*)d_out; a.ws = (unsigned char*)d_ws;
#if MK_ONE_LAUNCH
    a.ph_lo = 0; a.ph_hi = NPHASE; a.use_bar = 1;
    hipLaunchKernelGGL(mk_fwd, dim3(grid), dim3(NTHREADS), LDS_BYTES, stream, a);
#else
    for (int ph = 0; ph < NPHASE; ++ph) {
        a.ph_lo = ph; a.ph_hi = ph + 1; a.use_bar = 0;
        hipLaunchKernelGGL(mk_fwd, dim3(grid), dim3(NTHREADS), LDS_BYTES, stream, a);
    }
#endif
}
```

```cpp
#include <hip/hip_runtime.h>
#include <cstdio>
#include <cstdint>
#include <cmath>

#ifndef MK_ONE_LAUNCH
#define MK_ONE_LAUNCH 1
#endif

constexpr int M = 16384, D = 1024, NIN = 3592, PLE = 256;
constexpr int NQ = 2048;
constexpr float EPS = 1e-6f;
constexpr float LOG2E = 1.4426950408889634f;
constexpr float C2 = 0.125f * LOG2E;
constexpr float LAMBDA_INIT = 0.2f;
constexpr int NWAVES = 8, NTHREADS = 512;
constexpr int LDS_BYTES = 147456;

typedef unsigned short bf16;
typedef float f32x4 __attribute__((ext_vector_type(4)));
typedef unsigned v4u __attribute__((ext_vector_type(4)));
typedef unsigned v2u __attribute__((ext_vector_type(2)));
#define LAS __attribute__((address_space(3)))

constexpr size_t MiB = 1u << 20;
constexpr size_t WS_CTL = 0, CTL_ZERO_BYTES = 1 * MiB;
constexpr size_t WS_WIN = 1 * MiB, WS_WOUT = 9 * MiB, WS_WQ = 11 * MiB, WS_WG = 15 * MiB, WS_WP = 18 * MiB;
constexpr int NINP = 3840;
constexpr size_t WS_SKB = 18 * MiB + 512 * 1024;
constexpr size_t WS_GATES = 17 * MiB;
constexpr size_t WS_XN = 20 * MiB;
constexpr size_t WS_QA = 52 * MiB, WS_KA = 68 * MiB, WS_VA = 84 * MiB, WS_MQ = 100 * MiB, WS_MK = 116 * MiB, WS_MV = 132 * MiB, WS_MO = 148 * MiB;
constexpr size_t WS_O1 = 164 * MiB, WS_O2 = 180 * MiB;
constexpr size_t WS_CQ = 196 * MiB, WS_CK = 212 * MiB;
constexpr size_t WS_HS = WS_XN;
constexpr size_t WS_ACAT = WS_QA;
constexpr size_t WS_QP = WS_VA;
constexpr size_t WS_ROUTE = WS_MO;
constexpr size_t WS_PB = 245 * MiB;
constexpr size_t WS_PP = WS_QA;
constexpr size_t WS_G2 = WS_VA;
constexpr size_t WS_EU8 = 20 * MiB, WS_EV8 = 36 * MiB;
constexpr size_t WS_SI = 19 * MiB;
constexpr size_t WS_RS = 253 * MiB;
constexpr size_t WS_X1G = 164 * MiB;
constexpr size_t WS_XN3 = 196 * MiB;
constexpr size_t WS_ST = 228 * MiB;
constexpr size_t WS_END = 256 * MiB;
constexpr int CW_BAR = 4096;
constexpr int CW_NORM = 1024, CW_QUEUE = 128;

__device__ __forceinline__ float bf2f(unsigned v) { return __uint_as_float(v << 16); }
__device__ __forceinline__ unsigned f2bf(float f) { unsigned u = __float_as_uint(f); return (u + 0x7fffu + ((u >> 16) & 1u)) >> 16; }
__device__ __forceinline__ unsigned pk2(float lo, float hi) { return f2bf(lo) | (f2bf(hi) << 16); }
__device__ __forceinline__ float wave_sum(float v) {
#pragma unroll
    for (int o = 1; o < 64; o <<= 1) v += __shfl_xor(v, o);
    return v;
}
__device__ __forceinline__ float sigmoidf_(float x) { return 1.f / (1.f + __expf(-x)); }
__device__ __forceinline__ unsigned f2sortu(float f) { const unsigned u = __float_as_uint(f); return (u & 0x80000000u) ? ~u : (u | 0x80000000u); }
__device__ __forceinline__ float sortu2f(unsigned s) { return __uint_as_float((s & 0x80000000u) ? (s & 0x7fffffffu) : ~s); }
__device__ __forceinline__ int tidx() { int t = threadIdx.x; asm volatile("" : "+v"(t)); return t; }

#define XB_TMO      128
#define XB_XCNT(j)  (256  + 64 * (j))
#define XB_XSUB(j)  (1280 + 64 * (j))
#define XB_XGEN(j)  (2304 + 64 * (j))
#define XB_TOP      3328
#define XB_TOPGEN   3392
#define XCD_BAR_WORDS 3456
#define XB_SPIN_CAP (1u << 25)
__device__ __forceinline__ unsigned xb_ld(unsigned* p)              { return __hip_atomic_load(p, __ATOMIC_RELAXED, __HIP_MEMORY_SCOPE_AGENT); }
__device__ __forceinline__ unsigned xb_add(unsigned* p, unsigned v) { return __hip_atomic_fetch_add(p, v, __ATOMIC_RELAXED, __HIP_MEMORY_SCOPE_AGENT); }
__device__ __forceinline__ unsigned xb_xcc_id() { return (unsigned)__builtin_amdgcn_s_getreg((3 << 11) | 20) & 0xFu; }
#define XB_SPIN(cond, bar) do { unsigned _sp = 0; while (cond) { __builtin_amdgcn_s_sleep(1); \
    if ((++_sp & 255u) == 0u) { if (xb_ld(&(bar)[XB_TMO])) break; if (_sp > XB_SPIN_CAP) { atomicAdd(&(bar)[XB_TMO], 1u); break; } } } } while (0)
struct XcdBarrier { unsigned* bar; unsigned x; volatile LAS unsigned* st; };
__device__ __forceinline__ XcdBarrier xcd_barrier_post(unsigned* bar, volatile LAS unsigned* st) {
    XcdBarrier b; b.bar = bar; b.x = xb_xcc_id(); b.st = st;
    if (tidx() == 0) (void)xb_add(&bar[XB_XCNT(b.x)], 1u);
    return b;
}
__device__ __forceinline__ void xcd_barrier_complete(unsigned* bar, unsigned x, unsigned& nloc, unsigned& nx) {
    const unsigned G = gridDim.x * gridDim.y * gridDim.z;
    unsigned sum, cnt, mine, sp = 0u;
    for (;;) {
        sum = 0u; cnt = 0u; mine = 0u;
#pragma unroll
        for (unsigned j = 0; j < 16; ++j) { const unsigned c = xb_ld(&bar[XB_XCNT(j)]); sum += c; cnt += (c > 0u) ? 1u : 0u; mine = (j == x) ? c : mine; }
        if (sum == G) break;
        __builtin_amdgcn_s_sleep(1);
        if ((++sp & 255u) == 0u) { if (xb_ld(&bar[XB_TMO])) break; if (sp > XB_SPIN_CAP) { atomicAdd(&bar[XB_TMO], 1u); break; } }
    }
    nloc = mine > 0u ? mine : 1u; nx = cnt > 0u ? cnt : 1u;
}
__device__ __forceinline__ void xcd_barrier(const XcdBarrier& b) {
    asm volatile("s_waitcnt vmcnt(0)" ::: "memory");
    __syncthreads();
    if (tidx() == 0) {
        unsigned* bar = b.bar;
        __builtin_amdgcn_s_waitcnt(0);
        unsigned nloc = b.st[0], nx = b.st[1];
        if (nloc == 0u) { xcd_barrier_complete(bar, b.x, nloc, nx); b.st[0] = nloc; b.st[1] = nx; }
        const unsigned old = xb_add(&bar[XB_XSUB(b.x)], 1u);
        const unsigned gen = old / nloc;
        if (old + 1u == (gen + 1u) * nloc) {
            __builtin_amdgcn_fence(__ATOMIC_RELEASE, "agent");
            asm volatile("s_waitcnt vmcnt(0)" ::: "memory");
            const unsigned og = xb_add(&bar[XB_TOP], 1u);
            const unsigned tg = og / nx;
            if (og + 1u == (tg + 1u) * nx) xb_add(&bar[XB_TOPGEN], 1u);
            else XB_SPIN(xb_ld(&bar[XB_TOPGEN]) == tg, bar);
            __builtin_amdgcn_fence(__ATOMIC_ACQUIRE, "agent");
            xb_add(&bar[XB_XGEN(b.x)], 1u);
            asm volatile("s_waitcnt vmcnt(0)" ::: "memory");
        } else {
            XB_SPIN(xb_ld(&bar[XB_XGEN(b.x)]) == gen, bar);
            __builtin_amdgcn_fence(__ATOMIC_ACQUIRE, "agent");
            asm volatile("s_waitcnt vmcnt(0)" ::: "memory");
        }
    }
    __syncthreads();
}

namespace pg8 {
#define PG8_LAS __attribute__((address_space(3)))
typedef unsigned short bf16_t;
typedef short bf16x8 __attribute__((ext_vector_type(8)));
typedef float f32x4 __attribute__((ext_vector_type(4)));
typedef unsigned u32x4 __attribute__((ext_vector_type(4)));
constexpr int BM = 256, BK = 64, HALF = 128, HTB = HALF * BK * 2  , STAGE_BYTES = 8 * HTB, NXCD = 8, WGM = 8;

__host__ __device__ __forceinline__ int lds_byte(int r, int c) { const int st = (r >> 4) * 2 + (c >> 5), rr = r & 15, cc = c & 31, ob = rr * 64 + cc * 2; return st * 1024 + (ob ^ (((ob >> 9) & 1) << 5)); }
__host__ __device__ __forceinline__ void stage_rc(int b, int& R, int& C) { const int st = b / 1024, sb = b % 1024, swz = sb ^ (((sb >> 9) & 1) << 5); R = (st >> 1) * 16 + swz / 64; C = (st & 1) * 32 + (swz % 64) / 2; }
__host__ __device__ __forceinline__ int perm32(int rho) { const int n = rho >> 4, i = rho & 15; return 8 * (i >> 2) + 4 * n + (i & 3); }

struct Unit { int pm, pn; };
struct Gemm { const bf16_t* A; const bf16_t* Bt; int M, N, K; };

struct StaticOrder {
    int nM, nN, nwg, G, c;
    __host__ __device__ void init(int M, int N, int G_, int c_) { nM = M / BM; nN = N / BM; nwg = nM * nN; G = G_; c = c_; }
    __host__ __device__ bool next(int i, Unit& u) const {
        const long L = (long)i * G + c; if (L >= nwg) return false;
        int wgid = (int)L; { const int q = nwg / NXCD, r = nwg % NXCD, xcd = wgid % NXCD, off = wgid / NXCD; wgid = (xcd < r ? xcd * (q + 1) : r * (q + 1) + (xcd - r) * q) + off; }
        const int nig = WGM * nN, gid = wgid / nig, fm = gid * WGM, gsz = (nM - fm) < WGM ? (nM - fm) : WGM;
        u.pm = fm + ((wgid % nig) % gsz); u.pn = (wgid % nig) / gsz; return true;
    }
    __device__ __forceinline__ void a_ready(const Unit&) const {}
    __device__ __forceinline__ void done(const Unit&) const {}
};

__device__ __forceinline__ unsigned cvt_pk_bf16(float lo, float hi) { unsigned r; asm volatile("v_cvt_pk_bf16_f32 %0, %1, %2" : "=v"(r) : "v"(lo), "v"(hi)); return r; }
typedef float f32x2 __attribute__((ext_vector_type(2)));
__device__ __forceinline__ f32x2 gelu_pk(f32x2 v) {
    const f32x2 av = __builtin_elementwise_abs(v), d = av * 0.2316418882f + 1.0f;
    f32x2 t; t.x = __builtin_amdgcn_rcpf(d.x); t.y = __builtin_amdgcn_rcpf(d.y);
    f32x2 q = t * 0.5307027145f + (-0.7265760135f); q = q * t + 0.7107068705f; q = q * t + (-0.142248368f); q = q * t + 0.127414796f; q = q * t;
    const f32x2 s = (v * v) * (-0.72134752044f);
    f32x2 e; e.x = __builtin_amdgcn_exp2f(s.x); e.y = __builtin_amdgcn_exp2f(s.y);
    const f32x2 m = v * (q * e), r = v - m;
    f32x2 o; o.x = v.x < 0.f ? m.x : r.x; o.y = v.y < 0.f ? m.y : r.y; return o;
}

template <int ACT  > struct EpiBf16 {
    static constexpr bool PERM = true, AFTER_DRAIN = false; static_assert(ACT == 0 || ACT == 1, "EpiBf16: ACT is 0 (none) or 1 (gelu_pk)");
    bf16_t* O; int ldc; const float* bias; int split_cols; size_t split_stride; float scale0;
    __device__ __forceinline__ void operator()(const f32x4 (&acc)[2][2][4][2], const Unit& u, int wr, int wc, int fr, int fq) const {
        const int row0 = u.pm * BM + wr * 64 + fr; int colt = u.pn * BM; bf16_t* base = O;
        float sc = 1.f; if (split_cols) { const int t = colt / split_cols; base += (size_t)t * split_stride; colt -= t * split_cols; if (t == 0) sc = scale0; }
        const int col0 = colt + wc * 32 + 8 * fq, bcol0 = u.pn * BM + wc * 32 + 8 * fq;
        f32x4 bv[2][2];
#pragma unroll
        for (int bj = 0; bj < 2; ++bj)
#pragma unroll
            for (int n = 0; n < 2; ++n) bv[bj][n] = bias ? *(const f32x4*)(bias + bcol0 + bj * HALF + 4 * n) : (f32x4){0.f, 0.f, 0.f, 0.f};
#pragma unroll
        for (int ai = 0; ai < 2; ++ai)
#pragma unroll
            for (int m = 0; m < 4; ++m) { bf16_t* rowp = base + (size_t)(row0 + ai * HALF + m * 16) * ldc + col0;
#pragma unroll
                for (int bj = 0; bj < 2; ++bj) { f32x4 v0 = acc[ai][bj][m][0] + bv[bj][0], v1 = acc[ai][bj][m][1] + bv[bj][1];
                    if (ACT == 1) { f32x2 a = gelu_pk((f32x2){v0[0], v0[1]}), b = gelu_pk((f32x2){v0[2], v0[3]}), c = gelu_pk((f32x2){v1[0], v1[1]}), d = gelu_pk((f32x2){v1[2], v1[3]});
                        v0 = (f32x4){a.x, a.y, b.x, b.y}; v1 = (f32x4){c.x, c.y, d.x, d.y}; }
                    v0 = v0 * sc; v1 = v1 * sc; u32x4 w; w.x = cvt_pk_bf16(v0[0], v0[1]); w.y = cvt_pk_bf16(v0[2], v0[3]); w.z = cvt_pk_bf16(v1[0], v1[1]); w.w = cvt_pk_bf16(v1[2], v1[3]);
                    *(u32x4*)(rowp + bj * HALF) = w; } }
    }
};

struct EpiProj {
    static constexpr bool PERM = true, AFTER_DRAIN = false;
    bf16_t* O; size_t split_stride; float scale0; float* gates;
    __device__ __forceinline__ void operator()(const f32x4 (&acc)[2][2][4][2], const Unit& u, int wr, int wc, int fr, int fq) const {
        const int row0 = u.pm * BM + wr * 64 + fr;
        if (u.pn == 14) {
            if (wc == 0 && fq == 0) {
#pragma unroll
                for (int ai = 0; ai < 2; ++ai)
#pragma unroll
                    for (int m = 0; m < 4; ++m) { float* g = gates + (size_t)(row0 + ai * HALF + m * 16) * 8; *(f32x4*)g = acc[ai][0][m][0]; *(f32x4*)(g + 4) = acc[ai][0][m][1]; }
            }
            return;
        }
        int colt = u.pn * BM; const int t = colt / 512; bf16_t* base = O + (size_t)t * split_stride; colt -= t * 512; const float sc = (t == 0) ? scale0 : 1.f;
        const int col0 = colt + wc * 32 + 8 * fq;
#pragma unroll
        for (int ai = 0; ai < 2; ++ai)
#pragma unroll
            for (int m = 0; m < 4; ++m) { bf16_t* rowp = base + (size_t)(row0 + ai * HALF + m * 16) * 512 + col0;
#pragma unroll
                for (int bj = 0; bj < 2; ++bj) { const f32x4 v0 = acc[ai][bj][m][0] * sc, v1 = acc[ai][bj][m][1] * sc;
                    u32x4 w; w.x = cvt_pk_bf16(v0[0], v0[1]); w.y = cvt_pk_bf16(v0[2], v0[3]); w.z = cvt_pk_bf16(v1[0], v1[1]); w.w = cvt_pk_bf16(v1[2], v1[3]);
                    *(u32x4*)(rowp + bj * HALF) = w; } }
    }
};
struct EpiResF32 {
    static constexpr bool PERM = false, AFTER_DRAIN = false;
    const float* base; float* out; int ldc;
    __device__ __forceinline__ void operator()(const f32x4 (&acc)[2][2][4][2], const Unit& u, int wr, int wc, int fr, int fq) const {
        const int row0 = u.pm * BM + wr * 64 + fr, col0 = u.pn * BM + wc * 32 + 4 * fq;
#pragma unroll
        for (int ai = 0; ai < 2; ++ai)
#pragma unroll
            for (int m = 0; m < 4; ++m) { const size_t off = (size_t)(row0 + ai * HALF + m * 16) * ldc + col0;
#pragma unroll
                for (int bj = 0; bj < 2; ++bj)
#pragma unroll
                    for (int n = 0; n < 2; ++n) { const size_t o = off + bj * HALF + n * 16; *(f32x4*)(out + o) = *(const f32x4*)(base + o) + acc[ai][bj][m][n]; } }
    }
};
struct EpiResX1 {
    static constexpr bool PERM = false, AFTER_DRAIN = false;
    const float* base; float* out; bf16_t* xg; float* rs; int ldc;
    __device__ __forceinline__ void operator()(const f32x4 (&acc)[2][2][4][2], const Unit& u, int wr, int wc, int fr, int fq) const {
        const int row0 = u.pm * BM + wr * 64 + fr, col0 = u.pn * BM + wc * 32 + 4 * fq;
#pragma unroll
        for (int ai = 0; ai < 2; ++ai)
#pragma unroll
            for (int m = 0; m < 4; ++m) { const int row = row0 + ai * HALF + m * 16; const size_t off = (size_t)row * ldc + col0; float ss = 0.f;
#pragma unroll
                for (int bj = 0; bj < 2; ++bj)
#pragma unroll
                    for (int n = 0; n < 2; ++n) { const size_t o = off + bj * HALF + n * 16; const f32x4 v = *(const f32x4*)(base + o) + acc[ai][bj][m][n]; *(f32x4*)(out + o) = v;
                        ss += (v[0] * v[0] + v[1] * v[1]) + (v[2] * v[2] + v[3] * v[3]);
                        typedef unsigned u32x2 __attribute__((ext_vector_type(2))); u32x2 pk; pk.x = cvt_pk_bf16(v[0], v[1]); pk.y = cvt_pk_bf16(v[2], v[3]); *(u32x2*)(xg + o) = pk; }
                ss += __shfl_xor(ss, 16); ss += __shfl_xor(ss, 32);
                if (fq == 0) rs[(size_t)row * 16 + u.pn * 4 + wc] = ss; }
    }
};
struct EpiSigBf16 {
    static constexpr bool PERM = true, AFTER_DRAIN = false;
    bf16_t* O; int ldc;
    __device__ __forceinline__ void operator()(const f32x4 (&acc)[2][2][4][2], const Unit& u, int wr, int wc, int fr, int fq) const {
        const int row0 = u.pm * BM + wr * 64 + fr, col0 = u.pn * BM + wc * 32 + 8 * fq;
#pragma unroll
        for (int ai = 0; ai < 2; ++ai)
#pragma unroll
            for (int m = 0; m < 4; ++m) { bf16_t* rowp = O + (size_t)(row0 + ai * HALF + m * 16) * ldc + col0;
#pragma unroll
                for (int bj = 0; bj < 2; ++bj) { f32x4 v0 = acc[ai][bj][m][0], v1 = acc[ai][bj][m][1];
#pragma unroll
                    for (int i = 0; i < 4; ++i) { v0[i] = 1.f / (1.f + __expf(-v0[i])); v1[i] = 1.f / (1.f + __expf(-v1[i])); }
                    u32x4 w; w.x = cvt_pk_bf16(v0[0], v0[1]); w.y = cvt_pk_bf16(v0[2], v0[3]); w.z = cvt_pk_bf16(v1[0], v1[1]); w.w = cvt_pk_bf16(v1[2], v1[3]);
                    *(u32x4*)(rowp + bj * HALF) = w; } }
    }
};
struct EpiGateFinal {
    static constexpr bool PERM = false, AFTER_DRAIN = false;
    const bf16_t* P; float* out; int ldc;
    __device__ __forceinline__ void operator()(const f32x4 (&acc)[2][2][4][2], const Unit& u, int wr, int wc, int fr, int fq) const {
        const int row0 = u.pm * BM + wr * 64 + fr, col0 = u.pn * BM + wc * 32 + 4 * fq;
#pragma unroll
        for (int ai = 0; ai < 2; ++ai)
#pragma unroll
            for (int m = 0; m < 4; ++m) { const size_t off = (size_t)(row0 + ai * HALF + m * 16) * ldc + col0;
#pragma unroll
                for (int bj = 0; bj < 2; ++bj)
#pragma unroll
                    for (int n = 0; n < 2; ++n) { const size_t o = off + bj * HALF + n * 16;
                        typedef unsigned u32x2 __attribute__((ext_vector_type(2))); const u32x2 g = *(const u32x2*)(P + o);
                        f32x4 pv; pv[0] = __uint_as_float(g.x << 16); pv[1] = __uint_as_float(g.x & 0xffff0000u); pv[2] = __uint_as_float(g.y << 16); pv[3] = __uint_as_float(g.y & 0xffff0000u);
                        f32x4 sg = acc[ai][bj][m][n];
#pragma unroll
                        for (int i = 0; i < 4; ++i) sg[i] = 1.f / (1.f + __expf(-sg[i]));
                        *(f32x4*)(out + o) = *(const f32x4*)(out + o) + sg * pv; } }
    }
};
struct EpiGateAcc {
    static constexpr bool PERM = false, AFTER_DRAIN = false;
    const bf16_t* G; float* out; int ldc;
    __device__ __forceinline__ void operator()(const f32x4 (&acc)[2][2][4][2], const Unit& u, int wr, int wc, int fr, int fq) const {
        const int row0 = u.pm * BM + wr * 64 + fr, col0 = u.pn * BM + wc * 32 + 4 * fq;
#pragma unroll
        for (int ai = 0; ai < 2; ++ai)
#pragma unroll
            for (int m = 0; m < 4; ++m) { const size_t off = (size_t)(row0 + ai * HALF + m * 16) * ldc + col0;
#pragma unroll
                for (int bj = 0; bj < 2; ++bj)
#pragma unroll
                    for (int n = 0; n < 2; ++n) { const size_t o = off + bj * HALF + n * 16;
                        typedef unsigned u32x2 __attribute__((ext_vector_type(2))); const u32x2 g = *(const u32x2*)(G + o);
                        f32x4 gv; gv[0] = __uint_as_float(g.x << 16); gv[1] = __uint_as_float(g.x & 0xffff0000u); gv[2] = __uint_as_float(g.y << 16); gv[3] = __uint_as_float(g.y & 0xffff0000u);
                        *(f32x4*)(out + o) = *(const f32x4*)(out + o) + gv * acc[ai][bj][m][n]; } }
    }
};
template <class Epi, class Sched, bool ALIGN_EPI = false, bool SP2 = false>
__device__ __forceinline__ void gemm_phase(PG8_LAS unsigned char* lds, const Gemm g, const Sched& S, const Epi& E) {
    const int tid = tidx(), wid = __builtin_amdgcn_readfirstlane(tid >> 6), lane = tid & 63, wr = wid >> 2, wc = wid & 3, fr = lane & 15, fq = lane >> 4;
    const int K = g.K, nt = K / BK;
    unsigned voffA[2], voffB[2];
#pragma unroll
    for (int i = 0; i < 2; ++i) { int R, C; stage_rc(tid * 16 + i * 8192, R, C); const int Rb = Epi::PERM ? ((R & ~31) + perm32(R & 31)) : R;
        voffA[i] = (unsigned)(R * K + C) * 2u; voffB[i] = (unsigned)(Rb * K + C) * 2u; }
    const size_t kstep = (size_t)(BK * 2);
    const size_t hstep = (size_t)HALF * K * 2;
    const size_t tstep = 2 * hstep;
    const unsigned ldsw = (unsigned)wid * 1024u;
    const int aoff = lds_byte(wr * 64 + fr, fq * 8), boff = lds_byte(wc * 32 + fr, fq * 8);
#define PG8_SA(b, h) (((b) * 2 + (h)) * HTB)
#define PG8_SB(b, h) ((4 + (b) * 2 + (h)) * HTB)
#define PG8_STAGE(bufoff, gbase, voff) do { _Pragma("unroll") for (int _i = 0; _i < 2; ++_i) \
        __builtin_amdgcn_global_load_lds((const unsigned*)((const char*)(gbase) + (voff)[_i]), (PG8_LAS unsigned*)(lds + (bufoff) + ldsw + _i * 8192), 16, 0, 0); } while (0)
#define PG8_LDA(dst, b, h) do { _Pragma("unroll") for (int m = 0; m < 4; ++m) _Pragma("unroll") for (int k = 0; k < 2; ++k) dst[m][k] = *(const PG8_LAS bf16x8*)(lds + PG8_SA(b, h) + aoff + m * 2048 + k * 1024); } while (0)
#define PG8_LDB(dst, b, h) do { _Pragma("unroll") for (int n = 0; n < 2; ++n) _Pragma("unroll") for (int k = 0; k < 2; ++k) dst[n][k] = *(const PG8_LAS bf16x8*)(lds + PG8_SB(b, h) + boff + n * 2048 + k * 1024); } while (0)
#define PG8_MMA(ai, bj, At, Bt) do { __builtin_amdgcn_s_setprio(1); _Pragma("unroll") for (int m = 0; m < 4; ++m) _Pragma("unroll") for (int n = 0; n < 2; ++n) _Pragma("unroll") for (int k = 0; k < 2; ++k) \
        acc[ai][bj][m][n] = __builtin_amdgcn_mfma_f32_16x16x32_bf16(Bt[n][k], At[m][k], acc[ai][bj][m][n], 0, 0, 0); __builtin_amdgcn_s_setprio(0); } while (0)
#define PG8_WAIT_V(n) asm volatile("s_waitcnt vmcnt(" #n ")" ::: "memory")
#define PG8_WAIT_L(n) asm volatile("s_waitcnt lgkmcnt(" #n ")" ::: "memory")
#define PG8_BAR __builtin_amdgcn_s_barrier()
#define PG8_SCHED __builtin_amdgcn_sched_barrier(0)
    Unit cur, nxt; int ui = 0;
    if (!S.next(0, cur)) return;
    f32x4 acc[2][2][4][2];
#pragma unroll
    for (int a = 0; a < 2; ++a)
#pragma unroll
        for (int b = 0; b < 2; ++b)
#pragma unroll
            for (int m = 0; m < 4; ++m)
#pragma unroll
                for (int n = 0; n < 2; ++n) acc[a][b][m][n] = (f32x4){0.f, 0.f, 0.f, 0.f};
    bf16x8 At[4][2], B0[2][2], B1[2][2];
    const char* cA = (const char*)g.A + (size_t)cur.pm * tstep; const char* cB = (const char*)g.Bt + (size_t)cur.pn * tstep;
    S.a_ready(cur);
    if constexpr (SP2) {
        PG8_STAGE(PG8_SB(0, 0), cB, voffB); PG8_STAGE(PG8_SB(0, 1), cB + hstep, voffB); PG8_STAGE(PG8_SA(0, 0), cA, voffA); PG8_STAGE(PG8_SA(0, 1), cA + hstep, voffA);
        if (wr == 1) PG8_BAR;
        PG8_WAIT_V(2); PG8_BAR;
        PG8_STAGE(PG8_SB(1, 0), cB + kstep, voffB); PG8_STAGE(PG8_SA(1, 0), cA + kstep, voffA); PG8_STAGE(PG8_SB(1, 1), cB + hstep + kstep, voffB);
        PG8_WAIT_V(6); PG8_BAR;
    } else {
        PG8_STAGE(PG8_SB(0, 0), cB, voffB); PG8_STAGE(PG8_SA(0, 0), cA, voffA); PG8_STAGE(PG8_SB(0, 1), cB + hstep, voffB); PG8_STAGE(PG8_SA(0, 1), cA + hstep, voffA);
        if (wr == 1) PG8_BAR;
        PG8_WAIT_V(4); PG8_BAR;
        PG8_STAGE(PG8_SB(1, 0), cB + kstep, voffB); PG8_STAGE(PG8_SA(1, 0), cA + kstep, voffA); PG8_STAGE(PG8_SB(1, 1), cB + hstep + kstep, voffB);
        PG8_WAIT_V(6); PG8_BAR;
    }
    for (;;) {
        const bool has_next = S.next(ui + 1, nxt);
        const char* nA = has_next ? (const char*)g.A + (size_t)nxt.pm * tstep : cA; const char* nB = has_next ? (const char*)g.Bt + (size_t)nxt.pn * tstep : cB;
        for (int t = 0; t < nt; t += 2) {
            const bool last = (t == nt - 2);
            const char* a1 = cA + (size_t)(t + 1) * kstep;
            const char* a2 = last ? nA : cA + (size_t)(t + 2) * kstep; const char* b2 = last ? nB : cB + (size_t)(t + 2) * kstep;
            const char* a3 = a2 + kstep; const char* b3 = b2 + kstep;
            if (last && has_next) S.a_ready(nxt);
            if constexpr (SP2) {
            PG8_LDB(B0, 0, 0); PG8_LDB(B1, 0, 1); PG8_SCHED; PG8_LDA(At, 0, 0); PG8_STAGE(PG8_SA(1, 1), a1 + hstep, voffA);
            PG8_WAIT_V(8); PG8_WAIT_L(0); PG8_BAR; PG8_MMA(0, 0, At, B0); PG8_MMA(0, 1, At, B1); PG8_BAR; PG8_SCHED;
            PG8_LDA(At, 0, 1); PG8_STAGE(PG8_SB(0, 0), b2, voffB); PG8_STAGE(PG8_SB(0, 1), b2 + hstep, voffB); PG8_STAGE(PG8_SA(0, 0), a2, voffA);
            PG8_WAIT_V(8); PG8_WAIT_L(0); PG8_BAR; PG8_MMA(1, 0, At, B0); PG8_MMA(1, 1, At, B1); PG8_BAR; PG8_SCHED;
            PG8_LDB(B0, 1, 0); PG8_LDB(B1, 1, 1); PG8_SCHED; PG8_LDA(At, 1, 0); PG8_STAGE(PG8_SA(0, 1), a2 + hstep, voffA);
            PG8_WAIT_V(8); PG8_WAIT_L(0); PG8_BAR; PG8_MMA(0, 0, At, B0); PG8_MMA(0, 1, At, B1); PG8_BAR; PG8_SCHED;
            PG8_LDA(At, 1, 1); PG8_STAGE(PG8_SB(1, 0), b3, voffB); PG8_STAGE(PG8_SB(1, 1), b3 + hstep, voffB); PG8_STAGE(PG8_SA(1, 0), a3, voffA);
            PG8_WAIT_V(8); PG8_WAIT_L(0); PG8_BAR; PG8_MMA(1, 0, At, B0); PG8_MMA(1, 1, At, B1); PG8_BAR; PG8_SCHED;
            } else {
            PG8_LDB(B0, 0, 0); PG8_SCHED; PG8_LDA(At, 0, 0); PG8_STAGE(PG8_SA(1, 1), a1 + hstep, voffA);
            PG8_WAIT_L(8); PG8_BAR; PG8_WAIT_L(0); PG8_MMA(0, 0, At, B0); PG8_BAR; PG8_SCHED;
            PG8_LDB(B1, 0, 1); PG8_STAGE(PG8_SB(0, 0), b2, voffB);
            PG8_BAR; PG8_WAIT_L(0); PG8_MMA(0, 1, At, B1); PG8_BAR;
            PG8_LDA(At, 0, 1); PG8_STAGE(PG8_SA(0, 0), a2, voffA);
            PG8_BAR; PG8_WAIT_L(0); PG8_MMA(1, 0, At, B0); PG8_BAR; PG8_SCHED;
            PG8_STAGE(PG8_SB(0, 1), b2 + hstep, voffB);
            PG8_WAIT_V(6); PG8_BAR; PG8_MMA(1, 1, At, B1); PG8_BAR;
            PG8_LDB(B0, 1, 0); PG8_SCHED; PG8_LDA(At, 1, 0); PG8_STAGE(PG8_SA(0, 1), a2 + hstep, voffA);
            PG8_WAIT_L(8); PG8_BAR; PG8_WAIT_L(0); PG8_MMA(0, 0, At, B0); PG8_BAR; PG8_SCHED;
            PG8_LDB(B1, 1, 1); PG8_STAGE(PG8_SB(1, 0), b3, voffB);
            PG8_BAR; PG8_WAIT_L(0); PG8_MMA(0, 1, At, B1); PG8_BAR;
            PG8_LDA(At, 1, 1); PG8_STAGE(PG8_SA(1, 0), a3, voffA);
            PG8_BAR; PG8_WAIT_L(0); PG8_MMA(1, 0, At, B0); PG8_BAR; PG8_SCHED;
            PG8_STAGE(PG8_SB(1, 1), b3 + hstep, voffB);
            PG8_WAIT_V(6); PG8_BAR; PG8_MMA(1, 1, At, B1); PG8_BAR;
            }
        }
        if constexpr (ALIGN_EPI) { if (wr == 0) PG8_BAR; }
        if constexpr (!Epi::AFTER_DRAIN) { E(acc, cur, wr, wc, fr, fq); S.done(cur); }
        if (!has_next) break;
#pragma unroll
        for (int a = 0; a < 2; ++a)
#pragma unroll
            for (int b = 0; b < 2; ++b)
#pragma unroll
                for (int m = 0; m < 4; ++m)
#pragma unroll
                    for (int n = 0; n < 2; ++n) acc[a][b][m][n] = (f32x4){0.f, 0.f, 0.f, 0.f};
        cur = nxt; cA = nA; cB = nB; ++ui;
        if constexpr (ALIGN_EPI) { if (wr == 1) PG8_BAR; }
    }
    PG8_WAIT_V(0);
    if constexpr (!ALIGN_EPI) { if (wr == 0) PG8_BAR; }
    PG8_BAR;
    if constexpr (Epi::AFTER_DRAIN) { E.fused(acc, cur, wr, wc, fr, fq, lds, wid, lane); S.done(cur); }
#undef PG8_SA
#undef PG8_SB
#undef PG8_STAGE
#undef PG8_LDA
#undef PG8_LDB
#undef PG8_MMA
#undef PG8_WAIT_V
#undef PG8_WAIT_L
#undef PG8_BAR
#undef PG8_SCHED
}
}

#include <hip/hip_bf16.h>
#include <cmath>
namespace attn_body {
using bf16=__hip_bfloat16;
using bf16x8=__attribute__((ext_vector_type(8)))short;
using s16x4=__attribute__((ext_vector_type(4)))short;
using f32x16=__attribute__((ext_vector_type(16)))float;
using u32x4=__attribute__((ext_vector_type(4)))unsigned;
constexpr int SEQ=16384,D=64,DM=512;
constexpr int NW=8,QBLK=32,QB=QBLK*NW,KVBLK=64,NQB=SEQ/QB;
constexpr int ATTN_PITCH=DM, ATTN_UNIT_ROWS=QB;
__device__ __forceinline__ int crow(int r,int hi){return (r&3)+8*(r>>2)+4*hi;}
#define SBAR() __builtin_amdgcn_sched_barrier(0)
__device__ __forceinline__ void cmask(f32x16&p0,f32x16&p1,int jb,int qrel,int hi){
  const float NEG=-INFINITY; int kb=64*jb+4*hi;
  #pragma unroll
  for(int r=0;r<16;++r){int kv=kb+(r&3)+8*(r>>2); if(kv>qrel)p0[r]=NEG; if(kv+32>qrel)p1[r]=NEG;}
}

constexpr int NSLOT=3, SLOTB=8192;
constexpr int LDS_K=0, LDS_V=NSLOT*SLOTB, LDS_WS=2*NSLOT*SLOTB, LDS_OST=LDS_WS+NW*64*4, LDS_BYTES=LDS_OST+NW*4096;
constexpr float C2=0.125f*1.4426950408889634f;
__device__ __forceinline__ void glds16(const void*gsrc,unsigned lds_dst){unsigned keep;
  asm volatile("s_mov_b32 %0, m0\n\ts_mov_b32 m0, %2\n\ts_nop 0\n\tglobal_load_lds_dwordx4 %1, off\n\ts_mov_b32 m0, %0":"=&s"(keep):"v"(gsrc),"s"(lds_dst):"memory");}
__device__ __forceinline__ float max3f(float a,float b,float c){float r;asm("v_max3_f32 %0, %1, %2, %3":"=v"(r):"v"(a),"v"(b),"v"(c));return r;}
__device__ __forceinline__ float max2f(float a,float b){float r;asm("v_max_f32_e32 %0, %1, %2":"=v"(r):"v"(a),"v"(b));return r;}
__device__ __forceinline__ float fadd_s(float a,float b){float r;asm("v_add_f32_e32 %0, %1, %2":"=v"(r):"v"(a),"v"(b));return r;}
__device__ __forceinline__ float fsub_s(float a,float b){float r;asm("v_sub_f32_e32 %0, %1, %2":"=v"(r):"v"(a),"v"(b));return r;}
typedef float f32x2_t __attribute__((ext_vector_type(2))); typedef __bf16 bf16x2_t __attribute__((ext_vector_type(2)));
__device__ __forceinline__ unsigned cvtpk_s(float lo,float hi){f32x2_t v={lo,hi};bf16x2_t b=__builtin_convertvector(v,bf16x2_t);return __builtin_bit_cast(unsigned,b);}
#define WAIT_BAR(N) asm volatile("s_waitcnt vmcnt(" #N ") lgkmcnt(0)\n\ts_barrier":::"memory")

__device__ __forceinline__ void qkt(f32x16&p0,f32x16&p1,const char*Kslot,const bf16x8*qr,int r32,int hi){
  const char*kb=Kslot+hi*1024+r32*16;
  #pragma unroll
  for(int d0=0;d0<4;++d0){
    const bf16x8 b0=*reinterpret_cast<const bf16x8*>(kb+d0*2048);
    const bf16x8 b1=*reinterpret_cast<const bf16x8*>(kb+d0*2048+512);
    p0=__builtin_amdgcn_mfma_f32_32x32x16_bf16(b0,qr[d0],p0,0,0,0);p1=__builtin_amdgcn_mfma_f32_32x32x16_bf16(b1,qr[d0],p1,0,0,0);}
}
typedef __attribute__((address_space(3))) const char* lds_cptr;
typedef short v4i16_t __attribute__((ext_vector_type(4)));
__device__ __forceinline__ void kload8(bf16x8*kf,lds_cptr kp){
  kf[0]=*(const __attribute__((address_space(3))) bf16x8*)(kp);      kf[1]=*(const __attribute__((address_space(3))) bf16x8*)(kp+512);
  kf[2]=*(const __attribute__((address_space(3))) bf16x8*)(kp+2048); kf[3]=*(const __attribute__((address_space(3))) bf16x8*)(kp+2560);
  kf[4]=*(const __attribute__((address_space(3))) bf16x8*)(kp+4096); kf[5]=*(const __attribute__((address_space(3))) bf16x8*)(kp+4608);
  kf[6]=*(const __attribute__((address_space(3))) bf16x8*)(kp+6144); kf[7]=*(const __attribute__((address_space(3))) bf16x8*)(kp+6656);
}
__device__ __forceinline__ void kload2(bf16x8*kf,lds_cptr kp,int j){ kf[2*j]=*(const __attribute__((address_space(3))) bf16x8*)(kp+j*2048); kf[2*j+1]=*(const __attribute__((address_space(3))) bf16x8*)(kp+j*2048+512); }
__device__ __forceinline__ s16x4 vtr(lds_cptr p){ return __builtin_bit_cast(s16x4,__builtin_amdgcn_ds_read_tr16_b64_v4i16((__attribute__((address_space(3))) v4i16_t*)p)); }
__device__ __forceinline__ float rowmax(const f32x16&p0,const f32x16&p1){
  float a=max3f(p0[0],p0[1],p1[0]),b=max3f(p0[2],p0[3],p1[1]);a=max3f(a,p1[2],p1[3]);
  #pragma unroll
  for(int r=4;r<16;r+=4){a=max3f(a,p0[r],p0[r+1]);b=max3f(b,p0[r+2],p0[r+3]);a=max3f(a,p1[r],p1[r+1]);b=max3f(b,p1[r+2],p1[r+3]);}
  const float m=max2f(a,b);
  auto rr=__builtin_amdgcn_permlane32_swap(__float_as_uint(m),__float_as_uint(m),false,false);
  return max2f(__uint_as_float(rr[0]),__uint_as_float(rr[1]));
}
__device__ __forceinline__ void pv(f32x16*o,int vb,bf16x8 pa0,bf16x8 pa1,bf16x8 pa2,bf16x8 pa3){
  #pragma unroll
  for(int d0=0;d0<2;++d0){s16x4 lo[4],hi[4];
    #pragma unroll
    for(int ks=0;ks<4;++ks){
      asm volatile("ds_read_b64_tr_b16 %0,%1 offset:%c2":"=&v"(lo[ks]):"v"(vb),"i"(d0*4096+ks*1024):"memory");
      asm volatile("ds_read_b64_tr_b16 %0,%1 offset:%c2":"=&v"(hi[ks]):"v"(vb),"i"(d0*4096+ks*1024+512):"memory");}
    asm volatile("s_waitcnt lgkmcnt(0)":::"memory");SBAR();
    #define PK(k) (bf16x8){lo[k][0],lo[k][1],lo[k][2],lo[k][3],hi[k][0],hi[k][1],hi[k][2],hi[k][3]}
    o[d0]=__builtin_amdgcn_mfma_f32_32x32x16_bf16(pa0,PK(0),o[d0],0,0,0);
    o[d0]=__builtin_amdgcn_mfma_f32_32x32x16_bf16(pa1,PK(1),o[d0],0,0,0);
    o[d0]=__builtin_amdgcn_mfma_f32_32x32x16_bf16(pa2,PK(2),o[d0],0,0,0);
    o[d0]=__builtin_amdgcn_mfma_f32_32x32x16_bf16(pa3,PK(3),o[d0],0,0,0);
    #undef PK
  }
}

#ifndef ATTN_STORE16
#define ATTN_STORE16(p,v) (*(u32x4*)(p)=(v))
#endif
template<int THRL> __device__ __forceinline__ void attn_unit(int qb,int t0,float slope2,const bf16*Q,const bf16*__restrict__ K,const bf16*__restrict__ V,bf16*O,char*shm){
  int tid_=tidx(); asm volatile("":"+v"(tid_));
  const int tid=tid_,lane=tid&63,r32=lane&31,hi=lane>>5; const int wid=__builtin_amdgcn_readfirstlane(tid>>6);
  const int q0=qb*QB;
  const bf16*Qw=Q+(long)(q0+wid*QBLK)*DM;
  const bf16*Kh=K+(long)t0*KVBLK*DM,*Vh=V+(long)t0*KVBLK*DM;
  const unsigned lds0=(unsigned)(uintptr_t)shm;
  float*wsf=(float*)(shm+LDS_WS)+wid*64;
  const bf16*ksrc=Kh+(long)lane*DM+wid*8;
  const bf16*vsrc=Vh+(long)(16*(wid&3)+(lane>>2))*DM+(wid>>2)*32+(lane&3)*8;
  const unsigned kdst=lds0+LDS_K+wid*1024, vdst=lds0+LDS_V+wid*1024;
  #define DMA_K(t,slot) glds16(ksrc+(long)(t)*KVBLK*DM,(unsigned)__builtin_amdgcn_readfirstlane(kdst+(slot)))
  #define DMA_V(t,slot) glds16(vsrc+(long)(t)*KVBLK*DM,(unsigned)__builtin_amdgcn_readfirstlane(vdst+(slot)))
  const int vb0=(int)(lds0+LDS_V)+((lane>>4)&1)*32+(lane&3)*8+(4*hi+((lane&15)>>2))*64;
  const char*Kbase=shm+LDS_K; bf16x8 kf[8];
  const lds_cptr shm3=(lds_cptr)shm; const lds_cptr kp0=shm3+LDS_K+hi*1024+r32*16; const lds_cptr vp0=shm3+LDS_V+((lane>>4)&1)*32+(lane&3)*8+(4*hi+((lane&15)>>2))*64;
  const int NT=(q0+QB)/KVBLK-t0;
  DMA_K(0,0);DMA_V(0,0);DMA_K(1,SLOTB);
  bf16x8 qr[4];
  #pragma unroll
  for(int d0=0;d0<4;++d0)qr[d0]=*reinterpret_cast<const bf16x8*>(&Qw[(long)r32*DM+d0*16+hi*8]);
  float mhat=0.f,l_reg=0.f;f32x16 o[2];o[0]=f32x16{};o[1]=f32x16{};
  #define CINIT(C0_,C1_,t_) do{ float s2_=slope2; asm volatile("":"+v"(s2_));   \
      const float bt_=fmaf(s2_,(float)(64*(t_)+4*hi),-mhat); const float bu_=fmaf(s2_,32.f,bt_); \
      _Pragma("unroll") for(int r=0;r<16;++r){ C0_[r]=fmaf(s2_,(float)((r&3)+8*(r>>2)),bt_); C1_[r]=fmaf(s2_,(float)((r&3)+8*(r>>2)),bu_); } }while(0)
  const int qrel=wid*QBLK+r32;
  #define CMASK(P0,P1,t) do{int jb_=(t)-(NT-4); if(jb_>=0)cmask(P0,P1,jb_,qrel,hi);}while(0)
  bool resc=false;
  #define START(P0,P1) do{ const float rm=rowmax(P0,P1); resc=false; \
    { const float dl=rm; mhat=fadd_s(mhat,dl); \
      _Pragma("unroll") for(int r=0;r<16;++r){P0[r]=fsub_s(P0[r],dl);P1[r]=fsub_s(P1[r],dl);} } \
    _Pragma("unroll") for(int r=0;r<16;++r)P0[r]=__builtin_amdgcn_exp2f(P0[r]); }while(0)
  #define RESC() do{ if(resc){ asm volatile("s_waitcnt lgkmcnt(0)":::"memory"); \
      _Pragma("unroll") for(int d_=0;d_<2;++d_) _Pragma("unroll") for(int r=0;r<16;++r)o[d_][r]*=wsf[crow(r,hi)]; } }while(0)
  f32x16 pA0,pA1,pB0,pB1;
  int sl_prev=0,sl_cur=0,sl_next=SLOTB;
  #define ROT() do{sl_prev=sl_cur;sl_cur=sl_next;sl_next=(sl_next==(NSLOT-1)*SLOTB)?0:sl_next+SLOTB;}while(0)
  DMA_K(2,2*SLOTB);
  WAIT_BAR(3);
  CINIT(pA0,pA1,0); qkt(pA0,pA1,Kbase,qr,r32,hi);asm volatile("s_nop 15\n\ts_nop 7":"+v"(pA0),"+v"(pA1));CMASK(pA0,pA1,0);
  START(pA0,pA1);
  _Pragma("unroll") for(int r=0;r<16;++r)pA1[r]=__builtin_amdgcn_exp2f(pA1[r]);
  WAIT_BAR(0);
  DMA_K(3,0);DMA_V(1,SLOTB);
  ROT();
  kload8(kf,kp0+sl_cur);
  WAIT_BAR(2);
  s16x4 vlo[8],vhi[8]; u32x4 pw0,pw1,pw2,pw3;
  #define PKW(P,B) cvtpk_s(P[B],P[B+1])
  #define PAF(k) __builtin_bit_cast(bf16x8,pw##k)
  #define VFR(i) (bf16x8){vlo[i][0],vlo[i][1],vlo[i][2],vlo[i][3],vhi[i][0],vhi[i][1],vhi[i][2],vhi[i][3]}
  #define PIN(x) asm volatile("":"+v"(x))
  #define MX3(a,b,c) __builtin_fmaxf(__builtin_fmaxf((a),(b)),(c))
  #define GAPA(MF,A0,A1,A2,A3,W0,W1,PW) do{ MF; sacc+=A0; sacc+=A1; sacc+=A2; sacc+=A3; PIN(sacc); W0; W1; PIN(PW); SBAR(); }while(0)
  #define EX(v) __builtin_amdgcn_exp2f(v)
  #define GAPB(MF,X,B) do{ MF; X[B]=EX(X[B]); X[B+1]=EX(X[B+1]); X[B+2]=EX(X[B+2]); X[B+3]=EX(X[B+3]); PIN(X); SBAR(); }while(0)
  #define VRD(i) do{ vlo[i]=vtr(vp_+(((i)>>2)*4096+((i)&3)*1024)); vhi[i]=vtr(vp_+(((i)>>2)*4096+((i)&3)*1024+512)); }while(0)
  #define KRD(G,j) do{ if(G){ kload2(kf,kp0+sl_next,j); SBAR(); } }while(0)
  #define STEP(C0,C1,P0,P1,t,GK,GV,GL) do{ SBAR(); \
    CINIT(C0,C1,t); PIN(C0); PIN(C1); SBAR(); \
    const lds_cptr vp_=vp0+sl_prev; \
    VRD(0); SBAR(); float sacc=(P0[0]+P0[1]); \
    GAPA(C0=__builtin_amdgcn_mfma_f32_32x32x16_bf16(kf[0],qr[0],C0,0,0,0), P0[2],P0[3],P0[4],P0[5],     pw0[0]=PKW(P0,0), pw0[1]=PKW(P0,2), pw0); \
    VRD(4); SBAR(); GAPA(C1=__builtin_amdgcn_mfma_f32_32x32x16_bf16(kf[1],qr[0],C1,0,0,0), P0[6],P0[7],P0[8],P0[9],     pw0[2]=PKW(P0,4), pw0[3]=PKW(P0,6), pw0); \
    VRD(1); SBAR(); GAPA(C0=__builtin_amdgcn_mfma_f32_32x32x16_bf16(kf[2],qr[1],C0,0,0,0),   P0[10],P0[11],P0[12],P0[13], pw1[0]=PKW(P0,8), pw1[1]=PKW(P0,10), pw1); \
    VRD(5); SBAR(); GAPA(C1=__builtin_amdgcn_mfma_f32_32x32x16_bf16(kf[3],qr[1],C1,0,0,0),   P0[14],P0[15],P1[0],P1[1],   pw1[2]=PKW(P0,12),pw1[3]=PKW(P0,14), pw1); \
    VRD(2); SBAR(); GAPA(C0=__builtin_amdgcn_mfma_f32_32x32x16_bf16(kf[4],qr[2],C0,0,0,0),   P1[2],P1[3],P1[4],P1[5],     pw2[0]=PKW(P1,0), pw2[1]=PKW(P1,2), pw2); \
    VRD(6); SBAR(); GAPA(C1=__builtin_amdgcn_mfma_f32_32x32x16_bf16(kf[5],qr[2],C1,0,0,0),   P1[6],P1[7],P1[8],P1[9],     pw2[2]=PKW(P1,4), pw2[3]=PKW(P1,6), pw2); \
    VRD(3); SBAR(); GAPA(C0=__builtin_amdgcn_mfma_f32_32x32x16_bf16(kf[6],qr[3],C0,0,0,0),   P1[10],P1[11],P1[12],P1[13], pw3[0]=PKW(P1,8), pw3[1]=PKW(P1,10), pw3); \
    VRD(7); SBAR(); GAPA(C1=__builtin_amdgcn_mfma_f32_32x32x16_bf16(kf[7],qr[3],C1,0,0,0),   P1[14],P1[15],0.f,0.f,       pw3[2]=PKW(P1,12),pw3[3]=PKW(P1,14), pw3); \
    l_reg+=sacc; \
    if(GK){DMA_K((t)+3,sl_cur);} if(GV){DMA_V((t)+1,sl_next);} \
    CMASK(C0,C1,t); \
    { float a=MX3(C0[0],C0[1],C1[0]),b=MX3(C0[2],C0[3],C1[1]); a=MX3(a,C1[2],C1[3]); \
      _Pragma("unroll") for(int r=4;r<16;r+=4){a=MX3(a,C0[r],C0[r+1]);b=MX3(b,C0[r+2],C0[r+3]);a=MX3(a,C1[r],C1[r+1]);b=MX3(b,C1[r+2],C1[r+3]);} \
      float rm=__builtin_fmaxf(a,b); { auto rr=__builtin_amdgcn_permlane32_swap(__float_as_uint(rm),__float_as_uint(rm),false,false); rm=__builtin_fmaxf(__uint_as_float(rr[0]),__uint_as_float(rr[1])); } \
      resc=false; \
      if(__builtin_expect(__any(rm>(float)THRL),0)){ const float dl=__builtin_fmaxf(rm,0.f); mhat+=dl; \
        _Pragma("unroll") for(int r=0;r<16;++r){C0[r]-=dl;C1[r]-=dl;} \
        const float f=__builtin_amdgcn_exp2f(-dl); l_reg*=f; if(hi==0)wsf[r32]=f; resc=true; } } \
    SBAR(); \
    GAPB(o[0]=__builtin_amdgcn_mfma_f32_32x32x16_bf16(PAF(0),VFR(0),o[0],0,0,0), C0,0); \
    GAPB(o[1]=__builtin_amdgcn_mfma_f32_32x32x16_bf16(PAF(0),VFR(4),o[1],0,0,0), C0,4); \
    KRD(GL,0); GAPB(o[0]=__builtin_amdgcn_mfma_f32_32x32x16_bf16(PAF(1),VFR(1),o[0],0,0,0), C0,8); \
    KRD(GL,1); GAPB(o[1]=__builtin_amdgcn_mfma_f32_32x32x16_bf16(PAF(1),VFR(5),o[1],0,0,0), C0,12); \
    KRD(GL,2); GAPB(o[0]=__builtin_amdgcn_mfma_f32_32x32x16_bf16(PAF(2),VFR(2),o[0],0,0,0), C1,0); \
    KRD(GL,3); GAPB(o[1]=__builtin_amdgcn_mfma_f32_32x32x16_bf16(PAF(2),VFR(6),o[1],0,0,0), C1,4); \
    GAPB(o[0]=__builtin_amdgcn_mfma_f32_32x32x16_bf16(PAF(3),VFR(3),o[0],0,0,0), C1,8); \
    GAPB(o[1]=__builtin_amdgcn_mfma_f32_32x32x16_bf16(PAF(3),VFR(7),o[1],0,0,0), C1,12); \
    }while(0)
  int t=1;
  #undef CMASK
  #define CMASK(P0,P1,t) do{}while(0)
  for(;t+5<NT;t+=2){
    STEP(pB0,pB1,pA0,pA1,t,true,true,true);     WAIT_BAR(2); RESC(); ROT();
    STEP(pA0,pA1,pB0,pB1,t+1,true,true,true);   WAIT_BAR(2); RESC(); ROT();
  }
  #undef CMASK
  #define CMASK(P0,P1,t) do{int jb_=(t)-(NT-4); if(jb_>=0)cmask(P0,P1,jb_,qrel,hi);}while(0)
  #define ENDW(tt) do{ if((tt)+3<NT){WAIT_BAR(2);} else if((tt)+2<NT){WAIT_BAR(1);} else {WAIT_BAR(0);} }while(0)
  for(;t+1<NT;t+=2){
    STEP(pB0,pB1,pA0,pA1,t,(t+3<NT),(t+1<NT),(t+1<NT));       ENDW(t);   RESC(); ROT();
    STEP(pA0,pA1,pB0,pB1,t+1,(t+4<NT),(t+2<NT),(t+2<NT));     ENDW(t+1); RESC(); ROT();
  }
  STEP(pB0,pB1,pA0,pA1,NT-1,false,false,false); RESC();
  { float sacc=pB0[0]+pB0[1]; _Pragma("unroll") for(int r=2;r<16;++r)sacc+=pB0[r]; _Pragma("unroll") for(int r=0;r<16;++r)sacc+=pB1[r]; l_reg+=sacc;
    pw0=(u32x4){PKW(pB0,0),PKW(pB0,2),PKW(pB0,4),PKW(pB0,6)};pw1=(u32x4){PKW(pB0,8),PKW(pB0,10),PKW(pB0,12),PKW(pB0,14)};pw2=(u32x4){PKW(pB1,0),PKW(pB1,2),PKW(pB1,4),PKW(pB1,6)};pw3=(u32x4){PKW(pB1,8),PKW(pB1,10),PKW(pB1,12),PKW(pB1,14)};
    SBAR(); pv(o,vb0+sl_cur,PAF(0),PAF(1),PAF(2),PAF(3)); }
  #undef PKW
  #undef PAF
  #undef VFR
  #undef PIN
  #undef MX3
  #undef GAPA
  #undef GAPB
  #undef EX
  #undef VRD
  #undef KRD
  #undef STEP
  #undef ENDW
  {auto rr=__builtin_amdgcn_permlane32_swap(__float_as_uint(l_reg),__float_as_uint(l_reg),false,false);l_reg=__uint_as_float(rr[0])+__uint_as_float(rr[1]);}
  if(hi==0)wsf[32+r32]=l_reg;asm volatile("s_waitcnt lgkmcnt(0)":::"memory");
  float rli[16];
  #pragma unroll
  for(int r=0;r<16;++r)rli[r]=__builtin_amdgcn_rcpf(wsf[32+crow(r,hi)]);
  bf16*Ow=O+(long)(q0+wid*QBLK)*DM;
  { bf16*stg=(bf16*)(shm+LDS_OST)+wid*2048;
    #pragma unroll
    for(int r=0;r<16;++r){const int orow=crow(r,hi);
      #pragma unroll
      for(int d0=0;d0<2;++d0)stg[orow*64+d0*32+r32]=__float2bfloat16(o[d0][r]*rli[r]);}
    asm volatile("s_waitcnt lgkmcnt(0)":::"memory");
    #pragma unroll
    for(int i=0;i<4;++i){const int row=i*8+(lane>>3),ch=lane&7; const u32x4 v=*(const u32x4*)(stg+row*64+ch*8); ATTN_STORE16(Ow+(long)row*DM+ch*8,v);} }
  asm volatile("s_waitcnt lgkmcnt(0)\n\ts_barrier":::"memory");
  #undef DMA_K
  #undef DMA_V
  #undef CMASK
  #undef CINIT
  #undef START
  #undef RESC
  #undef ROT
}
constexpr int ATTN_LDS_BYTES=LDS_BYTES;
template<int THRL=8> __device__ __forceinline__ void attn_dispatch(int u,char*lds,const bf16*QA,const bf16*KA,const bf16*VA,bf16*O1,bf16*O2,const unsigned*norms){
    const int h=3-(u>>8), r=u&255, qb=63-(r>>2), c=(r>>1)&1, vhalf=r&1, hv=h*2+c;
    const float slope2=__uint_as_float(__builtin_amdgcn_readfirstlane((0x3fb8aa3bu)-((unsigned)(2*(h+1))<<23)));
    const float Bnd=sqrtf(__uint_as_float(norms[16+hv*64+qb]))*sqrtf(__uint_as_float(norms[hv]))*1.0001f+0.01f;
    const float Dmin=-sortu2f(norms[528+hv*64+qb]);
    const float W=(Bnd-fminf(Dmin,Bnd)+34.f)/slope2+1.f;
    const int q0=qb*QB; int t0=0; if((float)q0>W){ t0=((int)(((float)q0-W)*(1.f/64.f)))&~1; }
    t0=__builtin_amdgcn_readfirstlane(t0);
    const bf16*Q=QA+hv*64; const bf16*K=KA+hv*64; const bf16*V=VA+h*128+vhalf*64; bf16*O=(c?O2:O1)+h*128+vhalf*64;
    attn_unit<THRL>(qb,t0,slope2,Q,K,V,O,lds);
}
#undef SBAR
#undef WAIT_BAR
}

__device__ __forceinline__ void ph_rmsnorm_bf16(const float* X, const float* g, bf16* O) {
    const int lane = tidx() & 63, wave = tidx() >> 6;
    const int gw = blockIdx.x * NWAVES + wave, NGW = gridDim.x * NWAVES;
    for (int m = gw; m < M; m += NGW) {
        const f32x4* xr = (const f32x4*)(X + (size_t)m * D) + lane;
        f32x4 v[4]; float s = 0.f;
#pragma unroll
        for (int j = 0; j < 4; ++j) { v[j] = xr[64 * j]; s += (v[j].x * v[j].x + v[j].y * v[j].y) + (v[j].z * v[j].z + v[j].w * v[j].w); }
        const float r = rsqrtf(wave_sum(s) * (1.f / D) + EPS);
        v2u* o8 = (v2u*)(O + (size_t)m * D) + lane;
#pragma unroll
        for (int j = 0; j < 4; ++j) { const f32x4 gg = ((const f32x4*)g)[lane + 64 * j]; v2u w; w.x = pk2(v[j].x * r * gg.x, v[j].y * r * gg.y); w.y = pk2(v[j].z * r * gg.z, v[j].w * r * gg.w); o8[64 * j] = w; }
    }
}
__device__ __forceinline__ void ph_rmsnorm_f32_inplace(float* X, const float* g) {
    const int lane = tidx() & 63, wave = tidx() >> 6;
    const int gw = blockIdx.x * NWAVES + wave, NGW = gridDim.x * NWAVES;
    for (int m = gw; m < M; m += NGW) {
        f32x4* xr = (f32x4*)(X + (size_t)m * D) + lane;
        f32x4 v[4]; float s = 0.f;
#pragma unroll
        for (int j = 0; j < 4; ++j) { v[j] = xr[64 * j]; s += (v[j].x * v[j].x + v[j].y * v[j].y) + (v[j].z * v[j].z + v[j].w * v[j].w); }
        const float r = rsqrtf(wave_sum(s) * (1.f / D) + EPS);
#pragma unroll
        for (int j = 0; j < 4; ++j) { const f32x4 gg = ((const f32x4*)g)[lane + 64 * j]; xr[64 * j] = v[j] * r * gg; }
    }
}

__device__ __forceinline__ void transpose_item(const float* W, int K, int N, int Npad, bf16* WT, LAS float* scr, int item, int lane, const float* kgain = nullptr) {
    const int nblk = Npad / 32, kb = item / nblk, nb = item % nblk, k0 = 64 * kb, n0 = 32 * nb;
    const int nn = n0 + (lane & 31);
#pragma unroll 8
    for (int i = 0; i < 32; ++i) { const int kk = 2 * i + (lane >> 5); const float gk = kgain ? kgain[k0 + kk] : 1.f; scr[kk * 33 + (lane & 31)] = (nn < N) ? W[(size_t)(k0 + kk) * N + nn] * gk : 0.f; }
    asm volatile("s_waitcnt lgkmcnt(0)" ::: "memory");
    const int c = lane & 7;
#pragma unroll
    for (int j = 0; j < 4; ++j) { const int n = (lane >> 3) + 8 * j; const LAS float* sp = scr + (8 * c) * 33 + n;
        v4u o; o.x = pk2(sp[0 * 33], sp[1 * 33]); o.y = pk2(sp[2 * 33], sp[3 * 33]); o.z = pk2(sp[4 * 33], sp[5 * 33]); o.w = pk2(sp[6 * 33], sp[7 * 33]);
        *(v4u*)(WT + (size_t)(n0 + n) * K + k0 + 8 * c) = o; }
    asm volatile("s_waitcnt lgkmcnt(0)" ::: "memory");
}
__device__ __forceinline__ void ph_weights_in(const float* w_in, bf16* WIN, LAS unsigned char* lds) {
    const int lane = tidx() & 63, wave = __builtin_amdgcn_readfirstlane(tidx() >> 6);
    LAS float* scr = (LAS float*)(lds + wave * 16384);
    const int gw = blockIdx.x * NWAVES + wave, NGW = gridDim.x * NWAVES;
    constexpr int I_IN = (D / 64) * (NINP / 32);
    for (int it = gw; it < I_IN; it += NGW) transpose_item(w_in, D, NIN, NINP, WIN, scr, it, lane);
}
constexpr int WCH_OUT = (D / 64) * (D / 32), WCH_Q = (D / 64) * (NQ / 32), WCH_P = (PLE / 64) * (D / 32), WCH_ITEMS = 2 * WCH_OUT + WCH_Q + WCH_P, WCH_CHUNKS = (WCH_ITEMS + 7) / 8;
__device__ __forceinline__ void weights_chunk(int chunk, const float* w_out, const float* w_query, const float* g_query, const float* w_gate, const float* w_proj, bf16* WOUT, bf16* WQ, bf16* WG, bf16* WP, LAS unsigned char* lds) {
    const int lane = tidx() & 63, wave = __builtin_amdgcn_readfirstlane(tidx() >> 6);
    LAS float* scr = (LAS float*)(lds + wave * 16384);
    int r = chunk * 8 + wave;
    if (r >= WCH_ITEMS) return;
    if (r < WCH_OUT) { transpose_item(w_out, D, D, D, WOUT, scr, r, lane); return; } r -= WCH_OUT;
    if (r < WCH_Q) { transpose_item(w_query, D, NQ, NQ, WQ, scr, r, lane, g_query); return; } r -= WCH_Q;
    if (r < WCH_OUT) { transpose_item(w_gate, D, D, D, WG, scr, r, lane); return; } r -= WCH_OUT;
    transpose_item(w_proj, PLE, D, D, WP, scr, r, lane);
}

template <class Epi>
__device__ __forceinline__ void naive_gemm(const bf16* A, int lda, const float* W, int K, int N, float* lds, Epi epi) {
    float* As = lds;
    float* Ws = lds + 32 * 65;
    const int tid = tidx(), tx = tid & 15, ty = tid >> 4;
    const int ntn = (N + 63) / 64, nt = (M / 64) * ntn;
    for (int t = blockIdx.x; t < nt; t += gridDim.x) {
        const int tm = t / ntn, tn = t % ntn, r0 = tm * 64, c0 = tn * 64;
        float acc[2][4];
#pragma unroll
        for (int i = 0; i < 2; ++i)
#pragma unroll
            for (int j = 0; j < 4; ++j) acc[i][j] = 0.f;
        for (int k0 = 0; k0 < K; k0 += 32) {
            { const int r = tid >> 3, kq = (tid & 7) * 4; const v2u v = *(const v2u*)(A + (size_t)(r0 + r) * lda + k0 + kq);
              As[(kq + 0) * 65 + r] = bf2f(v.x & 0xffffu); As[(kq + 1) * 65 + r] = bf2f(v.x >> 16); As[(kq + 2) * 65 + r] = bf2f(v.y & 0xffffu); As[(kq + 3) * 65 + r] = bf2f(v.y >> 16); }
            { const int kk = tid >> 4, nq = (tid & 15) * 4; const float* wp = W + (size_t)(k0 + kk) * N + c0 + nq;
#pragma unroll
              for (int j = 0; j < 4; ++j) Ws[kk * 64 + nq + j] = (c0 + nq + j < N) ? wp[j] : 0.f; }
            __syncthreads();
#pragma unroll 8
            for (int kk = 0; kk < 32; ++kk) {
                const float a0 = As[kk * 65 + ty], a1 = As[kk * 65 + ty + 32];
                const f32x4 b = *(const f32x4*)(Ws + kk * 64 + tx * 4);
                acc[0][0] += a0 * b.x; acc[0][1] += a0 * b.y; acc[0][2] += a0 * b.z; acc[0][3] += a0 * b.w;
                acc[1][0] += a1 * b.x; acc[1][1] += a1 * b.y; acc[1][2] += a1 * b.z; acc[1][3] += a1 * b.w;
            }
            __syncthreads();
        }
#pragma unroll
        for (int i = 0; i < 2; ++i)
#pragma unroll
            for (int j = 0; j < 4; ++j) { const int row = r0 + ty + 32 * i, col = c0 + tx * 4 + j; if (col < N) epi(row, col, acc[i][j]); }
    }
}

__device__ __forceinline__ void ph_attn_naive(const bf16* QA, const bf16* KA, const bf16* VA, bf16* O1, bf16* O2, float* lds) {
    float* Ks = lds; float* Vs = lds + 32 * 64; float* Ss = Vs + 32 * 128;
    const int tid = tidx(), qi = tid >> 3, cg = tid & 7;
    for (int item = blockIdx.x; item < 8 * 256; item += gridDim.x) {
        const int hv = item & 7, qb = 255 - (item >> 3);
        const int h = hv >> 1, c = hv & 1, q0 = qb * 64, qpos = q0 + qi;
        const float slope2 = exp2f(-2.f * (float)(h + 1)) * LOG2E;
        float q[64];
        { const v4u* qp = (const v4u*)(QA + (size_t)qpos * 512 + hv * 64);
#pragma unroll
          for (int i = 0; i < 8; ++i) { const v4u v = qp[i];
              q[8 * i + 0] = bf2f(v.x & 0xffffu); q[8 * i + 1] = bf2f(v.x >> 16); q[8 * i + 2] = bf2f(v.y & 0xffffu); q[8 * i + 3] = bf2f(v.y >> 16);
              q[8 * i + 4] = bf2f(v.z & 0xffffu); q[8 * i + 5] = bf2f(v.z >> 16); q[8 * i + 6] = bf2f(v.w & 0xffffu); q[8 * i + 7] = bf2f(v.w >> 16); } }
        float m = -INFINITY, l = 0.f, acc[16];
#pragma unroll
        for (int i = 0; i < 16; ++i) acc[i] = 0.f;
        const int ntile = (q0 + 64) / 32;
        for (int kt = 0; kt < ntile; ++kt) {
            const int k0 = kt * 32;
            __syncthreads();
            { const int kk = tid >> 4, d4 = (tid & 15) * 4; const v2u v = *(const v2u*)(KA + (size_t)(k0 + kk) * 512 + hv * 64 + d4);
              float* kd = Ks + kk * 64 + d4; kd[0] = bf2f(v.x & 0xffffu); kd[1] = bf2f(v.x >> 16); kd[2] = bf2f(v.y & 0xffffu); kd[3] = bf2f(v.y >> 16); }
            { const int kk = tid >> 4, e8 = (tid & 15) * 8; const v4u v = *(const v4u*)(VA + (size_t)(k0 + kk) * 512 + h * 128 + e8);
              float* vd = Vs + kk * 128 + e8; vd[0] = bf2f(v.x & 0xffffu); vd[1] = bf2f(v.x >> 16); vd[2] = bf2f(v.y & 0xffffu); vd[3] = bf2f(v.y >> 16);
              vd[4] = bf2f(v.z & 0xffffu); vd[5] = bf2f(v.z >> 16); vd[6] = bf2f(v.w & 0xffffu); vd[7] = bf2f(v.w >> 16); }
            __syncthreads();
#pragma unroll
            for (int j = 0; j < 4; ++j) {
                const int kk = cg + 8 * j; const float* kr = Ks + kk * 64; float s = 0.f;
#pragma unroll
                for (int d = 0; d < 64; ++d) s += q[d] * kr[d];
                const int kpos = k0 + kk;
                s = (kpos <= qpos) ? s - slope2 * (float)(qpos - kpos) : -INFINITY;
                Ss[qi * 33 + kk] = s;
            }
            __syncthreads();
            float tmax = -INFINITY;
#pragma unroll 8
            for (int kk = 0; kk < 32; ++kk) tmax = fmaxf(tmax, Ss[qi * 33 + kk]);
            const float mn = fmaxf(m, tmax), alpha = exp2f(m - mn);
            l *= alpha;
#pragma unroll
            for (int i = 0; i < 16; ++i) acc[i] *= alpha;
            for (int kk = 0; kk < 32; ++kk) {
                const float p = exp2f(Ss[qi * 33 + kk] - mn); l += p;
                const float* vr = Vs + kk * 128 + 16 * cg;
#pragma unroll
                for (int i = 0; i < 16; ++i) acc[i] += p * vr[i];
            }
            m = mn;
        }
        const float il = 1.f / l;
        bf16* O = c ? O2 : O1;
        v4u w0, w1;
        w0.x = pk2(acc[0] * il, acc[1] * il); w0.y = pk2(acc[2] * il, acc[3] * il); w0.z = pk2(acc[4] * il, acc[5] * il); w0.w = pk2(acc[6] * il, acc[7] * il);
        w1.x = pk2(acc[8] * il, acc[9] * il); w1.y = pk2(acc[10] * il, acc[11] * il); w1.z = pk2(acc[12] * il, acc[13] * il); w1.w = pk2(acc[14] * il, acc[15] * il);
        v4u* op = (v4u*)(O + (size_t)qpos * 512 + h * 128 + 16 * cg); op[0] = w0; op[1] = w1;
    }
}

__device__ __forceinline__ void ph_conv_naive(const bf16* MQ, const bf16* MK, const float* cw, const float* cb, bf16* CQ, bf16* CK) {
    const size_t n = (size_t)M * 512, stride = (size_t)gridDim.x * NTHREADS;
    for (size_t i = (size_t)blockIdx.x * NTHREADS + tidx(); i < n; i += stride) {
        const int t = (int)(i >> 9), c = (int)(i & 511);
        float aq = cb[c], ak = cb[512 + c];
#pragma unroll
        for (int j = 0; j < 4; ++j) { const int tt = t - 3 + j; if (tt >= 0) { aq += cw[j * 1024 + c] * bf2f(MQ[(size_t)tt * 512 + c]); ak += cw[j * 1024 + 512 + c] * bf2f(MK[(size_t)tt * 512 + c]); } }
        aq = aq * sigmoidf_(aq) * 0.08838834764831845f; ak = ak * sigmoidf_(ak);
        CQ[i] = (bf16)f2bf(aq); CK[i] = (bf16)f2bf(ak);
    }
}
__device__ __forceinline__ void ph_mlstm_naive(const bf16* CQ, const bf16* CK, const bf16* MV, const float* GATES, const float* b_i, const float* b_f, float* HS, float* lds) {
    if (blockIdx.x >= 4) return;
    const int h = blockIdx.x, tid = tidx(), e = tid & 127, dg = tid >> 7;
    float* qs = lds; float* ks = qs + 64 * 128; float* vs = ks + 64 * 128; float* fs = vs + 64 * 128; float* is_ = fs + 64; float* red = is_ + 64; float* redd = red + 512;
    float C[32], n[32];
#pragma unroll
    for (int i = 0; i < 32; ++i) { C[i] = 0.f; n[i] = 0.f; }
    for (int c0 = 0; c0 < M; c0 += 64) {
        __syncthreads();
        for (int i = tid; i < 64 * 128; i += NTHREADS) { const int tt = i >> 7, d = i & 127; const size_t g = (size_t)(c0 + tt) * 512 + h * 128 + d; qs[i] = bf2f(CQ[g]); ks[i] = bf2f(CK[g]); vs[i] = bf2f(MV[g]); }
        if (tid < 64) { const float fp = GATES[(size_t)(c0 + tid) * 8 + 4 + h] + b_f[h], ip = GATES[(size_t)(c0 + tid) * 8 + h] + b_i[h]; fs[tid] = 1.f / (1.f + expf(-fp)); is_[tid] = expf(ip); }
        __syncthreads();
        for (int tt = 0; tt < 64; ++tt) {
            const float f = fs[tt], ii = is_[tt], ve = vs[tt * 128 + e]; float pn = 0.f, pd = 0.f;
#pragma unroll
            for (int i = 0; i < 32; ++i) { const float kd = ks[tt * 128 + dg * 32 + i], qd = qs[tt * 128 + dg * 32 + i], ik = ii * kd;
                C[i] = f * C[i] + ik * ve; n[i] = f * n[i] + ik; pn += qd * C[i]; pd += qd * n[i]; }
            red[dg * 128 + e] = pn; if (e == 0) redd[dg] = pd;
            __syncthreads();
            if (dg == 0) { const float num = (red[e] + red[128 + e]) + (red[256 + e] + red[384 + e]), den = (redd[0] + redd[1]) + (redd[2] + redd[3]);
                HS[(size_t)(c0 + tt) * 512 + h * 128 + e] = num / fmaxf(fabsf(den), 1.f); }
            __syncthreads();
        }
    }
}
template <bool DO_ML>
__device__ __forceinline__ void ph_combine(const bf16* O1, const bf16* O2, const bf16* MO, const float* HS, const float* lq1, const float* lk1, const float* lq2, const float* lk2,
                                           const float* subln_g, const float* ml_g, bf16* ACAT) {
    const int lane = tidx() & 63, wave = tidx() >> 6;
    const int gw = blockIdx.x * NWAVES + wave, NGW = gridDim.x * NWAVES;
    const float lam = expf(wave_sum(lq1[lane] * lk1[lane])) - expf(wave_sum(lq2[lane] * lk2[lane])) + LAMBDA_INIT;
    for (int m = gw; m < M; m += NGW) {
        const int c0 = lane * 8;
        float a[8], b[8];
        { const v4u u1 = *(const v4u*)(O1 + (size_t)m * 512 + c0), u2 = *(const v4u*)(O2 + (size_t)m * 512 + c0);
          const unsigned w1[4] = {u1.x, u1.y, u1.z, u1.w}, w2[4] = {u2.x, u2.y, u2.z, u2.w};
#pragma unroll
          for (int i = 0; i < 4; ++i) { a[2 * i] = bf2f(w1[i] & 0xffffu) - lam * bf2f(w2[i] & 0xffffu); a[2 * i + 1] = bf2f(w1[i] >> 16) - lam * bf2f(w2[i] >> 16); } }
        if (DO_ML) { const v4u uo = *(const v4u*)(MO + (size_t)m * 512 + c0); const unsigned wo[4] = {uo.x, uo.y, uo.z, uo.w};
          const f32x4 h0 = *(const f32x4*)(HS + (size_t)m * 512 + c0), h1 = *(const f32x4*)(HS + (size_t)m * 512 + c0 + 4);
          const float hh[8] = {h0.x, h0.y, h0.z, h0.w, h1.x, h1.y, h1.z, h1.w};
#pragma unroll
          for (int i = 0; i < 4; ++i) { b[2 * i] = sigmoidf_(bf2f(wo[i] & 0xffffu)) * hh[2 * i]; b[2 * i + 1] = sigmoidf_(bf2f(wo[i] >> 16)) * hh[2 * i + 1]; } }
        else {
#pragma unroll
          for (int i = 0; i < 8; ++i) b[i] = 0.f; }
        float sa = 0.f, sb = 0.f;
#pragma unroll
        for (int i = 0; i < 8; ++i) { sa += a[i] * a[i]; sb += b[i] * b[i]; }
#pragma unroll
        for (int o = 1; o < 16; o <<= 1) { sa += __shfl_xor(sa, o); sb += __shfl_xor(sb, o); }
        const float ra = rsqrtf(sa * (1.f / 128.f) + EPS) * (1.f - LAMBDA_INIT), rb = rsqrtf(sb * (1.f / 128.f) + EPS);
        const int cc = c0 & 127, hh_ = lane >> 4;
        v4u wa, wb;
        { const float* g = subln_g + cc; wa.x = pk2(a[0] * ra * g[0], a[1] * ra * g[1]); wa.y = pk2(a[2] * ra * g[2], a[3] * ra * g[3]); wa.z = pk2(a[4] * ra * g[4], a[5] * ra * g[5]); wa.w = pk2(a[6] * ra * g[6], a[7] * ra * g[7]); }
        { const float* g = ml_g + hh_ * 128 + cc; wb.x = pk2(b[0] * rb * g[0], b[1] * rb * g[1]); wb.y = pk2(b[2] * rb * g[2], b[3] * rb * g[3]); wb.z = pk2(b[4] * rb * g[4], b[5] * rb * g[5]); wb.w = pk2(b[6] * rb * g[6], b[7] * rb * g[7]); }
        *(v4u*)(ACAT + (size_t)m * 1024 + c0) = wa; if (DO_ML) *(v4u*)(ACAT + (size_t)m * 1024 + 512 + c0) = wb;
    }
}


namespace ml {
typedef short bf16x8 __attribute__((ext_vector_type(8)));
typedef float f32x16 __attribute__((ext_vector_type(16)));
typedef LAS unsigned char* lptr;
constexpr int LD128 = 272, LD64 = 144;
constexpr int QP_OFF = 0, K_OFF = 17408, Y_OFF = 0, KWT_OFF = 34816, VT_OFF = 53248, SM_OFF = 71680, CT_OFF = 80896, SMALL_OFF = 115712;
constexpr int LDY = 132;
constexpr int ST_STRIDE = 16384 + 256;
__device__ __forceinline__ int crow(int r, int hi) { return (r & 3) + 8 * (r >> 2) + 4 * hi; }
template <int KS>
__device__ __forceinline__ void mm_tile(f32x16& acc, lptr A, int lda, lptr Bt, int ldb, int r32, int hi) {
    lptr ap = A + r32 * lda + hi * 16; lptr bp = Bt + r32 * ldb + hi * 16;
#pragma unroll
    for (int ks = 0; ks < KS; ++ks) {
        const bf16x8 a = *(const LAS bf16x8*)(ap + ks * 32);
        const bf16x8 b = *(const LAS bf16x8*)(bp + ks * 32);
        acc = __builtin_amdgcn_mfma_f32_32x32x16_bf16(a, b, acc, 0, 0, 0);
    }
}
__device__ __forceinline__ float gates_chunk(const float* GATES, float bi, float bf_, int t0, int h, int lane, LAS float* eb, LAS float* wcol, LAS float* wupd, LAS float* misc) {
    const float fp = GATES[(size_t)(t0 + lane) * 8 + 4 + h] + bf_, ip = GATES[(size_t)(t0 + lane) * 8 + h] + bi;
    const float lf = fminf(fp, 0.f) - log1pf(__expf(-fabsf(fp)));
    float b = lf;
#pragma unroll
    for (int o = 1; o < 64; o <<= 1) { const float u = __shfl_up(b, o); if (lane >= o) b += u; }
    const float bL = __shfl(b, 63);
    eb[lane] = __expf(b); wcol[lane] = __expf(ip - b); wupd[lane] = __expf(bL - b + ip); if (lane == 0) misc[0] = __expf(bL);
    return bL;
}
__device__ __forceinline__ void stage_transposed(const bf16* CK, const bf16* MV, int t0, int h, lptr lds, const LAS float* wupd, int tid) {
    const int sp = tid & 31, c = tid >> 5;
    const size_t g0 = (size_t)(t0 + 2 * sp) * 512 + h * 128 + c * 8;
    const v4u k0 = *(const v4u*)(CK + g0), k1 = *(const v4u*)(CK + g0 + 512), v0 = *(const v4u*)(MV + g0), v1 = *(const v4u*)(MV + g0 + 512);
    const float w0 = wupd[2 * sp], w1 = wupd[2 * sp + 1];
    const unsigned ka[4] = {k0.x, k0.y, k0.z, k0.w}, kb[4] = {k1.x, k1.y, k1.z, k1.w}, va[4] = {v0.x, v0.y, v0.z, v0.w}, vb[4] = {v1.x, v1.y, v1.z, v1.w};
    lptr kw = lds + KWT_OFF + (8 * c) * LD64 + 4 * sp; lptr vt = lds + VT_OFF + (8 * c) * LD64 + 4 * sp;
#pragma unroll
    for (int i = 0; i < 4; ++i) {
        *(LAS unsigned*)(kw + (2 * i) * LD64) = pk2(w0 * bf2f(ka[i] & 0xffffu), w1 * bf2f(kb[i] & 0xffffu));
        *(LAS unsigned*)(kw + (2 * i + 1) * LD64) = pk2(w0 * bf2f(ka[i] >> 16), w1 * bf2f(kb[i] >> 16));
        *(LAS unsigned*)(vt + (2 * i) * LD64) = (va[i] & 0xffffu) | (vb[i] << 16);
        *(LAS unsigned*)(vt + (2 * i + 1) * LD64) = (va[i] >> 16) | (vb[i] & 0xffff0000u);
    }
}
__device__ __forceinline__ void state_update(f32x16 (&accS)[2], lptr lds, float aL, int wave, int r32, int hi) {
    const int er = wave & 3, dc0 = 2 * (wave >> 2);
#pragma unroll
    for (int i = 0; i < 2; ++i) {
#pragma unroll
        for (int r = 0; r < 16; ++r) accS[i][r] *= aL;
        mm_tile<4>(accS[i], lds + VT_OFF + (32 * er) * LD64, LD64, lds + KWT_OFF + (32 * (dc0 + i)) * LD64, LD64, r32, hi);
    }
}
__device__ __forceinline__ float kwt_rowsum(lptr lds, int d) {
    float s = 0.f; lptr p = lds + KWT_OFF + d * LD64;
#pragma unroll
    for (int i = 0; i < 8; ++i) { const v4u q = *(const LAS v4u*)(p + 16 * i);
        s += (bf2f(q.x & 0xffffu) + bf2f(q.x >> 16)) + (bf2f(q.y & 0xffffu) + bf2f(q.y >> 16)) + (bf2f(q.z & 0xffffu) + bf2f(q.z >> 16)) + (bf2f(q.w & 0xffffu) + bf2f(q.w >> 16)); }
    return s;
}

__device__ __forceinline__ void conv_items(const bf16* MQ, const bf16* MK, const float* cw, const float* cb, bf16* CQ, bf16* CK) {
    const int tid = tidx(), ch = tid & 15, rg = tid >> 4;
    for (int item = blockIdx.x; item < 256; item += gridDim.x) {
        const int h = item >> 6, j = item & 63, col = h * 128 + ch * 8;
        float wq[4][8], wk[4][8], bq[8], bk[8];
#pragma unroll
        for (int jj = 0; jj < 4; ++jj)
#pragma unroll
            for (int e = 0; e < 8; e += 4) { const f32x4 a = *(const f32x4*)(cw + jj * 1024 + col + e), b = *(const f32x4*)(cw + jj * 1024 + 512 + col + e);
                wq[jj][e] = a.x; wq[jj][e + 1] = a.y; wq[jj][e + 2] = a.z; wq[jj][e + 3] = a.w; wk[jj][e] = b.x; wk[jj][e + 1] = b.y; wk[jj][e + 2] = b.z; wk[jj][e + 3] = b.w; }
#pragma unroll
        for (int e = 0; e < 8; ++e) { bq[e] = cb[col + e]; bk[e] = cb[512 + col + e]; }
#pragma unroll 1
        for (int ps = 0; ps < 2; ++ps) {
            const int t0 = j * 256 + rg * 8 + ps * 4;
            v4u qi[7], ki[7];
#pragma unroll
            for (int r = 0; r < 7; ++r) { const int tt = t0 - 3 + r; if (tt >= 0) { qi[r] = *(const v4u*)(MQ + (size_t)tt * 512 + col); ki[r] = *(const v4u*)(MK + (size_t)tt * 512 + col); } else { qi[r] = (v4u){0u, 0u, 0u, 0u}; ki[r] = (v4u){0u, 0u, 0u, 0u}; } }
#pragma unroll
            for (int o = 0; o < 4; ++o) {
                float aq[8], ak[8];
#pragma unroll
                for (int e = 0; e < 8; ++e) { aq[e] = bq[e]; ak[e] = bk[e]; }
#pragma unroll
                for (int jj = 0; jj < 4; ++jj) { const v4u q = qi[o + jj], k = ki[o + jj]; const unsigned qa[4] = {q.x, q.y, q.z, q.w}, ka[4] = {k.x, k.y, k.z, k.w};
#pragma unroll
                    for (int e = 0; e < 4; ++e) { aq[2 * e] += wq[jj][2 * e] * bf2f(qa[e] & 0xffffu); aq[2 * e + 1] += wq[jj][2 * e + 1] * bf2f(qa[e] >> 16);
                                                  ak[2 * e] += wk[jj][2 * e] * bf2f(ka[e] & 0xffffu); ak[2 * e + 1] += wk[jj][2 * e + 1] * bf2f(ka[e] >> 16); } }
#pragma unroll
                for (int e = 0; e < 8; ++e) { aq[e] = aq[e] * sigmoidf_(aq[e]) * 0.08838834764831845f; ak[e] = ak[e] * sigmoidf_(ak[e]); }
                v4u oq, ok; oq.x = pk2(aq[0], aq[1]); oq.y = pk2(aq[2], aq[3]); oq.z = pk2(aq[4], aq[5]); oq.w = pk2(aq[6], aq[7]);
                ok.x = pk2(ak[0], ak[1]); ok.y = pk2(ak[2], ak[3]); ok.z = pk2(ak[4], ak[5]); ok.w = pk2(ak[6], ak[7]);
                *(v4u*)(CQ + (size_t)(t0 + o) * 512 + col) = oq; *(v4u*)(CK + (size_t)(t0 + o) * 512 + col) = ok;
            }
        }
    }
}
__device__ __forceinline__ void b1_item(int item, const bf16* CK, const bf16* MV, const float* GATES, const float* b_i, const float* b_f, float* ST, lptr lds) {
    const int tid = tidx(), lane = tid & 63, r32 = lane & 31, hi = lane >> 5; const int wave = __builtin_amdgcn_readfirstlane(tid >> 6);
    LAS float* eb = (LAS float*)(lds + SMALL_OFF); LAS float* wcol = eb + 64; LAS float* wupd = wcol + 64; LAS float* misc = wupd + 64 + 64 + 128;
    {
        const int h = item >> 6, j = item & 63;
        f32x16 accS[2]; accS[0] = f32x16{}; accS[1] = f32x16{};
        float nv = 0.f, sumb = 0.f;
        const float bi = b_i[h], bf_ = b_f[h];
        for (int c = 0; c < 4; ++c) {
            const int t0 = j * 256 + c * 64;
            __syncthreads();
            if (wave == 0) sumb += gates_chunk(GATES, bi, bf_, t0, h, lane, eb, wcol, wupd, misc);
            __syncthreads();
            stage_transposed(CK, MV, t0, h, lds, wupd, tid);
            const float aL = misc[0];
            __syncthreads();
            state_update(accS, lds, aL, wave, r32, hi);
            if (tid < 128) nv = aL * nv + kwt_rowsum(lds, tid);
        }
        float* st = ST + (size_t)item * ST_STRIDE;
#pragma unroll
        for (int i = 0; i < 2; ++i)
#pragma unroll
            for (int r = 0; r < 16; ++r) st[((wave * 2 + i) * 16 + r) * 64 + lane] = accS[i][r];
        if (tid < 128) st[16384 + tid] = nv;
        if (tid == 0) st[16384 + 128] = __expf(sumb);
    }
}
__device__ __forceinline__ void phase_b2(float* ST) {
    const int gt = blockIdx.x * NTHREADS + tidx(), NGT = gridDim.x * NTHREADS;
    for (int q = gt; q < 4 * (16384 + 128); q += NGT) {
        const int h = q / (16384 + 128), e = q % (16384 + 128);
        float* base = ST + (size_t)h * 64 * ST_STRIDE;
        float c = 0.f;
#pragma unroll 1
        for (int jb = 0; jb < 64; jb += 16) {
            float u[16], a[16];
#pragma unroll
            for (int k = 0; k < 16; ++k) { u[k] = base[(size_t)(jb + k) * ST_STRIDE + e]; a[k] = base[(size_t)(jb + k) * ST_STRIDE + 16384 + 128]; }
#pragma unroll
            for (int k = 0; k < 16; ++k) { base[(size_t)(jb + k) * ST_STRIDE + e] = c; c = a[k] * c + u[k]; }
        }
    }
}
__device__ __forceinline__ void phase_b3(const bf16* CQ, const bf16* CK, const bf16* MV, const bf16* MO, const float* GATES, const float* b_i, const float* b_f, const float* ml_g,
                                         const float* ST, bf16* ACAT, lptr lds) {
    const int tid = tidx(), lane = tid & 63, r32 = lane & 31, hi = lane >> 5; const int wave = __builtin_amdgcn_readfirstlane(tid >> 6);
    LAS float* eb = (LAS float*)(lds + SMALL_OFF); LAS float* wcol = eb + 64; LAS float* wupd = wcol + 64; LAS float* dinv = wupd + 64; LAS float* nvec = dinv + 64; LAS float* misc = nvec + 128;
    const int er = wave & 3, dc0 = 2 * (wave >> 2);
    for (int item = blockIdx.x; item < 256; item += gridDim.x) {
        const int h = item >> 6, j = item & 63;
        const float* st = ST + (size_t)item * ST_STRIDE;
        f32x16 accS[2];
#pragma unroll
        for (int i = 0; i < 2; ++i)
#pragma unroll
            for (int r = 0; r < 16; ++r) accS[i][r] = st[((wave * 2 + i) * 16 + r) * 64 + lane];
        __syncthreads();
        if (tid < 128) nvec[tid] = st[16384 + tid];
#pragma unroll
        for (int i = 0; i < 2; ++i)
#pragma unroll
            for (int r = 0; r < 16; ++r) *(LAS unsigned short*)(lds + CT_OFF + (32 * er + crow(r, hi)) * LD128 + (32 * (dc0 + i) + r32) * 2) = (unsigned short)f2bf(accS[i][r]);
        const float bi = b_i[h], bf_ = b_f[h];
        for (int c = 0; c < 4; ++c) {
            const int t0 = j * 256 + c * 64;
            __syncthreads();
            if (wave == 0) (void)gates_chunk(GATES, bi, bf_, t0, h, lane, eb, wcol, wupd, misc);
            __syncthreads();
#pragma unroll
            for (int i = 0; i < 2; ++i) { const int p = tid + 512 * i, row = p >> 4, ch = p & 15; const size_t g = (size_t)(t0 + row) * 512 + h * 128 + ch * 8;
                const v4u qv = *(const v4u*)(CQ + g), kv = *(const v4u*)(CK + g); const float e_ = eb[row];
                v4u qo; qo.x = pk2(e_ * bf2f(qv.x & 0xffffu), e_ * bf2f(qv.x >> 16)); qo.y = pk2(e_ * bf2f(qv.y & 0xffffu), e_ * bf2f(qv.y >> 16));
                qo.z = pk2(e_ * bf2f(qv.z & 0xffffu), e_ * bf2f(qv.z >> 16)); qo.w = pk2(e_ * bf2f(qv.w & 0xffffu), e_ * bf2f(qv.w >> 16));
                *(LAS v4u*)(lds + QP_OFF + row * LD128 + ch * 16) = qo; *(LAS v4u*)(lds + K_OFF + row * LD128 + ch * 16) = kv; }
            stage_transposed(CK, MV, t0, h, lds, wupd, tid);
            const float aL = misc[0];
            __syncthreads();
            const int tr = wave >> 2, tc = wave & 3;
            if (wave < 4) {
                const int sr = wave >> 1, sc = wave & 1;
                f32x16 sa = f32x16{};
                mm_tile<8>(sa, lds + QP_OFF + (32 * sr) * LD128, LD128, lds + K_OFF + (32 * sc) * LD128, LD128, r32, hi);
                const int s_ = 32 * sc + r32; const float wc_ = wcol[s_];
#pragma unroll
                for (int r = 0; r < 16; ++r) { const int t_ = 32 * sr + crow(r, hi); const float v = (s_ <= t_) ? sa[r] * wc_ : 0.f;
                    *(LAS unsigned short*)(lds + SM_OFF + t_ * LD64 + s_ * 2) = (unsigned short)f2bf(v); }
            }
            f32x16 acc = f32x16{};
            mm_tile<8>(acc, lds + QP_OFF + (32 * tr) * LD128, LD128, lds + CT_OFF + (32 * tc) * LD128, LD128, r32, hi);
            __syncthreads();
            mm_tile<4>(acc, lds + SM_OFF + (32 * tr) * LD64, LD64, lds + VT_OFF + (32 * tc) * LD64, LD64, r32, hi);
            if (tid < 64) {
                float dn = 0.f; lptr qp = lds + QP_OFF + tid * LD128;
#pragma unroll 4
                for (int i = 0; i < 16; ++i) { const v4u q = *(const LAS v4u*)(qp + 16 * i); const LAS float* nn = nvec + 8 * i;
                    dn += bf2f(q.x & 0xffffu) * nn[0] + bf2f(q.x >> 16) * nn[1] + bf2f(q.y & 0xffffu) * nn[2] + bf2f(q.y >> 16) * nn[3]
                        + bf2f(q.z & 0xffffu) * nn[4] + bf2f(q.z >> 16) * nn[5] + bf2f(q.w & 0xffffu) * nn[6] + bf2f(q.w >> 16) * nn[7]; }
                lptr sp_ = lds + SM_OFF + tid * LD64;
#pragma unroll
                for (int i = 0; i < 8; ++i) { const v4u q = *(const LAS v4u*)(sp_ + 16 * i);
                    dn += (bf2f(q.x & 0xffffu) + bf2f(q.x >> 16)) + (bf2f(q.y & 0xffffu) + bf2f(q.y >> 16)) + (bf2f(q.z & 0xffffu) + bf2f(q.z >> 16)) + (bf2f(q.w & 0xffffu) + bf2f(q.w >> 16)); }
                dinv[tid] = 1.f / fmaxf(fabsf(dn), 1.f);
            }
            __syncthreads();
#pragma unroll
            for (int r = 0; r < 16; ++r) { const int t_ = 32 * tr + crow(r, hi); *(LAS float*)(lds + Y_OFF + (t_ * LDY + 32 * tc + r32) * 4) = acc[r] * dinv[t_]; }
            state_update(accS, lds, aL, wave, r32, hi);
            float nnew = 0.f;
            if (tid < 128) nnew = aL * nvec[tid] + kwt_rowsum(lds, tid);
            __syncthreads();
            if (tid < 128) nvec[tid] = nnew;
#pragma unroll
            for (int i = 0; i < 2; ++i)
#pragma unroll
                for (int r = 0; r < 16; ++r) *(LAS unsigned short*)(lds + CT_OFF + (32 * er + crow(r, hi)) * LD128 + (32 * (dc0 + i) + r32) * 2) = (unsigned short)f2bf(accS[i][r]);
#pragma unroll 2
            for (int rr = 0; rr < 8; ++rr) { const int t_ = wave * 8 + rr; const size_t grow = (size_t)(t0 + t_);
                const float y0 = *(const LAS float*)(lds + Y_OFF + (t_ * LDY + 2 * lane) * 4), y1 = *(const LAS float*)(lds + Y_OFF + (t_ * LDY + 2 * lane + 1) * 4);
                const unsigned ov = *(const unsigned*)(MO + grow * 512 + h * 128 + 2 * lane);
                const float z0 = y0 * sigmoidf_(bf2f(ov & 0xffffu)), z1 = y1 * sigmoidf_(bf2f(ov >> 16));
                const float rs = rsqrtf(wave_sum(z0 * z0 + z1 * z1) * (1.f / 128.f) + EPS);
                *(unsigned*)(ACAT + grow * 1024 + 512 + h * 128 + 2 * lane) = pk2(z0 * rs * ml_g[h * 128 + 2 * lane], z1 * rs * ml_g[h * 128 + 2 * lane + 1]); }
        }
    }
}
}

__device__ __forceinline__ void ph_route_naive(const bf16* QP, const float* SK, int2* ROUTE, float* lds) {
    float* qs = lds; float* sc = qs + 2048; float* sv = sc + 2048; int* si = (int*)(sv + 256); float* cand = (float*)(si + 256); float* tops = cand + 2048; int* tope = (int*)(tops + 128);
    const int tid = tidx();
    for (int t = blockIdx.x; t < M; t += gridDim.x) {
        __syncthreads();
        for (int i = tid; i < 2048; i += NTHREADS) qs[i] = bf2f(QP[(size_t)t * 2048 + i]);
        __syncthreads();
#pragma unroll 1
        for (int j = 0; j < 4; ++j) { const int sidx = tid + 512 * j, hc = sidx >> 7; const float* kp = SK + (size_t)sidx * 128; const float* qq = qs + hc * 128; float s = 0.f;
            for (int d = 0; d < 128; d += 4) { const f32x4 kv = *(const f32x4*)(kp + d); s += qq[d] * kv.x + qq[d + 1] * kv.y + qq[d + 2] * kv.z + qq[d + 3] * kv.w; }
            sc[sidx] = s; }
        __syncthreads();
        if (tid < 16) { const int hc = tid;
            for (int k = 0; k < 16; ++k) { float best = -INFINITY; int bi = 0;
                for (int n = 0; n < 128; ++n) { const float v = sc[hc * 128 + n]; if (v > best) { best = v; bi = n; } }
                sv[hc * 16 + k] = best; si[hc * 16 + k] = bi; sc[hc * 128 + bi] = -INFINITY; } }
        __syncthreads();
        for (int i = tid; i < 2048; i += NTHREADS) { const int h = i >> 8, a = (i >> 4) & 15, b = i & 15; cand[i] = sv[(2 * h) * 16 + a] + sv[(2 * h + 1) * 16 + b]; }
        __syncthreads();
        if (tid < 8) { const int h = tid;
            for (int k = 0; k < 16; ++k) { float best = -INFINITY; int bi = 0;
                for (int n = 0; n < 256; ++n) { const float v = cand[h * 256 + n]; if (v > best) { best = v; bi = n; } }
                tops[h * 16 + k] = best; tope[h * 16 + k] = si[(2 * h) * 16 + (bi >> 4)] * 128 + si[(2 * h + 1) * 16 + (bi & 15)]; cand[h * 256 + bi] = -INFINITY; }
            const float mx = tops[h * 16]; float sum = 0.f;
            for (int k = 0; k < 16; ++k) sum += expf(tops[h * 16 + k] - mx);
            const float inv = 1.f / sum;
            for (int k = 0; k < 16; ++k) ROUTE[((size_t)t * 8 + h) * 16 + k] = make_int2(tope[h * 16 + k], __float_as_int(expf(tops[h * 16 + k] - mx) * inv)); }
    }
}
__device__ __forceinline__ void ph_expert_naive(const bf16* XN, const int2* ROUTE, const float* EU, const float* EV, float* X, float* lds) {
    float* xs = lds; float* ws = xs + 1024; int* es = (int*)(ws + 128); float* gs = (float*)(es + 128);
    const int tid = tidx();
    for (int t = blockIdx.x; t < M; t += gridDim.x) {
        __syncthreads();
        for (int i = tid; i < 1024; i += NTHREADS) xs[i] = bf2f(XN[(size_t)t * 1024 + i]);
        if (tid < 128) { const int2 r = ROUTE[(size_t)t * 128 + tid]; es[tid] = r.x; gs[tid] = __int_as_float(r.y); }
        __syncthreads();
        { const int e = tid >> 2, part = tid & 3; const float* u = EU + (size_t)es[e] * 1024 + part * 4; const float* xx = xs + part * 4; float s = 0.f;
          for (int d = 0; d < 1024; d += 16) { const f32x4 uv = *(const f32x4*)(u + d); s += xx[d] * uv.x + xx[d + 1] * uv.y + xx[d + 2] * uv.z + xx[d + 3] * uv.w; }
          s += __shfl_xor(s, 1); s += __shfl_xor(s, 2);
          const float a = 0.5f * s * (1.f + erff(s * 0.7071067811865476f));
          if (part == 0) ws[e] = gs[e] * a; }
        __syncthreads();
#pragma unroll 1
        for (int j = 0; j < 2; ++j) { const int n = tid + 512 * j; float o = 0.f;
            for (int e = 0; e < 128; ++e) o += ws[e] * EV[(size_t)es[e] * 1024 + n];
            X[(size_t)t * 1024 + n] += o; }
    }
}


namespace peer {
typedef __bf16 bf16x2_t __attribute__((ext_vector_type(2)));
typedef float f32x2_t __attribute__((ext_vector_type(2)));
typedef LAS unsigned char* lptr;
__device__ __forceinline__ float dot2(unsigned a, unsigned b, float c) { return __builtin_amdgcn_fdot2_f32_bf16(__builtin_bit_cast(bf16x2_t, a), __builtin_bit_cast(bf16x2_t, b), c, false); }
template <int CTRL> __device__ __forceinline__ float dpp(float x) { return __builtin_bit_cast(float, __builtin_amdgcn_mov_dpp(__builtin_bit_cast(int, x), CTRL, 0xf, 0xf, true)); }
__device__ __forceinline__ float row16_sum(float x) { x += dpp<0x128>(x); x += dpp<0x124>(x); x += dpp<0x122>(x); x += dpp<0x121>(x); return x; }
__device__ __forceinline__ unsigned fp8lo_bf16(unsigned w) { return __builtin_bit_cast(unsigned, __builtin_amdgcn_cvt_scalef32_pk_bf16_fp8(w, 1.0f, false)); }
__device__ __forceinline__ unsigned fp8hi_bf16(unsigned w) { return __builtin_bit_cast(unsigned, __builtin_amdgcn_cvt_scalef32_pk_bf16_fp8(w, 1.0f, true)); }
__device__ __forceinline__ float dot16(const v4u& u, const v4u& x0, const v4u& x1, float d) {
    d = dot2(fp8lo_bf16(u.x), x0.x, d); d = dot2(fp8hi_bf16(u.x), x0.y, d); d = dot2(fp8lo_bf16(u.y), x0.z, d); d = dot2(fp8hi_bf16(u.y), x0.w, d);
    d = dot2(fp8lo_bf16(u.z), x1.x, d); d = dot2(fp8hi_bf16(u.z), x1.y, d); d = dot2(fp8lo_bf16(u.w), x1.z, d); return dot2(fp8hi_bf16(u.w), x1.w, d);
}
__device__ __forceinline__ void convert_tables(const float* EU, const float* EV, const float* gu, unsigned char* EU8, unsigned char* EV8, float* SI) {
    const int lane = tidx() & 63, wave = tidx() >> 6;
    const int gw = blockIdx.x * NWAVES + wave, NGW = gridDim.x * NWAVES;
    f32x4 gg[4];
#pragma unroll
    for (int j = 0; j < 4; ++j) gg[j] = *(const f32x4*)(gu + 4 * lane + 256 * j);
    for (int r0 = gw * 4; r0 < 2 * 16384; r0 += NGW * 4) {
        f32x4 v[4][4];
#pragma unroll
        for (int q = 0; q < 4; ++q) { const int r = r0 + q; const bool second = r >= 16384; const float* src = (second ? EV : EU) + (size_t)(second ? r - 16384 : r) * 1024 + 4 * lane;
#pragma unroll
            for (int j = 0; j < 4; ++j) v[q][j] = *(const f32x4*)(src + 256 * j); }
#pragma unroll
        for (int q = 0; q < 4; ++q) { const int r = r0 + q; const bool second = r >= 16384; const int row = second ? r - 16384 : r;
            float am = 0.f;
#pragma unroll
            for (int j = 0; j < 4; ++j) { if (!second) v[q][j] = v[q][j] * gg[j];
                am = fmaxf(am, fmaxf(fmaxf(fabsf(v[q][j].x), fabsf(v[q][j].y)), fmaxf(fabsf(v[q][j].z), fabsf(v[q][j].w)))); }
#pragma unroll
            for (int o = 1; o < 64; o <<= 1) am = fmaxf(am, __shfl_xor(am, o));
            const int e = (int)((__float_as_uint(am) >> 23) & 0xffu) - 127;
            const bool ok = am > 1e-30f;
            const float sc = ok ? __uint_as_float((unsigned)(127 + 6 - e) << 23) : 1.f, isc = ok ? __uint_as_float((unsigned)(127 - 6 + e) << 23) : 1.f;
            unsigned char* dst = (second ? EV8 : EU8) + (size_t)row * 1024 + 4 * lane;
#pragma unroll
            for (int j = 0; j < 4; ++j) { int p = __builtin_amdgcn_cvt_pk_fp8_f32(v[q][j].x * sc, v[q][j].y * sc, 0, false); p = __builtin_amdgcn_cvt_pk_fp8_f32(v[q][j].z * sc, v[q][j].w * sc, p, true); *(unsigned*)(dst + 256 * j) = (unsigned)p; }
            if (lane == 0) SI[r] = isc; }
    }
}
__device__ __forceinline__ void expert_phase(const bf16* XG, const float* RS, bf16* XN, const int2* ROUTE, const unsigned char* EU8, const unsigned char* EV8, const float* SI, const float* X, float* XO, const float* g_next, lptr lds) {
    const int lane = tidx() & 63, grp = lane >> 4, li = lane & 15; const int wave = __builtin_amdgcn_readfirstlane(tidx() >> 6);
    LAS int* ids = (LAS int*)(lds + wave * 1536); LAS float* wts = (LAS float*)(ids + 128); LAS float* sus = wts + 128;
    const int gw = blockIdx.x * NWAVES + wave, NGW = gridDim.x * NWAVES;
    for (int t = gw; t < M; t += NGW) {
        v4u xq[8];
#pragma unroll
        for (int j = 0; j < 4; ++j) { const bf16* xp = XG + (size_t)t * 1024 + 256 * j + 16 * li; xq[2 * j] = *(const v4u*)xp; xq[2 * j + 1] = *(const v4u*)(xp + 8); }
        const float rt = rsqrtf(row16_sum(RS[(size_t)t * 16 + li]) * (1.f / D) + EPS);
        { const int2 r0 = ROUTE[(size_t)t * 128 + lane], r1 = ROUTE[(size_t)t * 128 + 64 + lane];
          ids[lane] = r0.x; ids[lane + 64] = r1.x; wts[lane] = __int_as_float(r0.y) * SI[16384 + r0.x]; wts[lane + 64] = __int_as_float(r1.y) * SI[16384 + r1.x]; sus[lane] = SI[r0.x]; sus[lane + 64] = SI[r1.x]; }
        v4u ua[8], ub[8];
#define PEER_ULOAD(buf, b) do { _Pragma("unroll") for (int ps = 0; ps < 2; ++ps) { const unsigned char* up_ = EU8 + (size_t)ids[8 * (b) + 4 * ps + grp] * 1024 + 16 * li; \
            _Pragma("unroll") for (int j = 0; j < 4; ++j) buf[4 * ps + j] = *(const v4u*)(up_ + 256 * j); } } while (0)
#define PEER_UCOMP(buf, b) do { _Pragma("unroll") for (int ps = 0; ps < 2; ++ps) { float d_ = 0.f; \
            _Pragma("unroll") for (int j = 0; j < 4; ++j) d_ = dot16(buf[4 * ps + j], xq[2 * j], xq[2 * j + 1], d_); \
            d_ = row16_sum(d_) * (rt * sus[8 * (b) + 4 * ps + grp]); \
            const float a_ = 0.5f * d_ * (1.f + erff(d_ * 0.7071067811865476f)); if (li == 0) wts[8 * (b) + 4 * ps + grp] *= a_; } } while (0)
        PEER_ULOAD(ua, 0);
#pragma unroll 1
        for (int b = 0; b < 16; b += 2) {
            PEER_ULOAD(ub, b + 1);
            PEER_UCOMP(ua, b);
            if (b + 2 < 16) PEER_ULOAD(ua, b + 2);
            PEER_UCOMP(ub, b + 1);
        }
#undef PEER_ULOAD
#undef PEER_UCOMP
        float acc[16];
#pragma unroll
        for (int i = 0; i < 16; ++i) acc[i] = 0.f;
        v4u va[8], vb[8];
#define PEER_VLOAD(buf, b) do { _Pragma("unroll") for (int k = 0; k < 8; ++k) buf[k] = *(const v4u*)(EV8 + (size_t)ids[8 * (b) + k] * 1024 + 16 * lane); } while (0)
#define PEER_VCOMP(buf, b) do { _Pragma("unroll") for (int k = 0; k < 8; ++k) { const float w_ = wts[8 * (b) + k]; const v4u q_ = buf[k]; \
            const unsigned qq_[4] = {q_.x, q_.y, q_.z, q_.w}; \
            _Pragma("unroll") for (int i = 0; i < 4; ++i) { const f32x2_t lo_ = __builtin_amdgcn_cvt_pk_f32_fp8((int)qq_[i], false), hi_ = __builtin_amdgcn_cvt_pk_f32_fp8((int)qq_[i], true); \
                acc[4 * i + 0] = fmaf(w_, lo_.x, acc[4 * i + 0]); acc[4 * i + 1] = fmaf(w_, lo_.y, acc[4 * i + 1]); acc[4 * i + 2] = fmaf(w_, hi_.x, acc[4 * i + 2]); acc[4 * i + 3] = fmaf(w_, hi_.y, acc[4 * i + 3]); } } } while (0)
        PEER_VLOAD(va, 0);
#pragma unroll 1
        for (int b = 0; b < 16; b += 2) {
            PEER_VLOAD(vb, b + 1);
            PEER_VCOMP(va, b);
            if (b + 2 < 16) PEER_VLOAD(va, b + 2);
            PEER_VCOMP(vb, b + 1);
        }
#undef PEER_VLOAD
#undef PEER_VCOMP
        { const float* xi = X + (size_t)t * 1024 + 16 * lane; float* xo = XO + (size_t)t * 1024 + 16 * lane;
#pragma unroll
          for (int i = 0; i < 4; ++i) { f32x4 a = *(const f32x4*)(xi + 4 * i); a.x += acc[4 * i + 0]; a.y += acc[4 * i + 1]; a.z += acc[4 * i + 2]; a.w += acc[4 * i + 3]; *(f32x4*)(xo + 4 * i) = a;
              acc[4 * i + 0] = a.x; acc[4 * i + 1] = a.y; acc[4 * i + 2] = a.z; acc[4 * i + 3] = a.w; }
          float ss = 0.f;
#pragma unroll
          for (int i = 0; i < 16; ++i) ss += acc[i] * acc[i];
          const float rn = rsqrtf(wave_sum(ss) * (1.f / D) + EPS);
          const float* gp = g_next + 16 * lane; v4u w0, w1;
          w0.x = pk2(acc[0] * rn * gp[0], acc[1] * rn * gp[1]); w0.y = pk2(acc[2] * rn * gp[2], acc[3] * rn * gp[3]); w0.z = pk2(acc[4] * rn * gp[4], acc[5] * rn * gp[5]); w0.w = pk2(acc[6] * rn * gp[6], acc[7] * rn * gp[7]);
          w1.x = pk2(acc[8] * rn * gp[8], acc[9] * rn * gp[9]); w1.y = pk2(acc[10] * rn * gp[10], acc[11] * rn * gp[11]); w1.z = pk2(acc[12] * rn * gp[12], acc[13] * rn * gp[13]); w1.w = pk2(acc[14] * rn * gp[14], acc[15] * rn * gp[15]);
          bf16* xnp = XN + (size_t)t * 1024 + 16 * lane; *(v4u*)xnp = w0; *(v4u*)(xnp + 8) = w1; }
    }
}

template <int P>
__device__ __forceinline__ void expert_phase_mp(const bf16* XG, const float* RS, bf16* XN, const int2* ROUTE, const unsigned char* EU8, const unsigned char* EV8, const float* SI,
                                                const float* X, float* XO, const float* g_next, lptr lds) {
    constexpr int SH = (P == 8) ? 11 : (P == 4) ? 12 : (P == 2) ? 13 : 14;
    const int lane = tidx() & 63, grp = lane >> 4, li = lane & 15; const int wave = __builtin_amdgcn_readfirstlane(tidx() >> 6);
    lptr wl = lds + wave * 15616;
    lptr XS = wl;
    LAS unsigned* FLE = (LAS unsigned*)(wl + 8192);
    LAS float* SW = (LAS float*)(wl + 8192 + 3072);
    LAS float* RT = (LAS float*)(wl + 8192 + 3072 + 2048);
    LAS int* QS = (LAS int*)(wl + 8192 + 3072 + 2048 + 16);
    LAS float* SU = (LAS float*)(wl + 8192 + 3072 + 2048 + 16 + 48);
    const int gw = blockIdx.x * NWAVES + wave, NGW = gridDim.x * NWAVES;
    const unsigned long long ltmask = (1ull << lane) - 1ull;
#pragma unroll 1
    for (int g4 = 0; g4 < 2; ++g4) {
        int tk[4];
#pragma unroll
        for (int k = 0; k < 4; ++k) tk[k] = gw + (g4 * 4 + k) * NGW;
        int2 e0[4], e1[4];
#pragma unroll
        for (int k = 0; k < 4; ++k) {
            const v4u a = *(const v4u*)(XG + (size_t)tk[k] * 1024 + 16 * lane), b = *(const v4u*)(XG + (size_t)tk[k] * 1024 + 16 * lane + 8);
            *(LAS v4u*)(XS + k * 2048 + 32 * lane) = a; *(LAS v4u*)(XS + k * 2048 + 32 * lane + 16) = b;
            e0[k] = ROUTE[(size_t)tk[k] * 128 + lane]; e1[k] = ROUTE[(size_t)tk[k] * 128 + 64 + lane];
            SW[k * 128 + lane] = __int_as_float(e0[k].y) * SI[16384 + e0[k].x]; SW[k * 128 + 64 + lane] = __int_as_float(e1[k].y) * SI[16384 + e1[k].x];
            SU[k * 128 + lane] = SI[e0[k].x]; SU[k * 128 + 64 + lane] = SI[e1[k].x];
            const float r = rsqrtf(row16_sum(RS[(size_t)tk[k] * 16 + li]) * (1.f / D) + EPS); if (lane == 0) RT[k] = r;
        }
        int qbase = 0;
#pragma unroll 1
        for (int p = 0; p < P; ++p) {
            if (lane == 0) QS[p] = qbase;
            int base = 4 * qbase;
#pragma unroll
            for (int k = 0; k < 4; ++k) {
                const bool in0 = (e0[k].x >> SH) == p, in1 = (e1[k].x >> SH) == p;
                const unsigned long long m0 = __ballot(in0), m1 = __ballot(in1);
                const int c0 = __popcll(m0), c1 = __popcll(m1), n = c0 + c1, npad = (n + 3) & ~3;
                if (in0) FLE[base + __popcll(m0 & ltmask)] = (unsigned)e0[k].x | 0x4000u | ((unsigned)(k * 128 + lane) << 16);
                if (in1) FLE[base + c0 + __popcll(m1 & ltmask)] = (unsigned)e1[k].x | 0x4000u | ((unsigned)(k * 128 + 64 + lane) << 16);
                if (lane < npad - n) FLE[base + n + lane] = (unsigned)(p << SH) | ((unsigned)(k * 128) << 16);
                base += npad;
            }
            { const int nq = base >> 2, ext = (4 - (nq & 3)) & 3;
              if (lane < 4 * ext) FLE[base + lane] = (unsigned)(p << SH) | ((unsigned)(3 * 128) << 16); base += 4 * ext; }
            qbase = base >> 2;
        }
        if (lane == 0) QS[P] = qbase;
        v4u ua[8], ub[8]; unsigned ea[2], eb_[2];
#define MP_ULOAD(buf, ent, q) do { _Pragma("unroll") for (int h2 = 0; h2 < 2; ++h2) { ent[h2] = FLE[4 * ((q) + h2) + grp]; const unsigned char* up_ = EU8 + (size_t)(ent[h2] & 0x3FFFu) * 1024 + 16 * li; \
            _Pragma("unroll") for (int j = 0; j < 4; ++j) buf[4 * h2 + j] = *(const v4u*)(up_ + 256 * j); } } while (0)
#define MP_UCOMP(buf, ent) do { _Pragma("unroll") for (int h2 = 0; h2 < 2; ++h2) { const int tok_ = (int)(ent[h2] >> 23) & 3; lptr xp_ = XS + tok_ * 2048 + 32 * li; float d_ = 0.f; \
            _Pragma("unroll") for (int j = 0; j < 4; ++j) { const v4u x0_ = *(const LAS v4u*)(xp_ + 512 * j), x1_ = *(const LAS v4u*)(xp_ + 512 * j + 16); d_ = dot16(buf[4 * h2 + j], x0_, x1_, d_); } \
            d_ = row16_sum(d_) * (RT[tok_] * SU[(ent[h2] >> 16) & 511u]); \
            const float a_ = 0.5f * d_ * (1.f + erff(d_ * 0.7071067811865476f)); if (li == 0 && (ent[h2] & 0x4000u)) SW[ent[h2] >> 16] *= a_; } } while (0)
#pragma unroll 1
        for (int p = 0; p < P; ++p) {
            const int q0 = QS[p], q1 = QS[p + 1];
            if (q0 < q1) {
                MP_ULOAD(ua, ea, q0);
#pragma unroll 1
                for (int q = q0; q < q1; q += 4) {
                    MP_ULOAD(ub, eb_, q + 2);
                    MP_UCOMP(ua, ea);
                    if (q + 4 < q1) MP_ULOAD(ua, ea, q + 4);
                    MP_UCOMP(ub, eb_);
                }
            }
        }
#undef MP_ULOAD
#undef MP_UCOMP
        float acc[4][16];
#pragma unroll
        for (int k = 0; k < 4; ++k)
#pragma unroll
            for (int i = 0; i < 16; ++i) acc[k][i] = 0.f;
        v4u va[8], vb[8]; unsigned na[8], nb[8];
#define MP_VLOAD(buf, ents, q) do { _Pragma("unroll") for (int r = 0; r < 8; ++r) { ents[r] = FLE[4 * (q) + r]; buf[r] = *(const v4u*)(EV8 + (size_t)(ents[r] & 0x3FFFu) * 1024 + 16 * lane); } } while (0)
#define MP_VACC(K, buf, ents, R0) do { _Pragma("unroll") for (int r = R0; r < R0 + 4; ++r) { const float w_ = (ents[r] & 0x4000u) ? SW[ents[r] >> 16] : 0.f; const v4u q_ = buf[r]; \
            const unsigned qq_[4] = {q_.x, q_.y, q_.z, q_.w}; \
            _Pragma("unroll") for (int i = 0; i < 4; ++i) { const f32x2_t lo_ = __builtin_amdgcn_cvt_pk_f32_fp8((int)qq_[i], false), hi_ = __builtin_amdgcn_cvt_pk_f32_fp8((int)qq_[i], true); \
                acc[K][4 * i + 0] = fmaf(w_, lo_.x, acc[K][4 * i + 0]); acc[K][4 * i + 1] = fmaf(w_, lo_.y, acc[K][4 * i + 1]); acc[K][4 * i + 2] = fmaf(w_, hi_.x, acc[K][4 * i + 2]); acc[K][4 * i + 3] = fmaf(w_, hi_.y, acc[K][4 * i + 3]); } } } while (0)
#define MP_VCOMP1(buf, ents, R0) do { const int tok_ = __builtin_amdgcn_readfirstlane((int)(ents[R0] >> 23) & 3); \
            if (tok_ == 0) MP_VACC(0, buf, ents, R0); else if (tok_ == 1) MP_VACC(1, buf, ents, R0); else if (tok_ == 2) MP_VACC(2, buf, ents, R0); else MP_VACC(3, buf, ents, R0); } while (0)
#define MP_VCOMP(buf, ents) do { MP_VCOMP1(buf, ents, 0); MP_VCOMP1(buf, ents, 4); } while (0)
#pragma unroll 1
        for (int p = 0; p < P; ++p) {
            const int q0 = QS[p], q1 = QS[p + 1];
            if (q0 < q1) {
                MP_VLOAD(va, na, q0);
#pragma unroll 1
                for (int q = q0; q < q1; q += 4) {
                    MP_VLOAD(vb, nb, q + 2);
                    MP_VCOMP(va, na);
                    if (q + 4 < q1) MP_VLOAD(va, na, q + 4);
                    MP_VCOMP(vb, nb);
                }
            }
        }
#undef MP_VLOAD
#undef MP_VACC
#undef MP_VCOMP1
#undef MP_VCOMP
#pragma unroll
        for (int k = 0; k < 4; ++k) {
            const float* xi = X + (size_t)tk[k] * 1024 + 16 * lane; float* xo = XO + (size_t)tk[k] * 1024 + 16 * lane;
            float ss = 0.f;
#pragma unroll
            for (int i = 0; i < 4; ++i) { f32x4 a = *(const f32x4*)(xi + 4 * i); a.x += acc[k][4 * i + 0]; a.y += acc[k][4 * i + 1]; a.z += acc[k][4 * i + 2]; a.w += acc[k][4 * i + 3]; *(f32x4*)(xo + 4 * i) = a;
                acc[k][4 * i + 0] = a.x; acc[k][4 * i + 1] = a.y; acc[k][4 * i + 2] = a.z; acc[k][4 * i + 3] = a.w; ss += (a.x * a.x + a.y * a.y) + (a.z * a.z + a.w * a.w); }
            const float rn = rsqrtf(wave_sum(ss) * (1.f / D) + EPS);
            const float* gp = g_next + 16 * lane; v4u w0, w1;
            w0.x = pk2(acc[k][0] * rn * gp[0], acc[k][1] * rn * gp[1]); w0.y = pk2(acc[k][2] * rn * gp[2], acc[k][3] * rn * gp[3]); w0.z = pk2(acc[k][4] * rn * gp[4], acc[k][5] * rn * gp[5]); w0.w = pk2(acc[k][6] * rn * gp[6], acc[k][7] * rn * gp[7]);
            w1.x = pk2(acc[k][8] * rn * gp[8], acc[k][9] * rn * gp[9]); w1.y = pk2(acc[k][10] * rn * gp[10], acc[k][11] * rn * gp[11]); w1.z = pk2(acc[k][12] * rn * gp[12], acc[k][13] * rn * gp[13]); w1.w = pk2(acc[k][14] * rn * gp[14], acc[k][15] * rn * gp[15]);
            bf16* xnp = XN + (size_t)tk[k] * 1024 + 16 * lane; *(v4u*)xnp = w0; *(v4u*)(xnp + 8) = w1;
        }
    }
}
}


namespace route {
typedef short bf16x8 __attribute__((ext_vector_type(8)));
typedef float f32x16 __attribute__((ext_vector_type(16)));
typedef LAS unsigned char* lptr;
__device__ __forceinline__ unsigned f2sort(float f) { const unsigned u = __float_as_uint(f); return (u & 0x80000000u) ? ~u : (u | 0x80000000u); }
__device__ __forceinline__ float sort2f(unsigned s) { return __uint_as_float((s & 0x80000000u) ? (s & 0x7fffffffu) : ~s); }
__device__ __forceinline__ unsigned umax_(unsigned a, unsigned b) { return a > b ? a : b; }
__device__ __forceinline__ unsigned umin_(unsigned a, unsigned b) { return a < b ? a : b; }
__device__ __forceinline__ unsigned selu(int hi, unsigned a, unsigned b) { asm volatile("" : "+v"(a), "+v"(b)); return hi ? b : a; }
__device__ __forceinline__ float self(int hi, float a, float b) { asm volatile("" : "+v"(a), "+v"(b)); return hi ? b : a; }
__device__ __forceinline__ unsigned partner32(unsigned x, int hi) { auto r = __builtin_amdgcn_permlane32_swap(x, x, false, false); return hi ? r[0] : r[1]; }
__device__ __forceinline__ void sort16_desc(unsigned (&x)[16]) {
#pragma unroll
    for (int k = 2; k <= 16; k <<= 1)
#pragma unroll
        for (int j = k >> 1; j > 0; j >>= 1)
#pragma unroll
            for (int i = 0; i < 16; ++i) { const int l = i ^ j; if (l > i) { const bool desc = ((i & k) == 0); const unsigned a = x[i], b = x[l], mx = umax_(a, b), mn = umin_(a, b); x[i] = desc ? mx : mn; x[l] = desc ? mn : mx; } }
}
__device__ __forceinline__ void merge_top16(unsigned (&a)[16], const unsigned (&b)[16]) {
#pragma unroll
    for (int i = 0; i < 16; ++i) a[i] = umax_(a[i], b[15 - i]);
#pragma unroll
    for (int j = 8; j > 0; j >>= 1)
#pragma unroll
        for (int i = 0; i < 16; ++i) { const int l = i ^ j; if (l > i) { const unsigned p = a[i], q = a[l]; a[i] = umax_(p, q); a[l] = umin_(p, q); } }
}
__device__ __forceinline__ void convert_subkeys(const float* SK, bf16* SKB) {
    const int n8 = 16 * 128 * 128 / 8, stride = gridDim.x * NTHREADS;
    for (int i = blockIdx.x * NTHREADS + tidx(); i < n8; i += stride) { const f32x4 a = *(const f32x4*)(SK + (size_t)i * 8), b = *(const f32x4*)(SK + (size_t)i * 8 + 4);
        v4u o; o.x = pk2(a.x, a.y); o.y = pk2(a.z, a.w); o.z = pk2(b.x, b.y); o.w = pk2(b.z, b.w); *(v4u*)(SKB + (size_t)i * 8) = o; }
}
__device__ __forceinline__ void route_phase(const bf16* QP, const bf16* SKB, const float* RS, int2* ROUTE, lptr lds) {
    const int lane = tidx() & 63, r32 = lane & 31, hi = lane >> 5; const int wave = __builtin_amdgcn_readfirstlane(tidx() >> 6);
    LAS int* myl = (LAS int*)(lds + wave * 8448) + lane * 33;
    const int gw = blockIdx.x * NWAVES + wave, NGW = gridDim.x * NWAVES;
    for (int it = gw; it < 4096; it += NGW) {
        const int tb = it >> 3, h = it & 7, token = tb * 32 + r32;
        unsigned top0[16], top1[16];
#pragma unroll
        for (int i = 0; i < 16; ++i) { top0[i] = 0u; top1[i] = 0u; }
#pragma unroll
        for (int c = 0; c < 2; ++c) {
            const int hc = h * 2 + c;
            bf16x8 qf[8];
#pragma unroll
            for (int ks = 0; ks < 8; ++ks) qf[ks] = *(const bf16x8*)(QP + (size_t)token * 2048 + hc * 128 + 16 * ks + 8 * hi);
#pragma unroll 1
            for (int kt = 0; kt < 4; ++kt) {
                const bf16* ap = SKB + ((size_t)(hc * 128 + 32 * kt + r32)) * 128 + 8 * hi;
                f32x16 acc = f32x16{};
#pragma unroll
                for (int ks = 0; ks < 8; ++ks) { const bf16x8 a = *(const bf16x8*)(ap + 16 * ks); acc = __builtin_amdgcn_mfma_f32_32x32x16_bf16(a, qf[ks], acc, 0, 0, 0); }
                const unsigned code0 = 127u - (unsigned)(32 * kt + 4 * hi);
                unsigned pt[16];
#pragma unroll
                for (int r = 0; r < 16; ++r) pt[r] = (f2sort(acc[r]) & ~0x7Fu) | (code0 - (unsigned)((r & 3) + 8 * (r >> 2)));
                sort16_desc(pt);
                if (c == 0) merge_top16(top0, pt); else merge_top16(top1, pt);
            }
            { unsigned oth[16];
#pragma unroll
              for (int i = 0; i < 16; ++i) oth[i] = partner32(c == 0 ? top0[i] : top1[i], hi);
              if (c == 0) merge_top16(top0, oth); else merge_top16(top1, oth); }
        }
#pragma unroll
        for (int i = 0; i < 16; ++i) { myl[i] = 127 - (int)(top0[i] & 0x7Fu); myl[16 + i] = 127 - (int)(top1[i] & 0x7Fu); }
        float a1[16], ai[8];
#pragma unroll
        for (int i = 0; i < 16; ++i) a1[i] = sort2f(top1[i] & ~0x7Fu);
#pragma unroll
        for (int i = 0; i < 8; ++i) ai[i] = sort2f(selu(hi, top0[i], top0[8 + i]) & ~0x7Fu);
        unsigned top2[16];
#pragma unroll
        for (int i = 0; i < 16; ++i) top2[i] = 0u;
#pragma unroll
        for (int ii = 0; ii < 8; ++ii) {
            unsigned rw[16];
#pragma unroll
            for (int j = 0; j < 16; ++j) rw[j] = (f2sort(ai[ii] + a1[j]) & ~0xFFu) | (255u - (unsigned)(128 * hi + 16 * ii + j));
            merge_top16(top2, rw);
        }
        { unsigned oth[16];
#pragma unroll
          for (int i = 0; i < 16; ++i) oth[i] = partner32(top2[i], hi);
          merge_top16(top2, oth); }
        float rt; { const f32x4* rp = (const f32x4*)(RS + (size_t)token * 16); const f32x4 a = rp[0], b = rp[1], c = rp[2], d = rp[3];
            rt = rsqrtf((((a.x + a.y) + (a.z + a.w)) + ((b.x + b.y) + (b.z + b.w)) + ((c.x + c.y) + (c.z + c.w)) + ((d.x + d.y) + (d.z + d.w))) * (1.f / D) + EPS); }
        const float mx = sort2f(top2[0] & ~0xFFu);
        float ex[16], sum = 0.f;
#pragma unroll
        for (int k = 0; k < 16; ++k) { ex[k] = __expf(rt * (sort2f(top2[k] & ~0xFFu) - mx)); sum += ex[k]; }
        const float inv = 1.f / sum;
        int2* dst = ROUTE + ((size_t)token * 8 + h) * 16 + 8 * hi;
#pragma unroll
        for (int k = 0; k < 8; k += 2) {
            const unsigned p0 = selu(hi, top2[k], top2[8 + k]), p1 = selu(hi, top2[k + 1], top2[9 + k]);
            const float g0 = self(hi, ex[k], ex[8 + k]) * inv, g1 = self(hi, ex[k + 1], ex[9 + k]) * inv;
            const int pos0 = 255 - (int)(p0 & 0xFFu), pos1 = 255 - (int)(p1 & 0xFFu);
            const int e0 = myl[pos0 >> 4] * 128 + myl[16 + (pos0 & 15)], e1 = myl[pos1 >> 4] * 128 + myl[16 + (pos1 & 15)];
            v4u o; o.x = (unsigned)e0; o.y = __float_as_uint(g0); o.z = (unsigned)e1; o.w = __float_as_uint(g1);
            *(v4u*)(dst + k) = o;
        }
    }
}
}


__device__ __forceinline__ void ph_qk_norms(const bf16* QA, const bf16* KA, unsigned* norms) {
    const int lane = tidx() & 63, wave = tidx() >> 6;
    const int gw = blockIdx.x * NWAVES + wave, NGW = gridDim.x * NWAVES;
    for (int m0 = gw * 8; m0 < M; m0 += NGW * 8) {
        v4u q[8], k[8];
#pragma unroll
        for (int r = 0; r < 8; ++r) { q[r] = *(const v4u*)(QA + (size_t)(m0 + r) * 512 + lane * 8); k[r] = *(const v4u*)(KA + (size_t)(m0 + r) * 512 + lane * 8); }
        float mq = 0.f, mk = 0.f, md = -INFINITY;
#pragma unroll
        for (int r = 0; r < 8; ++r) {
            const unsigned qa[4] = {q[r].x, q[r].y, q[r].z, q[r].w}, ka[4] = {k[r].x, k[r].y, k[r].z, k[r].w};
            float sq = 0.f, sk = 0.f, sd = 0.f;
#pragma unroll
            for (int i = 0; i < 4; ++i) { const float a = bf2f(qa[i] & 0xffffu), b = bf2f(qa[i] >> 16), c = bf2f(ka[i] & 0xffffu), d = bf2f(ka[i] >> 16); sq += a * a + b * b; sk += c * c + d * d; sd += a * c + b * d; }
#pragma unroll
            for (int o = 1; o < 8; o <<= 1) { sq += __shfl_xor(sq, o); sk += __shfl_xor(sk, o); sd += __shfl_xor(sd, o); }
            mq = fmaxf(mq, sq); mk = fmaxf(mk, sk); md = fmaxf(md, -sd);
        }
        if ((lane & 7) == 0) { const int hv = lane >> 3, qb = m0 >> 8;
            atomicMax(norms + hv, __float_as_uint(mk)); atomicMax(norms + 16 + hv * 64 + qb, __float_as_uint(mq)); atomicMax(norms + 528 + hv * 64 + qb, f2sortu(md)); }
    }
}

constexpr int NPHASE = 12;
struct Args { const float* in[24]; float* out; unsigned char* ws; int ph_lo, ph_hi, use_bar, pad; };

__global__ void __launch_bounds__(NTHREADS, 2) mk_fwd(Args args) {
    extern __shared__ __attribute__((aligned(16))) unsigned char lds_raw[];
    float* lds = (float*)lds_raw;
    volatile LAS unsigned* MISC = (volatile LAS unsigned*)((LAS unsigned char*)lds_raw + (LDS_BYTES - 64));
    unsigned char* ws = args.ws;
    unsigned* ctl = (unsigned*)(ws + WS_CTL);
    const float* x = args.in[0]; const float* p = args.in[1]; const float* norm_mix_g = args.in[2]; const float* w_in = args.in[3];
    const float* conv_w = args.in[4]; const float* conv_b = args.in[5]; const float* b_ig = args.in[6]; const float* b_fg = args.in[7];
    const float* lq1 = args.in[8]; const float* lk1 = args.in[9]; const float* lq2 = args.in[10]; const float* lk2 = args.in[11];
    const float* subln_g = args.in[12]; const float* ml_g = args.in[13]; const float* w_out = args.in[14]; const float* norm_ffn_g = args.in[15];
    const float* w_query = args.in[16]; const float* sub_keys = args.in[17]; const float* expert_u = args.in[18]; const float* expert_v = args.in[19];
    const float* norm_ple_g = args.in[20]; const float* w_ple_gate = args.in[21]; const float* w_ple_proj = args.in[22]; const float* final_g = args.in[23];
    float* out = args.out;
    bf16* XN = (bf16*)(ws + WS_XN); float* GATES = (float*)(ws + WS_GATES);
    bf16* QA = (bf16*)(ws + WS_QA); bf16* KA = (bf16*)(ws + WS_KA); bf16* VA = (bf16*)(ws + WS_VA);
    bf16* MQ = (bf16*)(ws + WS_MQ); bf16* MK = (bf16*)(ws + WS_MK); bf16* MV = (bf16*)(ws + WS_MV); bf16* MO = (bf16*)(ws + WS_MO);
    bf16* O1 = (bf16*)(ws + WS_O1); bf16* O2 = (bf16*)(ws + WS_O2); bf16* CQ = (bf16*)(ws + WS_CQ); bf16* CK = (bf16*)(ws + WS_CK);
    float* HS = (float*)(ws + WS_HS); bf16* ACAT = (bf16*)(ws + WS_ACAT); bf16* QP = (bf16*)(ws + WS_QP); int2* ROUTE = (int2*)(ws + WS_ROUTE);
    bf16* PB = (bf16*)(ws + WS_PB); bf16* PP = (bf16*)(ws + WS_PP);
    float* ST = (float*)(ws + WS_ST);
    bf16* SKB = (bf16*)(ws + WS_SKB);
    unsigned char* EU8 = ws + WS_EU8; unsigned char* EV8 = ws + WS_EV8; float* SI = (float*)(ws + WS_SI);
    float* RS = (float*)(ws + WS_RS); bf16* X1G = (bf16*)(ws + WS_X1G); bf16* XN3 = (bf16*)(ws + WS_XN3);
    bf16* WIN = (bf16*)(ws + WS_WIN); bf16* WOUT = (bf16*)(ws + WS_WOUT); bf16* WQ = (bf16*)(ws + WS_WQ); bf16* WG = (bf16*)(ws + WS_WG); bf16* WP = (bf16*)(ws + WS_WP);
    LAS unsigned char* ldsb = (LAS unsigned char*)lds_raw;

    XcdBarrier bar; bar.bar = ctl + CW_BAR; bar.x = 0; bar.st = nullptr;
    if (args.use_bar) {
        if (tidx() < 16) MISC[tidx()] = 0u;
        __syncthreads();
        bar = xcd_barrier_post(ctl + CW_BAR, MISC + 8);
    }
    const int lo = args.ph_lo, hi = args.ph_hi;
#define IN(k) (lo <= (k) && (k) < hi)
#define SEAM(k) do { if (IN(k) && IN((k) + 1)) xcd_barrier(bar); } while (0)

    if (IN(0)) { route::convert_subkeys(sub_keys, SKB); ph_weights_in(w_in, WIN, ldsb);
        for (int ch = blockIdx.x; ch < WCH_CHUNKS; ch += gridDim.x) weights_chunk(ch, w_out, w_query, norm_ffn_g, w_ple_gate, w_ple_proj, WOUT, WQ, WG, WP, ldsb);
        ph_rmsnorm_bf16(x, norm_mix_g, XN);
        { const size_t n = (size_t)M * PLE / 8, stride = (size_t)gridDim.x * NTHREADS;
          for (size_t i = (size_t)blockIdx.x * NTHREADS + tidx(); i < n; i += stride) { const f32x4 a = *(const f32x4*)(p + i * 8), b = *(const f32x4*)(p + i * 8 + 4);
              v4u o; o.x = pk2(a.x, a.y); o.y = pk2(a.z, a.w); o.z = pk2(b.x, b.y); o.w = pk2(b.z, b.w); *(v4u*)(PB + i * 8) = o; } }
    } SEAM(0);
    if (IN(1)) {
        pg8::Gemm g{XN, WIN, M, NINP, D}; pg8::StaticOrder S; S.init(M, NINP, (int)gridDim.x, (int)blockIdx.x);
        pg8::EpiProj E{QA, (size_t)(WS_KA - WS_QA) / 2, C2, GATES};
        pg8::gemm_phase<pg8::EpiProj, pg8::StaticOrder, true, true>(ldsb, g, S, E);
    } SEAM(1);
    if (IN(2)) { ph_qk_norms(QA, KA, ctl + CW_NORM); ml::conv_items(MQ, MK, conv_w, conv_b, CQ, CK); } SEAM(2);
    if (IN(3)) {
        constexpr int Q_ATT = 1024, Q_END = Q_ATT + 256;
        for (;;) {
            __syncthreads();
            if (tidx() == 0) MISC[0] = __hip_atomic_fetch_add(ctl + CW_QUEUE, 1u, __ATOMIC_RELAXED, __HIP_MEMORY_SCOPE_AGENT);
            __syncthreads();
            const int u = (int)__builtin_amdgcn_readfirstlane(MISC[0]);
            if (u >= Q_END) break;
            if (u < Q_ATT) attn_body::attn_dispatch<8>(u, (char*)lds_raw, (const attn_body::bf16*)QA, (const attn_body::bf16*)KA, (const attn_body::bf16*)VA, (attn_body::bf16*)O1, (attn_body::bf16*)O2, ctl + CW_NORM);
            else ml::b1_item(u - Q_ATT, CK, MV, GATES, b_ig, b_fg, ST, ldsb);
        }
    } SEAM(3);
    if (IN(4)) { ml::phase_b2(ST); peer::convert_tables(expert_u, expert_v, norm_ffn_g, EU8, EV8, SI); } SEAM(4);
    if (IN(5)) { ml::phase_b3(CQ, CK, MV, MO, GATES, b_ig, b_fg, ml_g, ST, ACAT, ldsb); ph_combine<false>(O1, O2, MO, HS, lq1, lk1, lq2, lk2, subln_g, ml_g, ACAT); } SEAM(5);
    if (IN(6)) {
        pg8::Gemm g{ACAT, WOUT, M, D, D}; pg8::StaticOrder S; S.init(M, D, (int)gridDim.x, (int)blockIdx.x);
        pg8::EpiResX1 E{x, out, X1G, RS, D};
        pg8::gemm_phase<pg8::EpiResX1, pg8::StaticOrder, true, true>(ldsb, g, S, E);
    } SEAM(6);
    if (IN(7)) {
        { pg8::Gemm g{X1G, WQ, M, NQ, D}; pg8::StaticOrder S; S.init(M, NQ, (int)gridDim.x, (int)blockIdx.x);
          pg8::EpiBf16<0> E{QP, NQ, nullptr, 0, 0, 1.f};
          pg8::gemm_phase<pg8::EpiBf16<0>, pg8::StaticOrder, true, true>(ldsb, g, S, E); }
        { pg8::Gemm g{PB, WP, M, D, PLE}; pg8::StaticOrder S; S.init(M, D, (int)gridDim.x, (int)blockIdx.x);
          pg8::EpiBf16<0> E{PP, D, nullptr, 0, 0, 1.f};
          pg8::gemm_phase<pg8::EpiBf16<0>, pg8::StaticOrder, true, true>(ldsb, g, S, E); }
    } SEAM(7);
    if (IN(8)) { route::route_phase(QP, SKB, RS, ROUTE, ldsb); } SEAM(8);
    if (IN(9)) { peer::expert_phase_mp<4>(X1G, RS, XN3, ROUTE, EU8, EV8, SI, out, out, norm_ple_g, ldsb); } SEAM(9);
    if (IN(10)) {
        pg8::Gemm g{XN3, WG, M, D, D}; pg8::StaticOrder S; S.init(M, D, (int)gridDim.x, (int)blockIdx.x);
        pg8::EpiGateFinal E{PP, out, D};
        pg8::gemm_phase<pg8::EpiGateFinal, pg8::StaticOrder, true, true>(ldsb, g, S, E);
    } SEAM(10);
    if (IN(11)) { ph_rmsnorm_f32_inplace(out, final_g); }
#undef IN
#undef SEAM
}

extern "C" void kernel_launch(void* const* d_in, const int* in_sizes, int n_in, void* d_out, int out_size, void* d_ws, size_t ws_size, hipStream_t stream) {
    static int grid = 0;
    if (grid == 0) {
        if (n_in != 24 || in_sizes[0] != M * D || out_size != M * D || ws_size < WS_END) { fprintf(stderr, "kernel_launch: unexpected shapes (n_in %d, in0 %d, out %d, ws %zu)\n", n_in, n_in > 0 ? in_sizes[0] : -1, out_size, ws_size); grid = -1; return; }
        int dev = 0, cus = 0;
        if (hipGetDevice(&dev) != hipSuccess || hipDeviceGetAttribute(&cus, hipDeviceAttributeMultiprocessorCount, dev) != hipSuccess) { grid = -1; return; }
        if (hipFuncSetAttribute((const void*)mk_fwd, hipFuncAttributeMaxDynamicSharedMemorySize, LDS_BYTES) != hipSuccess) { fprintf(stderr, "kernel_launch: hipFuncSetAttribute failed\n"); grid = -1; return; }
        (void)hipGetLastError();
        grid = cus;
    }
    if (grid < 0) return;
    if (hipMemsetAsync((char*)d_ws + WS_CTL, 0, CTL_ZERO_BYTES, stream) != hipSuccess) return;
    Args a{};
    for (int i = 0; i < 24; ++i) a.in[i] = (const float*)d_in[i];
    a.out = (float*)d_out; a.ws = (unsigned char*)d_ws;
#if MK_ONE_LAUNCH
    a.ph_lo = 0; a.ph_hi = NPHASE; a.use_bar = 1;
    hipLaunchKernelGGL(mk_fwd, dim3(grid), dim3(NTHREADS), LDS_BYTES, stream, a);
#else
    for (int ph = 0; ph < NPHASE; ++ph) {
        a.ph_lo = ph; a.ph_hi = ph + 1; a.use_bar = 0;
        hipLaunchKernelGGL(mk_fwd, dim3(grid), dim3(NTHREADS), LDS_BYTES, stream, a);
    }
#endif
}
```

```cpp
#include <hip/hip_runtime.h>
#include <cstdio>
#include <cstdint>
#include <cmath>

#ifndef MK_ONE_LAUNCH
#define MK_ONE_LAUNCH 1
#endif

constexpr int M = 16384, D = 1024, NIN = 3592, PLE = 256;
constexpr int NQ = 2048;
constexpr float EPS = 1e-6f;
constexpr float LOG2E = 1.4426950408889634f;
constexpr float C2 = 0.125f * LOG2E;
constexpr float LAMBDA_INIT = 0.2f;
constexpr int NWAVES = 8, NTHREADS = 512;
constexpr int LDS_BYTES = 147456;

typedef unsigned short bf16;
typedef float f32x4 __attribute__((ext_vector_type(4)));
typedef unsigned v4u __attribute__((ext_vector_type(4)));
typedef unsigned v2u __attribute__((ext_vector_type(2)));
#define LAS __attribute__((address_space(3)))

constexpr size_t MiB = 1u << 20;
constexpr size_t WS_CTL = 0, CTL_ZERO_BYTES = 1 * MiB;
constexpr size_t WS_WIN = 1 * MiB, WS_WOUT = 9 * MiB, WS_WQ = 11 * MiB, WS_WG = 15 * MiB, WS_WP = 18 * MiB;
constexpr int NINP = 3840;
constexpr size_t WS_SKB = 18 * MiB + 512 * 1024;
constexpr size_t WS_GATES = 17 * MiB;
constexpr size_t WS_XN = 20 * MiB;
constexpr size_t WS_QA = 52 * MiB, WS_KA = 68 * MiB, WS_VA = 84 * MiB, WS_MQ = 100 * MiB, WS_MK = 116 * MiB, WS_MV = 132 * MiB, WS_MO = 148 * MiB;
constexpr size_t WS_O1 = 164 * MiB, WS_O2 = 180 * MiB;
constexpr size_t WS_CQ = 196 * MiB, WS_CK = 212 * MiB;
constexpr size_t WS_HS = WS_XN;
constexpr size_t WS_ACAT = WS_QA;
constexpr size_t WS_QP = WS_VA;
constexpr size_t WS_ROUTE = WS_MO;
constexpr size_t WS_PB = 245 * MiB;
constexpr size_t WS_PP = WS_QA;
constexpr size_t WS_G2 = WS_VA;
constexpr size_t WS_EU8 = 20 * MiB, WS_EV8 = 36 * MiB;
constexpr size_t WS_SI = 19 * MiB;
constexpr size_t WS_RS = 253 * MiB;
constexpr size_t WS_X1G = 164 * MiB;
constexpr size_t WS_XN3 = 196 * MiB;
constexpr size_t WS_ST = 228 * MiB;
constexpr size_t WS_END = 256 * MiB;
constexpr int CW_BAR = 4096;
constexpr int CW_NORM = 1024, CW_QUEUE = 128;

__device__ __forceinline__ float bf2f(unsigned v) { return __uint_as_float(v << 16); }
__device__ __forceinline__ unsigned f2bf(float f) { unsigned u = __float_as_uint(f); return (u + 0x7fffu + ((u >> 16) & 1u)) >> 16; }
__device__ __forceinline__ unsigned pk2(float lo, float hi) { return f2bf(lo) | (f2bf(hi) << 16); }
__device__ __forceinline__ float wave_sum(float v) {
#pragma unroll
    for (int o = 1; o < 64; o <<= 1) v += __shfl_xor(v, o);
    return v;
}
__device__ __forceinline__ float sigmoidf_(float x) { return 1.f / (1.f + __expf(-x)); }
__device__ __forceinline__ unsigned f2sortu(float f) { const unsigned u = __float_as_uint(f); return (u & 0x80000000u) ? ~u : (u | 0x80000000u); }
__device__ __forceinline__ float sortu2f(unsigned s) { return __uint_as_float((s & 0x80000000u) ? (s & 0x7fffffffu) : ~s); }
__device__ __forceinline__ int tidx() { int t = threadIdx.x; asm volatile("" : "+v"(t)); return t; }

#define XB_TMO      128
#define XB_XCNT(j)  (256  + 64 * (j))
#define XB_XSUB(j)  (1280 + 64 * (j))
#define XB_XGEN(j)  (2304 + 64 * (j))
#define XB_TOP      3328
#define XB_TOPGEN   3392
#define XCD_BAR_WORDS 3456
#define XB_SPIN_CAP (1u << 25)
__device__ __forceinline__ unsigned xb_ld(unsigned* p)              { return __hip_atomic_load(p, __ATOMIC_RELAXED, __HIP_MEMORY_SCOPE_AGENT); }
__device__ __forceinline__ unsigned xb_add(unsigned* p, unsigned v) { return __hip_atomic_fetch_add(p, v, __ATOMIC_RELAXED, __HIP_MEMORY_SCOPE_AGENT); }
__device__ __forceinline__ unsigned xb_xcc_id() { return (unsigned)__builtin_amdgcn_s_getreg((3 << 11) | 20) & 0xFu; }
#define XB_SPIN(cond, bar) do { unsigned _sp = 0; while (cond) { __builtin_amdgcn_s_sleep(1); \
    if ((++_sp & 255u) == 0u) { if (xb_ld(&(bar)[XB_TMO])) break; if (_sp > XB_SPIN_CAP) { atomicAdd(&(bar)[XB_TMO], 1u); break; } } } } while (0)
struct XcdBarrier { unsigned* bar; unsigned x; volatile LAS unsigned* st; };
__device__ __forceinline__ XcdBarrier xcd_barrier_post(unsigned* bar, volatile LAS unsigned* st) {
    XcdBarrier b; b.bar = bar; b.x = xb_xcc_id(); b.st = st;
    if (tidx() == 0) (void)xb_add(&bar[XB_XCNT(b.x)], 1u);
    return b;
}
__device__ __forceinline__ void xcd_barrier_complete(unsigned* bar, unsigned x, unsigned& nloc, unsigned& nx) {
    const unsigned G = gridDim.x * gridDim.y * gridDim.z;
    unsigned sum, cnt, mine, sp = 0u;
    for (;;) {
        sum = 0u; cnt = 0u; mine = 0u;
#pragma unroll
        for (unsigned j = 0; j < 16; ++j) { const unsigned c = xb_ld(&bar[XB_XCNT(j)]); sum += c; cnt += (c > 0u) ? 1u : 0u; mine = (j == x) ? c : mine; }
        if (sum == G) break;
        __builtin_amdgcn_s_sleep(1);
        if ((++sp & 255u) == 0u) { if (xb_ld(&bar[XB_TMO])) break; if (sp > XB_SPIN_CAP) { atomicAdd(&bar[XB_TMO], 1u); break; } }
    }
    nloc = mine > 0u ? mine : 1u; nx = cnt > 0u ? cnt : 1u;
}
__device__ __forceinline__ void xcd_barrier(const XcdBarrier& b) {
    asm volatile("s_waitcnt vmcnt(0)" ::: "memory");
    __syncthreads();
    if (tidx() == 0) {
        unsigned* bar = b.bar;
        __builtin_amdgcn_s_waitcnt(0);
        unsigned nloc = b.st[0], nx = b.st[1];
        if (nloc == 0u) { xcd_barrier_complete(bar, b.x, nloc, nx); b.st[0] = nloc; b.st[1] = nx; }
        const unsigned old = xb_add(&bar[XB_XSUB(b.x)], 1u);
        const unsigned gen = old / nloc;
        if (old + 1u == (gen + 1u) * nloc) {
            __builtin_amdgcn_fence(__ATOMIC_RELEASE, "agent");
            asm volatile("s_waitcnt vmcnt(0)" ::: "memory");
            const unsigned og = xb_add(&bar[XB_TOP], 1u);
            const unsigned tg = og / nx;
            if (og + 1u == (tg + 1u) * nx) xb_add(&bar[XB_TOPGEN], 1u);
            else XB_SPIN(xb_ld(&bar[XB_TOPGEN]) == tg, bar);
            __builtin_amdgcn_fence(__ATOMIC_ACQUIRE, "agent");
            xb_add(&bar[XB_XGEN(b.x)], 1u);
            asm volatile("s_waitcnt vmcnt(0)" ::: "memory");
        } else {
            XB_SPIN(xb_ld(&bar[XB_XGEN(b.x)]) == gen, bar);
            __builtin_amdgcn_fence(__ATOMIC_ACQUIRE, "agent");
            asm volatile("s_waitcnt vmcnt(0)" ::: "memory");
        }
    }
    __syncthreads();
}

namespace pg8 {
#define PG8_LAS __attribute__((address_space(3)))
typedef unsigned short bf16_t;
typedef short bf16x8 __attribute__((ext_vector_type(8)));
typedef float f32x4 __attribute__((ext_vector_type(4)));
typedef unsigned u32x4 __attribute__((ext_vector_type(4)));
constexpr int BM = 256, BK = 64, HALF = 128, HTB = HALF * BK * 2  , STAGE_BYTES = 8 * HTB, NXCD = 8, WGM = 8;

__host__ __device__ __forceinline__ int lds_byte(int r, int c) { const int st = (r >> 4) * 2 + (c >> 5), rr = r & 15, cc = c & 31, ob = rr * 64 + cc * 2; return st * 1024 + (ob ^ (((ob >> 9) & 1) << 5)); }
__host__ __device__ __forceinline__ void stage_rc(int b, int& R, int& C) { const int st = b / 1024, sb = b % 1024, swz = sb ^ (((sb >> 9) & 1) << 5); R = (st >> 1) * 16 + swz / 64; C = (st & 1) * 32 + (swz % 64) / 2; }
__host__ __device__ __forceinline__ int perm32(int rho) { const int n = rho >> 4, i = rho & 15; return 8 * (i >> 2) + 4 * n + (i & 3); }

struct Unit { int pm, pn; };
struct Gemm { const bf16_t* A; const bf16_t* Bt; int M, N, K; };

struct StaticOrder {
    int nM, nN, nwg, G, c;
    __host__ __device__ void init(int M, int N, int G_, int c_) { nM = M / BM; nN = N / BM; nwg = nM * nN; G = G_; c = c_; }
    __host__ __device__ bool next(int i, Unit& u) const {
        const long L = (long)i * G + c; if (L >= nwg) return false;
        int wgid = (int)L; { const int q = nwg / NXCD, r = nwg % NXCD, xcd = wgid % NXCD, off = wgid / NXCD; wgid = (xcd < r ? xcd * (q + 1) : r * (q + 1) + (xcd - r) * q) + off; }
        const int nig = WGM * nN, gid = wgid / nig, fm = gid * WGM, gsz = (nM - fm) < WGM ? (nM - fm) : WGM;
        u.pm = fm + ((wgid % nig) % gsz); u.pn = (wgid % nig) / gsz; return true;
    }
    __device__ __forceinline__ void a_ready(const Unit&) const {}
    __device__ __forceinline__ void done(const Unit&) const {}
};

__device__ __forceinline__ unsigned cvt_pk_bf16(float lo, float hi) { unsigned r; asm volatile("v_cvt_pk_bf16_f32 %0, %1, %2" : "=v"(r) : "v"(lo), "v"(hi)); return r; }
typedef float f32x2 __attribute__((ext_vector_type(2)));
__device__ __forceinline__ f32x2 gelu_pk(f32x2 v) {
    const f32x2 av = __builtin_elementwise_abs(v), d = av * 0.2316418882f + 1.0f;
    f32x2 t; t.x = __builtin_amdgcn_rcpf(d.x); t.y = __builtin_amdgcn_rcpf(d.y);
    f32x2 q = t * 0.5307027145f + (-0.7265760135f); q = q * t + 0.7107068705f; q = q * t + (-0.142248368f); q = q * t + 0.127414796f; q = q * t;
    const f32x2 s = (v * v) * (-0.72134752044f);
    f32x2 e; e.x = __builtin_amdgcn_exp2f(s.x); e.y = __builtin_amdgcn_exp2f(s.y);
    const f32x2 m = v * (q * e), r = v - m;
    f32x2 o; o.x = v.x < 0.f ? m.x : r.x; o.y = v.y < 0.f ? m.y : r.y; return o;
}

template <int ACT  > struct EpiBf16 {
    static constexpr bool PERM = true, AFTER_DRAIN = false; static_assert(ACT == 0 || ACT == 1, "EpiBf16: ACT is 0 (none) or 1 (gelu_pk)");
    bf16_t* O; int ldc; const float* bias; int split_cols; size_t split_stride; float scale0;
    __device__ __forceinline__ void operator()(const f32x4 (&acc)[2][2][4][2], const Unit& u, int wr, int wc, int fr, int fq) const {
        const int row0 = u.pm * BM + wr * 64 + fr; int colt = u.pn * BM; bf16_t* base = O;
        float sc = 1.f; if (split_cols) { const int t = colt / split_cols; base += (size_t)t * split_stride; colt -= t * split_cols; if (t == 0) sc = scale0; }
        const int col0 = colt + wc * 32 + 8 * fq, bcol0 = u.pn * BM + wc * 32 + 8 * fq;
        f32x4 bv[2][2];
#pragma unroll
        for (int bj = 0; bj < 2; ++bj)
#pragma unroll
            for (int n = 0; n < 2; ++n) bv[bj][n] = bias ? *(const f32x4*)(bias + bcol0 + bj * HALF + 4 * n) : (f32x4){0.f, 0.f, 0.f, 0.f};
#pragma unroll
        for (int ai = 0; ai < 2; ++ai)
#pragma unroll
            for (int m = 0; m < 4; ++m) { bf16_t* rowp = base + (size_t)(row0 + ai * HALF + m * 16) * ldc + col0;
#pragma unroll
                for (int bj = 0; bj < 2; ++bj) { f32x4 v0 = acc[ai][bj][m][0] + bv[bj][0], v1 = acc[ai][bj][m][1] + bv[bj][1];
                    if (ACT == 1) { f32x2 a = gelu_pk((f32x2){v0[0], v0[1]}), b = gelu_pk((f32x2){v0[2], v0[3]}), c = gelu_pk((f32x2){v1[0], v1[1]}), d = gelu_pk((f32x2){v1[2], v1[3]});
                        v0 = (f32x4){a.x, a.y, b.x, b.y}; v1 = (f32x4){c.x, c.y, d.x, d.y}; }
                    v0 = v0 * sc; v1 = v1 * sc; u32x4 w; w.x = cvt_pk_bf16(v0[0], v0[1]); w.y = cvt_pk_bf16(v0[2], v0[3]); w.z = cvt_pk_bf16(v1[0], v1[1]); w.w = cvt_pk_bf16(v1[2], v1[3]);
                    *(u32x4*)(rowp + bj * HALF) = w; } }
    }
};

struct EpiProj {
    static constexpr bool PERM = true, AFTER_DRAIN = false;
    bf16_t* O; size_t split_stride; float scale0; float* gates;
    __device__ __forceinline__ void operator()(const f32x4 (&acc)[2][2][4][2], const Unit& u, int wr, int wc, int fr, int fq) const {
        const int row0 = u.pm * BM + wr * 64 + fr;
        if (u.pn == 14) {
            if (wc == 0 && fq == 0) {
#pragma unroll
                for (int ai = 0; ai < 2; ++ai)
#pragma unroll
                    for (int m = 0; m < 4; ++m) { float* g = gates + (size_t)(row0 + ai * HALF + m * 16) * 8; *(f32x4*)g = acc[ai][0][m][0]; *(f32x4*)(g + 4) = acc[ai][0][m][1]; }
            }
            return;
        }
        int colt = u.pn * BM; const int t = colt / 512; bf16_t* base = O + (size_t)t * split_stride; colt -= t * 512; const float sc = (t == 0) ? scale0 : 1.f;
        const int col0 = colt + wc * 32 + 8 * fq;
#pragma unroll
        for (int ai = 0; ai < 2; ++ai)
#pragma unroll
            for (int m = 0; m < 4; ++m) { bf16_t* rowp = base + (size_t)(row0 + ai * HALF + m * 16) * 512 + col0;
#pragma unroll
                for (int bj = 0; bj < 2; ++bj) { const f32x4 v0 = acc[ai][bj][m][0] * sc, v1 = acc[ai][bj][m][1] * sc;
                    u32x4 w; w.x = cvt_pk_bf16(v0[0], v0[1]); w.y = cvt_pk_bf16(v0[2], v0[3]); w.z = cvt_pk_bf16(v1[0], v1[1]); w.w = cvt_pk_bf16(v1[2], v1[3]);
                    *(u32x4*)(rowp + bj * HALF) = w; } }
    }
};
struct EpiResF32 {
    static constexpr bool PERM = false, AFTER_DRAIN = false;
    const float* base; float* out; int ldc;
    __device__ __forceinline__ void operator()(const f32x4 (&acc)[2][2][4][2], const Unit& u, int wr, int wc, int fr, int fq) const {
        const int row0 = u.pm * BM + wr * 64 + fr, col0 = u.pn * BM + wc * 32 + 4 * fq;
#pragma unroll
        for (int ai = 0; ai < 2; ++ai)
#pragma unroll
            for (int m = 0; m < 4; ++m) { const size_t off = (size_t)(row0 + ai * HALF + m * 16) * ldc + col0;
#pragma unroll
                for (int bj = 0; bj < 2; ++bj)
#pragma unroll
                    for (int n = 0; n < 2; ++n) { const size_t o = off + bj * HALF + n * 16; *(f32x4*)(out + o) = *(const f32x4*)(base + o) + acc[ai][bj][m][n]; } }
    }
};
struct EpiResX1 {
    static constexpr bool PERM = false, AFTER_DRAIN = false;
    const float* base; float* out; bf16_t* xg; float* rs; int ldc;
    __device__ __forceinline__ void operator()(const f32x4 (&acc)[2][2][4][2], const Unit& u, int wr, int wc, int fr, int fq) const {
        const int row0 = u.pm * BM + wr * 64 + fr, col0 = u.pn * BM + wc * 32 + 4 * fq;
#pragma unroll
        for (int ai = 0; ai < 2; ++ai)
#pragma unroll
            for (int m = 0; m < 4; ++m) { const int row = row0 + ai * HALF + m * 16; const size_t off = (size_t)row * ldc + col0; float ss = 0.f;
#pragma unroll
                for (int bj = 0; bj < 2; ++bj)
#pragma unroll
                    for (int n = 0; n < 2; ++n) { const size_t o = off + bj * HALF + n * 16; const f32x4 v = *(const f32x4*)(base + o) + acc[ai][bj][m][n]; *(f32x4*)(out + o) = v;
                        ss += (v[0] * v[0] + v[1] * v[1]) + (v[2] * v[2] + v[3] * v[3]);
                        typedef unsigned u32x2 __attribute__((ext_vector_type(2))); u32x2 pk; pk.x = cvt_pk_bf16(v[0], v[1]); pk.y = cvt_pk_bf16(v[2], v[3]); *(u32x2*)(xg + o) = pk; }
                ss += __shfl_xor(ss, 16); ss += __shfl_xor(ss, 32);
                if (fq == 0) rs[(size_t)row * 16 + u.pn * 4 + wc] = ss; }
    }
};
struct EpiSigBf16 {
    static constexpr bool PERM = true, AFTER_DRAIN = false;
    bf16_t* O; int ldc;
    __device__ __forceinline__ void operator()(const f32x4 (&acc)[2][2][4][2], const Unit& u, int wr, int wc, int fr, int fq) const {
        const int row0 = u.pm * BM + wr * 64 + fr, col0 = u.pn * BM + wc * 32 + 8 * fq;
#pragma unroll
        for (int ai = 0; ai < 2; ++ai)
#pragma unroll
            for (int m = 0; m < 4; ++m) { bf16_t* rowp = O + (size_t)(row0 + ai * HALF + m * 16) * ldc + col0;
#pragma unroll
                for (int bj = 0; bj < 2; ++bj) { f32x4 v0 = acc[ai][bj][m][0], v1 = acc[ai][bj][m][1];
#pragma unroll
                    for (int i = 0; i < 4; ++i) { v0[i] = 1.f / (1.f + __expf(-v0[i])); v1[i] = 1.f / (1.f + __expf(-v1[i])); }
                    u32x4 w; w.x = cvt_pk_bf16(v0[0], v0[1]); w.y = cvt_pk_bf16(v0[2], v0[3]); w.z = cvt_pk_bf16(v1[0], v1[1]); w.w = cvt_pk_bf16(v1[2], v1[3]);
                    *(u32x4*)(rowp + bj * HALF) = w; } }
    }
};
struct EpiGateFinal {
    static constexpr bool PERM = false, AFTER_DRAIN = false;
    const bf16_t* P; float* out; int ldc;
    __device__ __forceinline__ void operator()(const f32x4 (&acc)[2][2][4][2], const Unit& u, int wr, int wc, int fr, int fq) const {
        const int row0 = u.pm * BM + wr * 64 + fr, col0 = u.pn * BM + wc * 32 + 4 * fq;
#pragma unroll
        for (int ai = 0; ai < 2; ++ai)
#pragma unroll
            for (int m = 0; m < 4; ++m) { const size_t off = (size_t)(row0 + ai * HALF + m * 16) * ldc + col0;
#pragma unroll
                for (int bj = 0; bj < 2; ++bj)
#pragma unroll
                    for (int n = 0; n < 2; ++n) { const size_t o = off + bj * HALF + n * 16;
                        typedef unsigned u32x2 __attribute__((ext_vector_type(2))); const u32x2 g = *(const u32x2*)(P + o);
                        f32x4 pv; pv[0] = __uint_as_float(g.x << 16); pv[1] = __uint_as_float(g.x & 0xffff0000u); pv[2] = __uint_as_float(g.y << 16); pv[3] = __uint_as_float(g.y & 0xffff0000u);
                        f32x4 sg = acc[ai][bj][m][n];
#pragma unroll
                        for (int i = 0; i < 4; ++i) sg[i] = 1.f / (1.f + __expf(-sg[i]));
                        *(f32x4*)(out + o) = *(const f32x4*)(out + o) + sg * pv; } }
    }
};
struct EpiGateAcc {
    static constexpr bool PERM = false, AFTER_DRAIN = false;
    const bf16_t* G; float* out; int ldc;
    __device__ __forceinline__ void operator()(const f32x4 (&acc)[2][2][4][2], const Unit& u, int wr, int wc, int fr, int fq) const {
        const int row0 = u.pm * BM + wr * 64 + fr, col0 = u.pn * BM + wc * 32 + 4 * fq;
#pragma unroll
        for (int ai = 0; ai < 2; ++ai)
#pragma unroll
            for (int m = 0; m < 4; ++m) { const size_t off = (size_t)(row0 + ai * HALF + m * 16) * ldc + col0;
#pragma unroll
                for (int bj = 0; bj < 2; ++bj)
#pragma unroll
                    for (int n = 0; n < 2; ++n) { const size_t o = off + bj * HALF + n * 16;
                        typedef unsigned u32x2 __attribute__((ext_vector_type(2))); const u32x2 g = *(const u32x2*)(G + o);
                        f32x4 gv; gv[0] = __uint_as_float(g.x << 16); gv[1] = __uint_as_float(g.x & 0xffff0000u); gv[2] = __uint_as_float(g.y << 16); gv[3] = __uint_as_float(g.y & 0xffff0000u);
                        *(f32x4*)(out + o) = *(const f32x4*)(out + o) + gv * acc[ai][bj][m][n]; } }
    }
};
template <class Epi, class Sched, bool ALIGN_EPI = false, bool SP2 = false>
__device__ __forceinline__ void gemm_phase(PG8_LAS unsigned char* lds, const Gemm g, const Sched& S, const Epi& E) {
    const int tid = tidx(), wid = __builtin_amdgcn_readfirstlane(tid >> 6), lane = tid & 63, wr = wid >> 2, wc = wid & 3, fr = lane & 15, fq = lane >> 4;
    const int K = g.K, nt = K / BK;
    unsigned voffA[2], voffB[2];
#pragma unroll
    for (int i = 0; i < 2; ++i) { int R, C; stage_rc(tid * 16 + i * 8192, R, C); const int Rb = Epi::PERM ? ((R & ~31) + perm32(R & 31)) : R;
        voffA[i] = (unsigned)(R * K + C) * 2u; voffB[i] = (unsigned)(Rb * K + C) * 2u; }
    const size_t kstep = (size_t)(BK * 2);
    const size_t hstep = (size_t)HALF * K * 2;
    const size_t tstep = 2 * hstep;
    const unsigned ldsw = (unsigned)wid * 1024u;
    const int aoff = lds_byte(wr * 64 + fr, fq * 8), boff = lds_byte(wc * 32 + fr, fq * 8);
#define PG8_SA(b, h) (((b) * 2 + (h)) * HTB)
#define PG8_SB(b, h) ((4 + (b) * 2 + (h)) * HTB)
#define PG8_STAGE(bufoff, gbase, voff) do { _Pragma("unroll") for (int _i = 0; _i < 2; ++_i) \
        __builtin_amdgcn_global_load_lds((const unsigned*)((const char*)(gbase) + (voff)[_i]), (PG8_LAS unsigned*)(lds + (bufoff) + ldsw + _i * 8192), 16, 0, 0); } while (0)
#define PG8_LDA(dst, b, h) do { _Pragma("unroll") for (int m = 0; m < 4; ++m) _Pragma("unroll") for (int k = 0; k < 2; ++k) dst[m][k] = *(const PG8_LAS bf16x8*)(lds + PG8_SA(b, h) + aoff + m * 2048 + k * 1024); } while (0)
#define PG8_LDB(dst, b, h) do { _Pragma("unroll") for (int n = 0; n < 2; ++n) _Pragma("unroll") for (int k = 0; k < 2; ++k) dst[n][k] = *(const PG8_LAS bf16x8*)(lds + PG8_SB(b, h) + boff + n * 2048 + k * 1024); } while (0)
#define PG8_MMA(ai, bj, At, Bt) do { __builtin_amdgcn_s_setprio(1); _Pragma("unroll") for (int m = 0; m < 4; ++m) _Pragma("unroll") for (int n = 0; n < 2; ++n) _Pragma("unroll") for (int k = 0; k < 2; ++k) \
        acc[ai][bj][m][n] = __builtin_amdgcn_mfma_f32_16x16x32_bf16(Bt[n][k], At[m][k], acc[ai][bj][m][n], 0, 0, 0); __builtin_amdgcn_s_setprio(0); } while (0)
#define PG8_WAIT_V(n) asm volatile("s_waitcnt vmcnt(" #n ")" ::: "memory")
#define PG8_WAIT_L(n) asm volatile("s_waitcnt lgkmcnt(" #n ")" ::: "memory")
#define PG8_BAR __builtin_amdgcn_s_barrier()
#define PG8_SCHED __builtin_amdgcn_sched_barrier(0)
    Unit cur, nxt; int ui = 0;
    if (!S.next(0, cur)) return;
    f32x4 acc[2][2][4][2];
#pragma unroll
    for (int a = 0; a < 2; ++a)
#pragma unroll
        for (int b = 0; b < 2; ++b)
#pragma unroll
            for (int m = 0; m < 4; ++m)
#pragma unroll
                for (int n = 0; n < 2; ++n) acc[a][b][m][n] = (f32x4){0.f, 0.f, 0.f, 0.f};
    bf16x8 At[4][2], B0[2][2], B1[2][2];
    const char* cA = (const char*)g.A + (size_t)cur.pm * tstep; const char* cB = (const char*)g.Bt + (size_t)cur.pn * tstep;
    S.a_ready(cur);
    if constexpr (SP2) {
        PG8_STAGE(PG8_SB(0, 0), cB, voffB); PG8_STAGE(PG8_SB(0, 1), cB + hstep, voffB); PG8_STAGE(PG8_SA(0, 0), cA, voffA); PG8_STAGE(PG8_SA(0, 1), cA + hstep, voffA);
        if (wr == 1) PG8_BAR;
        PG8_WAIT_V(2); PG8_BAR;
        PG8_STAGE(PG8_SB(1, 0), cB + kstep, voffB); PG8_STAGE(PG8_SA(1, 0), cA + kstep, voffA); PG8_STAGE(PG8_SB(1, 1), cB + hstep + kstep, voffB);
        PG8_WAIT_V(6); PG8_BAR;
    } else {
        PG8_STAGE(PG8_SB(0, 0), cB, voffB); PG8_STAGE(PG8_SA(0, 0), cA, voffA); PG8_STAGE(PG8_SB(0, 1), cB + hstep, voffB); PG8_STAGE(PG8_SA(0, 1), cA + hstep, voffA);
        if (wr == 1) PG8_BAR;
        PG8_WAIT_V(4); PG8_BAR;
        PG8_STAGE(PG8_SB(1, 0), cB + kstep, voffB); PG8_STAGE(PG8_SA(1, 0), cA + kstep, voffA); PG8_STAGE(PG8_SB(1, 1), cB + hstep + kstep, voffB);
        PG8_WAIT_V(6); PG8_BAR;
    }
    for (;;) {
        const bool has_next = S.next(ui + 1, nxt);
        const char* nA = has_next ? (const char*)g.A + (size_t)nxt.pm * tstep : cA; const char* nB = has_next ? (const char*)g.Bt + (size_t)nxt.pn * tstep : cB;
        for (int t = 0; t < nt; t += 2) {
            const bool last = (t == nt - 2);
            const char* a1 = cA + (size_t)(t + 1) * kstep;
            const char* a2 = last ? nA : cA + (size_t)(t + 2) * kstep; const char* b2 = last ? nB : cB + (size_t)(t + 2) * kstep;
            const char* a3 = a2 + kstep; const char* b3 = b2 + kstep;
            if (last && has_next) S.a_ready(nxt);
            if constexpr (SP2) {
            PG8_LDB(B0, 0, 0); PG8_LDB(B1, 0, 1); PG8_SCHED; PG8_LDA(At, 0, 0); PG8_STAGE(PG8_SA(1, 1), a1 + hstep, voffA);
            PG8_WAIT_V(8); PG8_WAIT_L(0); PG8_BAR; PG8_MMA(0, 0, At, B0); PG8_MMA(0, 1, At, B1); PG8_BAR; PG8_SCHED;
            PG8_LDA(At, 0, 1); PG8_STAGE(PG8_SB(0, 0), b2, voffB); PG8_STAGE(PG8_SB(0, 1), b2 + hstep, voffB); PG8_STAGE(PG8_SA(0, 0), a2, voffA);
            PG8_WAIT_V(8); PG8_WAIT_L(0); PG8_BAR; PG8_MMA(1, 0, At, B0); PG8_MMA(1, 1, At, B1); PG8_BAR; PG8_SCHED;
            PG8_LDB(B0, 1, 0); PG8_LDB(B1, 1, 1); PG8_SCHED; PG8_LDA(At, 1, 0); PG8_STAGE(PG8_SA(0, 1), a2 + hstep, voffA);
            PG8_WAIT_V(8); PG8_WAIT_L(0); PG8_BAR; PG8_MMA(0, 0, At, B0); PG8_MMA(0, 1, At, B1); PG8_BAR; PG8_SCHED;
            PG8_LDA(At, 1, 1); PG8_STAGE(PG8_SB(1, 0), b3, voffB); PG8_STAGE(PG8_SB(1, 1), b3 + hstep, voffB); PG8_STAGE(PG8_SA(1, 0), a3, voffA);
            PG8_WAIT_V(8); PG8_WAIT_L(0); PG8_BAR; PG8_MMA(1, 0, At, B0); PG8_MMA(1, 1, At, B1); PG8_BAR; PG8_SCHED;
            } else {
            PG8_LDB(B0, 0, 0); PG8_SCHED; PG8_LDA(At, 0, 0); PG8_STAGE(PG8_SA(1, 1), a1 + hstep, voffA);
            PG8_WAIT_L(8); PG8_BAR; PG8_WAIT_L(0); PG8_MMA(0, 0, At, B0); PG8_BAR; PG8_SCHED;
            PG8_LDB(B1, 0, 1); PG8_STAGE(PG8_SB(0, 0), b2, voffB);
            PG8_BAR; PG8_WAIT_L(0); PG8_MMA(0, 1, At, B1); PG8_BAR;
            PG8_LDA(At, 0, 1); PG8_STAGE(PG8_SA(0, 0), a2, voffA);
            PG8_BAR; PG8_WAIT_L(0); PG8_MMA(1, 0, At, B0); PG8_BAR; PG8_SCHED;
            PG8_STAGE(PG8_SB(0, 1), b2 + hstep, voffB);
            PG8_WAIT_V(6); PG8_BAR; PG8_MMA(1, 1, At, B1); PG8_BAR;
            PG8_LDB(B0, 1, 0); PG8_SCHED; PG8_LDA(At, 1, 0); PG8_STAGE(PG8_SA(0, 1), a2 + hstep, voffA);
            PG8_WAIT_L(8); PG8_BAR; PG8_WAIT_L(0); PG8_MMA(0, 0, At, B0); PG8_BAR; PG8_SCHED;
            PG8_LDB(B1, 1, 1); PG8_STAGE(PG8_SB(1, 0), b3, voffB);
            PG8_BAR; PG8_WAIT_L(0); PG8_MMA(0, 1, At, B1); PG8_BAR;
            PG8_LDA(At, 1, 1); PG8_STAGE(PG8_SA(1, 0), a3, voffA);
            PG8_BAR; PG8_WAIT_L(0); PG8_MMA(1, 0, At, B0); PG8_BAR; PG8_SCHED;
            PG8_STAGE(PG8_SB(1, 1), b3 + hstep, voffB);
            PG8_WAIT_V(6); PG8_BAR; PG8_MMA(1, 1, At, B1); PG8_BAR;
            }
        }
        if constexpr (ALIGN_EPI) { if (wr == 0) PG8_BAR; }
        if constexpr (!Epi::AFTER_DRAIN) { E(acc, cur, wr, wc, fr, fq); S.done(cur); }
        if (!has_next) break;
#pragma unroll
        for (int a = 0; a < 2; ++a)
#pragma unroll
            for (int b = 0; b < 2; ++b)
#pragma unroll
                for (int m = 0; m < 4; ++m)
#pragma unroll
                    for (int n = 0; n < 2; ++n) acc[a][b][m][n] = (f32x4){0.f, 0.f, 0.f, 0.f};
        cur = nxt; cA = nA; cB = nB; ++ui;
        if constexpr (ALIGN_EPI) { if (wr == 1) PG8_BAR; }
    }
    PG8_WAIT_V(0);
    if constexpr (!ALIGN_EPI) { if (wr == 0) PG8_BAR; }
    PG8_BAR;
    if constexpr (Epi::AFTER_DRAIN) { E.fused(acc, cur, wr, wc, fr, fq, lds, wid, lane); S.done(cur); }
#undef PG8_SA
#undef PG8_SB
#undef PG8_STAGE
#undef PG8_LDA
#undef PG8_LDB
#undef PG8_MMA
#undef PG8_WAIT_V
#undef PG8_WAIT_L
#undef PG8_BAR
#undef PG8_SCHED
}
}

#include <hip/hip_bf16.h>
#include <cmath>
namespace attn_body {
using bf16=__hip_bfloat16;
using bf16x8=__attribute__((ext_vector_type(8)))short;
using s16x4=__attribute__((ext_vector_type(4)))short;
using f32x16=__attribute__((ext_vector_type(16)))float;
using u32x4=__attribute__((ext_vector_type(4)))unsigned;
constexpr int SEQ=16384,D=64,DM=512;
constexpr int NW=8,QBLK=32,QB=QBLK*NW,KVBLK=64,NQB=SEQ/QB;
constexpr int ATTN_PITCH=DM, ATTN_UNIT_ROWS=QB;
__device__ __forceinline__ int crow(int r,int hi){return (r&3)+8*(r>>2)+4*hi;}
#define SBAR() __builtin_amdgcn_sched_barrier(0)
__device__ __forceinline__ void cmask(f32x16&p0,f32x16&p1,int jb,int qrel,int hi){
  const float NEG=-INFINITY; int kb=64*jb+4*hi;
  #pragma unroll
  for(int r=0;r<16;++r){int kv=kb+(r&3)+8*(r>>2); if(kv>qrel)p0[r]=NEG; if(kv+32>qrel)p1[r]=NEG;}
}

constexpr int NSLOT=3, SLOTB=8192;
constexpr int LDS_K=0, LDS_V=NSLOT*SLOTB, LDS_WS=2*NSLOT*SLOTB, LDS_OST=LDS_WS+NW*64*4, LDS_BYTES=LDS_OST+NW*4096;
constexpr float C2=0.125f*1.4426950408889634f;
__device__ __forceinline__ void glds16(const void*gsrc,unsigned lds_dst){unsigned keep;
  asm volatile("s_mov_b32 %0, m0\n\ts_mov_b32 m0, %2\n\ts_nop 0\n\tglobal_load_lds_dwordx4 %1, off\n\ts_mov_b32 m0, %0":"=&s"(keep):"v"(gsrc),"s"(lds_dst):"memory");}
__device__ __forceinline__ float max3f(float a,float b,float c){float r;asm("v_max3_f32 %0, %1, %2, %3":"=v"(r):"v"(a),"v"(b),"v"(c));return r;}
__device__ __forceinline__ float max2f(float a,float b){float r;asm("v_max_f32_e32 %0, %1, %2":"=v"(r):"v"(a),"v"(b));return r;}
__device__ __forceinline__ float fadd_s(float a,float b){float r;asm("v_add_f32_e32 %0, %1, %2":"=v"(r):"v"(a),"v"(b));return r;}
__device__ __forceinline__ float fsub_s(float a,float b){float r;asm("v_sub_f32_e32 %0, %1, %2":"=v"(r):"v"(a),"v"(b));return r;}
typedef float f32x2_t __attribute__((ext_vector_type(2))); typedef __bf16 bf16x2_t __attribute__((ext_vector_type(2)));
__device__ __forceinline__ unsigned cvtpk_s(float lo,float hi){f32x2_t v={lo,hi};bf16x2_t b=__builtin_convertvector(v,bf16x2_t);return __builtin_bit_cast(unsigned,b);}
#define WAIT_BAR(N) asm volatile("s_waitcnt vmcnt(" #N ") lgkmcnt(0)\n\ts_barrier":::"memory")

__device__ __forceinline__ void qkt(f32x16&p0,f32x16&p1,const char*Kslot,const bf16x8*qr,int r32,int hi){
  const char*kb=Kslot+hi*1024+r32*16;
  #pragma unroll
  for(int d0=0;d0<4;++d0){
    const bf16x8 b0=*reinterpret_cast<const bf16x8*>(kb+d0*2048);
    const bf16x8 b1=*reinterpret_cast<const bf16x8*>(kb+d0*2048+512);
    p0=__builtin_amdgcn_mfma_f32_32x32x16_bf16(b0,qr[d0],p0,0,0,0);p1=__builtin_amdgcn_mfma_f32_32x32x16_bf16(b1,qr[d0],p1,0,0,0);}
}
typedef __attribute__((address_space(3))) const char* lds_cptr;
typedef short v4i16_t __attribute__((ext_vector_type(4)));
__device__ __forceinline__ void kload8(bf16x8*kf,lds_cptr kp){
  kf[0]=*(const __attribute__((address_space(3))) bf16x8*)(kp);      kf[1]=*(const __attribute__((address_space(3))) bf16x8*)(kp+512);
  kf[2]=*(const __attribute__((address_space(3))) bf16x8*)(kp+2048); kf[3]=*(const __attribute__((address_space(3))) bf16x8*)(kp+2560);
  kf[4]=*(const __attribute__((address_space(3))) bf16x8*)(kp+4096); kf[5]=*(const __attribute__((address_space(3))) bf16x8*)(kp+4608);
  kf[6]=*(const __attribute__((address_space(3))) bf16x8*)(kp+6144); kf[7]=*(const __attribute__((address_space(3))) bf16x8*)(kp+6656);
}
__device__ __forceinline__ void kload2(bf16x8*kf,lds_cptr kp,int j){ kf[2*j]=*(const __attribute__((address_space(3))) bf16x8*)(kp+j*2048); kf[2*j+1]=*(const __attribute__((address_space(3))) bf16x8*)(kp+j*2048+512); }
__device__ __forceinline__ s16x4 vtr(lds_cptr p){ return __builtin_bit_cast(s16x4,__builtin_amdgcn_ds_read_tr16_b64_v4i16((__attribute__((address_space(3))) v4i16_t*)p)); }
__device__ __forceinline__ float rowmax(const f32x16&p0,const f32x16&p1){
  float a=max3f(p0[0],p0[1],p1[0]),b=max3f(p0[2],p0[3],p1[1]);a=max3f(a,p1[2],p1[3]);
  #pragma unroll
  for(int r=4;r<16;r+=4){a=max3f(a,p0[r],p0[r+1]);b=max3f(b,p0[r+2],p0[r+3]);a=max3f(a,p1[r],p1[r+1]);b=max3f(b,p1[r+2],p1[r+3]);}
  const float m=max2f(a,b);
  auto rr=__builtin_amdgcn_permlane32_swap(__float_as_uint(m),__float_as_uint(m),false,false);
  return max2f(__uint_as_float(rr[0]),__uint_as_float(rr[1]));
}
__device__ __forceinline__ void pv(f32x16*o,int vb,bf16x8 pa0,bf16x8 pa1,bf16x8 pa2,bf16x8 pa3){
  #pragma unroll
  for(int d0=0;d0<2;++d0){s16x4 lo[4],hi[4];
    #pragma unroll
    for(int ks=0;ks<4;++ks){
      asm volatile("ds_read_b64_tr_b16 %0,%1 offset:%c2":"=&v"(lo[ks]):"v"(vb),"i"(d0*4096+ks*1024):"memory");
      asm volatile("ds_read_b64_tr_b16 %0,%1 offset:%c2":"=&v"(hi[ks]):"v"(vb),"i"(d0*4096+ks*1024+512):"memory");}
    asm volatile("s_waitcnt lgkmcnt(0)":::"memory");SBAR();
    #define PK(k) (bf16x8){lo[k][0],lo[k][1],lo[k][2],lo[k][3],hi[k][0],hi[k][1],hi[k][2],hi[k][3]}
    o[d0]=__builtin_amdgcn_mfma_f32_32x32x16_bf16(pa0,PK(0),o[d0],0,0,0);
    o[d0]=__builtin_amdgcn_mfma_f32_32x32x16_bf16(pa1,PK(1),o[d0],0,0,0);
    o[d0]=__builtin_amdgcn_mfma_f32_32x32x16_bf16(pa2,PK(2),o[d0],0,0,0);
    o[d0]=__builtin_amdgcn_mfma_f32_32x32x16_bf16(pa3,PK(3),o[d0],0,0,0);
    #undef PK
  }
}

#ifndef ATTN_STORE16
#define ATTN_STORE16(p,v) (*(u32x4*)(p)=(v))
#endif
template<int THRL> __device__ __forceinline__ void attn_unit(int qb,int t0,float slope2,const bf16*Q,const bf16*__restrict__ K,const bf16*__restrict__ V,bf16*O,char*shm){
  int tid_=tidx(); asm volatile("":"+v"(tid_));
  const int tid=tid_,lane=tid&63,r32=lane&31,hi=lane>>5; const int wid=__builtin_amdgcn_readfirstlane(tid>>6);
  const int q0=qb*QB;
  const bf16*Qw=Q+(long)(q0+wid*QBLK)*DM;
  const bf16*Kh=K+(long)t0*KVBLK*DM,*Vh=V+(long)t0*KVBLK*DM;
  const unsigned lds0=(unsigned)(uintptr_t)shm;
  float*wsf=(float*)(shm+LDS_WS)+wid*64;
  const bf16*ksrc=Kh+(long)lane*DM+wid*8;
  const bf16*vsrc=Vh+(long)(16*(wid&3)+(lane>>2))*DM+(wid>>2)*32+(lane&3)*8;
  const unsigned kdst=lds0+LDS_K+wid*1024, vdst=lds0+LDS_V+wid*1024;
  #define DMA_K(t,slot) glds16(ksrc+(long)(t)*KVBLK*DM,(unsigned)__builtin_amdgcn_readfirstlane(kdst+(slot)))
  #define DMA_V(t,slot) glds16(vsrc+(long)(t)*KVBLK*DM,(unsigned)__builtin_amdgcn_readfirstlane(vdst+(slot)))
  const int vb0=(int)(lds0+LDS_V)+((lane>>4)&1)*32+(lane&3)*8+(4*hi+((lane&15)>>2))*64;
  const char*Kbase=shm+LDS_K; bf16x8 kf[8];
  const lds_cptr shm3=(lds_cptr)shm; const lds_cptr kp0=shm3+LDS_K+hi*1024+r32*16; const lds_cptr vp0=shm3+LDS_V+((lane>>4)&1)*32+(lane&3)*8+(4*hi+((lane&15)>>2))*64;
  const int NT=(q0+QB)/KVBLK-t0;
  DMA_K(0,0);DMA_V(0,0);DMA_K(1,SLOTB);
  bf16x8 qr[4];
  #pragma unroll
  for(int d0=0;d0<4;++d0)qr[d0]=*reinterpret_cast<const bf16x8*>(&Qw[(long)r32*DM+d0*16+hi*8]);
  float mhat=0.f,l_reg=0.f;f32x16 o[2];o[0]=f32x16{};o[1]=f32x16{};
  #define CINIT(C0_,C1_,t_) do{ float s2_=slope2; asm volatile("":"+v"(s2_));   \
      const float bt_=fmaf(s2_,(float)(64*(t_)+4*hi),-mhat); const float bu_=fmaf(s2_,32.f,bt_); \
      _Pragma("unroll") for(int r=0;r<16;++r){ C0_[r]=fmaf(s2_,(float)((r&3)+8*(r>>2)),bt_); C1_[r]=fmaf(s2_,(float)((r&3)+8*(r>>2)),bu_); } }while(0)
  const int qrel=wid*QBLK+r32;
  #define CMASK(P0,P1,t) do{int jb_=(t)-(NT-4); if(jb_>=0)cmask(P0,P1,jb_,qrel,hi);}while(0)
  bool resc=false;
  #define START(P0,P1) do{ const float rm=rowmax(P0,P1); resc=false; \
    { const float dl=rm; mhat=fadd_s(mhat,dl); \
      _Pragma("unroll") for(int r=0;r<16;++r){P0[r]=fsub_s(P0[r],dl);P1[r]=fsub_s(P1[r],dl);} } \
    _Pragma("unroll") for(int r=0;r<16;++r)P0[r]=__builtin_amdgcn_exp2f(P0[r]); }while(0)
  #define RESC() do{ if(resc){ asm volatile("s_waitcnt lgkmcnt(0)":::"memory"); \
      _Pragma("unroll") for(int d_=0;d_<2;++d_) _Pragma("unroll") for(int r=0;r<16;++r)o[d_][r]*=wsf[crow(r,hi)]; } }while(0)
  f32x16 pA0,pA1,pB0,pB1;
  int sl_prev=0,sl_cur=0,sl_next=SLOTB;
  #define ROT() do{sl_prev=sl_cur;sl_cur=sl_next;sl_next=(sl_next==(NSLOT-1)*SLOTB)?0:sl_next+SLOTB;}while(0)
  DMA_K(2,2*SLOTB);
  WAIT_BAR(3);
  CINIT(pA0,pA1,0); qkt(pA0,pA1,Kbase,qr,r32,hi);asm volatile("s_nop 15\n\ts_nop 7":"+v"(pA0),"+v"(pA1));CMASK(pA0,pA1,0);
  START(pA0,pA1);
  _Pragma("unroll") for(int r=0;r<16;++r)pA1[r]=__builtin_amdgcn_exp2f(pA1[r]);
  WAIT_BAR(0);
  DMA_K(3,0);DMA_V(1,SLOTB);
  ROT();
  kload8(kf,kp0+sl_cur);
  WAIT_BAR(2);
  s16x4 vlo[8],vhi[8]; u32x4 pw0,pw1,pw2,pw3;
  #define PKW(P,B) cvtpk_s(P[B],P[B+1])
  #define PAF(k) __builtin_bit_cast(bf16x8,pw##k)
  #define VFR(i) (bf16x8){vlo[i][0],vlo[i][1],vlo[i][2],vlo[i][3],vhi[i][0],vhi[i][1],vhi[i][2],vhi[i][3]}
  #define PIN(x) asm volatile("":"+v"(x))
  #define MX3(a,b,c) __builtin_fmaxf(__builtin_fmaxf((a),(b)),(c))
  #define GAPA(MF,A0,A1,A2,A3,W0,W1,PW) do{ MF; sacc+=A0; sacc+=A1; sacc+=A2; sacc+=A3; PIN(sacc); W0; W1; PIN(PW); SBAR(); }while(0)
  #define EX(v) __builtin_amdgcn_exp2f(v)
  #define GAPB(MF,X,B) do{ MF; X[B]=EX(X[B]); X[B+1]=EX(X[B+1]); X[B+2]=EX(X[B+2]); X[B+3]=EX(X[B+3]); PIN(X); SBAR(); }while(0)
  #define VRD(i) do{ vlo[i]=vtr(vp_+(((i)>>2)*4096+((i)&3)*1024)); vhi[i]=vtr(vp_+(((i)>>2)*4096+((i)&3)*1024+512)); }while(0)
  #define KRD(G,j) do{ if(G){ kload2(kf,kp0+sl_next,j); SBAR(); } }while(0)
  #define STEP(C0,C1,P0,P1,t,GK,GV,GL) do{ SBAR(); \
    CINIT(C0,C1,t); PIN(C0); PIN(C1); SBAR(); \
    const lds_cptr vp_=vp0+sl_prev; \
    VRD(0); SBAR(); float sacc=(P0[0]+P0[1]); \
    GAPA(C0=__builtin_amdgcn_mfma_f32_32x32x16_bf16(kf[0],qr[0],C0,0,0,0), P0[2],P0[3],P0[4],P0[5],     pw0[0]=PKW(P0,0), pw0[1]=PKW(P0,2), pw0); \
    VRD(4); SBAR(); GAPA(C1=__builtin_amdgcn_mfma_f32_32x32x16_bf16(kf[1],qr[0],C1,0,0,0), P0[6],P0[7],P0[8],P0[9],     pw0[2]=PKW(P0,4), pw0[3]=PKW(P0,6), pw0); \
    VRD(1); SBAR(); GAPA(C0=__builtin_amdgcn_mfma_f32_32x32x16_bf16(kf[2],qr[1],C0,0,0,0),   P0[10],P0[11],P0[12],P0[13], pw1[0]=PKW(P0,8), pw1[1]=PKW(P0,10), pw1); \
    VRD(5); SBAR(); GAPA(C1=__builtin_amdgcn_mfma_f32_32x32x16_bf16(kf[3],qr[1],C1,0,0,0),   P0[14],P0[15],P1[0],P1[1],   pw1[2]=PKW(P0,12),pw1[3]=PKW(P0,14), pw1); \
    VRD(2); SBAR(); GAPA(C0=__builtin_amdgcn_mfma_f32_32x32x16_bf16(kf[4],qr[2],C0,0,0,0),   P1[2],P1[3],P1[4],P1[5],     pw2[0]=PKW(P1,0), pw2[1]=PKW(P1,2), pw2); \
    VRD(6); SBAR(); GAPA(C1=__builtin_amdgcn_mfma_f32_32x32x16_bf16(kf[5],qr[2],C1,0,0,0),   P1[6],P1[7],P1[8],P1[9],     pw2[2]=PKW(P1,4), pw2[3]=PKW(P1,6), pw2); \
    VRD(3); SBAR(); GAPA(C0=__builtin_amdgcn_mfma_f32_32x32x16_bf16(kf[6],qr[3],C0,0,0,0),   P1[10],P1[11],P1[12],P1[13], pw3[0]=PKW(P1,8), pw3[1]=PKW(P1,10), pw3); \
    VRD(7); SBAR(); GAPA(C1=__builtin_amdgcn_mfma_f32_32x32x16_bf16(kf[7],qr[3],C1,0,0,0),   P1[14],P1[15],0.f,0.f,       pw3[2]=PKW(P1,12),pw3[3]=PKW(P1,14), pw3); \
    l_reg+=sacc; \
    if(GK){DMA_K((t)+3,sl_cur);} if(GV){DMA_V((t)+1,sl_next);} \
    CMASK(C0,C1,t); \
    { float a=MX3(C0[0],C0[1],C1[0]),b=MX3(C0[2],C0[3],C1[1]); a=MX3(a,C1[2],C1[3]); \
      _Pragma("unroll") for(int r=4;r<16;r+=4){a=MX3(a,C0[r],C0[r+1]);b=MX3(b,C0[r+2],C0[r+3]);a=MX3(a,C1[r],C1[r+1]);b=MX3(b,C1[r+2],C1[r+3]);} \
      float rm=__builtin_fmaxf(a,b); { auto rr=__builtin_amdgcn_permlane32_swap(__float_as_uint(rm),__float_as_uint(rm),false,false); rm=__builtin_fmaxf(__uint_as_float(rr[0]),__uint_as_float(rr[1])); } \
      resc=false; \
      if(__builtin_expect(__any(rm>(float)THRL),0)){ const float dl=__builtin_fmaxf(rm,0.f); mhat+=dl; \
        _Pragma("unroll") for(int r=0;r<16;++r){C0[r]-=dl;C1[r]-=dl;} \
        const float f=__builtin_amdgcn_exp2f(-dl); l_reg*=f; if(hi==0)wsf[r32]=f; resc=true; } } \
    SBAR(); \
    GAPB(o[0]=__builtin_amdgcn_mfma_f32_32x32x16_bf16(PAF(0),VFR(0),o[0],0,0,0), C0,0); \
    GAPB(o[1]=__builtin_amdgcn_mfma_f32_32x32x16_bf16(PAF(0),VFR(4),o[1],0,0,0), C0,4); \
    KRD(GL,0); GAPB(o[0]=__builtin_amdgcn_mfma_f32_32x32x16_bf16(PAF(1),VFR(1),o[0],0,0,0), C0,8); \
    KRD(GL,1); GAPB(o[1]=__builtin_amdgcn_mfma_f32_32x32x16_bf16(PAF(1),VFR(5),o[1],0,0,0), C0,12); \
    KRD(GL,2); GAPB(o[0]=__builtin_amdgcn_mfma_f32_32x32x16_bf16(PAF(2),VFR(2),o[0],0,0,0), C1,0); \
    KRD(GL,3); GAPB(o[1]=__builtin_amdgcn_mfma_f32_32x32x16_bf16(PAF(2),VFR(6),o[1],0,0,0), C1,4); \
    GAPB(o[0]=__builtin_amdgcn_mfma_f32_32x32x16_bf16(PAF(3),VFR(3),o[0],0,0,0), C1,8); \
    GAPB(o[1]=__builtin_amdgcn_mfma_f32_32x32x16_bf16(PAF(3),VFR(7),o[1],0,0,0), C1,12); \
    }while(0)
  int t=1;
  #undef CMASK
  #define CMASK(P0,P1,t) do{}while(0)
  for(;t+5<NT;t+=2){
    STEP(pB0,pB1,pA0,pA1,t,true,true,true);     WAIT_BAR(2); RESC(); ROT();
    STEP(pA0,pA1,pB0,pB1,t+1,true,true,true);   WAIT_BAR(2); RESC(); ROT();
  }
  #undef CMASK
  #define CMASK(P0,P1,t) do{int jb_=(t)-(NT-4); if(jb_>=0)cmask(P0,P1,jb_,qrel,hi);}while(0)
  #define ENDW(tt) do{ if((tt)+3<NT){WAIT_BAR(2);} else if((tt)+2<NT){WAIT_BAR(1);} else {WAIT_BAR(0);} }while(0)
  for(;t+1<NT;t+=2){
    STEP(pB0,pB1,pA0,pA1,t,(t+3<NT),(t+1<NT),(t+1<NT));       ENDW(t);   RESC(); ROT();
    STEP(pA0,pA1,pB0,pB1,t+1,(t+4<NT),(t+2<NT),(t+2<NT));     ENDW(t+1); RESC(); ROT();
  }
  STEP(pB0,pB1,pA0,pA1,NT-1,false,false,false); RESC();
  { float sacc=pB0[0]+pB0[1]; _Pragma("unroll") for(int r=2;r<16;++r)sacc+=pB0[r]; _Pragma("unroll") for(int r=0;r<16;++r)sacc+=pB1[r]; l_reg+=sacc;
    pw0=(u32x4){PKW(pB0,0),PKW(pB0,2),PKW(pB0,4),PKW(pB0,6)};pw1=(u32x4){PKW(pB0,8),PKW(pB0,10),PKW(pB0,12),PKW(pB0,14)};pw2=(u32x4){PKW(pB1,0),PKW(pB1,2),PKW(pB1,4),PKW(pB1,6)};pw3=(u32x4){PKW(pB1,8),PKW(pB1,10),PKW(pB1,12),PKW(pB1,14)};
    SBAR(); pv(o,vb0+sl_cur,PAF(0),PAF(1),PAF(2),PAF(3)); }
  #undef PKW
  #undef PAF
  #undef VFR
  #undef PIN
  #undef MX3
  #undef GAPA
  #undef GAPB
  #undef EX
  #undef VRD
  #undef KRD
  #undef STEP
  #undef ENDW
  {auto rr=__builtin_amdgcn_permlane32_swap(__float_as_uint(l_reg),__float_as_uint(l_reg),false,false);l_reg=__uint_as_float(rr[0])+__uint_as_float(rr[1]);}
  if(hi==0)wsf[32+r32]=l_reg;asm volatile("s_waitcnt lgkmcnt(0)":::"memory");
  float rli[16];
  #pragma unroll
  for(int r=0;r<16;++r)rli[r]=__builtin_amdgcn_rcpf(wsf[32+crow(r,hi)]);
  bf16*Ow=O+(long)(q0+wid*QBLK)*DM;
  { bf16*stg=(bf16*)(shm+LDS_OST)+wid*2048;
    #pragma unroll
    for(int r=0;r<16;++r){const int orow=crow(r,hi);
      #pragma unroll
      for(int d0=0;d0<2;++d0)stg[orow*64+d0*32+r32]=__float2bfloat16(o[d0][r]*rli[r]);}
    asm volatile("s_waitcnt lgkmcnt(0)":::"memory");
    #pragma unroll
    for(int i=0;i<4;++i){const int row=i*8+(lane>>3),ch=lane&7; const u32x4 v=*(const u32x4*)(stg+row*64+ch*8); ATTN_STORE16(Ow+(long)row*DM+ch*8,v);} }
  asm volatile("s_waitcnt lgkmcnt(0)\n\ts_barrier":::"memory");
  #undef DMA_K
  #undef DMA_V
  #undef CMASK
  #undef CINIT
  #undef START
  #undef RESC
  #undef ROT
}
constexpr int ATTN_LDS_BYTES=LDS_BYTES;
template<int THRL=8> __device__ __forceinline__ void attn_dispatch(int u,char*lds,const bf16*QA,const bf16*KA,const bf16*VA,bf16*O1,bf16*O2,const unsigned*norms){
    const int h=3-(u>>8), r=u&255, qb=63-(r>>2), c=(r>>1)&1, vhalf=r&1, hv=h*2+c;
    const float slope2=__uint_as_float(__builtin_amdgcn_readfirstlane((0x3fb8aa3bu)-((unsigned)(2*(h+1))<<23)));
    const float Bnd=sqrtf(__uint_as_float(norms[16+hv*64+qb]))*sqrtf(__uint_as_float(norms[hv]))*1.0001f+0.01f;
    const float Dmin=-sortu2f(norms[528+hv*64+qb]);
    const float W=(Bnd-fminf(Dmin,Bnd)+34.f)/slope2+1.f;
    const int q0=qb*QB; int t0=0; if((float)q0>W){ t0=((int)(((float)q0-W)*(1.f/64.f)))&~1; }
    t0=__builtin_amdgcn_readfirstlane(t0);
    const bf16*Q=QA+hv*64; const bf16*K=KA+hv*64; const bf16*V=VA+h*128+vhalf*64; bf16*O=(c?O2:O1)+h*128+vhalf*64;
    attn_unit<THRL>(qb,t0,slope2,Q,K,V,O,lds);
}
#undef SBAR
#undef WAIT_BAR
}

__device__ __forceinline__ void ph_rmsnorm_bf16(const float* X, const float* g, bf16* O) {
    const int lane = tidx() & 63, wave = tidx() >> 6;
    const int gw = blockIdx.x * NWAVES + wave, NGW = gridDim.x * NWAVES;
    for (int m = gw; m < M; m += NGW) {
        const f32x4* xr = (const f32x4*)(X + (size_t)m * D) + lane;
        f32x4 v[4]; float s = 0.f;
#pragma unroll
        for (int j = 0; j < 4; ++j) { v[j] = xr[64 * j]; s += (v[j].x * v[j].x + v[j].y * v[j].y) + (v[j].z * v[j].z + v[j].w * v[j].w); }
        const float r = rsqrtf(wave_sum(s) * (1.f / D) + EPS);
        v2u* o8 = (v2u*)(O + (size_t)m * D) + lane;
#pragma unroll
        for (int j = 0; j < 4; ++j) { const f32x4 gg = ((const f32x4*)g)[lane + 64 * j]; v2u w; w.x = pk2(v[j].x * r * gg.x, v[j].y * r * gg.y); w.y = pk2(v[j].z * r * gg.z, v[j].w * r * gg.w); o8[64 * j] = w; }
    }
}
__device__ __forceinline__ void ph_rmsnorm_f32_inplace(float* X, const float* g) {
    const int lane = tidx() & 63, wave = tidx() >> 6;
    const int gw = blockIdx.x * NWAVES + wave, NGW = gridDim.x * NWAVES;
    for (int m = gw; m < M; m += NGW) {
        f32x4* xr = (f32x4*)(X + (size_t)m * D) + lane;
        f32x4 v[4]; float s = 0.f;
#pragma unroll
        for (int j = 0; j < 4; ++j) { v[j] = xr[64 * j]; s += (v[j].x * v[j].x + v[j].y * v[j].y) + (v[j].z * v[j].z + v[j].w * v[j].w); }
        const float r = rsqrtf(wave_sum(s) * (1.f / D) + EPS);
#pragma unroll
        for (int j = 0; j < 4; ++j) { const f32x4 gg = ((const f32x4*)g)[lane + 64 * j]; xr[64 * j] = v[j] * r * gg; }
    }
}

__device__ __forceinline__ void transpose_item(const float* W, int K, int N, int Npad, bf16* WT, LAS float* scr, int item, int lane, const float* kgain = nullptr) {
    const int nblk = Npad / 32, kb = item / nblk, nb = item % nblk, k0 = 64 * kb, n0 = 32 * nb;
    const int nn = n0 + (lane & 31);
#pragma unroll 8
    for (int i = 0; i < 32; ++i) { const int kk = 2 * i + (lane >> 5); const float gk = kgain ? kgain[k0 + kk] : 1.f; scr[kk * 33 + (lane & 31)] = (nn < N) ? W[(size_t)(k0 + kk) * N + nn] * gk : 0.f; }
    asm volatile("s_waitcnt lgkmcnt(0)" ::: "memory");
    const int c = lane & 7;
#pragma unroll
    for (int j = 0; j < 4; ++j) { const int n = (lane >> 3) + 8 * j; const LAS float* sp = scr + (8 * c) * 33 + n;
        v4u o; o.x = pk2(sp[0 * 33], sp[1 * 33]); o.y = pk2(sp[2 * 33], sp[3 * 33]); o.z = pk2(sp[4 * 33], sp[5 * 33]); o.w = pk2(sp[6 * 33], sp[7 * 33]);
        *(v4u*)(WT + (size_t)(n0 + n) * K + k0 + 8 * c) = o; }
    asm volatile("s_waitcnt lgkmcnt(0)" ::: "memory");
}
__device__ __forceinline__ void ph_weights_in(const float* w_in, bf16* WIN, LAS unsigned char* lds) {
    const int lane = tidx() & 63, wave = __builtin_amdgcn_readfirstlane(tidx() >> 6);
    LAS float* scr = (LAS float*)(lds + wave * 16384);
    const int gw = blockIdx.x * NWAVES + wave, NGW = gridDim.x * NWAVES;
    constexpr int I_IN = (D / 64) * (NINP / 32);
    for (int it = gw; it < I_IN; it += NGW) transpose_item(w_in, D, NIN, NINP, WIN, scr, it, lane);
}
constexpr int WCH_OUT = (D / 64) * (D / 32), WCH_Q = (D / 64) * (NQ / 32), WCH_P = (PLE / 64) * (D / 32), WCH_ITEMS = 2 * WCH_OUT + WCH_Q + WCH_P, WCH_CHUNKS = (WCH_ITEMS + 7) / 8;
__device__ __forceinline__ void weights_chunk(int chunk, const float* w_out, const float* w_query, const float* g_query, const float* w_gate, const float* w_proj, bf16* WOUT, bf16* WQ, bf16* WG, bf16* WP, LAS unsigned char* lds) {
    const int lane = tidx() & 63, wave = __builtin_amdgcn_readfirstlane(tidx() >> 6);
    LAS float* scr = (LAS float*)(lds + wave * 16384);
    int r = chunk * 8 + wave;
    if (r >= WCH_ITEMS) return;
    if (r < WCH_OUT) { transpose_item(w_out, D, D, D, WOUT, scr, r, lane); return; } r -= WCH_OUT;
    if (r < WCH_Q) { transpose_item(w_query, D, NQ, NQ, WQ, scr, r, lane, g_query); return; } r -= WCH_Q;
    if (r < WCH_OUT) { transpose_item(w_gate, D, D, D, WG, scr, r, lane); return; } r -= WCH_OUT;
    transpose_item(w_proj, PLE, D, D, WP, scr, r, lane);
}

template <class Epi>
__device__ __forceinline__ void naive_gemm(const bf16* A, int lda, const float* W, int K, int N, float* lds, Epi epi) {
    float* As = lds;
    float* Ws = lds + 32 * 65;
    const int tid = tidx(), tx = tid & 15, ty = tid >> 4;
    const int ntn = (N + 63) / 64, nt = (M / 64) * ntn;
    for (int t = blockIdx.x; t < nt; t += gridDim.x) {
        const int tm = t / ntn, tn = t % ntn, r0 = tm * 64, c0 = tn * 64;
        float acc[2][4];
#pragma unroll
        for (int i = 0; i < 2; ++i)
#pragma unroll
            for (int j = 0; j < 4; ++j) acc[i][j] = 0.f;
        for (int k0 = 0; k0 < K; k0 += 32) {
            { const int r = tid >> 3, kq = (tid & 7) * 4; const v2u v = *(const v2u*)(A + (size_t)(r0 + r) * lda + k0 + kq);
              As[(kq + 0) * 65 + r] = bf2f(v.x & 0xffffu); As[(kq + 1) * 65 + r] = bf2f(v.x >> 16); As[(kq + 2) * 65 + r] = bf2f(v.y & 0xffffu); As[(kq + 3) * 65 + r] = bf2f(v.y >> 16); }
            { const int kk = tid >> 4, nq = (tid & 15) * 4; const float* wp = W + (size_t)(k0 + kk) * N + c0 + nq;
#pragma unroll
              for (int j = 0; j < 4; ++j) Ws[kk * 64 + nq + j] = (c0 + nq + j < N) ? wp[j] : 0.f; }
            __syncthreads();
#pragma unroll 8
            for (int kk = 0; kk < 32; ++kk) {
                const float a0 = As[kk * 65 + ty], a1 = As[kk * 65 + ty + 32];
                const f32x4 b = *(const f32x4*)(Ws + kk * 64 + tx * 4);
                acc[0][0] += a0 * b.x; acc[0][1] += a0 * b.y; acc[0][2] += a0 * b.z; acc[0][3] += a0 * b.w;
                acc[1][0] += a1 * b.x; acc[1][1] += a1 * b.y; acc[1][2] += a1 * b.z; acc[1][3] += a1 * b.w;
            }
            __syncthreads();
        }
#pragma unroll
        for (int i = 0; i < 2; ++i)
#pragma unroll
            for (int j = 0; j < 4; ++j) { const int row = r0 + ty + 32 * i, col = c0 + tx * 4 + j; if (col < N) epi(row, col, acc[i][j]); }
    }
}

__device__ __forceinline__ void ph_attn_naive(const bf16* QA, const bf16* KA, const bf16* VA, bf16* O1, bf16* O2, float* lds) {
    float* Ks = lds; float* Vs = lds + 32 * 64; float* Ss = Vs + 32 * 128;
    const int tid = tidx(), qi = tid >> 3, cg = tid & 7;
    for (int item = blockIdx.x; item < 8 * 256; item += gridDim.x) {
        const int hv = item & 7, qb = 255 - (item >> 3);
        const int h = hv >> 1, c = hv & 1, q0 = qb * 64, qpos = q0 + qi;
        const float slope2 = exp2f(-2.f * (float)(h + 1)) * LOG2E;
        float q[64];
        { const v4u* qp = (const v4u*)(QA + (size_t)qpos * 512 + hv * 64);
#pragma unroll
          for (int i = 0; i < 8; ++i) { const v4u v = qp[i];
              q[8 * i + 0] = bf2f(v.x & 0xffffu); q[8 * i + 1] = bf2f(v.x >> 16); q[8 * i + 2] = bf2f(v.y & 0xffffu); q[8 * i + 3] = bf2f(v.y >> 16);
              q[8 * i + 4] = bf2f(v.z & 0xffffu); q[8 * i + 5] = bf2f(v.z >> 16); q[8 * i + 6] = bf2f(v.w & 0xffffu); q[8 * i + 7] = bf2f(v.w >> 16); } }
        float m = -INFINITY, l = 0.f, acc[16];
#pragma unroll
        for (int i = 0; i < 16; ++i) acc[i] = 0.f;
        const int ntile = (q0 + 64) / 32;
        for (int kt = 0; kt < ntile; ++kt) {
            const int k0 = kt * 32;
            __syncthreads();
            { const int kk = tid >> 4, d4 = (tid & 15) * 4; const v2u v = *(const v2u*)(KA + (size_t)(k0 + kk) * 512 + hv * 64 + d4);
              float* kd = Ks + kk * 64 + d4; kd[0] = bf2f(v.x & 0xffffu); kd[1] = bf2f(v.x >> 16); kd[2] = bf2f(v.y & 0xffffu); kd[3] = bf2f(v.y >> 16); }
            { const int kk = tid >> 4, e8 = (tid & 15) * 8; const v4u v = *(const v4u*)(VA + (size_t)(k0 + kk) * 512 + h * 128 + e8);
              float* vd = Vs + kk * 128 + e8; vd[0] = bf2f(v.x & 0xffffu); vd[1] = bf2f(v.x >> 16); vd[2] = bf2f(v.y & 0xffffu); vd[3] = bf2f(v.y >> 16);
              vd[4] = bf2f(v.z & 0xffffu); vd[5] = bf2f(v.z >> 16); vd[6] = bf2f(v.w & 0xffffu); vd[7] = bf2f(v.w >> 16); }
            __syncthreads();
#pragma unroll
            for (int j = 0; j < 4; ++j) {
                const int kk = cg + 8 * j; const float* kr = Ks + kk * 64; float s = 0.f;
#pragma unroll
                for (int d = 0; d < 64; ++d) s += q[d] * kr[d];
                const int kpos = k0 + kk;
                s = (kpos <= qpos) ? s - slope2 * (float)(qpos - kpos) : -INFINITY;
                Ss[qi * 33 + kk] = s;
            }
            __syncthreads();
            float tmax = -INFINITY;
#pragma unroll 8
            for (int kk = 0; kk < 32; ++kk) tmax = fmaxf(tmax, Ss[qi * 33 + kk]);
            const float mn = fmaxf(m, tmax), alpha = exp2f(m - mn);
            l *= alpha;
#pragma unroll
            for (int i = 0; i < 16; ++i) acc[i] *= alpha;
            for (int kk = 0; kk < 32; ++kk) {
                const float p = exp2f(Ss[qi * 33 + kk] - mn); l += p;
                const float* vr = Vs + kk * 128 + 16 * cg;
#pragma unroll
                for (int i = 0; i < 16; ++i) acc[i] += p * vr[i];
            }
            m = mn;
        }
        const float il = 1.f / l;
        bf16* O = c ? O2 : O1;
        v4u w0, w1;
        w0.x = pk2(acc[0] * il, acc[1] * il); w0.y = pk2(acc[2] * il, acc[3] * il); w0.z = pk2(acc[4] * il, acc[5] * il); w0.w = pk2(acc[6] * il, acc[7] * il);
        w1.x = pk2(acc[8] * il, acc[9] * il); w1.y = pk2(acc[10] * il, acc[11] * il); w1.z = pk2(acc[12] * il, acc[13] * il); w1.w = pk2(acc[14] * il, acc[15] * il);
        v4u* op = (v4u*)(O + (size_t)qpos * 512 + h * 128 + 16 * cg); op[0] = w0; op[1] = w1;
    }
}

__device__ __forceinline__ void ph_conv_naive(const bf16* MQ, const bf16* MK, const float* cw, const float* cb, bf16* CQ, bf16* CK) {
    const size_t n = (size_t)M * 512, stride = (size_t)gridDim.x * NTHREADS;
    for (size_t i = (size_t)blockIdx.x * NTHREADS + tidx(); i < n; i += stride) {
        const int t = (int)(i >> 9), c = (int)(i & 511);
        float aq = cb[c], ak = cb[512 + c];
#pragma unroll
        for (int j = 0; j < 4; ++j) { const int tt = t - 3 + j; if (tt >= 0) { aq += cw[j * 1024 + c] * bf2f(MQ[(size_t)tt * 512 + c]); ak += cw[j * 1024 + 512 + c] * bf2f(MK[(size_t)tt * 512 + c]); } }
        aq = aq * sigmoidf_(aq) * 0.08838834764831845f; ak = ak * sigmoidf_(ak);
        CQ[i] = (bf16)f2bf(aq); CK[i] = (bf16)f2bf(ak);
    }
}
__device__ __forceinline__ void ph_mlstm_naive(const bf16* CQ, const bf16* CK, const bf16* MV, const float* GATES, const float* b_i, const float* b_f, float* HS, float* lds) {
    if (blockIdx.x >= 4) return;
    const int h = blockIdx.x, tid = tidx(), e = tid & 127, dg = tid >> 7;
    float* qs = lds; float* ks = qs + 64 * 128; float* vs = ks + 64 * 128; float* fs = vs + 64 * 128; float* is_ = fs + 64; float* red = is_ + 64; float* redd = red + 512;
    float C[32], n[32];
#pragma unroll
    for (int i = 0; i < 32; ++i) { C[i] = 0.f; n[i] = 0.f; }
    for (int c0 = 0; c0 < M; c0 += 64) {
        __syncthreads();
        for (int i = tid; i < 64 * 128; i += NTHREADS) { const int tt = i >> 7, d = i & 127; const size_t g = (size_t)(c0 + tt) * 512 + h * 128 + d; qs[i] = bf2f(CQ[g]); ks[i] = bf2f(CK[g]); vs[i] = bf2f(MV[g]); }
        if (tid < 64) { const float fp = GATES[(size_t)(c0 + tid) * 8 + 4 + h] + b_f[h], ip = GATES[(size_t)(c0 + tid) * 8 + h] + b_i[h]; fs[tid] = 1.f / (1.f + expf(-fp)); is_[tid] = expf(ip); }
        __syncthreads();
        for (int tt = 0; tt < 64; ++tt) {
            const float f = fs[tt], ii = is_[tt], ve = vs[tt * 128 + e]; float pn = 0.f, pd = 0.f;
#pragma unroll
            for (int i = 0; i < 32; ++i) { const float kd = ks[tt * 128 + dg * 32 + i], qd = qs[tt * 128 + dg * 32 + i], ik = ii * kd;
                C[i] = f * C[i] + ik * ve; n[i] = f * n[i] + ik; pn += qd * C[i]; pd += qd * n[i]; }
            red[dg * 128 + e] = pn; if (e == 0) redd[dg] = pd;
            __syncthreads();
            if (dg == 0) { const float num = (red[e] + red[128 + e]) + (red[256 + e] + red[384 + e]), den = (redd[0] + redd[1]) + (redd[2] + redd[3]);
                HS[(size_t)(c0 + tt) * 512 + h * 128 + e] = num / fmaxf(fabsf(den), 1.f); }
            __syncthreads();
        }
    }
}
template <bool DO_ML>
__device__ __forceinline__ void ph_combine(const bf16* O1, const bf16* O2, const bf16* MO, const float* HS, const float* lq1, const float* lk1, const float* lq2, const float* lk2,
                                           const float* subln_g, const float* ml_g, bf16* ACAT) {
    const int lane = tidx() & 63, wave = tidx() >> 6;
    const int gw = blockIdx.x * NWAVES + wave, NGW = gridDim.x * NWAVES;
    const float lam = expf(wave_sum(lq1[lane] * lk1[lane])) - expf(wave_sum(lq2[lane] * lk2[lane])) + LAMBDA_INIT;
    for (int m = gw; m < M; m += NGW) {
        const int c0 = lane * 8;
        float a[8], b[8];
        { const v4u u1 = *(const v4u*)(O1 + (size_t)m * 512 + c0), u2 = *(const v4u*)(O2 + (size_t)m * 512 + c0);
          const unsigned w1[4] = {u1.x, u1.y, u1.z, u1.w}, w2[4] = {u2.x, u2.y, u2.z, u2.w};
#pragma unroll
          for (int i = 0; i < 4; ++i) { a[2 * i] = bf2f(w1[i] & 0xffffu) - lam * bf2f(w2[i] & 0xffffu); a[2 * i + 1] = bf2f(w1[i] >> 16) - lam * bf2f(w2[i] >> 16); } }
        if (DO_ML) { const v4u uo = *(const v4u*)(MO + (size_t)m * 512 + c0); const unsigned wo[4] = {uo.x, uo.y, uo.z, uo.w};
          const f32x4 h0 = *(const f32x4*)(HS + (size_t)m * 512 + c0), h1 = *(const f32x4*)(HS + (size_t)m * 512 + c0 + 4);
          const float hh[8] = {h0.x, h0.y, h0.z, h0.w, h1.x, h1.y, h1.z, h1.w};
#pragma unroll
          for (int i = 0; i < 4; ++i) { b[2 * i] = sigmoidf_(bf2f(wo[i] & 0xffffu)) * hh[2 * i]; b[2 * i + 1] = sigmoidf_(bf2f(wo[i] >> 16)) * hh[2 * i + 1]; } }
        else {
#pragma unroll
          for (int i = 0; i < 8; ++i) b[i] = 0.f; }
        float sa = 0.f, sb = 0.f;
#pragma unroll
        for (int i = 0; i < 8; ++i) { sa += a[i] * a[i]; sb += b[i] * b[i]; }
#pragma unroll
        for (int o = 1; o < 16; o <<= 1) { sa += __shfl_xor(sa, o); sb += __shfl_xor(sb, o); }
        const float ra = rsqrtf(sa * (1.f / 128.f) + EPS) * (1.f - LAMBDA_INIT), rb = rsqrtf(sb * (1.f / 128.f) + EPS);
        const int cc = c0 & 127, hh_ = lane >> 4;
        v4u wa, wb;
        { const float* g = subln_g + cc; wa.x = pk2(a[0] * ra * g[0], a[1] * ra * g[1]); wa.y = pk2(a[2] * ra * g[2], a[3] * ra * g[3]); wa.z = pk2(a[4] * ra * g[4], a[5] * ra * g[5]); wa.w = pk2(a[6] * ra * g[6], a[7] * ra * g[7]); }
        { const float* g = ml_g + hh_ * 128 + cc; wb.x = pk2(b[0] * rb * g[0], b[1] * rb * g[1]); wb.y = pk2(b[2] * rb * g[2], b[3] * rb * g[3]); wb.z = pk2(b[4] * rb * g[4], b[5] * rb * g[5]); wb.w = pk2(b[6] * rb * g[6], b[7] * rb * g[7]); }
        *(v4u*)(ACAT + (size_t)m * 1024 + c0) = wa; if (DO_ML) *(v4u*)(ACAT + (size_t)m * 1024 + 512 + c0) = wb;
    }
}


namespace ml {
typedef short bf16x8 __attribute__((ext_vector_type(8)));
typedef float f32x16 __attribute__((ext_vector_type(16)));
typedef LAS unsigned char* lptr;
constexpr int LD128 = 272, LD64 = 144;
constexpr int QP_OFF = 0, K_OFF = 17408, Y_OFF = 0, KWT_OFF = 34816, VT_OFF = 53248, SM_OFF = 71680, CT_OFF = 80896, SMALL_OFF = 115712;
constexpr int LDY = 132;
constexpr int ST_STRIDE = 16384 + 256;
__device__ __forceinline__ int crow(int r, int hi) { return (r & 3) + 8 * (r >> 2) + 4 * hi; }
template <int KS>
__device__ __forceinline__ void mm_tile(f32x16& acc, lptr A, int lda, lptr Bt, int ldb, int r32, int hi) {
    lptr ap = A + r32 * lda + hi * 16; lptr bp = Bt + r32 * ldb + hi * 16;
#pragma unroll
    for (int ks = 0; ks < KS; ++ks) {
        const bf16x8 a = *(const LAS bf16x8*)(ap + ks * 32);
        const bf16x8 b = *(const LAS bf16x8*)(bp + ks * 32);
        acc = __builtin_amdgcn_mfma_f32_32x32x16_bf16(a, b, acc, 0, 0, 0);
    }
}
__device__ __forceinline__ float gates_chunk(const float* GATES, float bi, float bf_, int t0, int h, int lane, LAS float* eb, LAS float* wcol, LAS float* wupd, LAS float* misc) {
    const float fp = GATES[(size_t)(t0 + lane) * 8 + 4 + h] + bf_, ip = GATES[(size_t)(t0 + lane) * 8 + h] + bi;
    const float lf = fminf(fp, 0.f) - log1pf(__expf(-fabsf(fp)));
    float b = lf;
#pragma unroll
    for (int o = 1; o < 64; o <<= 1) { const float u = __shfl_up(b, o); if (lane >= o) b += u; }
    const float bL = __shfl(b, 63);
    eb[lane] = __expf(b); wcol[lane] = __expf(ip - b); wupd[lane] = __expf(bL - b + ip); if (lane == 0) misc[0] = __expf(bL);
    return bL;
}
__device__ __forceinline__ void stage_transposed(const bf16* CK, const bf16* MV, int t0, int h, lptr lds, const LAS float* wupd, int tid) {
    const int sp = tid & 31, c = tid >> 5;
    const size_t g0 = (size_t)(t0 + 2 * sp) * 512 + h * 128 + c * 8;
    const v4u k0 = *(const v4u*)(CK + g0), k1 = *(const v4u*)(CK + g0 + 512), v0 = *(const v4u*)(MV + g0), v1 = *(const v4u*)(MV + g0 + 512);
    const float w0 = wupd[2 * sp], w1 = wupd[2 * sp + 1];
    const unsigned ka[4] = {k0.x, k0.y, k0.z, k0.w}, kb[4] = {k1.x, k1.y, k1.z, k1.w}, va[4] = {v0.x, v0.y, v0.z, v0.w}, vb[4] = {v1.x, v1.y, v1.z, v1.w};
    lptr kw = lds + KWT_OFF + (8 * c) * LD64 + 4 * sp; lptr vt = lds + VT_OFF + (8 * c) * LD64 + 4 * sp;
#pragma unroll
    for (int i = 0; i < 4; ++i) {
        *(LAS unsigned*)(kw + (2 * i) * LD64) = pk2(w0 * bf2f(ka[i] & 0xffffu), w1 * bf2f(kb[i] & 0xffffu));
        *(LAS unsigned*)(kw + (2 * i + 1) * LD64) = pk2(w0 * bf2f(ka[i] >> 16), w1 * bf2f(kb[i] >> 16));
        *(LAS unsigned*)(vt + (2 * i) * LD64) = (va[i] & 0xffffu) | (vb[i] << 16);
        *(LAS unsigned*)(vt + (2 * i + 1) * LD64) = (va[i] >> 16) | (vb[i] & 0xffff0000u);
    }
}
__device__ __forceinline__ void state_update(f32x16 (&accS)[2], lptr lds, float aL, int wave, int r32, int hi) {
    const int er = wave & 3, dc0 = 2 * (wave >> 2);
#pragma unroll
    for (int i = 0; i < 2; ++i) {
#pragma unroll
        for (int r = 0; r < 16; ++r) accS[i][r] *= aL;
        mm_tile<4>(accS[i], lds + VT_OFF + (32 * er) * LD64, LD64, lds + KWT_OFF + (32 * (dc0 + i)) * LD64, LD64, r32, hi);
    }
}
__device__ __forceinline__ float kwt_rowsum(lptr lds, int d) {
    float s = 0.f; lptr p = lds + KWT_OFF + d * LD64;
#pragma unroll
    for (int i = 0; i < 8; ++i) { const v4u q = *(const LAS v4u*)(p + 16 * i);
        s += (bf2f(q.x & 0xffffu) + bf2f(q.x >> 16)) + (bf2f(q.y & 0xffffu) + bf2f(q.y >> 16)) + (bf2f(q.z & 0xffffu) + bf2f(q.z >> 16)) + (bf2f(q.w & 0xffffu) + bf2f(q.w >> 16)); }
    return s;
}

__device__ __forceinline__ void conv_items(const bf16* MQ, const bf16* MK, const float* cw, const float* cb, bf16* CQ, bf16* CK) {
    const int tid = tidx(), ch = tid & 15, rg = tid >> 4;
    for (int item = blockIdx.x; item < 256; item += gridDim.x) {
        const int h = item >> 6, j = item & 63, col = h * 128 + ch * 8;
        float wq[4][8], wk[4][8], bq[8], bk[8];
#pragma unroll
        for (int jj = 0; jj < 4; ++jj)
#pragma unroll
            for (int e = 0; e < 8; e += 4) { const f32x4 a = *(const f32x4*)(cw + jj * 1024 + col + e), b = *(const f32x4*)(cw + jj * 1024 + 512 + col + e);
                wq[jj][e] = a.x; wq[jj][e + 1] = a.y; wq[jj][e + 2] = a.z; wq[jj][e + 3] = a.w; wk[jj][e] = b.x; wk[jj][e + 1] = b.y; wk[jj][e + 2] = b.z; wk[jj][e + 3] = b.w; }
#pragma unroll
        for (int e = 0; e < 8; ++e) { bq[e] = cb[col + e]; bk[e] = cb[512 + col + e]; }
#pragma unroll 1
        for (int ps = 0; ps < 2; ++ps) {
            const int t0 = j * 256 + rg * 8 + ps * 4;
            v4u qi[7], ki[7];
#pragma unroll
            for (int r = 0; r < 7; ++r) { const int tt = t0 - 3 + r; if (tt >= 0) { qi[r] = *(const v4u*)(MQ + (size_t)tt * 512 + col); ki[r] = *(const v4u*)(MK + (size_t)tt * 512 + col); } else { qi[r] = (v4u){0u, 0u, 0u, 0u}; ki[r] = (v4u){0u, 0u, 0u, 0u}; } }
#pragma unroll
            for (int o = 0; o < 4; ++o) {
                float aq[8], ak[8];
#pragma unroll
                for (int e = 0; e < 8; ++e) { aq[e] = bq[e]; ak[e] = bk[e]; }
#pragma unroll
                for (int jj = 0; jj < 4; ++jj) { const v4u q = qi[o + jj], k = ki[o + jj]; const unsigned qa[4] = {q.x, q.y, q.z, q.w}, ka[4] = {k.x, k.y, k.z, k.w};
#pragma unroll
                    for (int e = 0; e < 4; ++e) { aq[2 * e] += wq[jj][2 * e] * bf2f(qa[e] & 0xffffu); aq[2 * e + 1] += wq[jj][2 * e + 1] * bf2f(qa[e] >> 16);
                                                  ak[2 * e] += wk[jj][2 * e] * bf2f(ka[e] & 0xffffu); ak[2 * e + 1] += wk[jj][2 * e + 1] * bf2f(ka[e] >> 16); } }
#pragma unroll
                for (int e = 0; e < 8; ++e) { aq[e] = aq[e] * sigmoidf_(aq[e]) * 0.08838834764831845f; ak[e] = ak[e] * sigmoidf_(ak[e]); }
                v4u oq, ok; oq.x = pk2(aq[0], aq[1]); oq.y = pk2(aq[2], aq[3]); oq.z = pk2(aq[4], aq[5]); oq.w = pk2(aq[6], aq[7]);
                ok.x = pk2(ak[0], ak[1]); ok.y = pk2(ak[2], ak[3]); ok.z = pk2(ak[4], ak[5]); ok.w = pk2(ak[6], ak[7]);
                *(v4u*)(CQ + (size_t)(t0 + o) * 512 + col) = oq; *(v4u*)(CK + (size_t)(t0 + o) * 512 + col) = ok;
            }
        }
    }
}
__device__ __forceinline__ void b1_item(int item, const bf16* CK, const bf16* MV, const float* GATES, const float* b_i, const float* b_f, float* ST, lptr lds) {
    const int tid = tidx(), lane = tid & 63, r32 = lane & 31, hi = lane >> 5; const int wave = __builtin_amdgcn_readfirstlane(tid >> 6);
    LAS float* eb = (LAS float*)(lds + SMALL_OFF); LAS float* wcol = eb + 64; LAS float* wupd = wcol + 64; LAS float* misc = wupd + 64 + 64 + 128;
    {
        const int h = item >> 6, j = item & 63;
        f32x16 accS[2]; accS[0] = f32x16{}; accS[1] = f32x16{};
        float nv = 0.f, sumb = 0.f;
        const float bi = b_i[h], bf_ = b_f[h];
        for (int c = 0; c < 4; ++c) {
            const int t0 = j * 256 + c * 64;
            __syncthreads();
            if (wave == 0) sumb += gates_chunk(GATES, bi, bf_, t0, h, lane, eb, wcol, wupd, misc);
            __syncthreads();
            stage_transposed(CK, MV, t0, h, lds, wupd, tid);
            const float aL = misc[0];
            __syncthreads();
            state_update(accS, lds, aL, wave, r32, hi);
            if (tid < 128) nv = aL * nv + kwt_rowsum(lds, tid);
        }
        float* st = ST + (size_t)item * ST_STRIDE;
#pragma unroll
        for (int i = 0; i < 2; ++i)
#pragma unroll
            for (int r = 0; r < 16; ++r) st[((wave * 2 + i) * 16 + r) * 64 + lane] = accS[i][r];
        if (tid < 128) st[16384 + tid] = nv;
        if (tid == 0) st[16384 + 128] = __expf(sumb);
    }
}
__device__ __forceinline__ void phase_b2(float* ST) {
    const int gt = blockIdx.x * NTHREADS + tidx(), NGT = gridDim.x * NTHREADS;
    for (int q = gt; q < 4 * (16384 + 128); q += NGT) {
        const int h = q / (16384 + 128), e = q % (16384 + 128);
        float* base = ST + (size_t)h * 64 * ST_STRIDE;
        float c = 0.f;
#pragma unroll 1
        for (int jb = 0; jb < 64; jb += 16) {
            float u[16], a[16];
#pragma unroll
            for (int k = 0; k < 16; ++k) { u[k] = base[(size_t)(jb + k) * ST_STRIDE + e]; a[k] = base[(size_t)(jb + k) * ST_STRIDE + 16384 + 128]; }
#pragma unroll
            for (int k = 0; k < 16; ++k) { base[(size_t)(jb + k) * ST_STRIDE + e] = c; c = a[k] * c + u[k]; }
        }
    }
}
__device__ __forceinline__ void phase_b3(const bf16* CQ, const bf16* CK, const bf16* MV, const bf16* MO, const float* GATES, const float* b_i, const float* b_f, const float* ml_g,
                                         const float* ST, bf16* ACAT, lptr lds) {
    const int tid = tidx(), lane = tid & 63, r32 = lane & 31, hi = lane >> 5; const int wave = __builtin_amdgcn_readfirstlane(tid >> 6);
    LAS float* eb = (LAS float*)(lds + SMALL_OFF); LAS float* wcol = eb + 64; LAS float* wupd = wcol + 64; LAS float* dinv = wupd + 64; LAS float* nvec = dinv + 64; LAS float* misc = nvec + 128;
    const int er = wave & 3, dc0 = 2 * (wave >> 2);
    for (int item = blockIdx.x; item < 256; item += gridDim.x) {
        const int h = item >> 6, j = item & 63;
        const float* st = ST + (size_t)item * ST_STRIDE;
        f32x16 accS[2];
#pragma unroll
        for (int i = 0; i < 2; ++i)
#pragma unroll
            for (int r = 0; r < 16; ++r) accS[i][r] = st[((wave * 2 + i) * 16 + r) * 64 + lane];
        __syncthreads();
        if (tid < 128) nvec[tid] = st[16384 + tid];
#pragma unroll
        for (int i = 0; i < 2; ++i)
#pragma unroll
            for (int r = 0; r < 16; ++r) *(LAS unsigned short*)(lds + CT_OFF + (32 * er + crow(r, hi)) * LD128 + (32 * (dc0 + i) + r32) * 2) = (unsigned short)f2bf(accS[i][r]);
        const float bi = b_i[h], bf_ = b_f[h];
        for (int c = 0; c < 4; ++c) {
            const int t0 = j * 256 + c * 64;
            __syncthreads();
            if (wave == 0) (void)gates_chunk(GATES, bi, bf_, t0, h, lane, eb, wcol, wupd, misc);
            __syncthreads();
#pragma unroll
            for (int i = 0; i < 2; ++i) { const int p = tid + 512 * i, row = p >> 4, ch = p & 15; const size_t g = (size_t)(t0 + row) * 512 + h * 128 + ch * 8;
                const v4u qv = *(const v4u*)(CQ + g), kv = *(const v4u*)(CK + g); const float e_ = eb[row];
                v4u qo; qo.x = pk2(e_ * bf2f(qv.x & 0xffffu), e_ * bf2f(qv.x >> 16)); qo.y = pk2(e_ * bf2f(qv.y & 0xffffu), e_ * bf2f(qv.y >> 16));
                qo.z = pk2(e_ * bf2f(qv.z & 0xffffu), e_ * bf2f(qv.z >> 16)); qo.w = pk2(e_ * bf2f(qv.w & 0xffffu), e_ * bf2f(qv.w >> 16));
                *(LAS v4u*)(lds + QP_OFF + row * LD128 + ch * 16) = qo; *(LAS v4u*)(lds + K_OFF + row * LD128 + ch * 16) = kv; }
            stage_transposed(CK, MV, t0, h, lds, wupd, tid);
            const float aL = misc[0];
            __syncthreads();
            const int tr = wave >> 2, tc = wave & 3;
            if (wave < 4) {
                const int sr = wave >> 1, sc = wave & 1;
                f32x16 sa = f32x16{};
                mm_tile<8>(sa, lds + QP_OFF + (32 * sr) * LD128, LD128, lds + K_OFF + (32 * sc) * LD128, LD128, r32, hi);
                const int s_ = 32 * sc + r32; const float wc_ = wcol[s_];
#pragma unroll
                for (int r = 0; r < 16; ++r) { const int t_ = 32 * sr + crow(r, hi); const float v = (s_ <= t_) ? sa[r] * wc_ : 0.f;
                    *(LAS unsigned short*)(lds + SM_OFF + t_ * LD64 + s_ * 2) = (unsigned short)f2bf(v); }
            }
            f32x16 acc = f32x16{};
            mm_tile<8>(acc, lds + QP_OFF + (32 * tr) * LD128, LD128, lds + CT_OFF + (32 * tc) * LD128, LD128, r32, hi);
            __syncthreads();
            mm_tile<4>(acc, lds + SM_OFF + (32 * tr) * LD64, LD64, lds + VT_OFF + (32 * tc) * LD64, LD64, r32, hi);
            if (tid < 64) {
                float dn = 0.f; lptr qp = lds + QP_OFF + tid * LD128;
#pragma unroll 4
                for (int i = 0; i < 16; ++i) { const v4u q = *(const LAS v4u*)(qp + 16 * i); const LAS float* nn = nvec + 8 * i;
                    dn += bf2f(q.x & 0xffffu) * nn[0] + bf2f(q.x >> 16) * nn[1] + bf2f(q.y & 0xffffu) * nn[2] + bf2f(q.y >> 16) * nn[3]
                        + bf2f(q.z & 0xffffu) * nn[4] + bf2f(q.z >> 16) * nn[5] + bf2f(q.w & 0xffffu) * nn[6] + bf2f(q.w >> 16) * nn[7]; }
                lptr sp_ = lds + SM_OFF + tid * LD64;
#pragma unroll
                for (int i = 0; i < 8; ++i) { const v4u q = *(const LAS v4u*)(sp_ + 16 * i);
                    dn += (bf2f(q.x & 0xffffu) + bf2f(q.x >> 16)) + (bf2f(q.y & 0xffffu) + bf2f(q.y >> 16)) + (bf2f(q.z & 0xffffu) + bf2f(q.z >> 16)) + (bf2f(q.w & 0xffffu) + bf2f(q.w >> 16)); }
                dinv[tid] = 1.f / fmaxf(fabsf(dn), 1.f);
            }
            __syncthreads();
#pragma unroll
            for (int r = 0; r < 16; ++r) { const int t_ = 32 * tr + crow(r, hi); *(LAS float*)(lds + Y_OFF + (t_ * LDY + 32 * tc + r32) * 4) = acc[r] * dinv[t_]; }
            state_update(accS, lds, aL, wave, r32, hi);
            float nnew = 0.f;
            if (tid < 128) nnew = aL * nvec[tid] + kwt_rowsum(lds, tid);
            __syncthreads();
            if (tid < 128) nvec[tid] = nnew;
#pragma unroll
            for (int i = 0; i < 2; ++i)
#pragma unroll
                for (int r = 0; r < 16; ++r) *(LAS unsigned short*)(lds + CT_OFF + (32 * er + crow(r, hi)) * LD128 + (32 * (dc0 + i) + r32) * 2) = (unsigned short)f2bf(accS[i][r]);
#pragma unroll 2
            for (int rr = 0; rr < 8; ++rr) { const int t_ = wave * 8 + rr; const size_t grow = (size_t)(t0 + t_);
                const float y0 = *(const LAS float*)(lds + Y_OFF + (t_ * LDY + 2 * lane) * 4), y1 = *(const LAS float*)(lds + Y_OFF + (t_ * LDY + 2 * lane + 1) * 4);
                const unsigned ov = *(const unsigned*)(MO + grow * 512 + h * 128 + 2 * lane);
                const float z0 = y0 * sigmoidf_(bf2f(ov & 0xffffu)), z1 = y1 * sigmoidf_(bf2f(ov >> 16));
                const float rs = rsqrtf(wave_sum(z0 * z0 + z1 * z1) * (1.f / 128.f) + EPS);
                *(unsigned*)(ACAT + grow * 1024 + 512 + h * 128 + 2 * lane) = pk2(z0 * rs * ml_g[h * 128 + 2 * lane], z1 * rs * ml_g[h * 128 + 2 * lane + 1]); }
        }
    }
}
}

__device__ __forceinline__ void ph_route_naive(const bf16* QP, const float* SK, int2* ROUTE, float* lds) {
    float* qs = lds; float* sc = qs + 2048; float* sv = sc + 2048; int* si = (int*)(sv + 256); float* cand = (float*)(si + 256); float* tops = cand + 2048; int* tope = (int*)(tops + 128);
    const int tid = tidx();
    for (int t = blockIdx.x; t < M; t += gridDim.x) {
        __syncthreads();
        for (int i = tid; i < 2048; i += NTHREADS) qs[i] = bf2f(QP[(size_t)t * 2048 + i]);
        __syncthreads();
#pragma unroll 1
        for (int j = 0; j < 4; ++j) { const int sidx = tid + 512 * j, hc = sidx >> 7; const float* kp = SK + (size_t)sidx * 128; const float* qq = qs + hc * 128; float s = 0.f;
            for (int d = 0; d < 128; d += 4) { const f32x4 kv = *(const f32x4*)(kp + d); s += qq[d] * kv.x + qq[d + 1] * kv.y + qq[d + 2] * kv.z + qq[d + 3] * kv.w; }
            sc[sidx] = s; }
        __syncthreads();
        if (tid < 16) { const int hc = tid;
            for (int k = 0; k < 16; ++k) { float best = -INFINITY; int bi = 0;
                for (int n = 0; n < 128; ++n) { const float v = sc[hc * 128 + n]; if (v > best) { best = v; bi = n; } }
                sv[hc * 16 + k] = best; si[hc * 16 + k] = bi; sc[hc * 128 + bi] = -INFINITY; } }
        __syncthreads();
        for (int i = tid; i < 2048; i += NTHREADS) { const int h = i >> 8, a = (i >> 4) & 15, b = i & 15; cand[i] = sv[(2 * h) * 16 + a] + sv[(2 * h + 1) * 16 + b]; }
        __syncthreads();
        if (tid < 8) { const int h = tid;
            for (int k = 0; k < 16; ++k) { float best = -INFINITY; int bi = 0;
                for (int n = 0; n < 256; ++n) { const float v = cand[h * 256 + n]; if (v > best) { best = v; bi = n; } }
                tops[h * 16 + k] = best; tope[h * 16 + k] = si[(2 * h) * 16 + (bi >> 4)] * 128 + si[(2 * h + 1) * 16 + (bi & 15)]; cand[h * 256 + bi] = -INFINITY; }
            const float mx = tops[h * 16]; float sum = 0.f;
            for (int k = 0; k < 16; ++k) sum += expf(tops[h * 16 + k] - mx);
            const float inv = 1.f / sum;
            for (int k = 0; k < 16; ++k) ROUTE[((size_t)t * 8 + h) * 16 + k] = make_int2(tope[h * 16 + k], __float_as_int(expf(tops[h * 16 + k] - mx) * inv)); }
    }
}
__device__ __forceinline__ void ph_expert_naive(const bf16* XN, const int2* ROUTE, const float* EU, const float* EV, float* X, float* lds) {
    float* xs = lds; float* ws = xs + 1024; int* es = (int*)(ws + 128); float* gs = (float*)(es + 128);
    const int tid = tidx();
    for (int t = blockIdx.x; t < M; t += gridDim.x) {
        __syncthreads();
        for (int i = tid; i < 1024; i += NTHREADS) xs[i] = bf2f(XN[(size_t)t * 1024 + i]);
        if (tid < 128) { const int2 r = ROUTE[(size_t)t * 128 + tid]; es[tid] = r.x; gs[tid] = __int_as_float(r.y); }
        __syncthreads();
        { const int e = tid >> 2, part = tid & 3; const float* u = EU + (size_t)es[e] * 1024 + part * 4; const float* xx = xs + part * 4; float s = 0.f;
          for (int d = 0; d < 1024; d += 16) { const f32x4 uv = *(const f32x4*)(u + d); s += xx[d] * uv.x + xx[d + 1] * uv.y + xx[d + 2] * uv.z + xx[d + 3] * uv.w; }
          s += __shfl_xor(s, 1); s += __shfl_xor(s, 2);
          const float a = 0.5f * s * (1.f + erff(s * 0.7071067811865476f));
          if (part == 0) ws[e] = gs[e] * a; }
        __syncthreads();
#pragma unroll 1
        for (int j = 0; j < 2; ++j) { const int n = tid + 512 * j; float o = 0.f;
            for (int e = 0; e < 128; ++e) o += ws[e] * EV[(size_t)es[e] * 1024 + n];
            X[(size_t)t * 1024 + n] += o; }
    }
}


namespace peer {
typedef __bf16 bf16x2_t __attribute__((ext_vector_type(2)));
typedef float f32x2_t __attribute__((ext_vector_type(2)));
typedef LAS unsigned char* lptr;
__device__ __forceinline__ float dot2(unsigned a, unsigned b, float c) { return __builtin_amdgcn_fdot2_f32_bf16(__builtin_bit_cast(bf16x2_t, a), __builtin_bit_cast(bf16x2_t, b), c, false); }
template <int CTRL> __device__ __forceinline__ float dpp(float x) { return __builtin_bit_cast(float, __builtin_amdgcn_mov_dpp(__builtin_bit_cast(int, x), CTRL, 0xf, 0xf, true)); }
__device__ __forceinline__ float row16_sum(float x) { x += dpp<0x128>(x); x += dpp<0x124>(x); x += dpp<0x122>(x); x += dpp<0x121>(x); return x; }
__device__ __forceinline__ unsigned fp8lo_bf16(unsigned w) { return __builtin_bit_cast(unsigned, __builtin_amdgcn_cvt_scalef32_pk_bf16_fp8(w, 1.0f, false)); }
__device__ __forceinline__ unsigned fp8hi_bf16(unsigned w) { return __builtin_bit_cast(unsigned, __builtin_amdgcn_cvt_scalef32_pk_bf16_fp8(w, 1.0f, true)); }
__device__ __forceinline__ float dot16(const v4u& u, const v4u& x0, const v4u& x1, float d) {
    d = dot2(fp8lo_bf16(u.x), x0.x, d); d = dot2(fp8hi_bf16(u.x), x0.y, d); d = dot2(fp8lo_bf16(u.y), x0.z, d); d = dot2(fp8hi_bf16(u.y), x0.w, d);
    d = dot2(fp8lo_bf16(u.z), x1.x, d); d = dot2(fp8hi_bf16(u.z), x1.y, d); d = dot2(fp8lo_bf16(u.w), x1.z, d); return dot2(fp8hi_bf16(u.w), x1.w, d);
}
__device__ __forceinline__ void convert_tables(const float* EU, const float* EV, const float* gu, unsigned char* EU8, unsigned char* EV8, float* SI) {
    const int lane = tidx() & 63, wave = tidx() >> 6;
    const int gw = blockIdx.x * NWAVES + wave, NGW = gridDim.x * NWAVES;
    f32x4 gg[4];
#pragma unroll
    for (int j = 0; j < 4; ++j) gg[j] = *(const f32x4*)(gu + 4 * lane + 256 * j);
    for (int r0 = gw * 4; r0 < 2 * 16384; r0 += NGW * 4) {
        f32x4 v[4][4];
#pragma unroll
        for (int q = 0; q < 4; ++q) { const int r = r0 + q; const bool second = r >= 16384; const float* src = (second ? EV : EU) + (size_t)(second ? r - 16384 : r) * 1024 + 4 * lane;
#pragma unroll
            for (int j = 0; j < 4; ++j) v[q][j] = *(const f32x4*)(src + 256 * j); }
#pragma unroll
        for (int q = 0; q < 4; ++q) { const int r = r0 + q; const bool second = r >= 16384; const int row = second ? r - 16384 : r;
            float am = 0.f;
#pragma unroll
            for (int j = 0; j < 4; ++j) { if (!second) v[q][j] = v[q][j] * gg[j];
                am = fmaxf(am, fmaxf(fmaxf(fabsf(v[q][j].x), fabsf(v[q][j].y)), fmaxf(fabsf(v[q][j].z), fabsf(v[q][j].w)))); }
#pragma unroll
            for (int o = 1; o < 64; o <<= 1) am = fmaxf(am, __shfl_xor(am, o));
            const int e = (int)((__float_as_uint(am) >> 23) & 0xffu) - 127;
            const bool ok = am > 1e-30f;
            const float sc = ok ? __uint_as_float((unsigned)(127 + 6 - e) << 23) : 1.f, isc = ok ? __uint_as_float((unsigned)(127 - 6 + e) << 23) : 1.f;
            unsigned char* dst = (second ? EV8 : EU8) + (size_t)row * 1024 + 4 * lane;
#pragma unroll
            for (int j = 0; j < 4; ++j) { int p = __builtin_amdgcn_cvt_pk_fp8_f32(v[q][j].x * sc, v[q][j].y * sc, 0, false); p = __builtin_amdgcn_cvt_pk_fp8_f32(v[q][j].z * sc, v[q][j].w * sc, p, true); *(unsigned*)(dst + 256 * j) = (unsigned)p; }
            if (lane == 0) SI[r] = isc; }
    }
}
__device__ __forceinline__ void expert_phase(const bf16* XG, const float* RS, bf16* XN, const int2* ROUTE, const unsigned char* EU8, const unsigned char* EV8, const float* SI, const float* X, float* XO, const float* g_next, lptr lds) {
    const int lane = tidx() & 63, grp = lane >> 4, li = lane & 15; const int wave = __builtin_amdgcn_readfirstlane(tidx() >> 6);
    LAS int* ids = (LAS int*)(lds + wave * 1536); LAS float* wts = (LAS float*)(ids + 128); LAS float* sus = wts + 128;
    const int gw = blockIdx.x * NWAVES + wave, NGW = gridDim.x * NWAVES;
    for (int t = gw; t < M; t += NGW) {
        v4u xq[8];
#pragma unroll
        for (int j = 0; j < 4; ++j) { const bf16* xp = XG + (size_t)t * 1024 + 256 * j + 16 * li; xq[2 * j] = *(const v4u*)xp; xq[2 * j + 1] = *(const v4u*)(xp + 8); }
        const float rt = rsqrtf(row16_sum(RS[(size_t)t * 16 + li]) * (1.f / D) + EPS);
        { const int2 r0 = ROUTE[(size_t)t * 128 + lane], r1 = ROUTE[(size_t)t * 128 + 64 + lane];
          ids[lane] = r0.x; ids[lane + 64] = r1.x; wts[lane] = __int_as_float(r0.y) * SI[16384 + r0.x]; wts[lane + 64] = __int_as_float(r1.y) * SI[16384 + r1.x]; sus[lane] = SI[r0.x]; sus[lane + 64] = SI[r1.x]; }
        v4u ua[8], ub[8];
#define PEER_ULOAD(buf, b) do { _Pragma("unroll") for (int ps = 0; ps < 2; ++ps) { const unsigned char* up_ = EU8 + (size_t)ids[8 * (b) + 4 * ps + grp] * 1024 + 16 * li; \
            _Pragma("unroll") for (int j = 0; j < 4; ++j) buf[4 * ps + j] = *(const v4u*)(up_ + 256 * j); } } while (0)
#define PEER_UCOMP(buf, b) do { _Pragma("unroll") for (int ps = 0; ps < 2; ++ps) { float d_ = 0.f; \
            _Pragma("unroll") for (int j = 0; j < 4; ++j) d_ = dot16(buf[4 * ps + j], xq[2 * j], xq[2 * j + 1], d_); \
            d_ = row16_sum(d_) * (rt * sus[8 * (b) + 4 * ps + grp]); \
            const float a_ = 0.5f * d_ * (1.f + erff(d_ * 0.7071067811865476f)); if (li == 0) wts[8 * (b) + 4 * ps + grp] *= a_; } } while (0)
        PEER_ULOAD(ua, 0);
#pragma unroll 1
        for (int b = 0; b < 16; b += 2) {
            PEER_ULOAD(ub, b + 1);
            PEER_UCOMP(ua, b);
            if (b + 2 < 16) PEER_ULOAD(ua, b + 2);
            PEER_UCOMP(ub, b + 1);
        }
#undef PEER_ULOAD
#undef PEER_UCOMP
        float acc[16];
#pragma unroll
        for (int i = 0; i < 16; ++i) acc[i] = 0.f;
        v4u va[8], vb[8];
#define PEER_VLOAD(buf, b) do { _Pragma("unroll") for (int k = 0; k < 8; ++k) buf[k] = *(const v4u*)(EV8 + (size_t)ids[8 * (b) + k] * 1024 + 16 * lane); } while (0)
#define PEER_VCOMP(buf, b) do { _Pragma("unroll") for (int k = 0; k < 8; ++k) { const float w_ = wts[8 * (b) + k]; const v4u q_ = buf[k]; \
            const unsigned qq_[4] = {q_.x, q_.y, q_.z, q_.w}; \
            _Pragma("unroll") for (int i = 0; i < 4; ++i) { const f32x2_t lo_ = __builtin_amdgcn_cvt_pk_f32_fp8((int)qq_[i], false), hi_ = __builtin_amdgcn_cvt_pk_f32_fp8((int)qq_[i], true); \
                acc[4 * i + 0] = fmaf(w_, lo_.x, acc[4 * i + 0]); acc[4 * i + 1] = fmaf(w_, lo_.y, acc[4 * i + 1]); acc[4 * i + 2] = fmaf(w_, hi_.x, acc[4 * i + 2]); acc[4 * i + 3] = fmaf(w_, hi_.y, acc[4 * i + 3]); } } } while (0)
        PEER_VLOAD(va, 0);
#pragma unroll 1
        for (int b = 0; b < 16; b += 2) {
            PEER_VLOAD(vb, b + 1);
            PEER_VCOMP(va, b);
            if (b + 2 < 16) PEER_VLOAD(va, b + 2);
            PEER_VCOMP(vb, b + 1);
        }
#undef PEER_VLOAD
#undef PEER_VCOMP
        { const float* xi = X + (size_t)t * 1024 + 16 * lane; float* xo = XO + (size_t)t * 1024 + 16 * lane;
#pragma unroll
          for (int i = 0; i < 4; ++i) { f32x4 a = *(const f32x4*)(xi + 4 * i); a.x += acc[4 * i + 0]; a.y += acc[4 * i + 1]; a.z += acc[4 * i + 2]; a.w += acc[4 * i + 3]; *(f32x4*)(xo + 4 * i) = a;
              acc[4 * i + 0] = a.x; acc[4 * i + 1] = a.y; acc[4 * i + 2] = a.z; acc[4 * i + 3] = a.w; }
          float ss = 0.f;
#pragma unroll
          for (int i = 0; i < 16; ++i) ss += acc[i] * acc[i];
          const float rn = rsqrtf(wave_sum(ss) * (1.f / D) + EPS);
          const float* gp = g_next + 16 * lane; v4u w0, w1;
          w0.x = pk2(acc[0] * rn * gp[0], acc[1] * rn * gp[1]); w0.y = pk2(acc[2] * rn * gp[2], acc[3] * rn * gp[3]); w0.z = pk2(acc[4] * rn * gp[4], acc[5] * rn * gp[5]); w0.w = pk2(acc[6] * rn * gp[6], acc[7] * rn * gp[7]);
          w1.x = pk2(acc[8] * rn * gp[8], acc[9] * rn * gp[9]); w1.y = pk2(acc[10] * rn * gp[10], acc[11] * rn * gp[11]); w1.z = pk2(acc[12] * rn * gp[12], acc[13] * rn * gp[13]); w1.w = pk2(acc[14] * rn * gp[14], acc[15] * rn * gp[15]);
          bf16* xnp = XN + (size_t)t * 1024 + 16 * lane; *(v4u*)xnp = w0; *(v4u*)(xnp + 8) = w1; }
    }
}

template <int P>
__device__ __forceinline__ void expert_phase_mp(const bf16* XG, const float* RS, bf16* XN, const int2* ROUTE, const unsigned char* EU8, const unsigned char* EV8, const float* SI,
                                                const float* X, float* XO, const float* g_next, lptr lds) {
    constexpr int SH = (P == 8) ? 11 : (P == 4) ? 12 : (P == 2) ? 13 : 14;
    const int lane = tidx() & 63, grp = lane >> 4, li = lane & 15; const int wave = __builtin_amdgcn_readfirstlane(tidx() >> 6);
    lptr wl = lds + wave * 15616;
    lptr XS = wl;
    LAS unsigned* FLE = (LAS unsigned*)(wl + 8192);
    LAS float* SW = (LAS float*)(wl + 8192 + 3072);
    LAS float* RT = (LAS float*)(wl + 8192 + 3072 + 2048);
    LAS int* QS = (LAS int*)(wl + 8192 + 3072 + 2048 + 16);
    LAS float* SU = (LAS float*)(wl + 8192 + 3072 + 2048 + 16 + 48);
    const int gw = blockIdx.x * NWAVES + wave, NGW = gridDim.x * NWAVES;
    const unsigned long long ltmask = (1ull << lane) - 1ull;
#pragma unroll 1
    for (int g4 = 0; g4 < 2; ++g4) {
        int tk[4];
#pragma unroll
        for (int k = 0; k < 4; ++k) tk[k] = gw + (g4 * 4 + k) * NGW;
        int2 e0[4], e1[4];
#pragma unroll
        for (int k = 0; k < 4; ++k) {
            const v4u a = *(const v4u*)(XG + (size_t)tk[k] * 1024 + 16 * lane), b = *(const v4u*)(XG + (size_t)tk[k] * 1024 + 16 * lane + 8);
            *(LAS v4u*)(XS + k * 2048 + 32 * lane) = a; *(LAS v4u*)(XS + k * 2048 + 32 * lane + 16) = b;
            e0[k] = ROUTE[(size_t)tk[k] * 128 + lane]; e1[k] = ROUTE[(size_t)tk[k] * 128 + 64 + lane];
            SW[k * 128 + lane] = __int_as_float(e0[k].y) * SI[16384 + e0[k].x]; SW[k * 128 + 64 + lane] = __int_as_float(e1[k].y) * SI[16384 + e1[k].x];
            SU[k * 128 + lane] = SI[e0[k].x]; SU[k * 128 + 64 + lane] = SI[e1[k].x];
            const float r = rsqrtf(row16_sum(RS[(size_t)tk[k] * 16 + li]) * (1.f / D) + EPS); if (lane == 0) RT[k] = r;
        }
        int qbase = 0;
#pragma unroll 1
        for (int p = 0; p < P; ++p) {
            int base = 4 * qbase;
#pragma unroll
            for (int k = 0; k < 4; ++k) {
                const bool in0 = (e0[k].x >> SH) == p, in1 = (e1[k].x >> SH) == p;
                const unsigned long long m0 = __ballot(in0), m1 = __ballot(in1);
                const int c0 = __popcll(m0), c1 = __popcll(m1), n = c0 + c1, npad = (n + 3) & ~3;
                if (in0) FLE[base + __popcll(m0 & ltmask)] = (unsigned)e0[k].x | 0x4000u | ((unsigned)(k * 128 + lane) << 16);
                if (in1) FLE[base + c0 + __popcll(m1 & ltmask)] = (unsigned)e1[k].x | 0x4000u | ((unsigned)(k * 128 + 64 + lane) << 16);
                if (lane < npad - n) FLE[base + n + lane] = (unsigned)(p << SH) | ((unsigned)(k * 128) << 16);
                base += npad;
            }
            qbase = base >> 2;
        }
        { const int ext = (4 - (qbase & 3)) & 3;
          if (lane < 4 * ext) FLE[4 * qbase + lane] = (unsigned)((P - 1) << SH) | ((unsigned)(3 * 128) << 16); qbase += ext; }
        const int qtot = qbase;
        v4u ua[8], ub[8]; unsigned ea[2], eb_[2];
#define MP_ULOAD(buf, ent, q) do { _Pragma("unroll") for (int h2 = 0; h2 < 2; ++h2) { ent[h2] = FLE[4 * ((q) + h2) + grp]; const unsigned char* up_ = EU8 + (size_t)(ent[h2] & 0x3FFFu) * 1024 + 16 * li; \
            _Pragma("unroll") for (int j = 0; j < 4; ++j) buf[4 * h2 + j] = *(const v4u*)(up_ + 256 * j); } } while (0)
#define MP_UCOMP(buf, ent) do { _Pragma("unroll") for (int h2 = 0; h2 < 2; ++h2) { const int tok_ = (int)(ent[h2] >> 23) & 3; lptr xp_ = XS + tok_ * 2048 + 32 * li; float d_ = 0.f; \
            _Pragma("unroll") for (int j = 0; j < 4; ++j) { const v4u x0_ = *(const LAS v4u*)(xp_ + 512 * j), x1_ = *(const LAS v4u*)(xp_ + 512 * j + 16); d_ = dot16(buf[4 * h2 + j], x0_, x1_, d_); } \
            d_ = row16_sum(d_) * (RT[tok_] * SU[(ent[h2] >> 16) & 511u]); \
            const float a_ = 0.5f * d_ * (1.f + erff(d_ * 0.7071067811865476f)); if (li == 0 && (ent[h2] & 0x4000u)) SW[ent[h2] >> 16] *= a_; } } while (0)
        MP_ULOAD(ua, ea, 0);
#pragma unroll 1
        for (int q = 0; q < qtot; q += 4) {
            MP_ULOAD(ub, eb_, q + 2);
            MP_UCOMP(ua, ea);
            if (q + 4 < qtot) MP_ULOAD(ua, ea, q + 4);
            MP_UCOMP(ub, eb_);
        }
#undef MP_ULOAD
#undef MP_UCOMP
        float acc[4][16];
#pragma unroll
        for (int k = 0; k < 4; ++k)
#pragma unroll
            for (int i = 0; i < 16; ++i) acc[k][i] = 0.f;
        v4u va[8], vb[8]; unsigned na[8], nb[8];
#define MP_VLOAD(buf, ents, q) do { _Pragma("unroll") for (int r = 0; r < 8; ++r) { ents[r] = FLE[4 * (q) + r]; buf[r] = *(const v4u*)(EV8 + (size_t)(ents[r] & 0x3FFFu) * 1024 + 16 * lane); } } while (0)
#define MP_VACC(K, buf, ents, R0) do { _Pragma("unroll") for (int r = R0; r < R0 + 4; ++r) { const float w_ = (ents[r] & 0x4000u) ? SW[ents[r] >> 16] : 0.f; const v4u q_ = buf[r]; \
            const unsigned qq_[4] = {q_.x, q_.y, q_.z, q_.w}; \
            _Pragma("unroll") for (int i = 0; i < 4; ++i) { const f32x2_t lo_ = __builtin_amdgcn_cvt_pk_f32_fp8((int)qq_[i], false), hi_ = __builtin_amdgcn_cvt_pk_f32_fp8((int)qq_[i], true); \
                acc[K][4 * i + 0] = fmaf(w_, lo_.x, acc[K][4 * i + 0]); acc[K][4 * i + 1] = fmaf(w_, lo_.y, acc[K][4 * i + 1]); acc[K][4 * i + 2] = fmaf(w_, hi_.x, acc[K][4 * i + 2]); acc[K][4 * i + 3] = fmaf(w_, hi_.y, acc[K][4 * i + 3]); } } } while (0)
#define MP_VCOMP1(buf, ents, R0) do { const int tok_ = __builtin_amdgcn_readfirstlane((int)(ents[R0] >> 23) & 3); \
            if (tok_ == 0) MP_VACC(0, buf, ents, R0); else if (tok_ == 1) MP_VACC(1, buf, ents, R0); else if (tok_ == 2) MP_VACC(2, buf, ents, R0); else MP_VACC(3, buf, ents, R0); } while (0)
#define MP_VCOMP(buf, ents) do { MP_VCOMP1(buf, ents, 0); MP_VCOMP1(buf, ents, 4); } while (0)
        MP_VLOAD(va, na, 0);
#pragma unroll 1
        for (int q = 0; q < qtot; q += 4) {
            MP_VLOAD(vb, nb, q + 2);
            MP_VCOMP(va, na);
            if (q + 4 < qtot) MP_VLOAD(va, na, q + 4);
            MP_VCOMP(vb, nb);
        }
#undef MP_VLOAD
#undef MP_VACC
#undef MP_VCOMP1
#undef MP_VCOMP
#pragma unroll
        for (int k = 0; k < 4; ++k) {
            const float* xi = X + (size_t)tk[k] * 1024 + 16 * lane; float* xo = XO + (size_t)tk[k] * 1024 + 16 * lane;
            float ss = 0.f;
#pragma unroll
            for (int i = 0; i < 4; ++i) { f32x4 a = *(const f32x4*)(xi + 4 * i); a.x += acc[k][4 * i + 0]; a.y += acc[k][4 * i + 1]; a.z += acc[k][4 * i + 2]; a.w += acc[k][4 * i + 3]; *(f32x4*)(xo + 4 * i) = a;
                acc[k][4 * i + 0] = a.x; acc[k][4 * i + 1] = a.y; acc[k][4 * i + 2] = a.z; acc[k][4 * i + 3] = a.w; ss += (a.x * a.x + a.y * a.y) + (a.z * a.z + a.w * a.w); }
            const float rn = rsqrtf(wave_sum(ss) * (1.f / D) + EPS);
            const float* gp = g_next + 16 * lane; v4u w0, w1;
            w0.x = pk2(acc[k][0] * rn * gp[0], acc[k][1] * rn * gp[1]); w0.y = pk2(acc[k][2] * rn * gp[2], acc[k][3] * rn * gp[3]); w0.z = pk2(acc[k][4] * rn * gp[4], acc[k][5] * rn * gp[5]); w0.w = pk2(acc[k][6] * rn * gp[6], acc[k][7] * rn * gp[7]);
            w1.x = pk2(acc[k][8] * rn * gp[8], acc[k][9] * rn * gp[9]); w1.y = pk2(acc[k][10] * rn * gp[10], acc[k][11] * rn * gp[11]); w1.z = pk2(acc[k][12] * rn * gp[12], acc[k][13] * rn * gp[13]); w1.w = pk2(acc[k][14] * rn * gp[14], acc[k][15] * rn * gp[15]);
            bf16* xnp = XN + (size_t)tk[k] * 1024 + 16 * lane; *(v4u*)xnp = w0; *(v4u*)(xnp + 8) = w1;
        }
    }
}
}


namespace route {
typedef short bf16x8 __attribute__((ext_vector_type(8)));
typedef float f32x16 __attribute__((ext_vector_type(16)));
typedef LAS unsigned char* lptr;
__device__ __forceinline__ unsigned f2sort(float f) { const unsigned u = __float_as_uint(f); return (u & 0x80000000u) ? ~u : (u | 0x80000000u); }
__device__ __forceinline__ float sort2f(unsigned s) { return __uint_as_float((s & 0x80000000u) ? (s & 0x7fffffffu) : ~s); }
__device__ __forceinline__ unsigned umax_(unsigned a, unsigned b) { return a > b ? a : b; }
__device__ __forceinline__ unsigned umin_(unsigned a, unsigned b) { return a < b ? a : b; }
__device__ __forceinline__ unsigned selu(int hi, unsigned a, unsigned b) { asm volatile("" : "+v"(a), "+v"(b)); return hi ? b : a; }
__device__ __forceinline__ float self(int hi, float a, float b) { asm volatile("" : "+v"(a), "+v"(b)); return hi ? b : a; }
__device__ __forceinline__ unsigned partner32(unsigned x, int hi) { auto r = __builtin_amdgcn_permlane32_swap(x, x, false, false); return hi ? r[0] : r[1]; }
__device__ __forceinline__ void sort16_desc(unsigned (&x)[16]) {
#pragma unroll
    for (int k = 2; k <= 16; k <<= 1)
#pragma unroll
        for (int j = k >> 1; j > 0; j >>= 1)
#pragma unroll
            for (int i = 0; i < 16; ++i) { const int l = i ^ j; if (l > i) { const bool desc = ((i & k) == 0); const unsigned a = x[i], b = x[l], mx = umax_(a, b), mn = umin_(a, b); x[i] = desc ? mx : mn; x[l] = desc ? mn : mx; } }
}
__device__ __forceinline__ void merge_top16(unsigned (&a)[16], const unsigned (&b)[16]) {
#pragma unroll
    for (int i = 0; i < 16; ++i) a[i] = umax_(a[i], b[15 - i]);
#pragma unroll
    for (int j = 8; j > 0; j >>= 1)
#pragma unroll
        for (int i = 0; i < 16; ++i) { const int l = i ^ j; if (l > i) { const unsigned p = a[i], q = a[l]; a[i] = umax_(p, q); a[l] = umin_(p, q); } }
}
__device__ __forceinline__ void convert_subkeys(const float* SK, bf16* SKB) {
    const int n8 = 16 * 128 * 128 / 8, stride = gridDim.x * NTHREADS;
    for (int i = blockIdx.x * NTHREADS + tidx(); i < n8; i += stride) { const f32x4 a = *(const f32x4*)(SK + (size_t)i * 8), b = *(const f32x4*)(SK + (size_t)i * 8 + 4);
        v4u o; o.x = pk2(a.x, a.y); o.y = pk2(a.z, a.w); o.z = pk2(b.x, b.y); o.w = pk2(b.z, b.w); *(v4u*)(SKB + (size_t)i * 8) = o; }
}
__device__ __forceinline__ void route_phase(const bf16* QP, const bf16* SKB, const float* RS, int2* ROUTE, lptr lds) {
    const int lane = tidx() & 63, r32 = lane & 31, hi = lane >> 5; const int wave = __builtin_amdgcn_readfirstlane(tidx() >> 6);
    LAS int* myl = (LAS int*)(lds + wave * 8448) + lane * 33;
    const int gw = blockIdx.x * NWAVES + wave, NGW = gridDim.x * NWAVES;
    for (int it = gw; it < 4096; it += NGW) {
        const int tb = it >> 3, h = it & 7, token = tb * 32 + r32;
        unsigned top0[16], top1[16];
#pragma unroll
        for (int i = 0; i < 16; ++i) { top0[i] = 0u; top1[i] = 0u; }
#pragma unroll
        for (int c = 0; c < 2; ++c) {
            const int hc = h * 2 + c;
            bf16x8 qf[8];
#pragma unroll
            for (int ks = 0; ks < 8; ++ks) qf[ks] = *(const bf16x8*)(QP + (size_t)token * 2048 + hc * 128 + 16 * ks + 8 * hi);
#pragma unroll 1
            for (int kt = 0; kt < 4; ++kt) {
                const bf16* ap = SKB + ((size_t)(hc * 128 + 32 * kt + r32)) * 128 + 8 * hi;
                f32x16 acc = f32x16{};
#pragma unroll
                for (int ks = 0; ks < 8; ++ks) { const bf16x8 a = *(const bf16x8*)(ap + 16 * ks); acc = __builtin_amdgcn_mfma_f32_32x32x16_bf16(a, qf[ks], acc, 0, 0, 0); }
                const unsigned code0 = 127u - (unsigned)(32 * kt + 4 * hi);
                unsigned pt[16];
#pragma unroll
                for (int r = 0; r < 16; ++r) pt[r] = (f2sort(acc[r]) & ~0x7Fu) | (code0 - (unsigned)((r & 3) + 8 * (r >> 2)));
                sort16_desc(pt);
                if (c == 0) merge_top16(top0, pt); else merge_top16(top1, pt);
            }
            { unsigned oth[16];
#pragma unroll
              for (int i = 0; i < 16; ++i) oth[i] = partner32(c == 0 ? top0[i] : top1[i], hi);
              if (c == 0) merge_top16(top0, oth); else merge_top16(top1, oth); }
        }
#pragma unroll
        for (int i = 0; i < 16; ++i) { myl[i] = 127 - (int)(top0[i] & 0x7Fu); myl[16 + i] = 127 - (int)(top1[i] & 0x7Fu); }
        float a1[16], ai[8];
#pragma unroll
        for (int i = 0; i < 16; ++i) a1[i] = sort2f(top1[i] & ~0x7Fu);
#pragma unroll
        for (int i = 0; i < 8; ++i) ai[i] = sort2f(selu(hi, top0[i], top0[8 + i]) & ~0x7Fu);
        unsigned top2[16];
#pragma unroll
        for (int i = 0; i < 16; ++i) top2[i] = 0u;
#pragma unroll
        for (int ii = 0; ii < 8; ++ii) {
            unsigned rw[16];
#pragma unroll
            for (int j = 0; j < 16; ++j) rw[j] = (f2sort(ai[ii] + a1[j]) & ~0xFFu) | (255u - (unsigned)(128 * hi + 16 * ii + j));
            merge_top16(top2, rw);
        }
        { unsigned oth[16];
#pragma unroll
          for (int i = 0; i < 16; ++i) oth[i] = partner32(top2[i], hi);
          merge_top16(top2, oth); }
        float rt; { const f32x4* rp = (const f32x4*)(RS + (size_t)token * 16); const f32x4 a = rp[0], b = rp[1], c = rp[2], d = rp[3];
            rt = rsqrtf((((a.x + a.y) + (a.z + a.w)) + ((b.x + b.y) + (b.z + b.w)) + ((c.x + c.y) + (c.z + c.w)) + ((d.x + d.y) + (d.z + d.w))) * (1.f / D) + EPS); }
        const float mx = sort2f(top2[0] & ~0xFFu);
        float ex[16], sum = 0.f;
#pragma unroll
        for (int k = 0; k < 16; ++k) { ex[k] = __expf(rt * (sort2f(top2[k] & ~0xFFu) - mx)); sum += ex[k]; }
        const float inv = 1.f / sum;
        int2* dst = ROUTE + ((size_t)token * 8 + h) * 16 + 8 * hi;
#pragma unroll
        for (int k = 0; k < 8; k += 2) {
            const unsigned p0 = selu(hi, top2[k], top2[8 + k]), p1 = selu(hi, top2[k + 1], top2[9 + k]);
            const float g0 = self(hi, ex[k], ex[8 + k]) * inv, g1 = self(hi, ex[k + 1], ex[9 + k]) * inv;
            const int pos0 = 255 - (int)(p0 & 0xFFu), pos1 = 255 - (int)(p1 & 0xFFu);
            const int e0 = myl[pos0 >> 4] * 128 + myl[16 + (pos0 & 15)], e1 = myl[pos1 >> 4] * 128 + myl[16 + (pos1 & 15)];
            v4u o; o.x = (unsigned)e0; o.y = __float_as_uint(g0); o.z = (unsigned)e1; o.w = __float_as_uint(g1);
            *(v4u*)(dst + k) = o;
        }
    }
}
}


__device__ __forceinline__ void ph_qk_norms(const bf16* QA, const bf16* KA, unsigned* norms) {
    const int lane = tidx() & 63, wave = tidx() >> 6;
    const int gw = blockIdx.x * NWAVES + wave, NGW = gridDim.x * NWAVES;
    for (int m0 = gw * 8; m0 < M; m0 += NGW * 8) {
        v4u q[8], k[8];
#pragma unroll
        for (int r = 0; r < 8; ++r) { q[r] = *(const v4u*)(QA + (size_t)(m0 + r) * 512 + lane * 8); k[r] = *(const v4u*)(KA + (size_t)(m0 + r) * 512 + lane * 8); }
        float mq = 0.f, mk = 0.f, md = -INFINITY;
#pragma unroll
        for (int r = 0; r < 8; ++r) {
            const unsigned qa[4] = {q[r].x, q[r].y, q[r].z, q[r].w}, ka[4] = {k[r].x, k[r].y, k[r].z, k[r].w};
            float sq = 0.f, sk = 0.f, sd = 0.f;
#pragma unroll
            for (int i = 0; i < 4; ++i) { const float a = bf2f(qa[i] & 0xffffu), b = bf2f(qa[i] >> 16), c = bf2f(ka[i] & 0xffffu), d = bf2f(ka[i] >> 16); sq += a * a + b * b; sk += c * c + d * d; sd += a * c + b * d; }
#pragma unroll
            for (int o = 1; o < 8; o <<= 1) { sq += __shfl_xor(sq, o); sk += __shfl_xor(sk, o); sd += __shfl_xor(sd, o); }
            mq = fmaxf(mq, sq); mk = fmaxf(mk, sk); md = fmaxf(md, -sd);
        }
        if ((lane & 7) == 0) { const int hv = lane >> 3, qb = m0 >> 8;
            atomicMax(norms + hv, __float_as_uint(mk)); atomicMax(norms + 16 + hv * 64 + qb, __float_as_uint(mq)); atomicMax(norms + 528 + hv * 64 + qb, f2sortu(md)); }
    }
}

constexpr int NPHASE = 12;
struct Args { const float* in[24]; float* out; unsigned char* ws; int ph_lo, ph_hi, use_bar, pad; };

__global__ void __launch_bounds__(NTHREADS, 2) mk_fwd(Args args) {
    extern __shared__ __attribute__((aligned(16))) unsigned char lds_raw[];
    float* lds = (float*)lds_raw;
    volatile LAS unsigned* MISC = (volatile LAS unsigned*)((LAS unsigned char*)lds_raw + (LDS_BYTES - 64));
    unsigned char* ws = args.ws;
    unsigned* ctl = (unsigned*)(ws + WS_CTL);
    const float* x = args.in[0]; const float* p = args.in[1]; const float* norm_mix_g = args.in[2]; const float* w_in = args.in[3];
    const float* conv_w = args.in[4]; const float* conv_b = args.in[5]; const float* b_ig = args.in[6]; const float* b_fg = args.in[7];
    const float* lq1 = args.in[8]; const float* lk1 = args.in[9]; const float* lq2 = args.in[10]; const float* lk2 = args.in[11];
    const float* subln_g = args.in[12]; const float* ml_g = args.in[13]; const float* w_out = args.in[14]; const float* norm_ffn_g = args.in[15];
    const float* w_query = args.in[16]; const float* sub_keys = args.in[17]; const float* expert_u = args.in[18]; const float* expert_v = args.in[19];
    const float* norm_ple_g = args.in[20]; const float* w_ple_gate = args.in[21]; const float* w_ple_proj = args.in[22]; const float* final_g = args.in[23];
    float* out = args.out;
    bf16* XN = (bf16*)(ws + WS_XN); float* GATES = (float*)(ws + WS_GATES);
    bf16* QA = (bf16*)(ws + WS_QA); bf16* KA = (bf16*)(ws + WS_KA); bf16* VA = (bf16*)(ws + WS_VA);
    bf16* MQ = (bf16*)(ws + WS_MQ); bf16* MK = (bf16*)(ws + WS_MK); bf16* MV = (bf16*)(ws + WS_MV); bf16* MO = (bf16*)(ws + WS_MO);
    bf16* O1 = (bf16*)(ws + WS_O1); bf16* O2 = (bf16*)(ws + WS_O2); bf16* CQ = (bf16*)(ws + WS_CQ); bf16* CK = (bf16*)(ws + WS_CK);
    float* HS = (float*)(ws + WS_HS); bf16* ACAT = (bf16*)(ws + WS_ACAT); bf16* QP = (bf16*)(ws + WS_QP); int2* ROUTE = (int2*)(ws + WS_ROUTE);
    bf16* PB = (bf16*)(ws + WS_PB); bf16* PP = (bf16*)(ws + WS_PP);
    float* ST = (float*)(ws + WS_ST);
    bf16* SKB = (bf16*)(ws + WS_SKB);
    unsigned char* EU8 = ws + WS_EU8; unsigned char* EV8 = ws + WS_EV8; float* SI = (float*)(ws + WS_SI);
    float* RS = (float*)(ws + WS_RS); bf16* X1G = (bf16*)(ws + WS_X1G); bf16* XN3 = (bf16*)(ws + WS_XN3);
    bf16* WIN = (bf16*)(ws + WS_WIN); bf16* WOUT = (bf16*)(ws + WS_WOUT); bf16* WQ = (bf16*)(ws + WS_WQ); bf16* WG = (bf16*)(ws + WS_WG); bf16* WP = (bf16*)(ws + WS_WP);
    LAS unsigned char* ldsb = (LAS unsigned char*)lds_raw;

    XcdBarrier bar; bar.bar = ctl + CW_BAR; bar.x = 0; bar.st = nullptr;
    if (args.use_bar) {
        if (tidx() < 16) MISC[tidx()] = 0u;
        __syncthreads();
        bar = xcd_barrier_post(ctl + CW_BAR, MISC + 8);
    }
    const int lo = args.ph_lo, hi = args.ph_hi;
#define IN(k) (lo <= (k) && (k) < hi)
#define SEAM(k) do { if (IN(k) && IN((k) + 1)) xcd_barrier(bar); } while (0)

    if (IN(0)) { route::convert_subkeys(sub_keys, SKB); ph_weights_in(w_in, WIN, ldsb);
        for (int ch = blockIdx.x; ch < WCH_CHUNKS; ch += gridDim.x) weights_chunk(ch, w_out, w_query, norm_ffn_g, w_ple_gate, w_ple_proj, WOUT, WQ, WG, WP, ldsb);
        ph_rmsnorm_bf16(x, norm_mix_g, XN);
        { const size_t n = (size_t)M * PLE / 8, stride = (size_t)gridDim.x * NTHREADS;
          for (size_t i = (size_t)blockIdx.x * NTHREADS + tidx(); i < n; i += stride) { const f32x4 a = *(const f32x4*)(p + i * 8), b = *(const f32x4*)(p + i * 8 + 4);
              v4u o; o.x = pk2(a.x, a.y); o.y = pk2(a.z, a.w); o.z = pk2(b.x, b.y); o.w = pk2(b.z, b.w); *(v4u*)(PB + i * 8) = o; } }
    } SEAM(0);
    if (IN(1)) {
        pg8::Gemm g{XN, WIN, M, NINP, D}; pg8::StaticOrder S; S.init(M, NINP, (int)gridDim.x, (int)blockIdx.x);
        pg8::EpiProj E{QA, (size_t)(WS_KA - WS_QA) / 2, C2, GATES};
        pg8::gemm_phase<pg8::EpiProj, pg8::StaticOrder, true, true>(ldsb, g, S, E);
    } SEAM(1);
    if (IN(2)) { ph_qk_norms(QA, KA, ctl + CW_NORM); ml::conv_items(MQ, MK, conv_w, conv_b, CQ, CK); } SEAM(2);
    if (IN(3)) {
        constexpr int Q_ATT = 1024, Q_END = Q_ATT + 256;
        for (;;) {
            __syncthreads();
            if (tidx() == 0) MISC[0] = __hip_atomic_fetch_add(ctl + CW_QUEUE, 1u, __ATOMIC_RELAXED, __HIP_MEMORY_SCOPE_AGENT);
            __syncthreads();
            const int u = (int)__builtin_amdgcn_readfirstlane(MISC[0]);
            if (u >= Q_END) break;
            if (u < Q_ATT) attn_body::attn_dispatch<8>(u, (char*)lds_raw, (const attn_body::bf16*)QA, (const attn_body::bf16*)KA, (const attn_body::bf16*)VA, (attn_body::bf16*)O1, (attn_body::bf16*)O2, ctl + CW_NORM);
            else ml::b1_item(u - Q_ATT, CK, MV, GATES, b_ig, b_fg, ST, ldsb);
        }
    } SEAM(3);
    if (IN(4)) { ml::phase_b2(ST); peer::convert_tables(expert_u, expert_v, norm_ffn_g, EU8, EV8, SI); } SEAM(4);
    if (IN(5)) { ml::phase_b3(CQ, CK, MV, MO, GATES, b_ig, b_fg, ml_g, ST, ACAT, ldsb); ph_combine<false>(O1, O2, MO, HS, lq1, lk1, lq2, lk2, subln_g, ml_g, ACAT); } SEAM(5);
    if (IN(6)) {
        pg8::Gemm g{ACAT, WOUT, M, D, D}; pg8::StaticOrder S; S.init(M, D, (int)gridDim.x, (int)blockIdx.x);
        pg8::EpiResX1 E{x, out, X1G, RS, D};
        pg8::gemm_phase<pg8::EpiResX1, pg8::StaticOrder, true, true>(ldsb, g, S, E);
    } SEAM(6);
    if (IN(7)) {
        { pg8::Gemm g{X1G, WQ, M, NQ, D}; pg8::StaticOrder S; S.init(M, NQ, (int)gridDim.x, (int)blockIdx.x);
          pg8::EpiBf16<0> E{QP, NQ, nullptr, 0, 0, 1.f};
          pg8::gemm_phase<pg8::EpiBf16<0>, pg8::StaticOrder, true, true>(ldsb, g, S, E); }
        { pg8::Gemm g{PB, WP, M, D, PLE}; pg8::StaticOrder S; S.init(M, D, (int)gridDim.x, (int)blockIdx.x);
          pg8::EpiBf16<0> E{PP, D, nullptr, 0, 0, 1.f};
          pg8::gemm_phase<pg8::EpiBf16<0>, pg8::StaticOrder, true, true>(ldsb, g, S, E); }
    } SEAM(7);
    if (IN(8)) { route::route_phase(QP, SKB, RS, ROUTE, ldsb); } SEAM(8);
    if (IN(9)) { peer::expert_phase_mp<4>(X1G, RS, XN3, ROUTE, EU8, EV8, SI, out, out, norm_ple_g, ldsb); } SEAM(9);
    if (IN(10)) {
        pg8::Gemm g{XN3, WG, M, D, D}; pg8::StaticOrder S; S.init(M, D, (int)gridDim.x, (int)blockIdx.x);
        pg8::EpiGateFinal E{PP, out, D};
        pg8::gemm_phase<pg8::EpiGateFinal, pg8::StaticOrder, true, true>(ldsb, g, S, E);
    } SEAM(10);
    if (IN(11)) { ph_rmsnorm_f32_inplace(out, final_g); }
#undef IN
#undef SEAM
}

extern "C" void kernel_launch(void* const* d_in, const int* in_sizes, int n_in, void* d_out, int out_size, void* d_ws, size_t ws_size, hipStream_t stream) {
    static int grid = 0;
    if (grid == 0) {
        if (n_in != 24 || in_sizes[0] != M * D || out_size != M * D || ws_size < WS_END) { fprintf(stderr, "kernel_launch: unexpected shapes (n_in %d, in0 %d, out %d, ws %zu)\n", n_in, n_in > 0 ? in_sizes[0] : -1, out_size, ws_size); grid = -1; return; }
        int dev = 0, cus = 0;
        if (hipGetDevice(&dev) != hipSuccess || hipDeviceGetAttribute(&cus, hipDeviceAttributeMultiprocessorCount, dev) != hipSuccess) { grid = -1; return; }
        if (hipFuncSetAttribute((const void*)mk_fwd, hipFuncAttributeMaxDynamicSharedMemorySize, LDS_BYTES) != hipSuccess) { fprintf(stderr, "kernel_launch: hipFuncSetAttribute failed\n"); grid = -1; return; }
        (void)hipGetLastError();
        grid = cus;
    }
    if (grid < 0) return;
    if (hipMemsetAsync((char*)d_ws + WS_CTL, 0, CTL_ZERO_BYTES, stream) != hipSuccess) return;
    Args a{};
    for (int i = 0; i < 24; ++i) a.in[i] = (const float*)d_in[i];
    a.out = (float*)d_out; a.ws = (unsigned char*)d_ws;
#if MK_ONE_LAUNCH
    a.ph_lo = 0; a.ph_hi = NPHASE; a.use_bar = 1;
    hipLaunchKernelGGL(mk_fwd, dim3(grid), dim3(NTHREADS), LDS_BYTES, stream, a);
#else
    for (int ph = 0; ph < NPHASE; ++ph) {
        a.ph_lo = ph; a.ph_hi = ph + 1; a.use_bar = 0;
        hipLaunchKernelGGL(mk_fwd, dim3(grid), dim3(NTHREADS), LDS_BYTES, stream, a);
    }
#endif
}
```

```cpp
#include <hip/hip_runtime.h>
#include <cstdio>
#include <cstdint>
#include <cmath>

#ifndef MK_ONE_LAUNCH
#define MK_ONE_LAUNCH 1
#endif

constexpr int M = 16384, D = 1024, NIN = 3592, PLE = 256;
constexpr int NQ = 2048;
constexpr float EPS = 1e-6f;
constexpr float LOG2E = 1.4426950408889634f;
constexpr float C2 = 0.125f * LOG2E;
constexpr float LAMBDA_INIT = 0.2f;
constexpr int NWAVES = 8, NTHREADS = 512;
constexpr int LDS_BYTES = 147456;

typedef unsigned short bf16;
typedef float f32x4 __attribute__((ext_vector_type(4)));
typedef unsigned v4u __attribute__((ext_vector_type(4)));
typedef unsigned v2u __attribute__((ext_vector_type(2)));
#define LAS __attribute__((address_space(3)))

constexpr size_t MiB = 1u << 20;
constexpr size_t WS_CTL = 0, CTL_ZERO_BYTES = 1 * MiB;
constexpr size_t WS_WIN = 1 * MiB, WS_WOUT = 9 * MiB, WS_WQ = 11 * MiB, WS_WG = 15 * MiB, WS_WP = 18 * MiB;
constexpr int NINP = 3840;
constexpr size_t WS_SKB = 18 * MiB + 512 * 1024;
constexpr size_t WS_GATES = 17 * MiB;
constexpr size_t WS_XN = 20 * MiB;
constexpr size_t WS_QA = 52 * MiB, WS_KA = 68 * MiB, WS_VA = 84 * MiB, WS_MQ = 100 * MiB, WS_MK = 116 * MiB, WS_MV = 132 * MiB, WS_MO = 148 * MiB;
constexpr size_t WS_O1 = 164 * MiB, WS_O2 = 180 * MiB;
constexpr size_t WS_CQ = 196 * MiB, WS_CK = 212 * MiB;
constexpr size_t WS_HS = WS_XN;
constexpr size_t WS_ACAT = WS_QA;
constexpr size_t WS_QP = WS_VA;
constexpr size_t WS_ROUTE = WS_MO;
constexpr size_t WS_PB = 245 * MiB;
constexpr size_t WS_PP = WS_QA;
constexpr size_t WS_G2 = WS_VA;
constexpr size_t WS_EU8 = 20 * MiB, WS_EV8 = 36 * MiB;
constexpr size_t WS_SI = 19 * MiB;
constexpr size_t WS_RS = 253 * MiB;
constexpr size_t WS_X1G = 164 * MiB;
constexpr size_t WS_XN3 = 196 * MiB;
constexpr size_t WS_ST = 228 * MiB;
constexpr size_t WS_END = 256 * MiB;
constexpr int CW_BAR = 4096;
constexpr int CW_NORM = 1024, CW_QUEUE = 128;

__device__ __forceinline__ float bf2f(unsigned v) { return __uint_as_float(v << 16); }
__device__ __forceinline__ unsigned f2bf(float f) { unsigned u = __float_as_uint(f); return (u + 0x7fffu + ((u >> 16) & 1u)) >> 16; }
__device__ __forceinline__ unsigned pk2(float lo, float hi) { return f2bf(lo) | (f2bf(hi) << 16); }
__device__ __forceinline__ float wave_sum(float v) {
#pragma unroll
    for (int o = 1; o < 64; o <<= 1) v += __shfl_xor(v, o);
    return v;
}
__device__ __forceinline__ float sigmoidf_(float x) { return 1.f / (1.f + __expf(-x)); }
__device__ __forceinline__ unsigned f2sortu(float f) { const unsigned u = __float_as_uint(f); return (u & 0x80000000u) ? ~u : (u | 0x80000000u); }
__device__ __forceinline__ float sortu2f(unsigned s) { return __uint_as_float((s & 0x80000000u) ? (s & 0x7fffffffu) : ~s); }
__device__ __forceinline__ int tidx() { int t = threadIdx.x; asm volatile("" : "+v"(t)); return t; }

#define XB_TMO      128
#define XB_XCNT(j)  (256  + 64 * (j))
#define XB_XSUB(j)  (1280 + 64 * (j))
#define XB_XGEN(j)  (2304 + 64 * (j))
#define XB_TOP      3328
#define XB_TOPGEN   3392
#define XCD_BAR_WORDS 3456
#define XB_SPIN_CAP (1u << 25)
__device__ __forceinline__ unsigned xb_ld(unsigned* p)              { return __hip_atomic_load(p, __ATOMIC_RELAXED, __HIP_MEMORY_SCOPE_AGENT); }
__device__ __forceinline__ unsigned xb_add(unsigned* p, unsigned v) { return __hip_atomic_fetch_add(p, v, __ATOMIC_RELAXED, __HIP_MEMORY_SCOPE_AGENT); }
__device__ __forceinline__ unsigned xb_xcc_id() { return (unsigned)__builtin_amdgcn_s_getreg((3 << 11) | 20) & 0xFu; }
#define XB_SPIN(cond, bar) do { unsigned _sp = 0; while (cond) { __builtin_amdgcn_s_sleep(1); \
    if ((++_sp & 255u) == 0u) { if (xb_ld(&(bar)[XB_TMO])) break; if (_sp > XB_SPIN_CAP) { atomicAdd(&(bar)[XB_TMO], 1u); break; } } } } while (0)
struct XcdBarrier { unsigned* bar; unsigned x; volatile LAS unsigned* st; };
__device__ __forceinline__ XcdBarrier xcd_barrier_post(unsigned* bar, volatile LAS unsigned* st) {
    XcdBarrier b; b.bar = bar; b.x = xb_xcc_id(); b.st = st;
    if (tidx() == 0) (void)xb_add(&bar[XB_XCNT(b.x)], 1u);
    return b;
}
__device__ __forceinline__ void xcd_barrier_complete(unsigned* bar, unsigned x, unsigned& nloc, unsigned& nx) {
    const unsigned G = gridDim.x * gridDim.y * gridDim.z;
    unsigned sum, cnt, mine, sp = 0u;
    for (;;) {
        sum = 0u; cnt = 0u; mine = 0u;
#pragma unroll
        for (unsigned j = 0; j < 16; ++j) { const unsigned c = xb_ld(&bar[XB_XCNT(j)]); sum += c; cnt += (c > 0u) ? 1u : 0u; mine = (j == x) ? c : mine; }
        if (sum == G) break;
        __builtin_amdgcn_s_sleep(1);
        if ((++sp & 255u) == 0u) { if (xb_ld(&bar[XB_TMO])) break; if (sp > XB_SPIN_CAP) { atomicAdd(&bar[XB_TMO], 1u); break; } }
    }
    nloc = mine > 0u ? mine : 1u; nx = cnt > 0u ? cnt : 1u;
}
__device__ __forceinline__ void xcd_barrier(const XcdBarrier& b) {
    asm volatile("s_waitcnt vmcnt(0)" ::: "memory");
    __syncthreads();
    if (tidx() == 0) {
        unsigned* bar = b.bar;
        __builtin_amdgcn_s_waitcnt(0);
        unsigned nloc = b.st[0], nx = b.st[1];
        if (nloc == 0u) { xcd_barrier_complete(bar, b.x, nloc, nx); b.st[0] = nloc; b.st[1] = nx; }
        const unsigned old = xb_add(&bar[XB_XSUB(b.x)], 1u);
        const unsigned gen = old / nloc;
        if (old + 1u == (gen + 1u) * nloc) {
            __builtin_amdgcn_fence(__ATOMIC_RELEASE, "agent");
            asm volatile("s_waitcnt vmcnt(0)" ::: "memory");
            const unsigned og = xb_add(&bar[XB_TOP], 1u);
            const unsigned tg = og / nx;
            if (og + 1u == (tg + 1u) * nx) xb_add(&bar[XB_TOPGEN], 1u);
            else XB_SPIN(xb_ld(&bar[XB_TOPGEN]) == tg, bar);
            __builtin_amdgcn_fence(__ATOMIC_ACQUIRE, "agent");
            xb_add(&bar[XB_XGEN(b.x)], 1u);
            asm volatile("s_waitcnt vmcnt(0)" ::: "memory");
        } else {
            XB_SPIN(xb_ld(&bar[XB_XGEN(b.x)]) == gen, bar);
            __builtin_amdgcn_fence(__ATOMIC_ACQUIRE, "agent");
            asm volatile("s_waitcnt vmcnt(0)" ::: "memory");
        }
    }
    __syncthreads();
}

namespace pg8 {
#define PG8_LAS __attribute__((address_space(3)))
typedef unsigned short bf16_t;
typedef short bf16x8 __attribute__((ext_vector_type(8)));
typedef float f32x4 __attribute__((ext_vector_type(4)));
typedef unsigned u32x4 __attribute__((ext_vector_type(4)));
constexpr int BM = 256, BK = 64, HALF = 128, HTB = HALF * BK * 2  , STAGE_BYTES = 8 * HTB, NXCD = 8, WGM = 8;

__host__ __device__ __forceinline__ int lds_byte(int r, int c) { const int st = (r >> 4) * 2 + (c >> 5), rr = r & 15, cc = c & 31, ob = rr * 64 + cc * 2; return st * 1024 + (ob ^ (((ob >> 9) & 1) << 5)); }
__host__ __device__ __forceinline__ void stage_rc(int b, int& R, int& C) { const int st = b / 1024, sb = b % 1024, swz = sb ^ (((sb >> 9) & 1) << 5); R = (st >> 1) * 16 + swz / 64; C = (st & 1) * 32 + (swz % 64) / 2; }
__host__ __device__ __forceinline__ int perm32(int rho) { const int n = rho >> 4, i = rho & 15; return 8 * (i >> 2) + 4 * n + (i & 3); }

struct Unit { int pm, pn; };
struct Gemm { const bf16_t* A; const bf16_t* Bt; int M, N, K; };

struct StaticOrder {
    int nM, nN, nwg, G, c;
    __host__ __device__ void init(int M, int N, int G_, int c_) { nM = M / BM; nN = N / BM; nwg = nM * nN; G = G_; c = c_; }
    __host__ __device__ bool next(int i, Unit& u) const {
        const long L = (long)i * G + c; if (L >= nwg) return false;
        int wgid = (int)L; { const int q = nwg / NXCD, r = nwg % NXCD, xcd = wgid % NXCD, off = wgid / NXCD; wgid = (xcd < r ? xcd * (q + 1) : r * (q + 1) + (xcd - r) * q) + off; }
        const int nig = WGM * nN, gid = wgid / nig, fm = gid * WGM, gsz = (nM - fm) < WGM ? (nM - fm) : WGM;
        u.pm = fm + ((wgid % nig) % gsz); u.pn = (wgid % nig) / gsz; return true;
    }
    __device__ __forceinline__ void a_ready(const Unit&) const {}
    __device__ __forceinline__ void done(const Unit&) const {}
};

__device__ __forceinline__ unsigned cvt_pk_bf16(float lo, float hi) { unsigned r; asm volatile("v_cvt_pk_bf16_f32 %0, %1, %2" : "=v"(r) : "v"(lo), "v"(hi)); return r; }
typedef float f32x2 __attribute__((ext_vector_type(2)));
__device__ __forceinline__ f32x2 gelu_pk(f32x2 v) {
    const f32x2 av = __builtin_elementwise_abs(v), d = av * 0.2316418882f + 1.0f;
    f32x2 t; t.x = __builtin_amdgcn_rcpf(d.x); t.y = __builtin_amdgcn_rcpf(d.y);
    f32x2 q = t * 0.5307027145f + (-0.7265760135f); q = q * t + 0.7107068705f; q = q * t + (-0.142248368f); q = q * t + 0.127414796f; q = q * t;
    const f32x2 s = (v * v) * (-0.72134752044f);
    f32x2 e; e.x = __builtin_amdgcn_exp2f(s.x); e.y = __builtin_amdgcn_exp2f(s.y);
    const f32x2 m = v * (q * e), r = v - m;
    f32x2 o; o.x = v.x < 0.f ? m.x : r.x; o.y = v.y < 0.f ? m.y : r.y; return o;
}

template <int ACT  > struct EpiBf16 {
    static constexpr bool PERM = true, AFTER_DRAIN = false; static_assert(ACT == 0 || ACT == 1, "EpiBf16: ACT is 0 (none) or 1 (gelu_pk)");
    bf16_t* O; int ldc; const float* bias; int split_cols; size_t split_stride; float scale0;
    __device__ __forceinline__ void operator()(const f32x4 (&acc)[2][2][4][2], const Unit& u, int wr, int wc, int fr, int fq) const {
        const int row0 = u.pm * BM + wr * 64 + fr; int colt = u.pn * BM; bf16_t* base = O;
        float sc = 1.f; if (split_cols) { const int t = colt / split_cols; base += (size_t)t * split_stride; colt -= t * split_cols; if (t == 0) sc = scale0; }
        const int col0 = colt + wc * 32 + 8 * fq, bcol0 = u.pn * BM + wc * 32 + 8 * fq;
        f32x4 bv[2][2];
#pragma unroll
        for (int bj = 0; bj < 2; ++bj)
#pragma unroll
            for (int n = 0; n < 2; ++n) bv[bj][n] = bias ? *(const f32x4*)(bias + bcol0 + bj * HALF + 4 * n) : (f32x4){0.f, 0.f, 0.f, 0.f};
#pragma unroll
        for (int ai = 0; ai < 2; ++ai)
#pragma unroll
            for (int m = 0; m < 4; ++m) { bf16_t* rowp = base + (size_t)(row0 + ai * HALF + m * 16) * ldc + col0;
#pragma unroll
                for (int bj = 0; bj < 2; ++bj) { f32x4 v0 = acc[ai][bj][m][0] + bv[bj][0], v1 = acc[ai][bj][m][1] + bv[bj][1];
                    if (ACT == 1) { f32x2 a = gelu_pk((f32x2){v0[0], v0[1]}), b = gelu_pk((f32x2){v0[2], v0[3]}), c = gelu_pk((f32x2){v1[0], v1[1]}), d = gelu_pk((f32x2){v1[2], v1[3]});
                        v0 = (f32x4){a.x, a.y, b.x, b.y}; v1 = (f32x4){c.x, c.y, d.x, d.y}; }
                    v0 = v0 * sc; v1 = v1 * sc; u32x4 w; w.x = cvt_pk_bf16(v0[0], v0[1]); w.y = cvt_pk_bf16(v0[2], v0[3]); w.z = cvt_pk_bf16(v1[0], v1[1]); w.w = cvt_pk_bf16(v1[2], v1[3]);
                    *(u32x4*)(rowp + bj * HALF) = w; } }
    }
};

struct EpiProj {
    static constexpr bool PERM = true, AFTER_DRAIN = false;
    bf16_t* O; size_t split_stride; float scale0; float* gates;
    __device__ __forceinline__ void operator()(const f32x4 (&acc)[2][2][4][2], const Unit& u, int wr, int wc, int fr, int fq) const {
        const int row0 = u.pm * BM + wr * 64 + fr;
        if (u.pn == 14) {
            if (wc == 0 && fq == 0) {
#pragma unroll
                for (int ai = 0; ai < 2; ++ai)
#pragma unroll
                    for (int m = 0; m < 4; ++m) { float* g = gates + (size_t)(row0 + ai * HALF + m * 16) * 8; *(f32x4*)g = acc[ai][0][m][0]; *(f32x4*)(g + 4) = acc[ai][0][m][1]; }
            }
            return;
        }
        int colt = u.pn * BM; const int t = colt / 512; bf16_t* base = O + (size_t)t * split_stride; colt -= t * 512; const float sc = (t == 0) ? scale0 : 1.f;
        const int col0 = colt + wc * 32 + 8 * fq;
#pragma unroll
        for (int ai = 0; ai < 2; ++ai)
#pragma unroll
            for (int m = 0; m < 4; ++m) { bf16_t* rowp = base + (size_t)(row0 + ai * HALF + m * 16) * 512 + col0;
#pragma unroll
                for (int bj = 0; bj < 2; ++bj) { const f32x4 v0 = acc[ai][bj][m][0] * sc, v1 = acc[ai][bj][m][1] * sc;
                    u32x4 w; w.x = cvt_pk_bf16(v0[0], v0[1]); w.y = cvt_pk_bf16(v0[2], v0[3]); w.z = cvt_pk_bf16(v1[0], v1[1]); w.w = cvt_pk_bf16(v1[2], v1[3]);
                    *(u32x4*)(rowp + bj * HALF) = w; } }
    }
};
struct EpiResF32 {
    static constexpr bool PERM = false, AFTER_DRAIN = false;
    const float* base; float* out; int ldc;
    __device__ __forceinline__ void operator()(const f32x4 (&acc)[2][2][4][2], const Unit& u, int wr, int wc, int fr, int fq) const {
        const int row0 = u.pm * BM + wr * 64 + fr, col0 = u.pn * BM + wc * 32 + 4 * fq;
#pragma unroll
        for (int ai = 0; ai < 2; ++ai)
#pragma unroll
            for (int m = 0; m < 4; ++m) { const size_t off = (size_t)(row0 + ai * HALF + m * 16) * ldc + col0;
#pragma unroll
                for (int bj = 0; bj < 2; ++bj)
#pragma unroll
                    for (int n = 0; n < 2; ++n) { const size_t o = off + bj * HALF + n * 16; *(f32x4*)(out + o) = *(const f32x4*)(base + o) + acc[ai][bj][m][n]; } }
    }
};
struct EpiResX1 {
    static constexpr bool PERM = false, AFTER_DRAIN = false;
    const float* base; float* out; bf16_t* xg; float* rs; int ldc;
    __device__ __forceinline__ void operator()(const f32x4 (&acc)[2][2][4][2], const Unit& u, int wr, int wc, int fr, int fq) const {
        const int row0 = u.pm * BM + wr * 64 + fr, col0 = u.pn * BM + wc * 32 + 4 * fq;
#pragma unroll
        for (int ai = 0; ai < 2; ++ai)
#pragma unroll
            for (int m = 0; m < 4; ++m) { const int row = row0 + ai * HALF + m * 16; const size_t off = (size_t)row * ldc + col0; float ss = 0.f;
#pragma unroll
                for (int bj = 0; bj < 2; ++bj)
#pragma unroll
                    for (int n = 0; n < 2; ++n) { const size_t o = off + bj * HALF + n * 16; const f32x4 v = *(const f32x4*)(base + o) + acc[ai][bj][m][n]; *(f32x4*)(out + o) = v;
                        ss += (v[0] * v[0] + v[1] * v[1]) + (v[2] * v[2] + v[3] * v[3]);
                        typedef unsigned u32x2 __attribute__((ext_vector_type(2))); u32x2 pk; pk.x = cvt_pk_bf16(v[0], v[1]); pk.y = cvt_pk_bf16(v[2], v[3]); *(u32x2*)(xg + o) = pk; }
                ss += __shfl_xor(ss, 16); ss += __shfl_xor(ss, 32);
                if (fq == 0) rs[(size_t)row * 16 + u.pn * 4 + wc] = ss; }
    }
};
struct EpiSigBf16 {
    static constexpr bool PERM = true, AFTER_DRAIN = false;
    bf16_t* O; int ldc;
    __device__ __forceinline__ void operator()(const f32x4 (&acc)[2][2][4][2], const Unit& u, int wr, int wc, int fr, int fq) const {
        const int row0 = u.pm * BM + wr * 64 + fr, col0 = u.pn * BM + wc * 32 + 8 * fq;
#pragma unroll
        for (int ai = 0; ai < 2; ++ai)
#pragma unroll
            for (int m = 0; m < 4; ++m) { bf16_t* rowp = O + (size_t)(row0 + ai * HALF + m * 16) * ldc + col0;
#pragma unroll
                for (int bj = 0; bj < 2; ++bj) { f32x4 v0 = acc[ai][bj][m][0], v1 = acc[ai][bj][m][1];
#pragma unroll
                    for (int i = 0; i < 4; ++i) { v0[i] = 1.f / (1.f + __expf(-v0[i])); v1[i] = 1.f / (1.f + __expf(-v1[i])); }
                    u32x4 w; w.x = cvt_pk_bf16(v0[0], v0[1]); w.y = cvt_pk_bf16(v0[2], v0[3]); w.z = cvt_pk_bf16(v1[0], v1[1]); w.w = cvt_pk_bf16(v1[2], v1[3]);
                    *(u32x4*)(rowp + bj * HALF) = w; } }
    }
};
struct EpiGateFinal {
    static constexpr bool PERM = false, AFTER_DRAIN = false;
    const bf16_t* P; float* out; int ldc;
    __device__ __forceinline__ void operator()(const f32x4 (&acc)[2][2][4][2], const Unit& u, int wr, int wc, int fr, int fq) const {
        const int row0 = u.pm * BM + wr * 64 + fr, col0 = u.pn * BM + wc * 32 + 4 * fq;
#pragma unroll
        for (int ai = 0; ai < 2; ++ai)
#pragma unroll
            for (int m = 0; m < 4; ++m) { const size_t off = (size_t)(row0 + ai * HALF + m * 16) * ldc + col0;
#pragma unroll
                for (int bj = 0; bj < 2; ++bj)
#pragma unroll
                    for (int n = 0; n < 2; ++n) { const size_t o = off + bj * HALF + n * 16;
                        typedef unsigned u32x2 __attribute__((ext_vector_type(2))); const u32x2 g = *(const u32x2*)(P + o);
                        f32x4 pv; pv[0] = __uint_as_float(g.x << 16); pv[1] = __uint_as_float(g.x & 0xffff0000u); pv[2] = __uint_as_float(g.y << 16); pv[3] = __uint_as_float(g.y & 0xffff0000u);
                        f32x4 sg = acc[ai][bj][m][n];
#pragma unroll
                        for (int i = 0; i < 4; ++i) sg[i] = 1.f / (1.f + __expf(-sg[i]));
                        *(f32x4*)(out + o) = *(const f32x4*)(out + o) + sg * pv; } }
    }
};
struct EpiGateAcc {
    static constexpr bool PERM = false, AFTER_DRAIN = false;
    const bf16_t* G; float* out; int ldc;
    __device__ __forceinline__ void operator()(const f32x4 (&acc)[2][2][4][2], const Unit& u, int wr, int wc, int fr, int fq) const {
        const int row0 = u.pm * BM + wr * 64 + fr, col0 = u.pn * BM + wc * 32 + 4 * fq;
#pragma unroll
        for (int ai = 0; ai < 2; ++ai)
#pragma unroll
            for (int m = 0; m < 4; ++m) { const size_t off = (size_t)(row0 + ai * HALF + m * 16) * ldc + col0;
#pragma unroll
                for (int bj = 0; bj < 2; ++bj)
#pragma unroll
                    for (int n = 0; n < 2; ++n) { const size_t o = off + bj * HALF + n * 16;
                        typedef unsigned u32x2 __attribute__((ext_vector_type(2))); const u32x2 g = *(const u32x2*)(G + o);
                        f32x4 gv; gv[0] = __uint_as_float(g.x << 16); gv[1] = __uint_as_float(g.x & 0xffff0000u); gv[2] = __uint_as_float(g.y << 16); gv[3] = __uint_as_float(g.y & 0xffff0000u);
                        *(f32x4*)(out + o) = *(const f32x4*)(out + o) + gv * acc[ai][bj][m][n]; } }
    }
};
template <class Epi, class Sched, bool ALIGN_EPI = false, bool SP2 = false>
__device__ __forceinline__ void gemm_phase(PG8_LAS unsigned char* lds, const Gemm g, const Sched& S, const Epi& E) {
    const int tid = tidx(), wid = __builtin_amdgcn_readfirstlane(tid >> 6), lane = tid & 63, wr = wid >> 2, wc = wid & 3, fr = lane & 15, fq = lane >> 4;
    const int K = g.K, nt = K / BK;
    unsigned voffA[2], voffB[2];
#pragma unroll
    for (int i = 0; i < 2; ++i) { int R, C; stage_rc(tid * 16 + i * 8192, R, C); const int Rb = Epi::PERM ? ((R & ~31) + perm32(R & 31)) : R;
        voffA[i] = (unsigned)(R * K + C) * 2u; voffB[i] = (unsigned)(Rb * K + C) * 2u; }
    const size_t kstep = (size_t)(BK * 2);
    const size_t hstep = (size_t)HALF * K * 2;
    const size_t tstep = 2 * hstep;
    const unsigned ldsw = (unsigned)wid * 1024u;
    const int aoff = lds_byte(wr * 64 + fr, fq * 8), boff = lds_byte(wc * 32 + fr, fq * 8);
#define PG8_SA(b, h) (((b) * 2 + (h)) * HTB)
#define PG8_SB(b, h) ((4 + (b) * 2 + (h)) * HTB)
#define PG8_STAGE(bufoff, gbase, voff) do { _Pragma("unroll") for (int _i = 0; _i < 2; ++_i) \
        __builtin_amdgcn_global_load_lds((const unsigned*)((const char*)(gbase) + (voff)[_i]), (PG8_LAS unsigned*)(lds + (bufoff) + ldsw + _i * 8192), 16, 0, 0); } while (0)
#define PG8_LDA(dst, b, h) do { _Pragma("unroll") for (int m = 0; m < 4; ++m) _Pragma("unroll") for (int k = 0; k < 2; ++k) dst[m][k] = *(const PG8_LAS bf16x8*)(lds + PG8_SA(b, h) + aoff + m * 2048 + k * 1024); } while (0)
#define PG8_LDB(dst, b, h) do { _Pragma("unroll") for (int n = 0; n < 2; ++n) _Pragma("unroll") for (int k = 0; k < 2; ++k) dst[n][k] = *(const PG8_LAS bf16x8*)(lds + PG8_SB(b, h) + boff + n * 2048 + k * 1024); } while (0)
#define PG8_MMA(ai, bj, At, Bt) do { __builtin_amdgcn_s_setprio(1); _Pragma("unroll") for (int m = 0; m < 4; ++m) _Pragma("unroll") for (int n = 0; n < 2; ++n) _Pragma("unroll") for (int k = 0; k < 2; ++k) \
        acc[ai][bj][m][n] = __builtin_amdgcn_mfma_f32_16x16x32_bf16(Bt[n][k], At[m][k], acc[ai][bj][m][n], 0, 0, 0); __builtin_amdgcn_s_setprio(0); } while (0)
#define PG8_WAIT_V(n) asm volatile("s_waitcnt vmcnt(" #n ")" ::: "memory")
#define PG8_WAIT_L(n) asm volatile("s_waitcnt lgkmcnt(" #n ")" ::: "memory")
#define PG8_BAR __builtin_amdgcn_s_barrier()
#define PG8_SCHED __builtin_amdgcn_sched_barrier(0)
    Unit cur, nxt; int ui = 0;
    if (!S.next(0, cur)) return;
    f32x4 acc[2][2][4][2];
#pragma unroll
    for (int a = 0; a < 2; ++a)
#pragma unroll
        for (int b = 0; b < 2; ++b)
#pragma unroll
            for (int m = 0; m < 4; ++m)
#pragma unroll
                for (int n = 0; n < 2; ++n) acc[a][b][m][n] = (f32x4){0.f, 0.f, 0.f, 0.f};
    bf16x8 At[4][2], B0[2][2], B1[2][2];
    const char* cA = (const char*)g.A + (size_t)cur.pm * tstep; const char* cB = (const char*)g.Bt + (size_t)cur.pn * tstep;
    S.a_ready(cur);
    if constexpr (SP2) {
        PG8_STAGE(PG8_SB(0, 0), cB, voffB); PG8_STAGE(PG8_SB(0, 1), cB + hstep, voffB); PG8_STAGE(PG8_SA(0, 0), cA, voffA); PG8_STAGE(PG8_SA(0, 1), cA + hstep, voffA);
        if (wr == 1) PG8_BAR;
        PG8_WAIT_V(2); PG8_BAR;
        PG8_STAGE(PG8_SB(1, 0), cB + kstep, voffB); PG8_STAGE(PG8_SA(1, 0), cA + kstep, voffA); PG8_STAGE(PG8_SB(1, 1), cB + hstep + kstep, voffB);
        PG8_WAIT_V(6); PG8_BAR;
    } else {
        PG8_STAGE(PG8_SB(0, 0), cB, voffB); PG8_STAGE(PG8_SA(0, 0), cA, voffA); PG8_STAGE(PG8_SB(0, 1), cB + hstep, voffB); PG8_STAGE(PG8_SA(0, 1), cA + hstep, voffA);
        if (wr == 1) PG8_BAR;
        PG8_WAIT_V(4); PG8_BAR;
        PG8_STAGE(PG8_SB(1, 0), cB + kstep, voffB); PG8_STAGE(PG8_SA(1, 0), cA + kstep, voffA); PG8_STAGE(PG8_SB(1, 1), cB + hstep + kstep, voffB);
        PG8_WAIT_V(6); PG8_BAR;
    }
    for (;;) {
        const bool has_next = S.next(ui + 1, nxt);
        const char* nA = has_next ? (const char*)g.A + (size_t)nxt.pm * tstep : cA; const char* nB = has_next ? (const char*)g.Bt + (size_t)nxt.pn * tstep : cB;
        for (int t = 0; t < nt; t += 2) {
            const bool last = (t == nt - 2);
            const char* a1 = cA + (size_t)(t + 1) * kstep;
            const char* a2 = last ? nA : cA + (size_t)(t + 2) * kstep; const char* b2 = last ? nB : cB + (size_t)(t + 2) * kstep;
            const char* a3 = a2 + kstep; const char* b3 = b2 + kstep;
            if (last && has_next) S.a_ready(nxt);
            if constexpr (SP2) {
            PG8_LDB(B0, 0, 0); PG8_LDB(B1, 0, 1); PG8_SCHED; PG8_LDA(At, 0, 0); PG8_STAGE(PG8_SA(1, 1), a1 + hstep, voffA);
            PG8_WAIT_V(8); PG8_WAIT_L(0); PG8_BAR; PG8_MMA(0, 0, At, B0); PG8_MMA(0, 1, At, B1); PG8_BAR; PG8_SCHED;
            PG8_LDA(At, 0, 1); PG8_STAGE(PG8_SB(0, 0), b2, voffB); PG8_STAGE(PG8_SB(0, 1), b2 + hstep, voffB); PG8_STAGE(PG8_SA(0, 0), a2, voffA);
            PG8_WAIT_V(8); PG8_WAIT_L(0); PG8_BAR; PG8_MMA(1, 0, At, B0); PG8_MMA(1, 1, At, B1); PG8_BAR; PG8_SCHED;
            PG8_LDB(B0, 1, 0); PG8_LDB(B1, 1, 1); PG8_SCHED; PG8_LDA(At, 1, 0); PG8_STAGE(PG8_SA(0, 1), a2 + hstep, voffA);
            PG8_WAIT_V(8); PG8_WAIT_L(0); PG8_BAR; PG8_MMA(0, 0, At, B0); PG8_MMA(0, 1, At, B1); PG8_BAR; PG8_SCHED;
            PG8_LDA(At, 1, 1); PG8_STAGE(PG8_SB(1, 0), b3, voffB); PG8_STAGE(PG8_SB(1, 1), b3 + hstep, voffB); PG8_STAGE(PG8_SA(1, 0), a3, voffA);
            PG8_WAIT_V(8); PG8_WAIT_L(0); PG8_BAR; PG8_MMA(1, 0, At, B0); PG8_MMA(1, 1, At, B1); PG8_BAR; PG8_SCHED;
            } else {
            PG8_LDB(B0, 0, 0); PG8_SCHED; PG8_LDA(At, 0, 0); PG8_STAGE(PG8_SA(1, 1), a1 + hstep, voffA);
            PG8_WAIT_L(8); PG8_BAR; PG8_WAIT_L(0); PG8_MMA(0, 0, At, B0); PG8_BAR; PG8_SCHED;
            PG8_LDB(B1, 0, 1); PG8_STAGE(PG8_SB(0, 0), b2, voffB);
            PG8_BAR; PG8_WAIT_L(0); PG8_MMA(0, 1, At, B1); PG8_BAR;
            PG8_LDA(At, 0, 1); PG8_STAGE(PG8_SA(0, 0), a2, voffA);
            PG8_BAR; PG8_WAIT_L(0); PG8_MMA(1, 0, At, B0); PG8_BAR; PG8_SCHED;
            PG8_STAGE(PG8_SB(0, 1), b2 + hstep, voffB);
            PG8_WAIT_V(6); PG8_BAR; PG8_MMA(1, 1, At, B1); PG8_BAR;
            PG8_LDB(B0, 1, 0); PG8_SCHED; PG8_LDA(At, 1, 0); PG8_STAGE(PG8_SA(0, 1), a2 + hstep, voffA);
            PG8_WAIT_L(8); PG8_BAR; PG8_WAIT_L(0); PG8_MMA(0, 0, At, B0); PG8_BAR; PG8_SCHED;
            PG8_LDB(B1, 1, 1); PG8_STAGE(PG8_SB(1, 0), b3, voffB);
            PG8_BAR; PG8_WAIT_L(0); PG8_MMA(0, 1, At, B1); PG8_BAR;
            PG8_LDA(At, 1, 1); PG8_STAGE(PG8_SA(1, 0), a3, voffA);
            PG8_BAR; PG8_WAIT_L(0); PG8_MMA(1, 0, At, B0); PG8_BAR; PG8_SCHED;
            PG8_STAGE(PG8_SB(1, 1), b3 + hstep, voffB);
            PG8_WAIT_V(6); PG8_BAR; PG8_MMA(1, 1, At, B1); PG8_BAR;
            }
        }
        if constexpr (ALIGN_EPI) { if (wr == 0) PG8_BAR; }
        if constexpr (!Epi::AFTER_DRAIN) { E(acc, cur, wr, wc, fr, fq); S.done(cur); }
        if (!has_next) break;
#pragma unroll
        for (int a = 0; a < 2; ++a)
#pragma unroll
            for (int b = 0; b < 2; ++b)
#pragma unroll
                for (int m = 0; m < 4; ++m)
#pragma unroll
                    for (int n = 0; n < 2; ++n) acc[a][b][m][n] = (f32x4){0.f, 0.f, 0.f, 0.f};
        cur = nxt; cA = nA; cB = nB; ++ui;
        if constexpr (ALIGN_EPI) { if (wr == 1) PG8_BAR; }
    }
    PG8_WAIT_V(0);
    if constexpr (!ALIGN_EPI) { if (wr == 0) PG8_BAR; }
    PG8_BAR;
    if constexpr (Epi::AFTER_DRAIN) { E.fused(acc, cur, wr, wc, fr, fq, lds, wid, lane); S.done(cur); }
#undef PG8_SA
#undef PG8_SB
#undef PG8_STAGE
#undef PG8_LDA
#undef PG8_LDB
#undef PG8_MMA
#undef PG8_WAIT_V
#undef PG8_WAIT_L
#undef PG8_BAR
#undef PG8_SCHED
}
}

#include <hip/hip_bf16.h>
#include <cmath>
namespace attn_body {
using bf16=__hip_bfloat16;
using bf16x8=__attribute__((ext_vector_type(8)))short;
using s16x4=__attribute__((ext_vector_type(4)))short;
using f32x16=__attribute__((ext_vector_type(16)))float;
using u32x4=__attribute__((ext_vector_type(4)))unsigned;
constexpr int SEQ=16384,D=64,DM=512;
constexpr int NW=8,QBLK=32,QB=QBLK*NW,KVBLK=64,NQB=SEQ/QB;
constexpr int ATTN_PITCH=DM, ATTN_UNIT_ROWS=QB;
__device__ __forceinline__ int crow(int r,int hi){return (r&3)+8*(r>>2)+4*hi;}
#define SBAR() __builtin_amdgcn_sched_barrier(0)
__device__ __forceinline__ void cmask(f32x16&p0,f32x16&p1,int jb,int qrel,int hi){
  const float NEG=-INFINITY; int kb=64*jb+4*hi;
  #pragma unroll
  for(int r=0;r<16;++r){int kv=kb+(r&3)+8*(r>>2); if(kv>qrel)p0[r]=NEG; if(kv+32>qrel)p1[r]=NEG;}
}

constexpr int NSLOT=3, SLOTB=8192;
constexpr int LDS_K=0, LDS_V=NSLOT*SLOTB, LDS_WS=2*NSLOT*SLOTB, LDS_OST=LDS_WS+NW*64*4, LDS_BYTES=LDS_OST+NW*4096;
constexpr float C2=0.125f*1.4426950408889634f;
__device__ __forceinline__ void glds16(const void*gsrc,unsigned lds_dst){unsigned keep;
  asm volatile("s_mov_b32 %0, m0\n\ts_mov_b32 m0, %2\n\ts_nop 0\n\tglobal_load_lds_dwordx4 %1, off\n\ts_mov_b32 m0, %0":"=&s"(keep):"v"(gsrc),"s"(lds_dst):"memory");}
__device__ __forceinline__ float max3f(float a,float b,float c){float r;asm("v_max3_f32 %0, %1, %2, %3":"=v"(r):"v"(a),"v"(b),"v"(c));return r;}
__device__ __forceinline__ float max2f(float a,float b){float r;asm("v_max_f32_e32 %0, %1, %2":"=v"(r):"v"(a),"v"(b));return r;}
__device__ __forceinline__ float fadd_s(float a,float b){float r;asm("v_add_f32_e32 %0, %1, %2":"=v"(r):"v"(a),"v"(b));return r;}
__device__ __forceinline__ float fsub_s(float a,float b){float r;asm("v_sub_f32_e32 %0, %1, %2":"=v"(r):"v"(a),"v"(b));return r;}
typedef float f32x2_t __attribute__((ext_vector_type(2))); typedef __bf16 bf16x2_t __attribute__((ext_vector_type(2)));
__device__ __forceinline__ unsigned cvtpk_s(float lo,float hi){f32x2_t v={lo,hi};bf16x2_t b=__builtin_convertvector(v,bf16x2_t);return __builtin_bit_cast(unsigned,b);}
#define WAIT_BAR(N) asm volatile("s_waitcnt vmcnt(" #N ") lgkmcnt(0)\n\ts_barrier":::"memory")

__device__ __forceinline__ void qkt(f32x16&p0,f32x16&p1,const char*Kslot,const bf16x8*qr,int r32,int hi){
  const char*kb=Kslot+hi*1024+r32*16;
  #pragma unroll
  for(int d0=0;d0<4;++d0){
    const bf16x8 b0=*reinterpret_cast<const bf16x8*>(kb+d0*2048);
    const bf16x8 b1=*reinterpret_cast<const bf16x8*>(kb+d0*2048+512);
    p0=__builtin_amdgcn_mfma_f32_32x32x16_bf16(b0,qr[d0],p0,0,0,0);p1=__builtin_amdgcn_mfma_f32_32x32x16_bf16(b1,qr[d0],p1,0,0,0);}
}
typedef __attribute__((address_space(3))) const char* lds_cptr;
typedef short v4i16_t __attribute__((ext_vector_type(4)));
__device__ __forceinline__ void kload8(bf16x8*kf,lds_cptr kp){
  kf[0]=*(const __attribute__((address_space(3))) bf16x8*)(kp);      kf[1]=*(const __attribute__((address_space(3))) bf16x8*)(kp+512);
  kf[2]=*(const __attribute__((address_space(3))) bf16x8*)(kp+2048); kf[3]=*(const __attribute__((address_space(3))) bf16x8*)(kp+2560);
  kf[4]=*(const __attribute__((address_space(3))) bf16x8*)(kp+4096); kf[5]=*(const __attribute__((address_space(3))) bf16x8*)(kp+4608);
  kf[6]=*(const __attribute__((address_space(3))) bf16x8*)(kp+6144); kf[7]=*(const __attribute__((address_space(3))) bf16x8*)(kp+6656);
}
__device__ __forceinline__ void kload2(bf16x8*kf,lds_cptr kp,int j){ kf[2*j]=*(const __attribute__((address_space(3))) bf16x8*)(kp+j*2048); kf[2*j+1]=*(const __attribute__((address_space(3))) bf16x8*)(kp+j*2048+512); }
__device__ __forceinline__ s16x4 vtr(lds_cptr p){ return __builtin_bit_cast(s16x4,__builtin_amdgcn_ds_read_tr16_b64_v4i16((__attribute__((address_space(3))) v4i16_t*)p)); }
__device__ __forceinline__ float rowmax(const f32x16&p0,const f32x16&p1){
  float a=max3f(p0[0],p0[1],p1[0]),b=max3f(p0[2],p0[3],p1[1]);a=max3f(a,p1[2],p1[3]);
  #pragma unroll
  for(int r=4;r<16;r+=4){a=max3f(a,p0[r],p0[r+1]);b=max3f(b,p0[r+2],p0[r+3]);a=max3f(a,p1[r],p1[r+1]);b=max3f(b,p1[r+2],p1[r+3]);}
  const float m=max2f(a,b);
  auto rr=__builtin_amdgcn_permlane32_swap(__float_as_uint(m),__float_as_uint(m),false,false);
  return max2f(__uint_as_float(rr[0]),__uint_as_float(rr[1]));
}
__device__ __forceinline__ void pv(f32x16*o,int vb,bf16x8 pa0,bf16x8 pa1,bf16x8 pa2,bf16x8 pa3){
  #pragma unroll
  for(int d0=0;d0<2;++d0){s16x4 lo[4],hi[4];
    #pragma unroll
    for(int ks=0;ks<4;++ks){
      asm volatile("ds_read_b64_tr_b16 %0,%1 offset:%c2":"=&v"(lo[ks]):"v"(vb),"i"(d0*4096+ks*1024):"memory");
      asm volatile("ds_read_b64_tr_b16 %0,%1 offset:%c2":"=&v"(hi[ks]):"v"(vb),"i"(d0*4096+ks*1024+512):"memory");}
    asm volatile("s_waitcnt lgkmcnt(0)":::"memory");SBAR();
    #define PK(k) (bf16x8){lo[k][0],lo[k][1],lo[k][2],lo[k][3],hi[k][0],hi[k][1],hi[k][2],hi[k][3]}
    o[d0]=__builtin_amdgcn_mfma_f32_32x32x16_bf16(pa0,PK(0),o[d0],0,0,0);
    o[d0]=__builtin_amdgcn_mfma_f32_32x32x16_bf16(pa1,PK(1),o[d0],0,0,0);
    o[d0]=__builtin_amdgcn_mfma_f32_32x32x16_bf16(pa2,PK(2),o[d0],0,0,0);
    o[d0]=__builtin_amdgcn_mfma_f32_32x32x16_bf16(pa3,PK(3),o[d0],0,0,0);
    #undef PK
  }
}

#ifndef ATTN_STORE16
#define ATTN_STORE16(p,v) (*(u32x4*)(p)=(v))
#endif
template<int THRL> __device__ __forceinline__ void attn_unit(int qb,int t0,float slope2,const bf16*Q,const bf16*__restrict__ K,const bf16*__restrict__ V,bf16*O,char*shm){
  int tid_=tidx(); asm volatile("":"+v"(tid_));
  const int tid=tid_,lane=tid&63,r32=lane&31,hi=lane>>5; const int wid=__builtin_amdgcn_readfirstlane(tid>>6);
  const int q0=qb*QB;
  const bf16*Qw=Q+(long)(q0+wid*QBLK)*DM;
  const bf16*Kh=K+(long)t0*KVBLK*DM,*Vh=V+(long)t0*KVBLK*DM;
  const unsigned lds0=(unsigned)(uintptr_t)shm;
  float*wsf=(float*)(shm+LDS_WS)+wid*64;
  const bf16*ksrc=Kh+(long)lane*DM+wid*8;
  const bf16*vsrc=Vh+(long)(16*(wid&3)+(lane>>2))*DM+(wid>>2)*32+(lane&3)*8;
  const unsigned kdst=lds0+LDS_K+wid*1024, vdst=lds0+LDS_V+wid*1024;
  #define DMA_K(t,slot) glds16(ksrc+(long)(t)*KVBLK*DM,(unsigned)__builtin_amdgcn_readfirstlane(kdst+(slot)))
  #define DMA_V(t,slot) glds16(vsrc+(long)(t)*KVBLK*DM,(unsigned)__builtin_amdgcn_readfirstlane(vdst+(slot)))
  const int vb0=(int)(lds0+LDS_V)+((lane>>4)&1)*32+(lane&3)*8+(4*hi+((lane&15)>>2))*64;
  const char*Kbase=shm+LDS_K; bf16x8 kf[8];
  const lds_cptr shm3=(lds_cptr)shm; const lds_cptr kp0=shm3+LDS_K+hi*1024+r32*16; const lds_cptr vp0=shm3+LDS_V+((lane>>4)&1)*32+(lane&3)*8+(4*hi+((lane&15)>>2))*64;
  const int NT=(q0+QB)/KVBLK-t0;
  DMA_K(0,0);DMA_V(0,0);DMA_K(1,SLOTB);
  bf16x8 qr[4];
  #pragma unroll
  for(int d0=0;d0<4;++d0)qr[d0]=*reinterpret_cast<const bf16x8*>(&Qw[(long)r32*DM+d0*16+hi*8]);
  float mhat=0.f,l_reg=0.f;f32x16 o[2];o[0]=f32x16{};o[1]=f32x16{};
  #define CINIT(C0_,C1_,t_) do{ float s2_=slope2; asm volatile("":"+v"(s2_));   \
      const float bt_=fmaf(s2_,(float)(64*(t_)+4*hi),-mhat); const float bu_=fmaf(s2_,32.f,bt_); \
      _Pragma("unroll") for(int r=0;r<16;++r){ C0_[r]=fmaf(s2_,(float)((r&3)+8*(r>>2)),bt_); C1_[r]=fmaf(s2_,(float)((r&3)+8*(r>>2)),bu_); } }while(0)
  const int qrel=wid*QBLK+r32;
  #define CMASK(P0,P1,t) do{int jb_=(t)-(NT-4); if(jb_>=0)cmask(P0,P1,jb_,qrel,hi);}while(0)
  bool resc=false;
  #define START(P0,P1) do{ const float rm=rowmax(P0,P1); resc=false; \
    { const float dl=rm; mhat=fadd_s(mhat,dl); \
      _Pragma("unroll") for(int r=0;r<16;++r){P0[r]=fsub_s(P0[r],dl);P1[r]=fsub_s(P1[r],dl);} } \
    _Pragma("unroll") for(int r=0;r<16;++r)P0[r]=__builtin_amdgcn_exp2f(P0[r]); }while(0)
  #define RESC() do{ if(resc){ asm volatile("s_waitcnt lgkmcnt(0)":::"memory"); \
      _Pragma("unroll") for(int d_=0;d_<2;++d_) _Pragma("unroll") for(int r=0;r<16;++r)o[d_][r]*=wsf[crow(r,hi)]; } }while(0)
  f32x16 pA0,pA1,pB0,pB1;
  int sl_prev=0,sl_cur=0,sl_next=SLOTB;
  #define ROT() do{sl_prev=sl_cur;sl_cur=sl_next;sl_next=(sl_next==(NSLOT-1)*SLOTB)?0:sl_next+SLOTB;}while(0)
  DMA_K(2,2*SLOTB);
  WAIT_BAR(3);
  CINIT(pA0,pA1,0); qkt(pA0,pA1,Kbase,qr,r32,hi);asm volatile("s_nop 15\n\ts_nop 7":"+v"(pA0),"+v"(pA1));CMASK(pA0,pA1,0);
  START(pA0,pA1);
  _Pragma("unroll") for(int r=0;r<16;++r)pA1[r]=__builtin_amdgcn_exp2f(pA1[r]);
  WAIT_BAR(0);
  DMA_K(3,0);DMA_V(1,SLOTB);
  ROT();
  kload8(kf,kp0+sl_cur);
  WAIT_BAR(2);
  s16x4 vlo[8],vhi[8]; u32x4 pw0,pw1,pw2,pw3;
  #define PKW(P,B) cvtpk_s(P[B],P[B+1])
  #define PAF(k) __builtin_bit_cast(bf16x8,pw##k)
  #define VFR(i) (bf16x8){vlo[i][0],vlo[i][1],vlo[i][2],vlo[i][3],vhi[i][0],vhi[i][1],vhi[i][2],vhi[i][3]}
  #define PIN(x) asm volatile("":"+v"(x))
  #define MX3(a,b,c) __builtin_fmaxf(__builtin_fmaxf((a),(b)),(c))
  #define GAPA(MF,A0,A1,A2,A3,W0,W1,PW) do{ MF; sacc+=A0; sacc+=A1; sacc+=A2; sacc+=A3; PIN(sacc); W0; W1; PIN(PW); SBAR(); }while(0)
  #define EX(v) __builtin_amdgcn_exp2f(v)
  #define GAPB(MF,X,B) do{ MF; X[B]=EX(X[B]); X[B+1]=EX(X[B+1]); X[B+2]=EX(X[B+2]); X[B+3]=EX(X[B+3]); PIN(X); SBAR(); }while(0)
  #define VRD(i) do{ vlo[i]=vtr(vp_+(((i)>>2)*4096+((i)&3)*1024)); vhi[i]=vtr(vp_+(((i)>>2)*4096+((i)&3)*1024+512)); }while(0)
  #define KRD(G,j) do{ if(G){ kload2(kf,kp0+sl_next,j); SBAR(); } }while(0)
  #define STEP(C0,C1,P0,P1,t,GK,GV,GL) do{ SBAR(); \
    CINIT(C0,C1,t); PIN(C0); PIN(C1); SBAR(); \
    const lds_cptr vp_=vp0+sl_prev; \
    VRD(0); SBAR(); float sacc=(P0[0]+P0[1]); \
    GAPA(C0=__builtin_amdgcn_mfma_f32_32x32x16_bf16(kf[0],qr[0],C0,0,0,0), P0[2],P0[3],P0[4],P0[5],     pw0[0]=PKW(P0,0), pw0[1]=PKW(P0,2), pw0); \
    VRD(4); SBAR(); GAPA(C1=__builtin_amdgcn_mfma_f32_32x32x16_bf16(kf[1],qr[0],C1,0,0,0), P0[6],P0[7],P0[8],P0[9],     pw0[2]=PKW(P0,4), pw0[3]=PKW(P0,6), pw0); \
    VRD(1); SBAR(); GAPA(C0=__builtin_amdgcn_mfma_f32_32x32x16_bf16(kf[2],qr[1],C0,0,0,0),   P0[10],P0[11],P0[12],P0[13], pw1[0]=PKW(P0,8), pw1[1]=PKW(P0,10), pw1); \
    VRD(5); SBAR(); GAPA(C1=__builtin_amdgcn_mfma_f32_32x32x16_bf16(kf[3],qr[1],C1,0,0,0),   P0[14],P0[15],P1[0],P1[1],   pw1[2]=PKW(P0,12),pw1[3]=PKW(P0,14), pw1); \
    VRD(2); SBAR(); GAPA(C0=__builtin_amdgcn_mfma_f32_32x32x16_bf16(kf[4],qr[2],C0,0,0,0),   P1[2],P1[3],P1[4],P1[5],     pw2[0]=PKW(P1,0), pw2[1]=PKW(P1,2), pw2); \
    VRD(6); SBAR(); GAPA(C1=__builtin_amdgcn_mfma_f32_32x32x16_bf16(kf[5],qr[2],C1,0,0,0),   P1[6],P1[7],P1[8],P1[9],     pw2[2]=PKW(P1,4), pw2[3]=PKW(P1,6), pw2); \
    VRD(3); SBAR(); GAPA(C0=__builtin_amdgcn_mfma_f32_32x32x16_bf16(kf[6],qr[3],C0,0,0,0),   P1[10],P1[11],P1[12],P1[13], pw3[0]=PKW(P1,8), pw3[1]=PKW(P1,10), pw3); \
    VRD(7); SBAR(); GAPA(C1=__builtin_amdgcn_mfma_f32_32x32x16_bf16(kf[7],qr[3],C1,0,0,0),   P1[14],P1[15],0.f,0.f,       pw3[2]=PKW(P1,12),pw3[3]=PKW(P1,14), pw3); \
    l_reg+=sacc; \
    if(GK){DMA_K((t)+3,sl_cur);} if(GV){DMA_V((t)+1,sl_next);} \
    CMASK(C0,C1,t); \
    { float a=MX3(C0[0],C0[1],C1[0]),b=MX3(C0[2],C0[3],C1[1]); a=MX3(a,C1[2],C1[3]); \
      _Pragma("unroll") for(int r=4;r<16;r+=4){a=MX3(a,C0[r],C0[r+1]);b=MX3(b,C0[r+2],C0[r+3]);a=MX3(a,C1[r],C1[r+1]);b=MX3(b,C1[r+2],C1[r+3]);} \
      float rm=__builtin_fmaxf(a,b); { auto rr=__builtin_amdgcn_permlane32_swap(__float_as_uint(rm),__float_as_uint(rm),false,false); rm=__builtin_fmaxf(__uint_as_float(rr[0]),__uint_as_float(rr[1])); } \
      resc=false; \
      if(__builtin_expect(__any(rm>(float)THRL),0)){ const float dl=__builtin_fmaxf(rm,0.f); mhat+=dl; \
        _Pragma("unroll") for(int r=0;r<16;++r){C0[r]-=dl;C1[r]-=dl;} \
        const float f=__builtin_amdgcn_exp2f(-dl); l_reg*=f; if(hi==0)wsf[r32]=f; resc=true; } } \
    SBAR(); \
    GAPB(o[0]=__builtin_amdgcn_mfma_f32_32x32x16_bf16(PAF(0),VFR(0),o[0],0,0,0), C0,0); \
    GAPB(o[1]=__builtin_amdgcn_mfma_f32_32x32x16_bf16(PAF(0),VFR(4),o[1],0,0,0), C0,4); \
    KRD(GL,0); GAPB(o[0]=__builtin_amdgcn_mfma_f32_32x32x16_bf16(PAF(1),VFR(1),o[0],0,0,0), C0,8); \
    KRD(GL,1); GAPB(o[1]=__builtin_amdgcn_mfma_f32_32x32x16_bf16(PAF(1),VFR(5),o[1],0,0,0), C0,12); \
    KRD(GL,2); GAPB(o[0]=__builtin_amdgcn_mfma_f32_32x32x16_bf16(PAF(2),VFR(2),o[0],0,0,0), C1,0); \
    KRD(GL,3); GAPB(o[1]=__builtin_amdgcn_mfma_f32_32x32x16_bf16(PAF(2),VFR(6),o[1],0,0,0), C1,4); \
    GAPB(o[0]=__builtin_amdgcn_mfma_f32_32x32x16_bf16(PAF(3),VFR(3),o[0],0,0,0), C1,8); \
    GAPB(o[1]=__builtin_amdgcn_mfma_f32_32x32x16_bf16(PAF(3),VFR(7),o[1],0,0,0), C1,12); \
    }while(0)
  int t=1;
  #undef CMASK
  #define CMASK(P0,P1,t) do{}while(0)
  for(;t+5<NT;t+=2){
    STEP(pB0,pB1,pA0,pA1,t,true,true,true);     WAIT_BAR(2); RESC(); ROT();
    STEP(pA0,pA1,pB0,pB1,t+1,true,true,true);   WAIT_BAR(2); RESC(); ROT();
  }
  #undef CMASK
  #define CMASK(P0,P1,t) do{int jb_=(t)-(NT-4); if(jb_>=0)cmask(P0,P1,jb_,qrel,hi);}while(0)
  #define ENDW(tt) do{ if((tt)+3<NT){WAIT_BAR(2);} else if((tt)+2<NT){WAIT_BAR(1);} else {WAIT_BAR(0);} }while(0)
  for(;t+1<NT;t+=2){
    STEP(pB0,pB1,pA0,pA1,t,(t+3<NT),(t+1<NT),(t+1<NT));       ENDW(t);   RESC(); ROT();
    STEP(pA0,pA1,pB0,pB1,t+1,(t+4<NT),(t+2<NT),(t+2<NT));     ENDW(t+1); RESC(); ROT();
  }
  STEP(pB0,pB1,pA0,pA1,NT-1,false,false,false); RESC();
  { float sacc=pB0[0]+pB0[1]; _Pragma("unroll") for(int r=2;r<16;++r)sacc+=pB0[r]; _Pragma("unroll") for(int r=0;r<16;++r)sacc+=pB1[r]; l_reg+=sacc;
    pw0=(u32x4){PKW(pB0,0),PKW(pB0,2),PKW(pB0,4),PKW(pB0,6)};pw1=(u32x4){PKW(pB0,8),PKW(pB0,10),PKW(pB0,12),PKW(pB0,14)};pw2=(u32x4){PKW(pB1,0),PKW(pB1,2),PKW(pB1,4),PKW(pB1,6)};pw3=(u32x4){PKW(pB1,8),PKW(pB1,10),PKW(pB1,12),PKW(pB1,14)};
    SBAR(); pv(o,vb0+sl_cur,PAF(0),PAF(1),PAF(2),PAF(3)); }
  #undef PKW
  #undef PAF
  #undef VFR
  #undef PIN
  #undef MX3
  #undef GAPA
  #undef GAPB
  #undef EX
  #undef VRD
  #undef KRD
  #undef STEP
  #undef ENDW
  {auto rr=__builtin_amdgcn_permlane32_swap(__float_as_uint(l_reg),__float_as_uint(l_reg),false,false);l_reg=__uint_as_float(rr[0])+__uint_as_float(rr[1]);}
  if(hi==0)wsf[32+r32]=l_reg;asm volatile("s_waitcnt lgkmcnt(0)":::"memory");
  float rli[16];
  #pragma unroll
  for(int r=0;r<16;++r)rli[r]=__builtin_amdgcn_rcpf(wsf[32+crow(r,hi)]);
  bf16*Ow=O+(long)(q0+wid*QBLK)*DM;
  { bf16*stg=(bf16*)(shm+LDS_OST)+wid*2048;
    #pragma unroll
    for(int r=0;r<16;++r){const int orow=crow(r,hi);
      #pragma unroll
      for(int d0=0;d0<2;++d0)stg[orow*64+d0*32+r32]=__float2bfloat16(o[d0][r]*rli[r]);}
    asm volatile("s_waitcnt lgkmcnt(0)":::"memory");
    #pragma unroll
    for(int i=0;i<4;++i){const int row=i*8+(lane>>3),ch=lane&7; const u32x4 v=*(const u32x4*)(stg+row*64+ch*8); ATTN_STORE16(Ow+(long)row*DM+ch*8,v);} }
  asm volatile("s_waitcnt lgkmcnt(0)\n\ts_barrier":::"memory");
  #undef DMA_K
  #undef DMA_V
  #undef CMASK
  #undef CINIT
  #undef START
  #undef RESC
  #undef ROT
}
constexpr int ATTN_LDS_BYTES=LDS_BYTES;
template<int THRL=8> __device__ __forceinline__ void attn_dispatch(int u,char*lds,const bf16*QA,const bf16*KA,const bf16*VA,bf16*O1,bf16*O2,const unsigned*norms){
    const int h=3-(u>>8), r=u&255, qb=63-(r>>2), c=(r>>1)&1, vhalf=r&1, hv=h*2+c;
    const float slope2=__uint_as_float(__builtin_amdgcn_readfirstlane((0x3fb8aa3bu)-((unsigned)(2*(h+1))<<23)));
    const float Bnd=sqrtf(__uint_as_float(norms[16+hv*64+qb]))*sqrtf(__uint_as_float(norms[hv]))*1.0001f+0.01f;
    const float Dmin=-sortu2f(norms[528+hv*64+qb]);
    const float W=(Bnd-fminf(Dmin,Bnd)+34.f)/slope2+1.f;
    const int q0=qb*QB; int t0=0; if((float)q0>W){ t0=((int)(((float)q0-W)*(1.f/64.f)))&~1; }
    t0=__builtin_amdgcn_readfirstlane(t0);
    const bf16*Q=QA+hv*64; const bf16*K=KA+hv*64; const bf16*V=VA+h*128+vhalf*64; bf16*O=(c?O2:O1)+h*128+vhalf*64;
    attn_unit<THRL>(qb,t0,slope2,Q,K,V,O,lds);
}
#undef SBAR
#undef WAIT_BAR
}

__device__ __forceinline__ void ph_rmsnorm_bf16(const float* X, const float* g, bf16* O) {
    const int lane = tidx() & 63, wave = tidx() >> 6;
    const int gw = blockIdx.x * NWAVES + wave, NGW = gridDim.x * NWAVES;
    for (int m = gw; m < M; m += NGW) {
        const f32x4* xr = (const f32x4*)(X + (size_t)m * D) + lane;
        f32x4 v[4]; float s = 0.f;
#pragma unroll
        for (int j = 0; j < 4; ++j) { v[j] = xr[64 * j]; s += (v[j].x * v[j].x + v[j].y * v[j].y) + (v[j].z * v[j].z + v[j].w * v[j].w); }
        const float r = rsqrtf(wave_sum(s) * (1.f / D) + EPS);
        v2u* o8 = (v2u*)(O + (size_t)m * D) + lane;
#pragma unroll
        for (int j = 0; j < 4; ++j) { const f32x4 gg = ((const f32x4*)g)[lane + 64 * j]; v2u w; w.x = pk2(v[j].x * r * gg.x, v[j].y * r * gg.y); w.y = pk2(v[j].z * r * gg.z, v[j].w * r * gg.w); o8[64 * j] = w; }
    }
}
__device__ __forceinline__ void ph_rmsnorm_f32_inplace(float* X, const float* g) {
    const int lane = tidx() & 63, wave = tidx() >> 6;
    const int gw = blockIdx.x * NWAVES + wave, NGW = gridDim.x * NWAVES;
    for (int m = gw; m < M; m += NGW) {
        f32x4* xr = (f32x4*)(X + (size_t)m * D) + lane;
        f32x4 v[4]; float s = 0.f;
#pragma unroll
        for (int j = 0; j < 4; ++j) { v[j] = xr[64 * j]; s += (v[j].x * v[j].x + v[j].y * v[j].y) + (v[j].z * v[j].z + v[j].w * v[j].w); }
        const float r = rsqrtf(wave_sum(s) * (1.f / D) + EPS);
#pragma unroll
        for (int j = 0; j < 4; ++j) { const f32x4 gg = ((const f32x4*)g)[lane + 64 * j]; xr[64 * j] = v[j] * r * gg; }
    }
}

__device__ __forceinline__ void transpose_item(const float* W, int K, int N, int Npad, bf16* WT, LAS float* scr, int item, int lane, const float* kgain = nullptr) {
    const int nblk = Npad / 32, kb = item / nblk, nb = item % nblk, k0 = 64 * kb, n0 = 32 * nb;
    const int nn = n0 + (lane & 31);
#pragma unroll 8
    for (int i = 0; i < 32; ++i) { const int kk = 2 * i + (lane >> 5); const float gk = kgain ? kgain[k0 + kk] : 1.f; scr[kk * 33 + (lane & 31)] = (nn < N) ? W[(size_t)(k0 + kk) * N + nn] * gk : 0.f; }
    asm volatile("s_waitcnt lgkmcnt(0)" ::: "memory");
    const int c = lane & 7;
#pragma unroll
    for (int j = 0; j < 4; ++j) { const int n = (lane >> 3) + 8 * j; const LAS float* sp = scr + (8 * c) * 33 + n;
        v4u o; o.x = pk2(sp[0 * 33], sp[1 * 33]); o.y = pk2(sp[2 * 33], sp[3 * 33]); o.z = pk2(sp[4 * 33], sp[5 * 33]); o.w = pk2(sp[6 * 33], sp[7 * 33]);
        *(v4u*)(WT + (size_t)(n0 + n) * K + k0 + 8 * c) = o; }
    asm volatile("s_waitcnt lgkmcnt(0)" ::: "memory");
}
__device__ __forceinline__ void ph_weights_in(const float* w_in, bf16* WIN, LAS unsigned char* lds) {
    const int lane = tidx() & 63, wave = __builtin_amdgcn_readfirstlane(tidx() >> 6);
    LAS float* scr = (LAS float*)(lds + wave * 16384);
    const int gw = blockIdx.x * NWAVES + wave, NGW = gridDim.x * NWAVES;
    constexpr int I_IN = (D / 64) * (NINP / 32);
    for (int it = gw; it < I_IN; it += NGW) transpose_item(w_in, D, NIN, NINP, WIN, scr, it, lane);
}
constexpr int WCH_OUT = (D / 64) * (D / 32), WCH_Q = (D / 64) * (NQ / 32), WCH_P = (PLE / 64) * (D / 32), WCH_ITEMS = 2 * WCH_OUT + WCH_Q + WCH_P, WCH_CHUNKS = (WCH_ITEMS + 7) / 8;
__device__ __forceinline__ void weights_chunk(int chunk, const float* w_out, const float* w_query, const float* g_query, const float* w_gate, const float* w_proj, bf16* WOUT, bf16* WQ, bf16* WG, bf16* WP, LAS unsigned char* lds) {
    const int lane = tidx() & 63, wave = __builtin_amdgcn_readfirstlane(tidx() >> 6);
    LAS float* scr = (LAS float*)(lds + wave * 16384);
    int r = chunk * 8 + wave;
    if (r >= WCH_ITEMS) return;
    if (r < WCH_OUT) { transpose_item(w_out, D, D, D, WOUT, scr, r, lane); return; } r -= WCH_OUT;
    if (r < WCH_Q) { transpose_item(w_query, D, NQ, NQ, WQ, scr, r, lane, g_query); return; } r -= WCH_Q;
    if (r < WCH_OUT) { transpose_item(w_gate, D, D, D, WG, scr, r, lane); return; } r -= WCH_OUT;
    transpose_item(w_proj, PLE, D, D, WP, scr, r, lane);
}

template <class Epi>
__device__ __forceinline__ void naive_gemm(const bf16* A, int lda, const float* W, int K, int N, float* lds, Epi epi) {
    float* As = lds;
    float* Ws = lds + 32 * 65;
    const int tid = tidx(), tx = tid & 15, ty = tid >> 4;
    const int ntn = (N + 63) / 64, nt = (M / 64) * ntn;
    for (int t = blockIdx.x; t < nt; t += gridDim.x) {
        const int tm = t / ntn, tn = t % ntn, r0 = tm * 64, c0 = tn * 64;
        float acc[2][4];
#pragma unroll
        for (int i = 0; i < 2; ++i)
#pragma unroll
            for (int j = 0; j < 4; ++j) acc[i][j] = 0.f;
        for (int k0 = 0; k0 < K; k0 += 32) {
            { const int r = tid >> 3, kq = (tid & 7) * 4; const v2u v = *(const v2u*)(A + (size_t)(r0 + r) * lda + k0 + kq);
              As[(kq + 0) * 65 + r] = bf2f(v.x & 0xffffu); As[(kq + 1) * 65 + r] = bf2f(v.x >> 16); As[(kq + 2) * 65 + r] = bf2f(v.y & 0xffffu); As[(kq + 3) * 65 + r] = bf2f(v.y >> 16); }
            { const int kk = tid >> 4, nq = (tid & 15) * 4; const float* wp = W + (size_t)(k0 + kk) * N + c0 + nq;
#pragma unroll
              for (int j = 0; j < 4; ++j) Ws[kk * 64 + nq + j] = (c0 + nq + j < N) ? wp[j] : 0.f; }
            __syncthreads();
#pragma unroll 8
            for (int kk = 0; kk < 32; ++kk) {
                const float a0 = As[kk * 65 + ty], a1 = As[kk * 65 + ty + 32];
                const f32x4 b = *(const f32x4*)(Ws + kk * 64 + tx * 4);
                acc[0][0] += a0 * b.x; acc[0][1] += a0 * b.y; acc[0][2] += a0 * b.z; acc[0][3] += a0 * b.w;
                acc[1][0] += a1 * b.x; acc[1][1] += a1 * b.y; acc[1][2] += a1 * b.z; acc[1][3] += a1 * b.w;
            }
            __syncthreads();
        }
#pragma unroll
        for (int i = 0; i < 2; ++i)
#pragma unroll
            for (int j = 0; j < 4; ++j) { const int row = r0 + ty + 32 * i, col = c0 + tx * 4 + j; if (col < N) epi(row, col, acc[i][j]); }
    }
}

__device__ __forceinline__ void ph_attn_naive(const bf16* QA, const bf16* KA, const bf16* VA, bf16* O1, bf16* O2, float* lds) {
    float* Ks = lds; float* Vs = lds + 32 * 64; float* Ss = Vs + 32 * 128;
    const int tid = tidx(), qi = tid >> 3, cg = tid & 7;
    for (int item = blockIdx.x; item < 8 * 256; item += gridDim.x) {
        const int hv = item & 7, qb = 255 - (item >> 3);
        const int h = hv >> 1, c = hv & 1, q0 = qb * 64, qpos = q0 + qi;
        const float slope2 = exp2f(-2.f * (float)(h + 1)) * LOG2E;
        float q[64];
        { const v4u* qp = (const v4u*)(QA + (size_t)qpos * 512 + hv * 64);
#pragma unroll
          for (int i = 0; i < 8; ++i) { const v4u v = qp[i];
              q[8 * i + 0] = bf2f(v.x & 0xffffu); q[8 * i + 1] = bf2f(v.x >> 16); q[8 * i + 2] = bf2f(v.y & 0xffffu); q[8 * i + 3] = bf2f(v.y >> 16);
              q[8 * i + 4] = bf2f(v.z & 0xffffu); q[8 * i + 5] = bf2f(v.z >> 16); q[8 * i + 6] = bf2f(v.w & 0xffffu); q[8 * i + 7] = bf2f(v.w >> 16); } }
        float m = -INFINITY, l = 0.f, acc[16];
#pragma unroll
        for (int i = 0; i < 16; ++i) acc[i] = 0.f;
        const int ntile = (q0 + 64) / 32;
        for (int kt = 0; kt < ntile; ++kt) {
            const int k0 = kt * 32;
            __syncthreads();
            { const int kk = tid >> 4, d4 = (tid & 15) * 4; const v2u v = *(const v2u*)(KA + (size_t)(k0 + kk) * 512 + hv * 64 + d4);
              float* kd = Ks + kk * 64 + d4; kd[0] = bf2f(v.x & 0xffffu); kd[1] = bf2f(v.x >> 16); kd[2] = bf2f(v.y & 0xffffu); kd[3] = bf2f(v.y >> 16); }
            { const int kk = tid >> 4, e8 = (tid & 15) * 8; const v4u v = *(const v4u*)(VA + (size_t)(k0 + kk) * 512 + h * 128 + e8);
              float* vd = Vs + kk * 128 + e8; vd[0] = bf2f(v.x & 0xffffu); vd[1] = bf2f(v.x >> 16); vd[2] = bf2f(v.y & 0xffffu); vd[3] = bf2f(v.y >> 16);
              vd[4] = bf2f(v.z & 0xffffu); vd[5] = bf2f(v.z >> 16); vd[6] = bf2f(v.w & 0xffffu); vd[7] = bf2f(v.w >> 16); }
            __syncthreads();
#pragma unroll
            for (int j = 0; j < 4; ++j) {
                const int kk = cg + 8 * j; const float* kr = Ks + kk * 64; float s = 0.f;
#pragma unroll
                for (int d = 0; d < 64; ++d) s += q[d] * kr[d];
                const int kpos = k0 + kk;
                s = (kpos <= qpos) ? s - slope2 * (float)(qpos - kpos) : -INFINITY;
                Ss[qi * 33 + kk] = s;
            }
            __syncthreads();
            float tmax = -INFINITY;
#pragma unroll 8
            for (int kk = 0; kk < 32; ++kk) tmax = fmaxf(tmax, Ss[qi * 33 + kk]);
            const float mn = fmaxf(m, tmax), alpha = exp2f(m - mn);
            l *= alpha;
#pragma unroll
            for (int i = 0; i < 16; ++i) acc[i] *= alpha;
            for (int kk = 0; kk < 32; ++kk) {
                const float p = exp2f(Ss[qi * 33 + kk] - mn); l += p;
                const float* vr = Vs + kk * 128 + 16 * cg;
#pragma unroll
                for (int i = 0; i < 16; ++i) acc[i] += p * vr[i];
            }
            m = mn;
        }
        const float il = 1.f / l;
        bf16* O = c ? O2 : O1;
        v4u w0, w1;
        w0.x = pk2(acc[0] * il, acc[1] * il); w0.y = pk2(acc[2] * il, acc[3] * il); w0.z = pk2(acc[4] * il, acc[5] * il); w0.w = pk2(acc[6] * il, acc[7] * il);
        w1.x = pk2(acc[8] * il, acc[9] * il); w1.y = pk2(acc[10] * il, acc[11] * il); w1.z = pk2(acc[12] * il, acc[13] * il); w1.w = pk2(acc[14] * il, acc[15] * il);
        v4u* op = (v4u*)(O + (size_t)qpos * 512 + h * 128 + 16 * cg); op[0] = w0; op[1] = w1;
    }
}

__device__ __forceinline__ void ph_conv_naive(const bf16* MQ, const bf16* MK, const float* cw, const float* cb, bf16* CQ, bf16* CK) {
    const size_t n = (size_t)M * 512, stride = (size_t)gridDim.x * NTHREADS;
    for (size_t i = (size_t)blockIdx.x * NTHREADS + tidx(); i < n; i += stride) {
        const int t = (int)(i >> 9), c = (int)(i & 511);
        float aq = cb[c], ak = cb[512 + c];
#pragma unroll
        for (int j = 0; j < 4; ++j) { const int tt = t - 3 + j; if (tt >= 0) { aq += cw[j * 1024 + c] * bf2f(MQ[(size_t)tt * 512 + c]); ak += cw[j * 1024 + 512 + c] * bf2f(MK[(size_t)tt * 512 + c]); } }
        aq = aq * sigmoidf_(aq) * 0.08838834764831845f; ak = ak * sigmoidf_(ak);
        CQ[i] = (bf16)f2bf(aq); CK[i] = (bf16)f2bf(ak);
    }
}
__device__ __forceinline__ void ph_mlstm_naive(const bf16* CQ, const bf16* CK, const bf16* MV, const float* GATES, const float* b_i, const float* b_f, float* HS, float* lds) {
    if (blockIdx.x >= 4) return;
    const int h = blockIdx.x, tid = tidx(), e = tid & 127, dg = tid >> 7;
    float* qs = lds; float* ks = qs + 64 * 128; float* vs = ks + 64 * 128; float* fs = vs + 64 * 128; float* is_ = fs + 64; float* red = is_ + 64; float* redd = red + 512;
    float C[32], n[32];
#pragma unroll
    for (int i = 0; i < 32; ++i) { C[i] = 0.f; n[i] = 0.f; }
    for (int c0 = 0; c0 < M; c0 += 64) {
        __syncthreads();
        for (int i = tid; i < 64 * 128; i += NTHREADS) { const int tt = i >> 7, d = i & 127; const size_t g = (size_t)(c0 + tt) * 512 + h * 128 + d; qs[i] = bf2f(CQ[g]); ks[i] = bf2f(CK[g]); vs[i] = bf2f(MV[g]); }
        if (tid < 64) { const float fp = GATES[(size_t)(c0 + tid) * 8 + 4 + h] + b_f[h], ip = GATES[(size_t)(c0 + tid) * 8 + h] + b_i[h]; fs[tid] = 1.f / (1.f + expf(-fp)); is_[tid] = expf(ip); }
        __syncthreads();
        for (int tt = 0; tt < 64; ++tt) {
            const float f = fs[tt], ii = is_[tt], ve = vs[tt * 128 + e]; float pn = 0.f, pd = 0.f;
#pragma unroll
            for (int i = 0; i < 32; ++i) { const float kd = ks[tt * 128 + dg * 32 + i], qd = qs[tt * 128 + dg * 32 + i], ik = ii * kd;
                C[i] = f * C[i] + ik * ve; n[i] = f * n[i] + ik; pn += qd * C[i]; pd += qd * n[i]; }
            red[dg * 128 + e] = pn; if (e == 0) redd[dg] = pd;
            __syncthreads();
            if (dg == 0) { const float num = (red[e] + red[128 + e]) + (red[256 + e] + red[384 + e]), den = (redd[0] + redd[1]) + (redd[2] + redd[3]);
                HS[(size_t)(c0 + tt) * 512 + h * 128 + e] = num / fmaxf(fabsf(den), 1.f); }
            __syncthreads();
        }
    }
}
template <bool DO_ML>
__device__ __forceinline__ void ph_combine(const bf16* O1, const bf16* O2, const bf16* MO, const float* HS, const float* lq1, const float* lk1, const float* lq2, const float* lk2,
                                           const float* subln_g, const float* ml_g, bf16* ACAT) {
    const int lane = tidx() & 63, wave = tidx() >> 6;
    const int gw = blockIdx.x * NWAVES + wave, NGW = gridDim.x * NWAVES;
    const float lam = expf(wave_sum(lq1[lane] * lk1[lane])) - expf(wave_sum(lq2[lane] * lk2[lane])) + LAMBDA_INIT;
    for (int m = gw; m < M; m += NGW) {
        const int c0 = lane * 8;
        float a[8], b[8];
        { const v4u u1 = *(const v4u*)(O1 + (size_t)m * 512 + c0), u2 = *(const v4u*)(O2 + (size_t)m * 512 + c0);
          const unsigned w1[4] = {u1.x, u1.y, u1.z, u1.w}, w2[4] = {u2.x, u2.y, u2.z, u2.w};
#pragma unroll
          for (int i = 0; i < 4; ++i) { a[2 * i] = bf2f(w1[i] & 0xffffu) - lam * bf2f(w2[i] & 0xffffu); a[2 * i + 1] = bf2f(w1[i] >> 16) - lam * bf2f(w2[i] >> 16); } }
        if (DO_ML) { const v4u uo = *(const v4u*)(MO + (size_t)m * 512 + c0); const unsigned wo[4] = {uo.x, uo.y, uo.z, uo.w};
          const f32x4 h0 = *(const f32x4*)(HS + (size_t)m * 512 + c0), h1 = *(const f32x4*)(HS + (size_t)m * 512 + c0 + 4);
          const float hh[8] = {h0.x, h0.y, h0.z, h0.w, h1.x, h1.y, h1.z, h1.w};
#pragma unroll
          for (int i = 0; i < 4; ++i) { b[2 * i] = sigmoidf_(bf2f(wo[i] & 0xffffu)) * hh[2 * i]; b[2 * i + 1] = sigmoidf_(bf2f(wo[i] >> 16)) * hh[2 * i + 1]; } }
        else {
#pragma unroll
          for (int i = 0; i < 8; ++i) b[i] = 0.f; }
        float sa = 0.f, sb = 0.f;
#pragma unroll
        for (int i = 0; i < 8; ++i) { sa += a[i] * a[i]; sb += b[i] * b[i]; }
#pragma unroll
        for (int o = 1; o < 16; o <<= 1) { sa += __shfl_xor(sa, o); sb += __shfl_xor(sb, o); }
        const float ra = rsqrtf(sa * (1.f / 128.f) + EPS) * (1.f - LAMBDA_INIT), rb = rsqrtf(sb * (1.f / 128.f) + EPS);
        const int cc = c0 & 127, hh_ = lane >> 4;
        v4u wa, wb;
        { const float* g = subln_g + cc; wa.x = pk2(a[0] * ra * g[0], a[1] * ra * g[1]); wa.y = pk2(a[2] * ra * g[2], a[3] * ra * g[3]); wa.z = pk2(a[4] * ra * g[4], a[5] * ra * g[5]); wa.w = pk2(a[6] * ra * g[6], a[7] * ra * g[7]); }
        { const float* g = ml_g + hh_ * 128 + cc; wb.x = pk2(b[0] * rb * g[0], b[1] * rb * g[1]); wb.y = pk2(b[2] * rb * g[2], b[3] * rb * g[3]); wb.z = pk2(b[4] * rb * g[4], b[5] * rb * g[5]); wb.w = pk2(b[6] * rb * g[6], b[7] * rb * g[7]); }
        *(v4u*)(ACAT + (size_t)m * 1024 + c0) = wa; if (DO_ML) *(v4u*)(ACAT + (size_t)m * 1024 + 512 + c0) = wb;
    }
}


namespace ml {
typedef short bf16x8 __attribute__((ext_vector_type(8)));
typedef float f32x16 __attribute__((ext_vector_type(16)));
typedef LAS unsigned char* lptr;
constexpr int LD128 = 272, LD64 = 144;
constexpr int QP_OFF = 0, K_OFF = 17408, Y_OFF = 0, KWT_OFF = 34816, VT_OFF = 53248, SM_OFF = 71680, CT_OFF = 80896, SMALL_OFF = 115712;
constexpr int LDY = 132;
constexpr int ST_STRIDE = 16384 + 256;
__device__ __forceinline__ int crow(int r, int hi) { return (r & 3) + 8 * (r >> 2) + 4 * hi; }
template <int KS>
__device__ __forceinline__ void mm_tile(f32x16& acc, lptr A, int lda, lptr Bt, int ldb, int r32, int hi) {
    lptr ap = A + r32 * lda + hi * 16; lptr bp = Bt + r32 * ldb + hi * 16;
#pragma unroll
    for (int ks = 0; ks < KS; ++ks) {
        const bf16x8 a = *(const LAS bf16x8*)(ap + ks * 32);
        const bf16x8 b = *(const LAS bf16x8*)(bp + ks * 32);
        acc = __builtin_amdgcn_mfma_f32_32x32x16_bf16(a, b, acc, 0, 0, 0);
    }
}
__device__ __forceinline__ float gates_chunk(const float* GATES, float bi, float bf_, int t0, int h, int lane, LAS float* eb, LAS float* wcol, LAS float* wupd, LAS float* misc) {
    const float fp = GATES[(size_t)(t0 + lane) * 8 + 4 + h] + bf_, ip = GATES[(size_t)(t0 + lane) * 8 + h] + bi;
    const float lf = fminf(fp, 0.f) - log1pf(__expf(-fabsf(fp)));
    float b = lf;
#pragma unroll
    for (int o = 1; o < 64; o <<= 1) { const float u = __shfl_up(b, o); if (lane >= o) b += u; }
    const float bL = __shfl(b, 63);
    eb[lane] = __expf(b); wcol[lane] = __expf(ip - b); wupd[lane] = __expf(bL - b + ip); if (lane == 0) misc[0] = __expf(bL);
    return bL;
}
struct RawT { v4u k0, k1, v0, v1; };
__device__ __forceinline__ void load_transposed(RawT& r, const bf16* CK, const bf16* MV, int t0, int h, int tid) {
    const int sp = tid & 31, c = tid >> 5;
    const size_t g0 = (size_t)(t0 + 2 * sp) * 512 + h * 128 + c * 8;
    r.k0 = *(const v4u*)(CK + g0); r.k1 = *(const v4u*)(CK + g0 + 512); r.v0 = *(const v4u*)(MV + g0); r.v1 = *(const v4u*)(MV + g0 + 512);
}
__device__ __forceinline__ void store_transposed(const RawT& r, lptr lds, const LAS float* wupd, int tid) {
    const int sp = tid & 31, c = tid >> 5;
    const float w0 = wupd[2 * sp], w1 = wupd[2 * sp + 1];
    const unsigned ka[4] = {r.k0.x, r.k0.y, r.k0.z, r.k0.w}, kb[4] = {r.k1.x, r.k1.y, r.k1.z, r.k1.w}, va[4] = {r.v0.x, r.v0.y, r.v0.z, r.v0.w}, vb[4] = {r.v1.x, r.v1.y, r.v1.z, r.v1.w};
    lptr kw = lds + KWT_OFF + (8 * c) * LD64 + 4 * sp; lptr vt = lds + VT_OFF + (8 * c) * LD64 + 4 * sp;
#pragma unroll
    for (int i = 0; i < 4; ++i) {
        *(LAS unsigned*)(kw + (2 * i) * LD64) = pk2(w0 * bf2f(ka[i] & 0xffffu), w1 * bf2f(kb[i] & 0xffffu));
        *(LAS unsigned*)(kw + (2 * i + 1) * LD64) = pk2(w0 * bf2f(ka[i] >> 16), w1 * bf2f(kb[i] >> 16));
        *(LAS unsigned*)(vt + (2 * i) * LD64) = (va[i] & 0xffffu) | (vb[i] << 16);
        *(LAS unsigned*)(vt + (2 * i + 1) * LD64) = (va[i] >> 16) | (vb[i] & 0xffff0000u);
    }
}
__device__ __forceinline__ void state_update(f32x16 (&accS)[2], lptr lds, float aL, int wave, int r32, int hi) {
    const int er = wave & 3, dc0 = 2 * (wave >> 2);
#pragma unroll
    for (int i = 0; i < 2; ++i) {
#pragma unroll
        for (int r = 0; r < 16; ++r) accS[i][r] *= aL;
        mm_tile<4>(accS[i], lds + VT_OFF + (32 * er) * LD64, LD64, lds + KWT_OFF + (32 * (dc0 + i)) * LD64, LD64, r32, hi);
    }
}
__device__ __forceinline__ float kwt_rowsum(lptr lds, int d) {
    float s = 0.f; lptr p = lds + KWT_OFF + d * LD64;
#pragma unroll
    for (int i = 0; i < 8; ++i) { const v4u q = *(const LAS v4u*)(p + 16 * i);
        s += (bf2f(q.x & 0xffffu) + bf2f(q.x >> 16)) + (bf2f(q.y & 0xffffu) + bf2f(q.y >> 16)) + (bf2f(q.z & 0xffffu) + bf2f(q.z >> 16)) + (bf2f(q.w & 0xffffu) + bf2f(q.w >> 16)); }
    return s;
}

__device__ __forceinline__ void conv_items(const bf16* MQ, const bf16* MK, const float* cw, const float* cb, bf16* CQ, bf16* CK) {
    const int tid = tidx(), ch = tid & 15, rg = tid >> 4;
    for (int item = blockIdx.x; item < 256; item += gridDim.x) {
        const int h = item >> 6, j = item & 63, col = h * 128 + ch * 8;
        float wq[4][8], wk[4][8], bq[8], bk[8];
#pragma unroll
        for (int jj = 0; jj < 4; ++jj)
#pragma unroll
            for (int e = 0; e < 8; e += 4) { const f32x4 a = *(const f32x4*)(cw + jj * 1024 + col + e), b = *(const f32x4*)(cw + jj * 1024 + 512 + col + e);
                wq[jj][e] = a.x; wq[jj][e + 1] = a.y; wq[jj][e + 2] = a.z; wq[jj][e + 3] = a.w; wk[jj][e] = b.x; wk[jj][e + 1] = b.y; wk[jj][e + 2] = b.z; wk[jj][e + 3] = b.w; }
#pragma unroll
        for (int e = 0; e < 8; ++e) { bq[e] = cb[col + e]; bk[e] = cb[512 + col + e]; }
#pragma unroll 1
        for (int ps = 0; ps < 2; ++ps) {
            const int t0 = j * 256 + rg * 8 + ps * 4;
            v4u qi[7], ki[7];
#pragma unroll
            for (int r = 0; r < 7; ++r) { const int tt = t0 - 3 + r; if (tt >= 0) { qi[r] = *(const v4u*)(MQ + (size_t)tt * 512 + col); ki[r] = *(const v4u*)(MK + (size_t)tt * 512 + col); } else { qi[r] = (v4u){0u, 0u, 0u, 0u}; ki[r] = (v4u){0u, 0u, 0u, 0u}; } }
#pragma unroll
            for (int o = 0; o < 4; ++o) {
                float aq[8], ak[8];
#pragma unroll
                for (int e = 0; e < 8; ++e) { aq[e] = bq[e]; ak[e] = bk[e]; }
#pragma unroll
                for (int jj = 0; jj < 4; ++jj) { const v4u q = qi[o + jj], k = ki[o + jj]; const unsigned qa[4] = {q.x, q.y, q.z, q.w}, ka[4] = {k.x, k.y, k.z, k.w};
#pragma unroll
                    for (int e = 0; e < 4; ++e) { aq[2 * e] += wq[jj][2 * e] * bf2f(qa[e] & 0xffffu); aq[2 * e + 1] += wq[jj][2 * e + 1] * bf2f(qa[e] >> 16);
                                                  ak[2 * e] += wk[jj][2 * e] * bf2f(ka[e] & 0xffffu); ak[2 * e + 1] += wk[jj][2 * e + 1] * bf2f(ka[e] >> 16); } }
#pragma unroll
                for (int e = 0; e < 8; ++e) { aq[e] = aq[e] * sigmoidf_(aq[e]) * 0.08838834764831845f; ak[e] = ak[e] * sigmoidf_(ak[e]); }
                v4u oq, ok; oq.x = pk2(aq[0], aq[1]); oq.y = pk2(aq[2], aq[3]); oq.z = pk2(aq[4], aq[5]); oq.w = pk2(aq[6], aq[7]);
                ok.x = pk2(ak[0], ak[1]); ok.y = pk2(ak[2], ak[3]); ok.z = pk2(ak[4], ak[5]); ok.w = pk2(ak[6], ak[7]);
                *(v4u*)(CQ + (size_t)(t0 + o) * 512 + col) = oq; *(v4u*)(CK + (size_t)(t0 + o) * 512 + col) = ok;
            }
        }
    }
}
__device__ __forceinline__ float gates_item(const float* GATES, float bi, float bf_, int j, int h, int wave, int lane, LAS float* eb, LAS float* wcol, LAS float* wupd, LAS float* misc) {
    float bL = 0.f;
    if (wave < 4) bL = gates_chunk(GATES, bi, bf_, j * 256 + wave * 64, h, lane, eb + 64 * wave, wcol + 64 * wave, wupd + 64 * wave, misc + wave);
    return bL;
}
__device__ __forceinline__ void b1_item(int item, const bf16* CK, const bf16* MV, const float* GATES, const float* b_i, const float* b_f, float* ST, lptr lds) {
    const int tid = tidx(), lane = tid & 63, r32 = lane & 31, hi = lane >> 5; const int wave = __builtin_amdgcn_readfirstlane(tid >> 6);
    LAS float* eb = (LAS float*)(lds + SMALL_OFF); LAS float* wcol = eb + 256; LAS float* wupd = wcol + 256; LAS float* misc = wupd + 256 + 64 + 128;
    {
        const int h = item >> 6, j = item & 63;
        f32x16 accS[2]; accS[0] = f32x16{}; accS[1] = f32x16{};
        float nv = 0.f;
        RawT raw; load_transposed(raw, CK, MV, j * 256, h, tid);
        __syncthreads();
        const float myb = gates_item(GATES, b_i[h], b_f[h], j, h, wave, lane, eb, wcol, wupd, misc);
        if (lane == 0 && wave < 4) misc[8 + wave] = myb;
        for (int c = 0; c < 4; ++c) {
            __syncthreads();
            store_transposed(raw, lds, wupd + 64 * c, tid);
            if (c + 1 < 4) load_transposed(raw, CK, MV, j * 256 + (c + 1) * 64, h, tid);
            const float aL = misc[c];
            __syncthreads();
            state_update(accS, lds, aL, wave, r32, hi);
            if (tid < 128) nv = aL * nv + kwt_rowsum(lds, tid);
        }
        float* st = ST + (size_t)item * ST_STRIDE;
#pragma unroll
        for (int i = 0; i < 2; ++i)
#pragma unroll
            for (int r = 0; r < 16; ++r) st[((wave * 2 + i) * 16 + r) * 64 + lane] = accS[i][r];
        if (tid < 128) st[16384 + tid] = nv;
        if (tid == 0) st[16384 + 128] = __expf((misc[8] + misc[9]) + (misc[10] + misc[11]));
    }
}
__device__ __forceinline__ void phase_b2(float* ST) {
    const int gt = blockIdx.x * NTHREADS + tidx(), NGT = gridDim.x * NTHREADS;
    for (int q = gt; q < 4 * (16384 + 128); q += NGT) {
        const int h = q / (16384 + 128), e = q % (16384 + 128);
        float* base = ST + (size_t)h * 64 * ST_STRIDE;
        float c = 0.f;
#pragma unroll 1
        for (int jb = 0; jb < 64; jb += 16) {
            float u[16], a[16];
#pragma unroll
            for (int k = 0; k < 16; ++k) { u[k] = base[(size_t)(jb + k) * ST_STRIDE + e]; a[k] = base[(size_t)(jb + k) * ST_STRIDE + 16384 + 128]; }
#pragma unroll
            for (int k = 0; k < 16; ++k) { base[(size_t)(jb + k) * ST_STRIDE + e] = c; c = a[k] * c + u[k]; }
        }
    }
}
__device__ __forceinline__ void phase_b3(const bf16* CQ, const bf16* CK, const bf16* MV, const bf16* MO, const float* GATES, const float* b_i, const float* b_f, const float* ml_g,
                                         const float* ST, bf16* ACAT, lptr lds) {
    const int tid = tidx(), lane = tid & 63, r32 = lane & 31, hi = lane >> 5; const int wave = __builtin_amdgcn_readfirstlane(tid >> 6);
    LAS float* eb = (LAS float*)(lds + SMALL_OFF); LAS float* wcol = eb + 256; LAS float* wupd = wcol + 256; LAS float* dinv = wupd + 256; LAS float* nvec = dinv + 64; LAS float* misc = nvec + 128;
    const int er = wave & 3, dc0 = 2 * (wave >> 2);
    for (int item = blockIdx.x; item < 256; item += gridDim.x) {
        const int h = item >> 6, j = item & 63;
        const float* st = ST + (size_t)item * ST_STRIDE;
        f32x16 accS[2];
#pragma unroll
        for (int i = 0; i < 2; ++i)
#pragma unroll
            for (int r = 0; r < 16; ++r) accS[i][r] = st[((wave * 2 + i) * 16 + r) * 64 + lane];
        __syncthreads();
        if (tid < 128) nvec[tid] = st[16384 + tid];
#pragma unroll
        for (int i = 0; i < 2; ++i)
#pragma unroll
            for (int r = 0; r < 16; ++r) *(LAS unsigned short*)(lds + CT_OFF + (32 * er + crow(r, hi)) * LD128 + (32 * (dc0 + i) + r32) * 2) = (unsigned short)f2bf(accS[i][r]);
        (void)gates_item(GATES, b_i[h], b_f[h], j, h, wave, lane, eb, wcol, wupd, misc);
        v4u rq[2], rk[2]; RawT raw; unsigned mo[8];
#define B3_LOAD_RAW(T0) do { _Pragma("unroll") for (int i = 0; i < 2; ++i) { const int p_ = tid + 512 * i, row_ = p_ >> 4, ch_ = p_ & 15; const size_t g_ = (size_t)((T0) + row_) * 512 + h * 128 + ch_ * 8; \
            rq[i] = *(const v4u*)(CQ + g_); rk[i] = *(const v4u*)(CK + g_); } load_transposed(raw, CK, MV, (T0), h, tid); } while (0)
        B3_LOAD_RAW(j * 256);
        for (int c = 0; c < 4; ++c) {
            const int t0 = j * 256 + c * 64;
            __syncthreads();
#pragma unroll
            for (int i = 0; i < 2; ++i) { const int p = tid + 512 * i, row = p >> 4, ch = p & 15;
                const v4u qv = rq[i], kv = rk[i]; const float e_ = eb[64 * c + row];
                v4u qo; qo.x = pk2(e_ * bf2f(qv.x & 0xffffu), e_ * bf2f(qv.x >> 16)); qo.y = pk2(e_ * bf2f(qv.y & 0xffffu), e_ * bf2f(qv.y >> 16));
                qo.z = pk2(e_ * bf2f(qv.z & 0xffffu), e_ * bf2f(qv.z >> 16)); qo.w = pk2(e_ * bf2f(qv.w & 0xffffu), e_ * bf2f(qv.w >> 16));
                *(LAS v4u*)(lds + QP_OFF + row * LD128 + ch * 16) = qo; *(LAS v4u*)(lds + K_OFF + row * LD128 + ch * 16) = kv; }
            store_transposed(raw, lds, wupd + 64 * c, tid);
            if (c + 1 < 4) B3_LOAD_RAW(t0 + 64);
#pragma unroll
            for (int rr = 0; rr < 8; ++rr) mo[rr] = *(const unsigned*)(MO + (size_t)(t0 + wave * 8 + rr) * 512 + h * 128 + 2 * lane);
            const float aL = misc[c];
            __syncthreads();
            const int tr = wave >> 2, tc = wave & 3;
            if (wave < 4) {
                const int sr = wave >> 1, sc = wave & 1;
                f32x16 sa = f32x16{};
                mm_tile<8>(sa, lds + QP_OFF + (32 * sr) * LD128, LD128, lds + K_OFF + (32 * sc) * LD128, LD128, r32, hi);
                const int s_ = 32 * sc + r32; const float wc_ = wcol[64 * c + s_];
#pragma unroll
                for (int r = 0; r < 16; ++r) { const int t_ = 32 * sr + crow(r, hi); const float v = (s_ <= t_) ? sa[r] * wc_ : 0.f;
                    *(LAS unsigned short*)(lds + SM_OFF + t_ * LD64 + s_ * 2) = (unsigned short)f2bf(v); }
            }
            f32x16 acc = f32x16{};
            mm_tile<8>(acc, lds + QP_OFF + (32 * tr) * LD128, LD128, lds + CT_OFF + (32 * tc) * LD128, LD128, r32, hi);
            __syncthreads();
            mm_tile<4>(acc, lds + SM_OFF + (32 * tr) * LD64, LD64, lds + VT_OFF + (32 * tc) * LD64, LD64, r32, hi);
            if (tid < 64) {
                float dn = 0.f; lptr qp = lds + QP_OFF + tid * LD128;
#pragma unroll 4
                for (int i = 0; i < 16; ++i) { const v4u q = *(const LAS v4u*)(qp + 16 * i); const LAS float* nn = nvec + 8 * i;
                    dn += bf2f(q.x & 0xffffu) * nn[0] + bf2f(q.x >> 16) * nn[1] + bf2f(q.y & 0xffffu) * nn[2] + bf2f(q.y >> 16) * nn[3]
                        + bf2f(q.z & 0xffffu) * nn[4] + bf2f(q.z >> 16) * nn[5] + bf2f(q.w & 0xffffu) * nn[6] + bf2f(q.w >> 16) * nn[7]; }
                lptr sp_ = lds + SM_OFF + tid * LD64;
#pragma unroll
                for (int i = 0; i < 8; ++i) { const v4u q = *(const LAS v4u*)(sp_ + 16 * i);
                    dn += (bf2f(q.x & 0xffffu) + bf2f(q.x >> 16)) + (bf2f(q.y & 0xffffu) + bf2f(q.y >> 16)) + (bf2f(q.z & 0xffffu) + bf2f(q.z >> 16)) + (bf2f(q.w & 0xffffu) + bf2f(q.w >> 16)); }
                dinv[tid] = 1.f / fmaxf(fabsf(dn), 1.f);
            }
            __syncthreads();
#pragma unroll
            for (int r = 0; r < 16; ++r) { const int t_ = 32 * tr + crow(r, hi); *(LAS float*)(lds + Y_OFF + (t_ * LDY + 32 * tc + r32) * 4) = acc[r] * dinv[t_]; }
            state_update(accS, lds, aL, wave, r32, hi);
            float nnew = 0.f;
            if (tid < 128) nnew = aL * nvec[tid] + kwt_rowsum(lds, tid);
            __syncthreads();
            if (tid < 128) nvec[tid] = nnew;
#pragma unroll
            for (int i = 0; i < 2; ++i)
#pragma unroll
                for (int r = 0; r < 16; ++r) *(LAS unsigned short*)(lds + CT_OFF + (32 * er + crow(r, hi)) * LD128 + (32 * (dc0 + i) + r32) * 2) = (unsigned short)f2bf(accS[i][r]);
#pragma unroll
            for (int rr = 0; rr < 8; ++rr) { const int t_ = wave * 8 + rr; const size_t grow = (size_t)(t0 + t_);
                const float y0 = *(const LAS float*)(lds + Y_OFF + (t_ * LDY + 2 * lane) * 4), y1 = *(const LAS float*)(lds + Y_OFF + (t_ * LDY + 2 * lane + 1) * 4);
                const unsigned ov = mo[rr];
                const float z0 = y0 * sigmoidf_(bf2f(ov & 0xffffu)), z1 = y1 * sigmoidf_(bf2f(ov >> 16));
                const float rs = rsqrtf(wave_sum(z0 * z0 + z1 * z1) * (1.f / 128.f) + EPS);
                *(unsigned*)(ACAT + grow * 1024 + 512 + h * 128 + 2 * lane) = pk2(z0 * rs * ml_g[h * 128 + 2 * lane], z1 * rs * ml_g[h * 128 + 2 * lane + 1]); }
        }
    }
}
#undef B3_LOAD_RAW
}

__device__ __forceinline__ void ph_route_naive(const bf16* QP, const float* SK, int2* ROUTE, float* lds) {
    float* qs = lds; float* sc = qs + 2048; float* sv = sc + 2048; int* si = (int*)(sv + 256); float* cand = (float*)(si + 256); float* tops = cand + 2048; int* tope = (int*)(tops + 128);
    const int tid = tidx();
    for (int t = blockIdx.x; t < M; t += gridDim.x) {
        __syncthreads();
        for (int i = tid; i < 2048; i += NTHREADS) qs[i] = bf2f(QP[(size_t)t * 2048 + i]);
        __syncthreads();
#pragma unroll 1
        for (int j = 0; j < 4; ++j) { const int sidx = tid + 512 * j, hc = sidx >> 7; const float* kp = SK + (size_t)sidx * 128; const float* qq = qs + hc * 128; float s = 0.f;
            for (int d = 0; d < 128; d += 4) { const f32x4 kv = *(const f32x4*)(kp + d); s += qq[d] * kv.x + qq[d + 1] * kv.y + qq[d + 2] * kv.z + qq[d + 3] * kv.w; }
            sc[sidx] = s; }
        __syncthreads();
        if (tid < 16) { const int hc = tid;
            for (int k = 0; k < 16; ++k) { float best = -INFINITY; int bi = 0;
                for (int n = 0; n < 128; ++n) { const float v = sc[hc * 128 + n]; if (v > best) { best = v; bi = n; } }
                sv[hc * 16 + k] = best; si[hc * 16 + k] = bi; sc[hc * 128 + bi] = -INFINITY; } }
        __syncthreads();
        for (int i = tid; i < 2048; i += NTHREADS) { const int h = i >> 8, a = (i >> 4) & 15, b = i & 15; cand[i] = sv[(2 * h) * 16 + a] + sv[(2 * h + 1) * 16 + b]; }
        __syncthreads();
        if (tid < 8) { const int h = tid;
            for (int k = 0; k < 16; ++k) { float best = -INFINITY; int bi = 0;
                for (int n = 0; n < 256; ++n) { const float v = cand[h * 256 + n]; if (v > best) { best = v; bi = n; } }
                tops[h * 16 + k] = best; tope[h * 16 + k] = si[(2 * h) * 16 + (bi >> 4)] * 128 + si[(2 * h + 1) * 16 + (bi & 15)]; cand[h * 256 + bi] = -INFINITY; }
            const float mx = tops[h * 16]; float sum = 0.f;
            for (int k = 0; k < 16; ++k) sum += expf(tops[h * 16 + k] - mx);
            const float inv = 1.f / sum;
            for (int k = 0; k < 16; ++k) ROUTE[((size_t)t * 8 + h) * 16 + k] = make_int2(tope[h * 16 + k], __float_as_int(expf(tops[h * 16 + k] - mx) * inv)); }
    }
}
__device__ __forceinline__ void ph_expert_naive(const bf16* XN, const int2* ROUTE, const float* EU, const float* EV, float* X, float* lds) {
    float* xs = lds; float* ws = xs + 1024; int* es = (int*)(ws + 128); float* gs = (float*)(es + 128);
    const int tid = tidx();
    for (int t = blockIdx.x; t < M; t += gridDim.x) {
        __syncthreads();
        for (int i = tid; i < 1024; i += NTHREADS) xs[i] = bf2f(XN[(size_t)t * 1024 + i]);
        if (tid < 128) { const int2 r = ROUTE[(size_t)t * 128 + tid]; es[tid] = r.x; gs[tid] = __int_as_float(r.y); }
        __syncthreads();
        { const int e = tid >> 2, part = tid & 3; const float* u = EU + (size_t)es[e] * 1024 + part * 4; const float* xx = xs + part * 4; float s = 0.f;
          for (int d = 0; d < 1024; d += 16) { const f32x4 uv = *(const f32x4*)(u + d); s += xx[d] * uv.x + xx[d + 1] * uv.y + xx[d + 2] * uv.z + xx[d + 3] * uv.w; }
          s += __shfl_xor(s, 1); s += __shfl_xor(s, 2);
          const float a = 0.5f * s * (1.f + erff(s * 0.7071067811865476f));
          if (part == 0) ws[e] = gs[e] * a; }
        __syncthreads();
#pragma unroll 1
        for (int j = 0; j < 2; ++j) { const int n = tid + 512 * j; float o = 0.f;
            for (int e = 0; e < 128; ++e) o += ws[e] * EV[(size_t)es[e] * 1024 + n];
            X[(size_t)t * 1024 + n] += o; }
    }
}


namespace peer {
typedef __bf16 bf16x2_t __attribute__((ext_vector_type(2)));
typedef float f32x2_t __attribute__((ext_vector_type(2)));
typedef LAS unsigned char* lptr;
__device__ __forceinline__ float dot2(unsigned a, unsigned b, float c) { return __builtin_amdgcn_fdot2_f32_bf16(__builtin_bit_cast(bf16x2_t, a), __builtin_bit_cast(bf16x2_t, b), c, false); }
template <int CTRL> __device__ __forceinline__ float dpp(float x) { return __builtin_bit_cast(float, __builtin_amdgcn_mov_dpp(__builtin_bit_cast(int, x), CTRL, 0xf, 0xf, true)); }
__device__ __forceinline__ float row16_sum(float x) { x += dpp<0x128>(x); x += dpp<0x124>(x); x += dpp<0x122>(x); x += dpp<0x121>(x); return x; }
__device__ __forceinline__ unsigned fp8lo_bf16(unsigned w) { return __builtin_bit_cast(unsigned, __builtin_amdgcn_cvt_scalef32_pk_bf16_fp8(w, 1.0f, false)); }
__device__ __forceinline__ unsigned fp8hi_bf16(unsigned w) { return __builtin_bit_cast(unsigned, __builtin_amdgcn_cvt_scalef32_pk_bf16_fp8(w, 1.0f, true)); }
__device__ __forceinline__ float dot16(const v4u& u, const v4u& x0, const v4u& x1, float d) {
    d = dot2(fp8lo_bf16(u.x), x0.x, d); d = dot2(fp8hi_bf16(u.x), x0.y, d); d = dot2(fp8lo_bf16(u.y), x0.z, d); d = dot2(fp8hi_bf16(u.y), x0.w, d);
    d = dot2(fp8lo_bf16(u.z), x1.x, d); d = dot2(fp8hi_bf16(u.z), x1.y, d); d = dot2(fp8lo_bf16(u.w), x1.z, d); return dot2(fp8hi_bf16(u.w), x1.w, d);
}
__device__ __forceinline__ void convert_tables(const float* EU, const float* EV, const float* gu, unsigned char* EU8, unsigned char* EV8, float* SI) {
    const int lane = tidx() & 63, wave = tidx() >> 6;
    const int gw = blockIdx.x * NWAVES + wave, NGW = gridDim.x * NWAVES;
    f32x4 gg[4];
#pragma unroll
    for (int j = 0; j < 4; ++j) gg[j] = *(const f32x4*)(gu + 4 * lane + 256 * j);
    for (int r0 = gw * 4; r0 < 2 * 16384; r0 += NGW * 4) {
        f32x4 v[4][4];
#pragma unroll
        for (int q = 0; q < 4; ++q) { const int r = r0 + q; const bool second = r >= 16384; const float* src = (second ? EV : EU) + (size_t)(second ? r - 16384 : r) * 1024 + 4 * lane;
#pragma unroll
            for (int j = 0; j < 4; ++j) v[q][j] = *(const f32x4*)(src + 256 * j); }
#pragma unroll
        for (int q = 0; q < 4; ++q) { const int r = r0 + q; const bool second = r >= 16384; const int row = second ? r - 16384 : r;
            float am = 0.f;
#pragma unroll
            for (int j = 0; j < 4; ++j) { if (!second) v[q][j] = v[q][j] * gg[j];
                am = fmaxf(am, fmaxf(fmaxf(fabsf(v[q][j].x), fabsf(v[q][j].y)), fmaxf(fabsf(v[q][j].z), fabsf(v[q][j].w)))); }
#pragma unroll
            for (int o = 1; o < 64; o <<= 1) am = fmaxf(am, __shfl_xor(am, o));
            const int e = (int)((__float_as_uint(am) >> 23) & 0xffu) - 127;
            const bool ok = am > 1e-30f;
            const float sc = ok ? __uint_as_float((unsigned)(127 + 6 - e) << 23) : 1.f, isc = ok ? __uint_as_float((unsigned)(127 - 6 + e) << 23) : 1.f;
            unsigned char* dst = (second ? EV8 : EU8) + (size_t)row * 1024 + 4 * lane;
#pragma unroll
            for (int j = 0; j < 4; ++j) { int p = __builtin_amdgcn_cvt_pk_fp8_f32(v[q][j].x * sc, v[q][j].y * sc, 0, false); p = __builtin_amdgcn_cvt_pk_fp8_f32(v[q][j].z * sc, v[q][j].w * sc, p, true); *(unsigned*)(dst + 256 * j) = (unsigned)p; }
            if (lane == 0) SI[r] = isc; }
    }
}
__device__ __forceinline__ void expert_phase(const bf16* XG, const float* RS, bf16* XN, const int2* ROUTE, const unsigned char* EU8, const unsigned char* EV8, const float* SI, const float* X, float* XO, const float* g_next, lptr lds) {
    const int lane = tidx() & 63, grp = lane >> 4, li = lane & 15; const int wave = __builtin_amdgcn_readfirstlane(tidx() >> 6);
    LAS int* ids = (LAS int*)(lds + wave * 1536); LAS float* wts = (LAS float*)(ids + 128); LAS float* sus = wts + 128;
    const int gw = blockIdx.x * NWAVES + wave, NGW = gridDim.x * NWAVES;
    for (int t = gw; t < M; t += NGW) {
        v4u xq[8];
#pragma unroll
        for (int j = 0; j < 4; ++j) { const bf16* xp = XG + (size_t)t * 1024 + 256 * j + 16 * li; xq[2 * j] = *(const v4u*)xp; xq[2 * j + 1] = *(const v4u*)(xp + 8); }
        const float rt = rsqrtf(row16_sum(RS[(size_t)t * 16 + li]) * (1.f / D) + EPS);
        { const int2 r0 = ROUTE[(size_t)t * 128 + lane], r1 = ROUTE[(size_t)t * 128 + 64 + lane];
          ids[lane] = r0.x; ids[lane + 64] = r1.x; wts[lane] = __int_as_float(r0.y) * SI[16384 + r0.x]; wts[lane + 64] = __int_as_float(r1.y) * SI[16384 + r1.x]; sus[lane] = SI[r0.x]; sus[lane + 64] = SI[r1.x]; }
        v4u ua[8], ub[8];
#define PEER_ULOAD(buf, b) do { _Pragma("unroll") for (int ps = 0; ps < 2; ++ps) { const unsigned char* up_ = EU8 + (size_t)ids[8 * (b) + 4 * ps + grp] * 1024 + 16 * li; \
            _Pragma("unroll") for (int j = 0; j < 4; ++j) buf[4 * ps + j] = *(const v4u*)(up_ + 256 * j); } } while (0)
#define PEER_UCOMP(buf, b) do { _Pragma("unroll") for (int ps = 0; ps < 2; ++ps) { float d_ = 0.f; \
            _Pragma("unroll") for (int j = 0; j < 4; ++j) d_ = dot16(buf[4 * ps + j], xq[2 * j], xq[2 * j + 1], d_); \
            d_ = row16_sum(d_) * (rt * sus[8 * (b) + 4 * ps + grp]); \
            const float a_ = 0.5f * d_ * (1.f + erff(d_ * 0.7071067811865476f)); if (li == 0) wts[8 * (b) + 4 * ps + grp] *= a_; } } while (0)
        PEER_ULOAD(ua, 0);
#pragma unroll 1
        for (int b = 0; b < 16; b += 2) {
            PEER_ULOAD(ub, b + 1);
            PEER_UCOMP(ua, b);
            if (b + 2 < 16) PEER_ULOAD(ua, b + 2);
            PEER_UCOMP(ub, b + 1);
        }
#undef PEER_ULOAD
#undef PEER_UCOMP
        float acc[16];
#pragma unroll
        for (int i = 0; i < 16; ++i) acc[i] = 0.f;
        v4u va[8], vb[8];
#define PEER_VLOAD(buf, b) do { _Pragma("unroll") for (int k = 0; k < 8; ++k) buf[k] = *(const v4u*)(EV8 + (size_t)ids[8 * (b) + k] * 1024 + 16 * lane); } while (0)
#define PEER_VCOMP(buf, b) do { _Pragma("unroll") for (int k = 0; k < 8; ++k) { const float w_ = wts[8 * (b) + k]; const v4u q_ = buf[k]; \
            const unsigned qq_[4] = {q_.x, q_.y, q_.z, q_.w}; \
            _Pragma("unroll") for (int i = 0; i < 4; ++i) { const f32x2_t lo_ = __builtin_amdgcn_cvt_pk_f32_fp8((int)qq_[i], false), hi_ = __builtin_amdgcn_cvt_pk_f32_fp8((int)qq_[i], true); \
                acc[4 * i + 0] = fmaf(w_, lo_.x, acc[4 * i + 0]); acc[4 * i + 1] = fmaf(w_, lo_.y, acc[4 * i + 1]); acc[4 * i + 2] = fmaf(w_, hi_.x, acc[4 * i + 2]); acc[4 * i + 3] = fmaf(w_, hi_.y, acc[4 * i + 3]); } } } while (0)
        PEER_VLOAD(va, 0);
#pragma unroll 1
        for (int b = 0; b < 16; b += 2) {
            PEER_VLOAD(vb, b + 1);
            PEER_VCOMP(va, b);
            if (b + 2 < 16) PEER_VLOAD(va, b + 2);
            PEER_VCOMP(vb, b + 1);
        }
#undef PEER_VLOAD
#undef PEER_VCOMP
        { const float* xi = X + (size_t)t * 1024 + 16 * lane; float* xo = XO + (size_t)t * 1024 + 16 * lane;
#pragma unroll
          for (int i = 0; i < 4; ++i) { f32x4 a = *(const f32x4*)(xi + 4 * i); a.x += acc[4 * i + 0]; a.y += acc[4 * i + 1]; a.z += acc[4 * i + 2]; a.w += acc[4 * i + 3]; *(f32x4*)(xo + 4 * i) = a;
              acc[4 * i + 0] = a.x; acc[4 * i + 1] = a.y; acc[4 * i + 2] = a.z; acc[4 * i + 3] = a.w; }
          float ss = 0.f;
#pragma unroll
          for (int i = 0; i < 16; ++i) ss += acc[i] * acc[i];
          const float rn = rsqrtf(wave_sum(ss) * (1.f / D) + EPS);
          const float* gp = g_next + 16 * lane; v4u w0, w1;
          w0.x = pk2(acc[0] * rn * gp[0], acc[1] * rn * gp[1]); w0.y = pk2(acc[2] * rn * gp[2], acc[3] * rn * gp[3]); w0.z = pk2(acc[4] * rn * gp[4], acc[5] * rn * gp[5]); w0.w = pk2(acc[6] * rn * gp[6], acc[7] * rn * gp[7]);
          w1.x = pk2(acc[8] * rn * gp[8], acc[9] * rn * gp[9]); w1.y = pk2(acc[10] * rn * gp[10], acc[11] * rn * gp[11]); w1.z = pk2(acc[12] * rn * gp[12], acc[13] * rn * gp[13]); w1.w = pk2(acc[14] * rn * gp[14], acc[15] * rn * gp[15]);
          bf16* xnp = XN + (size_t)t * 1024 + 16 * lane; *(v4u*)xnp = w0; *(v4u*)(xnp + 8) = w1; }
    }
}

template <int P>
__device__ __forceinline__ void expert_phase_mp(const bf16* XG, const float* RS, bf16* XN, const int2* ROUTE, const unsigned char* EU8, const unsigned char* EV8, const float* SI,
                                                const float* X, float* XO, const float* g_next, lptr lds) {
    constexpr int SH = (P == 8) ? 11 : (P == 4) ? 12 : (P == 2) ? 13 : 14;
    const int lane = tidx() & 63, grp = lane >> 4, li = lane & 15; const int wave = __builtin_amdgcn_readfirstlane(tidx() >> 6);
    lptr wl = lds + wave * 15616;
    lptr XS = wl;
    LAS unsigned* FLE = (LAS unsigned*)(wl + 8192);
    LAS float* SW = (LAS float*)(wl + 8192 + 3072);
    LAS float* RT = (LAS float*)(wl + 8192 + 3072 + 2048);
    LAS int* QS = (LAS int*)(wl + 8192 + 3072 + 2048 + 16);
    LAS float* SU = (LAS float*)(wl + 8192 + 3072 + 2048 + 16 + 48);
    const int gw = blockIdx.x * NWAVES + wave, NGW = gridDim.x * NWAVES;
    const unsigned long long ltmask = (1ull << lane) - 1ull;
#pragma unroll 1
    for (int g4 = 0; g4 < 2; ++g4) {
        int tk[4];
#pragma unroll
        for (int k = 0; k < 4; ++k) tk[k] = gw + (g4 * 4 + k) * NGW;
        int2 e0[4], e1[4];
#pragma unroll
        for (int k = 0; k < 4; ++k) {
            const v4u a = *(const v4u*)(XG + (size_t)tk[k] * 1024 + 16 * lane), b = *(const v4u*)(XG + (size_t)tk[k] * 1024 + 16 * lane + 8);
            *(LAS v4u*)(XS + k * 2048 + 32 * lane) = a; *(LAS v4u*)(XS + k * 2048 + 32 * lane + 16) = b;
            e0[k] = ROUTE[(size_t)tk[k] * 128 + lane]; e1[k] = ROUTE[(size_t)tk[k] * 128 + 64 + lane];
            SW[k * 128 + lane] = __int_as_float(e0[k].y) * SI[16384 + e0[k].x]; SW[k * 128 + 64 + lane] = __int_as_float(e1[k].y) * SI[16384 + e1[k].x];
            SU[k * 128 + lane] = SI[e0[k].x]; SU[k * 128 + 64 + lane] = SI[e1[k].x];
            const float r = rsqrtf(row16_sum(RS[(size_t)tk[k] * 16 + li]) * (1.f / D) + EPS); if (lane == 0) RT[k] = r;
        }
        int qbase = 0;
#pragma unroll 1
        for (int p = 0; p < P; ++p) {
            int base = 4 * qbase;
#pragma unroll
            for (int k = 0; k < 4; ++k) {
                const bool in0 = (e0[k].x >> SH) == p, in1 = (e1[k].x >> SH) == p;
                const unsigned long long m0 = __ballot(in0), m1 = __ballot(in1);
                const int c0 = __popcll(m0), c1 = __popcll(m1), n = c0 + c1, npad = (n + 3) & ~3;
                if (in0) FLE[base + __popcll(m0 & ltmask)] = (unsigned)e0[k].x | 0x4000u | ((unsigned)(k * 128 + lane) << 16);
                if (in1) FLE[base + c0 + __popcll(m1 & ltmask)] = (unsigned)e1[k].x | 0x4000u | ((unsigned)(k * 128 + 64 + lane) << 16);
                if (lane < npad - n) FLE[base + n + lane] = (unsigned)(p << SH) | ((unsigned)(k * 128) << 16);
                base += npad;
            }
            qbase = base >> 2;
        }
        { const int ext = (4 - (qbase & 3)) & 3;
          if (lane < 4 * ext) FLE[4 * qbase + lane] = (unsigned)((P - 1) << SH) | ((unsigned)(3 * 128) << 16); qbase += ext; }
        const int qtot = qbase;
        v4u ua[8], ub[8]; unsigned ea[2], eb_[2];
#define MP_ULOAD(buf, ent, q) do { _Pragma("unroll") for (int h2 = 0; h2 < 2; ++h2) { ent[h2] = FLE[4 * ((q) + h2) + grp]; const unsigned char* up_ = EU8 + (size_t)(ent[h2] & 0x3FFFu) * 1024 + 16 * li; \
            _Pragma("unroll") for (int j = 0; j < 4; ++j) buf[4 * h2 + j] = *(const v4u*)(up_ + 256 * j); } } while (0)
#define MP_UCOMP(buf, ent) do { _Pragma("unroll") for (int h2 = 0; h2 < 2; ++h2) { const int tok_ = (int)(ent[h2] >> 23) & 3; lptr xp_ = XS + tok_ * 2048 + 32 * li; float d_ = 0.f; \
            _Pragma("unroll") for (int j = 0; j < 4; ++j) { const v4u x0_ = *(const LAS v4u*)(xp_ + 512 * j), x1_ = *(const LAS v4u*)(xp_ + 512 * j + 16); d_ = dot16(buf[4 * h2 + j], x0_, x1_, d_); } \
            d_ = row16_sum(d_) * (RT[tok_] * SU[(ent[h2] >> 16) & 511u]); \
            const float a_ = 0.5f * d_ * (1.f + erff(d_ * 0.7071067811865476f)); if (li == 0 && (ent[h2] & 0x4000u)) SW[ent[h2] >> 16] *= a_; } } while (0)
        MP_ULOAD(ua, ea, 0);
#pragma unroll 1
        for (int q = 0; q < qtot; q += 4) {
            MP_ULOAD(ub, eb_, q + 2);
            MP_UCOMP(ua, ea);
            if (q + 4 < qtot) MP_ULOAD(ua, ea, q + 4);
            MP_UCOMP(ub, eb_);
        }
#undef MP_ULOAD
#undef MP_UCOMP
        float acc[4][16];
#pragma unroll
        for (int k = 0; k < 4; ++k)
#pragma unroll
            for (int i = 0; i < 16; ++i) acc[k][i] = 0.f;
        v4u va[8], vb[8]; unsigned na[8], nb[8];
#define MP_VLOAD(buf, ents, q) do { _Pragma("unroll") for (int r = 0; r < 8; ++r) { ents[r] = FLE[4 * (q) + r]; buf[r] = *(const v4u*)(EV8 + (size_t)(ents[r] & 0x3FFFu) * 1024 + 16 * lane); } } while (0)
#define MP_VACC(K, buf, ents, R0) do { _Pragma("unroll") for (int r = R0; r < R0 + 4; ++r) { const float w_ = (ents[r] & 0x4000u) ? SW[ents[r] >> 16] : 0.f; const v4u q_ = buf[r]; \
            const unsigned qq_[4] = {q_.x, q_.y, q_.z, q_.w}; \
            _Pragma("unroll") for (int i = 0; i < 4; ++i) { const f32x2_t lo_ = __builtin_amdgcn_cvt_pk_f32_fp8((int)qq_[i], false), hi_ = __builtin_amdgcn_cvt_pk_f32_fp8((int)qq_[i], true); \
                acc[K][4 * i + 0] = fmaf(w_, lo_.x, acc[K][4 * i + 0]); acc[K][4 * i + 1] = fmaf(w_, lo_.y, acc[K][4 * i + 1]); acc[K][4 * i + 2] = fmaf(w_, hi_.x, acc[K][4 * i + 2]); acc[K][4 * i + 3] = fmaf(w_, hi_.y, acc[K][4 * i + 3]); } } } while (0)
#define MP_VCOMP1(buf, ents, R0) do { const int tok_ = __builtin_amdgcn_readfirstlane((int)(ents[R0] >> 23) & 3); \
            if (tok_ == 0) MP_VACC(0, buf, ents, R0); else if (tok_ == 1) MP_VACC(1, buf, ents, R0); else if (tok_ == 2) MP_VACC(2, buf, ents, R0); else MP_VACC(3, buf, ents, R0); } while (0)
#define MP_VCOMP(buf, ents) do { MP_VCOMP1(buf, ents, 0); MP_VCOMP1(buf, ents, 4); } while (0)
        MP_VLOAD(va, na, 0);
#pragma unroll 1
        for (int q = 0; q < qtot; q += 4) {
            MP_VLOAD(vb, nb, q + 2);
            MP_VCOMP(va, na);
            if (q + 4 < qtot) MP_VLOAD(va, na, q + 4);
            MP_VCOMP(vb, nb);
        }
#undef MP_VLOAD
#undef MP_VACC
#undef MP_VCOMP1
#undef MP_VCOMP
#pragma unroll
        for (int k = 0; k < 4; ++k) {
            const float* xi = X + (size_t)tk[k] * 1024 + 16 * lane; float* xo = XO + (size_t)tk[k] * 1024 + 16 * lane;
            float ss = 0.f;
#pragma unroll
            for (int i = 0; i < 4; ++i) { f32x4 a = *(const f32x4*)(xi + 4 * i); a.x += acc[k][4 * i + 0]; a.y += acc[k][4 * i + 1]; a.z += acc[k][4 * i + 2]; a.w += acc[k][4 * i + 3]; *(f32x4*)(xo + 4 * i) = a;
                acc[k][4 * i + 0] = a.x; acc[k][4 * i + 1] = a.y; acc[k][4 * i + 2] = a.z; acc[k][4 * i + 3] = a.w; ss += (a.x * a.x + a.y * a.y) + (a.z * a.z + a.w * a.w); }
            const float rn = rsqrtf(wave_sum(ss) * (1.f / D) + EPS);
            const float* gp = g_next + 16 * lane; v4u w0, w1;
            w0.x = pk2(acc[k][0] * rn * gp[0], acc[k][1] * rn * gp[1]); w0.y = pk2(acc[k][2] * rn * gp[2], acc[k][3] * rn * gp[3]); w0.z = pk2(acc[k][4] * rn * gp[4], acc[k][5] * rn * gp[5]); w0.w = pk2(acc[k][6] * rn * gp[6], acc[k][7] * rn * gp[7]);
            w1.x = pk2(acc[k][8] * rn * gp[8], acc[k][9] * rn * gp[9]); w1.y = pk2(acc[k][10] * rn * gp[10], acc[k][11] * rn * gp[11]); w1.z = pk2(acc[k][12] * rn * gp[12], acc[k][13] * rn * gp[13]); w1.w = pk2(acc[k][14] * rn * gp[14], acc[k][15] * rn * gp[15]);
            bf16* xnp = XN + (size_t)tk[k] * 1024 + 16 * lane; *(v4u*)xnp = w0; *(v4u*)(xnp + 8) = w1;
        }
    }
}
}


namespace route {
typedef short bf16x8 __attribute__((ext_vector_type(8)));
typedef float f32x16 __attribute__((ext_vector_type(16)));
typedef LAS unsigned char* lptr;
__device__ __forceinline__ unsigned f2sort(float f) { const unsigned u = __float_as_uint(f); return (u & 0x80000000u) ? ~u : (u | 0x80000000u); }
__device__ __forceinline__ float sort2f(unsigned s) { return __uint_as_float((s & 0x80000000u) ? (s & 0x7fffffffu) : ~s); }
__device__ __forceinline__ unsigned umax_(unsigned a, unsigned b) { return a > b ? a : b; }
__device__ __forceinline__ unsigned umin_(unsigned a, unsigned b) { return a < b ? a : b; }
__device__ __forceinline__ unsigned selu(int hi, unsigned a, unsigned b) { asm volatile("" : "+v"(a), "+v"(b)); return hi ? b : a; }
__device__ __forceinline__ float self(int hi, float a, float b) { asm volatile("" : "+v"(a), "+v"(b)); return hi ? b : a; }
__device__ __forceinline__ unsigned partner32(unsigned x, int hi) { auto r = __builtin_amdgcn_permlane32_swap(x, x, false, false); return hi ? r[0] : r[1]; }
__device__ __forceinline__ void sort16_desc(unsigned (&x)[16]) {
#pragma unroll
    for (int k = 2; k <= 16; k <<= 1)
#pragma unroll
        for (int j = k >> 1; j > 0; j >>= 1)
#pragma unroll
            for (int i = 0; i < 16; ++i) { const int l = i ^ j; if (l > i) { const bool desc = ((i & k) == 0); const unsigned a = x[i], b = x[l], mx = umax_(a, b), mn = umin_(a, b); x[i] = desc ? mx : mn; x[l] = desc ? mn : mx; } }
}
__device__ __forceinline__ void merge_top16(unsigned (&a)[16], const unsigned (&b)[16]) {
#pragma unroll
    for (int i = 0; i < 16; ++i) a[i] = umax_(a[i], b[15 - i]);
#pragma unroll
    for (int j = 8; j > 0; j >>= 1)
#pragma unroll
        for (int i = 0; i < 16; ++i) { const int l = i ^ j; if (l > i) { const unsigned p = a[i], q = a[l]; a[i] = umax_(p, q); a[l] = umin_(p, q); } }
}
__device__ __forceinline__ void convert_subkeys(const float* SK, bf16* SKB) {
    const int n8 = 16 * 128 * 128 / 8, stride = gridDim.x * NTHREADS;
    for (int i = blockIdx.x * NTHREADS + tidx(); i < n8; i += stride) { const f32x4 a = *(const f32x4*)(SK + (size_t)i * 8), b = *(const f32x4*)(SK + (size_t)i * 8 + 4);
        v4u o; o.x = pk2(a.x, a.y); o.y = pk2(a.z, a.w); o.z = pk2(b.x, b.y); o.w = pk2(b.z, b.w); *(v4u*)(SKB + (size_t)i * 8) = o; }
}
__device__ __forceinline__ void route_phase(const bf16* QP, const bf16* SKB, const float* RS, int2* ROUTE, lptr lds) {
    const int lane = tidx() & 63, r32 = lane & 31, hi = lane >> 5; const int wave = __builtin_amdgcn_readfirstlane(tidx() >> 6);
    LAS int* myl = (LAS int*)(lds + wave * 8448) + lane * 33;
    const int gw = blockIdx.x * NWAVES + wave, NGW = gridDim.x * NWAVES;
    for (int it = gw; it < 4096; it += NGW) {
        const int tb = it >> 3, h = it & 7, token = tb * 32 + r32;
        unsigned top0[16], top1[16];
#pragma unroll
        for (int i = 0; i < 16; ++i) { top0[i] = 0u; top1[i] = 0u; }
        bf16x8 qf0[8], qf1[8], afA[8], afB[8];
#pragma unroll
        for (int ks = 0; ks < 8; ++ks) { qf0[ks] = *(const bf16x8*)(QP + (size_t)token * 2048 + (h * 2) * 128 + 16 * ks + 8 * hi); qf1[ks] = *(const bf16x8*)(QP + (size_t)token * 2048 + (h * 2 + 1) * 128 + 16 * ks + 8 * hi); }
#define ROUTE_LOADA(buf, s_) do { const bf16* ap_ = SKB + ((size_t)((h * 2 + ((s_) >> 2)) * 128 + 32 * ((s_) & 3) + r32)) * 128 + 8 * hi; _Pragma("unroll") for (int ks = 0; ks < 8; ++ks) buf[ks] = *(const bf16x8*)(ap_ + 16 * ks); } while (0)
#define ROUTE_STEP(cur, nxt, s_) do { if ((s_) + 1 < 8) ROUTE_LOADA(nxt, (s_) + 1); \
            f32x16 acc_ = f32x16{}; \
            _Pragma("unroll") for (int ks = 0; ks < 8; ++ks) acc_ = __builtin_amdgcn_mfma_f32_32x32x16_bf16(cur[ks], ((s_) < 4) ? qf0[ks] : qf1[ks], acc_, 0, 0, 0); \
            const unsigned code0_ = 127u - (unsigned)(32 * ((s_) & 3) + 4 * hi); unsigned pt_[16]; \
            _Pragma("unroll") for (int r = 0; r < 16; ++r) pt_[r] = (f2sort(acc_[r]) & ~0x7Fu) | (code0_ - (unsigned)((r & 3) + 8 * (r >> 2))); \
            sort16_desc(pt_); \
            if ((s_) < 4) merge_top16(top0, pt_); else merge_top16(top1, pt_); \
            if (((s_) & 3) == 3) { unsigned oth_[16];     \
                _Pragma("unroll") for (int i = 0; i < 16; ++i) oth_[i] = partner32(((s_) < 4) ? top0[i] : top1[i], hi); \
                if ((s_) < 4) merge_top16(top0, oth_); else merge_top16(top1, oth_); } } while (0)
        ROUTE_LOADA(afA, 0);
        ROUTE_STEP(afA, afB, 0); ROUTE_STEP(afB, afA, 1); ROUTE_STEP(afA, afB, 2); ROUTE_STEP(afB, afA, 3);
        ROUTE_STEP(afA, afB, 4); ROUTE_STEP(afB, afA, 5); ROUTE_STEP(afA, afB, 6); ROUTE_STEP(afB, afA, 7);
#undef ROUTE_LOADA
#undef ROUTE_STEP
#pragma unroll
        for (int i = 0; i < 16; ++i) { myl[i] = 127 - (int)(top0[i] & 0x7Fu); myl[16 + i] = 127 - (int)(top1[i] & 0x7Fu); }
        float a1[16], ai[8];
#pragma unroll
        for (int i = 0; i < 16; ++i) a1[i] = sort2f(top1[i] & ~0x7Fu);
#pragma unroll
        for (int i = 0; i < 8; ++i) ai[i] = sort2f(selu(hi, top0[i], top0[8 + i]) & ~0x7Fu);
        unsigned top2[16];
#pragma unroll
        for (int i = 0; i < 16; ++i) top2[i] = 0u;
#pragma unroll
        for (int ii = 0; ii < 8; ++ii) {
            unsigned rw[16];
#pragma unroll
            for (int j = 0; j < 16; ++j) rw[j] = (f2sort(ai[ii] + a1[j]) & ~0xFFu) | (255u - (unsigned)(128 * hi + 16 * ii + j));
            merge_top16(top2, rw);
        }
        { unsigned oth[16];
#pragma unroll
          for (int i = 0; i < 16; ++i) oth[i] = partner32(top2[i], hi);
          merge_top16(top2, oth); }
        float rt; { const f32x4* rp = (const f32x4*)(RS + (size_t)token * 16); const f32x4 a = rp[0], b = rp[1], c = rp[2], d = rp[3];
            rt = rsqrtf((((a.x + a.y) + (a.z + a.w)) + ((b.x + b.y) + (b.z + b.w)) + ((c.x + c.y) + (c.z + c.w)) + ((d.x + d.y) + (d.z + d.w))) * (1.f / D) + EPS); }
        const float mx = sort2f(top2[0] & ~0xFFu);
        float ex[16], sum = 0.f;
#pragma unroll
        for (int k = 0; k < 16; ++k) { ex[k] = __expf(rt * (sort2f(top2[k] & ~0xFFu) - mx)); sum += ex[k]; }
        const float inv = 1.f / sum;
        int2* dst = ROUTE + ((size_t)token * 8 + h) * 16 + 8 * hi;
#pragma unroll
        for (int k = 0; k < 8; k += 2) {
            const unsigned p0 = selu(hi, top2[k], top2[8 + k]), p1 = selu(hi, top2[k + 1], top2[9 + k]);
            const float g0 = self(hi, ex[k], ex[8 + k]) * inv, g1 = self(hi, ex[k + 1], ex[9 + k]) * inv;
            const int pos0 = 255 - (int)(p0 & 0xFFu), pos1 = 255 - (int)(p1 & 0xFFu);
            const int e0 = myl[pos0 >> 4] * 128 + myl[16 + (pos0 & 15)], e1 = myl[pos1 >> 4] * 128 + myl[16 + (pos1 & 15)];
            v4u o; o.x = (unsigned)e0; o.y = __float_as_uint(g0); o.z = (unsigned)e1; o.w = __float_as_uint(g1);
            *(v4u*)(dst + k) = o;
        }
    }
}
}


__device__ __forceinline__ void ph_qk_norms(const bf16* QA, const bf16* KA, unsigned* norms) {
    const int lane = tidx() & 63, wave = tidx() >> 6;
    const int gw = blockIdx.x * NWAVES + wave, NGW = gridDim.x * NWAVES;
    for (int m0 = gw * 8; m0 < M; m0 += NGW * 8) {
        v4u q[8], k[8];
#pragma unroll
        for (int r = 0; r < 8; ++r) { q[r] = *(const v4u*)(QA + (size_t)(m0 + r) * 512 + lane * 8); k[r] = *(const v4u*)(KA + (size_t)(m0 + r) * 512 + lane * 8); }
        float mq = 0.f, mk = 0.f, md = -INFINITY;
#pragma unroll
        for (int r = 0; r < 8; ++r) {
            const unsigned qa[4] = {q[r].x, q[r].y, q[r].z, q[r].w}, ka[4] = {k[r].x, k[r].y, k[r].z, k[r].w};
            float sq = 0.f, sk = 0.f, sd = 0.f;
#pragma unroll
            for (int i = 0; i < 4; ++i) { const float a = bf2f(qa[i] & 0xffffu), b = bf2f(qa[i] >> 16), c = bf2f(ka[i] & 0xffffu), d = bf2f(ka[i] >> 16); sq += a * a + b * b; sk += c * c + d * d; sd += a * c + b * d; }
#pragma unroll
            for (int o = 1; o < 8; o <<= 1) { sq += __shfl_xor(sq, o); sk += __shfl_xor(sk, o); sd += __shfl_xor(sd, o); }
            mq = fmaxf(mq, sq); mk = fmaxf(mk, sk); md = fmaxf(md, -sd);
        }
        if ((lane & 7) == 0) { const int hv = lane >> 3, qb = m0 >> 8;
            atomicMax(norms + hv, __float_as_uint(mk)); atomicMax(norms + 16 + hv * 64 + qb, __float_as_uint(mq)); atomicMax(norms + 528 + hv * 64 + qb, f2sortu(md)); }
    }
}

constexpr int NPHASE = 12;
struct Args { const float* in[24]; float* out; unsigned char* ws; int ph_lo, ph_hi, use_bar, pad; };

__global__ void __launch_bounds__(NTHREADS, 2) mk_fwd(Args args) {
    extern __shared__ __attribute__((aligned(16))) unsigned char lds_raw[];
    float* lds = (float*)lds_raw;
    volatile LAS unsigned* MISC = (volatile LAS unsigned*)((LAS unsigned char*)lds_raw + (LDS_BYTES - 64));
    unsigned char* ws = args.ws;
    unsigned* ctl = (unsigned*)(ws + WS_CTL);
    const float* x = args.in[0]; const float* p = args.in[1]; const float* norm_mix_g = args.in[2]; const float* w_in = args.in[3];
    const float* conv_w = args.in[4]; const float* conv_b = args.in[5]; const float* b_ig = args.in[6]; const float* b_fg = args.in[7];
    const float* lq1 = args.in[8]; const float* lk1 = args.in[9]; const float* lq2 = args.in[10]; const float* lk2 = args.in[11];
    const float* subln_g = args.in[12]; const float* ml_g = args.in[13]; const float* w_out = args.in[14]; const float* norm_ffn_g = args.in[15];
    const float* w_query = args.in[16]; const float* sub_keys = args.in[17]; const float* expert_u = args.in[18]; const float* expert_v = args.in[19];
    const float* norm_ple_g = args.in[20]; const float* w_ple_gate = args.in[21]; const float* w_ple_proj = args.in[22]; const float* final_g = args.in[23];
    float* out = args.out;
    bf16* XN = (bf16*)(ws + WS_XN); float* GATES = (float*)(ws + WS_GATES);
    bf16* QA = (bf16*)(ws + WS_QA); bf16* KA = (bf16*)(ws + WS_KA); bf16* VA = (bf16*)(ws + WS_VA);
    bf16* MQ = (bf16*)(ws + WS_MQ); bf16* MK = (bf16*)(ws + WS_MK); bf16* MV = (bf16*)(ws + WS_MV); bf16* MO = (bf16*)(ws + WS_MO);
    bf16* O1 = (bf16*)(ws + WS_O1); bf16* O2 = (bf16*)(ws + WS_O2); bf16* CQ = (bf16*)(ws + WS_CQ); bf16* CK = (bf16*)(ws + WS_CK);
    float* HS = (float*)(ws + WS_HS); bf16* ACAT = (bf16*)(ws + WS_ACAT); bf16* QP = (bf16*)(ws + WS_QP); int2* ROUTE = (int2*)(ws + WS_ROUTE);
    bf16* PB = (bf16*)(ws + WS_PB); bf16* PP = (bf16*)(ws + WS_PP);
    float* ST = (float*)(ws + WS_ST);
    bf16* SKB = (bf16*)(ws + WS_SKB);
    unsigned char* EU8 = ws + WS_EU8; unsigned char* EV8 = ws + WS_EV8; float* SI = (float*)(ws + WS_SI);
    float* RS = (float*)(ws + WS_RS); bf16* X1G = (bf16*)(ws + WS_X1G); bf16* XN3 = (bf16*)(ws + WS_XN3);
    bf16* WIN = (bf16*)(ws + WS_WIN); bf16* WOUT = (bf16*)(ws + WS_WOUT); bf16* WQ = (bf16*)(ws + WS_WQ); bf16* WG = (bf16*)(ws + WS_WG); bf16* WP = (bf16*)(ws + WS_WP);
    LAS unsigned char* ldsb = (LAS unsigned char*)lds_raw;

    XcdBarrier bar; bar.bar = ctl + CW_BAR; bar.x = 0; bar.st = nullptr;
    if (args.use_bar) {
        if (tidx() < 16) MISC[tidx()] = 0u;
        __syncthreads();
        bar = xcd_barrier_post(ctl + CW_BAR, MISC + 8);
    }
    const int lo = args.ph_lo, hi = args.ph_hi;
#define IN(k) (lo <= (k) && (k) < hi)
#define SEAM(k) do { if (IN(k) && IN((k) + 1)) xcd_barrier(bar); } while (0)

    if (IN(0)) { route::convert_subkeys(sub_keys, SKB); ph_weights_in(w_in, WIN, ldsb);
        for (int ch = blockIdx.x; ch < WCH_CHUNKS; ch += gridDim.x) weights_chunk(ch, w_out, w_query, norm_ffn_g, w_ple_gate, w_ple_proj, WOUT, WQ, WG, WP, ldsb);
        ph_rmsnorm_bf16(x, norm_mix_g, XN);
        { const size_t n = (size_t)M * PLE / 8, stride = (size_t)gridDim.x * NTHREADS;
          for (size_t i = (size_t)blockIdx.x * NTHREADS + tidx(); i < n; i += stride) { const f32x4 a = *(const f32x4*)(p + i * 8), b = *(const f32x4*)(p + i * 8 + 4);
              v4u o; o.x = pk2(a.x, a.y); o.y = pk2(a.z, a.w); o.z = pk2(b.x, b.y); o.w = pk2(b.z, b.w); *(v4u*)(PB + i * 8) = o; } }
    } SEAM(0);
    if (IN(1)) {
        pg8::Gemm g{XN, WIN, M, NINP, D}; pg8::StaticOrder S; S.init(M, NINP, (int)gridDim.x, (int)blockIdx.x);
        pg8::EpiProj E{QA, (size_t)(WS_KA - WS_QA) / 2, C2, GATES};
        pg8::gemm_phase<pg8::EpiProj, pg8::StaticOrder, true, true>(ldsb, g, S, E);
    } SEAM(1);
    if (IN(2)) { ph_qk_norms(QA, KA, ctl + CW_NORM); ml::conv_items(MQ, MK, conv_w, conv_b, CQ, CK); } SEAM(2);
    if (IN(3)) {
        constexpr int Q_ATT = 1024, Q_END = Q_ATT + 256;
        for (;;) {
            __syncthreads();
            if (tidx() == 0) MISC[0] = __hip_atomic_fetch_add(ctl + CW_QUEUE, 1u, __ATOMIC_RELAXED, __HIP_MEMORY_SCOPE_AGENT);
            __syncthreads();
            const int u = (int)__builtin_amdgcn_readfirstlane(MISC[0]);
            if (u >= Q_END) break;
            if (u < Q_ATT) attn_body::attn_dispatch<8>(u, (char*)lds_raw, (const attn_body::bf16*)QA, (const attn_body::bf16*)KA, (const attn_body::bf16*)VA, (attn_body::bf16*)O1, (attn_body::bf16*)O2, ctl + CW_NORM);
            else ml::b1_item(u - Q_ATT, CK, MV, GATES, b_ig, b_fg, ST, ldsb);
        }
    } SEAM(3);
    if (IN(4)) { ml::phase_b2(ST); peer::convert_tables(expert_u, expert_v, norm_ffn_g, EU8, EV8, SI); } SEAM(4);
    if (IN(5)) { ml::phase_b3(CQ, CK, MV, MO, GATES, b_ig, b_fg, ml_g, ST, ACAT, ldsb); ph_combine<false>(O1, O2, MO, HS, lq1, lk1, lq2, lk2, subln_g, ml_g, ACAT); } SEAM(5);
    if (IN(6)) {
        pg8::Gemm g{ACAT, WOUT, M, D, D}; pg8::StaticOrder S; S.init(M, D, (int)gridDim.x, (int)blockIdx.x);
        pg8::EpiResX1 E{x, out, X1G, RS, D};
        pg8::gemm_phase<pg8::EpiResX1, pg8::StaticOrder, true, true>(ldsb, g, S, E);
    } SEAM(6);
    if (IN(7)) {
        { pg8::Gemm g{X1G, WQ, M, NQ, D}; pg8::StaticOrder S; S.init(M, NQ, (int)gridDim.x, (int)blockIdx.x);
          pg8::EpiBf16<0> E{QP, NQ, nullptr, 0, 0, 1.f};
          pg8::gemm_phase<pg8::EpiBf16<0>, pg8::StaticOrder, true, true>(ldsb, g, S, E); }
        { pg8::Gemm g{PB, WP, M, D, PLE}; pg8::StaticOrder S; S.init(M, D, (int)gridDim.x, (int)blockIdx.x);
          pg8::EpiBf16<0> E{PP, D, nullptr, 0, 0, 1.f};
          pg8::gemm_phase<pg8::EpiBf16<0>, pg8::StaticOrder, true, true>(ldsb, g, S, E); }
    } SEAM(7);
    if (IN(8)) { route::route_phase(QP, SKB, RS, ROUTE, ldsb); } SEAM(8);
    if (IN(9)) { peer::expert_phase_mp<4>(X1G, RS, XN3, ROUTE, EU8, EV8, SI, out, out, norm_ple_g, ldsb); } SEAM(9);
    if (IN(10)) {
        pg8::Gemm g{XN3, WG, M, D, D}; pg8::StaticOrder S; S.init(M, D, (int)gridDim.x, (int)blockIdx.x);
        pg8::EpiGateFinal E{PP, out, D};
        pg8::gemm_phase<pg8::EpiGateFinal, pg8::StaticOrder, true, true>(ldsb, g, S, E);
    } SEAM(10);
    if (IN(11)) { ph_rmsnorm_f32_inplace(out, final_g); }
#undef IN
#undef SEAM
}

extern "C" void kernel_launch(void* const* d_in, const int* in_sizes, int n_in, void* d_out, int out_size, void* d_ws, size_t ws_size, hipStream_t stream) {
    static int grid = 0;
    if (grid == 0) {
        if (n_in != 24 || in_sizes[0] != M * D || out_size != M * D || ws_size < WS_END) { fprintf(stderr, "kernel_launch: unexpected shapes (n_in %d, in0 %d, out %d, ws %zu)\n", n_in, n_in > 0 ? in_sizes[0] : -1, out_size, ws_size); grid = -1; return; }
        int dev = 0, cus = 0;
        if (hipGetDevice(&dev) != hipSuccess || hipDeviceGetAttribute(&cus, hipDeviceAttributeMultiprocessorCount, dev) != hipSuccess) { grid = -1; return; }
        if (hipFuncSetAttribute((const void*)mk_fwd, hipFuncAttributeMaxDynamicSharedMemorySize, LDS_BYTES) != hipSuccess) { fprintf(stderr, "kernel_launch: hipFuncSetAttribute failed\n"); grid = -1; return; }
        (void)hipGetLastError();
        grid = cus;
    }
    if (grid < 0) return;
    if (hipMemsetAsync((char*)d_ws + WS_CTL, 0, CTL_ZERO_BYTES, stream) != hipSuccess) return;
    Args a{};
    for (int i = 0; i < 24; ++i) a.in[i] = (const float*)d_in[i];
    a.out = (float*)d_out; a.ws = (unsigned char*)d_ws;
#if MK_ONE_LAUNCH
    a.ph_lo = 0; a.ph_hi = NPHASE; a.use_bar = 1;
    hipLaunchKernelGGL(mk_fwd, dim3(grid), dim3(NTHREADS), LDS_BYTES, stream, a);
#else
    for (int ph = 0; ph < NPHASE; ++ph) {
        a.ph_lo = ph; a.ph_hi = ph + 1; a.use_bar = 0;
        hipLaunchKernelGGL(mk_fwd, dim3(grid), dim3(NTHREADS), LDS_BYTES, stream, a);
    }
#endif
}
```
